# Optimizing an MI355X kernel written in HIP

```python
import math
import jax, jax.numpy as jnp
from jax import lax
import numpy as np

D_MODEL = 1024
BATCH = 8
SEQ = 4096
DEPTH = 4

MIX_WIDTH = D_MODEL
SGU_HEADS = 4
SGU_HEAD_DIM = 128
SGU_WIDTH = SGU_HEADS * SGU_HEAD_DIM
SGU_CHUNK = 128
SGU_W_STD = 0.05
GDN_HEADS = 4
GDN_DK = 128
GDN_DV = 128
GDN_QK_WIDTH = GDN_HEADS * GDN_DK
GDN_V_WIDTH = GDN_HEADS * GDN_DV
GDN_CHUNK = 64
CONV_WIDTH = 4
CONV_CHANNELS = 2 * GDN_QK_WIDTH + GDN_V_WIDTH
D_FF = 4 * D_MODEL
N_MOD = 6
RMS_EPS = 1e-6
LN_EPS = 1e-5
IN_SIZES = (SGU_WIDTH, SGU_WIDTH, GDN_QK_WIDTH, GDN_QK_WIDTH, GDN_V_WIDTH, GDN_V_WIDTH, GDN_HEADS, GDN_HEADS)
IN_WIDTH = 2 * SGU_WIDTH + 2 * GDN_QK_WIDTH + 2 * GDN_V_WIDTH + 2 * GDN_HEADS

kernel_name = 'hybrid_sgu_gdn_adaln_trunk'


def rmsnorm(x, g):
    xf = x.astype(jnp.float32)
    y = xf * lax.rsqrt(jnp.mean(xf * xf, axis=-1, keepdims=True) + RMS_EPS)
    return (y * g.astype(jnp.float32)).astype(x.dtype)


def layernorm(x, g, b):
    xf = x.astype(jnp.float32)
    mu = jnp.mean(xf, axis=-1, keepdims=True)
    xc = xf - mu
    y = xc * lax.rsqrt(jnp.mean(xc * xc, axis=-1, keepdims=True) + LN_EPS)
    return (y * g.astype(jnp.float32) + b.astype(jnp.float32)).astype(x.dtype)


def l2norm(x):
    xf = x.astype(jnp.float32)
    return xf * lax.rsqrt(jnp.sum(xf * xf, axis=-1, keepdims=True) + RMS_EPS)


def split_cols(p, sizes):
    out, start = [], 0
    for s in sizes:
        out.append(p[..., start:start + s])
        start += s
    return out


def causal_depthwise_conv(x, w):
    k = w.shape[0]
    return lax.conv_general_dilated(x, w[:, None, :], window_strides=(1,), padding=[(k - 1, 0)],
                                    dimension_numbers=('NWC', 'WIO', 'NWC'),
                                    feature_group_count=x.shape[-1])


def sgu_mixer(u, v, ln_g, ln_b, w_s, b_s):
    bsz, t, _ = u.shape
    n = t // SGU_CHUNK
    v = layernorm(v, ln_g, ln_b)
    vc = v.reshape(bsz, n, SGU_CHUNK, SGU_HEADS, SGU_HEAD_DIM)
    causal = jnp.tril(jnp.ones((SGU_CHUNK, SGU_CHUNK), dtype=bool))
    w = jnp.where(causal[None], w_s, 0.0)
    mixed = jnp.einsum('hts,bnshd->bnthd', w, vc) + b_s.T[None, None, :, :, None]
    return u * mixed.reshape(bsz, t, SGU_WIDTH)


def gated_delta_rule(q, k, v, g, beta):
    bsz, t, h, dk = q.shape
    dv = v.shape[-1]
    c = GDN_CHUNK
    n = t // c
    q = q.reshape(bsz, n, c, h, dk).transpose(0, 3, 1, 2, 4)
    k = k.reshape(bsz, n, c, h, dk).transpose(0, 3, 1, 2, 4)
    v = v.reshape(bsz, n, c, h, dv).transpose(0, 3, 1, 2, 4)
    g = g.reshape(bsz, n, c, h).transpose(0, 3, 1, 2)
    beta = beta.reshape(bsz, n, c, h).transpose(0, 3, 1, 2)
    g_cum = jnp.cumsum(g, axis=-1)
    idx = jnp.arange(c)
    incl = idx[:, None] >= idx[None, :]
    strict = idx[:, None] > idx[None, :]
    diff = g_cum[..., :, None] - g_cum[..., None, :]
    decay = jnp.where(incl, jnp.exp(jnp.where(incl, diff, 0.0)), 0.0)
    kk = jnp.einsum('bhntd,bhnsd->bhnts', k, k)
    m = jnp.where(strict, beta[..., :, None] * kk * decay, 0.0)
    a_mat = jnp.eye(c, dtype=jnp.float32) + m
    gamma = jnp.exp(g_cum)
    rhs = jnp.concatenate([beta[..., None] * v, (beta * gamma)[..., None] * k], axis=-1)
    sol = lax.linalg.triangular_solve(a_mat, rhs, left_side=True, lower=True, unit_diagonal=True)
    u_new = sol[..., :dv]
    w_k = sol[..., dv:]
    qk = jnp.einsum('bhntd,bhnsd->bhnts', q, k) * decay
    q_dec = q * gamma[..., None]
    k_dec = k * jnp.exp(g_cum[..., -1:] - g_cum)[..., None]
    gamma_last = gamma[..., -1]

    def step(s, inp):
        q_d, k_d, u_c, wk_c, a_c, gl = inp
        w = u_c - jnp.einsum('bhck,bhkv->bhcv', wk_c, s)
        o = jnp.einsum('bhck,bhkv->bhcv', q_d, s) + jnp.einsum('bhts,bhsv->bhtv', a_c, w)
        s = gl[..., None, None] * s + jnp.einsum('bhck,bhcv->bhkv', k_d, w)
        return s, o

    xs = tuple(jnp.moveaxis(a, 2, 0) for a in (q_dec, k_dec, u_new, w_k, qk, gamma_last))
    s0 = jnp.zeros((bsz, h, dk, dv), jnp.float32)
    _, o = lax.scan(step, s0, xs)
    return o.transpose(1, 0, 3, 2, 4).reshape(bsz, t, h, dv)


def gdn_mixer(q, k, v, z, b_raw, a_raw, conv_w, a_log, dt_bias, norm_g):
    bsz, t, _ = q.shape
    dtype = q.dtype
    qkv = jax.nn.silu(causal_depthwise_conv(jnp.concatenate([q, k, v], axis=-1), conv_w))
    q, k, v = split_cols(qkv, (GDN_QK_WIDTH, GDN_QK_WIDTH, GDN_V_WIDTH))
    q = l2norm(q.reshape(bsz, t, GDN_HEADS, GDN_DK)) * (GDN_DK ** -0.5)
    k = l2norm(k.reshape(bsz, t, GDN_HEADS, GDN_DK))
    v = v.reshape(bsz, t, GDN_HEADS, GDN_DV).astype(jnp.float32)
    beta = jax.nn.sigmoid(b_raw.astype(jnp.float32))
    g = -jnp.exp(a_log.astype(jnp.float32)) * jax.nn.softplus(a_raw.astype(jnp.float32) + dt_bias.astype(jnp.float32))
    o = gated_delta_rule(q, k, v, g, beta)
    o = rmsnorm(o, norm_g) * jax.nn.silu(z.reshape(bsz, t, GDN_HEADS, GDN_DV).astype(jnp.float32))
    return o.reshape(bsz, t, GDN_V_WIDTH).astype(dtype)


def setup_inputs(seed: int = 0) -> dict:
    key = jax.random.key(seed)
    ks = jax.random.split(key, 20)
    d = D_MODEL

    def nrm(k, shape, std):
        return jax.random.normal(k, shape, jnp.float32) * std

    dt = jnp.exp(jax.random.uniform(ks[12], (DEPTH, GDN_HEADS), jnp.float32,
                                    minval=math.log(1e-3), maxval=math.log(1e-1)))
    return {
        'x': nrm(ks[0], (BATCH, SEQ, d), 1.0),
        'c': nrm(ks[1], (BATCH, d), 1.0),
        'w_ada': nrm(ks[2], (DEPTH, d, N_MOD * d), 0.5 * d ** -0.5),
        'b_ada': nrm(ks[3], (DEPTH, N_MOD * d), 0.01),
        'norm1_g': 1.0 + nrm(ks[4], (DEPTH, d), 0.02),
        'w_in': nrm(ks[5], (DEPTH, d, IN_WIDTH), d ** -0.5),
        'sgu_ln_g': 1.0 + nrm(ks[6], (DEPTH, SGU_WIDTH), 0.02),
        'sgu_ln_b': nrm(ks[7], (DEPTH, SGU_WIDTH), 0.02),
        'sgu_w': nrm(ks[8], (DEPTH, SGU_HEADS, SGU_CHUNK, SGU_CHUNK), SGU_W_STD),
        'sgu_b': 1.0 + nrm(ks[9], (DEPTH, SGU_HEADS, SGU_CHUNK), 0.1),
        'conv_w': nrm(ks[10], (DEPTH, CONV_WIDTH, CONV_CHANNELS), CONV_WIDTH ** -0.5),
        'a_log': jnp.log(jax.random.uniform(ks[11], (DEPTH, GDN_HEADS), jnp.float32, minval=1.0, maxval=16.0)),
        'dt_bias': dt + jnp.log(-jnp.expm1(-dt)),
        'gdn_norm_g': 1.0 + nrm(ks[13], (DEPTH, GDN_DV), 0.02),
        'w_out': nrm(ks[14], (DEPTH, MIX_WIDTH, d), MIX_WIDTH ** -0.5),
        'norm2_g': 1.0 + nrm(ks[15], (DEPTH, d), 0.02),
        'w_ff1': nrm(ks[16], (DEPTH, d, D_FF), d ** -0.5),
        'w_ff2': nrm(ks[17], (DEPTH, D_FF, d), D_FF ** -0.5),
        'final_g': 1.0 + nrm(ks[18], (d,), 0.02),
    }


def reference(x, c, w_ada, b_ada, norm1_g, w_in, sgu_ln_g, sgu_ln_b, sgu_w, sgu_b, conv_w,
              a_log, dt_bias, gdn_norm_g, w_out, norm2_g, w_ff1, w_ff2, final_g):
    c_act = jax.nn.silu(c)
    for l in range(DEPTH):
        mod = (c_act @ w_ada[l] + b_ada[l])[:, None, :]
        sh1, sc1, g1, sh2, sc2, g2 = jnp.split(mod, N_MOD, axis=-1)
        h = rmsnorm(x, norm1_g[l]) * (1.0 + sc1) + sh1
        p = h @ w_in[l]
        u, vs, q, k, v, z, b_raw, a_raw = split_cols(p, IN_SIZES)
        y_sgu = sgu_mixer(jax.nn.gelu(u), jax.nn.gelu(vs), sgu_ln_g[l], sgu_ln_b[l], sgu_w[l], sgu_b[l])
        y_gdn = gdn_mixer(q, k, v, z, b_raw, a_raw, conv_w[l], a_log[l], dt_bias[l], gdn_norm_g[l])
        mix = jnp.concatenate([y_sgu, y_gdn], axis=-1)
        x = x + g1 * (mix @ w_out[l])
        h = rmsnorm(x, norm2_g[l]) * (1.0 + sc2) + sh2
        x = x + g2 * (jnp.square(jax.nn.relu(h @ w_ff1[l])) @ w_ff2[l])
    return rmsnorm(x, final_g)
```

```cpp
#include <hip/hip_runtime.h>
#include <hip/hip_cooperative_groups.h>
#include <cstdio>
#include <cstdint>
namespace cg = cooperative_groups;
namespace pg8 {
#define PG8_LAS __attribute__((address_space(3)))
typedef unsigned short bf16_t;
typedef short bf16x8 __attribute__((ext_vector_type(8)));
typedef float f32x4 __attribute__((ext_vector_type(4)));
typedef unsigned u32x4 __attribute__((ext_vector_type(4)));
constexpr int BM = 256, BK = 64, HALF = 128, HTB = HALF * BK * 2  , STAGE_BYTES = 8 * HTB, NXCD = 8, WGM = 8;

__host__ __device__ __forceinline__ int lds_byte(int r, int c) { const int st = (r >> 4) * 2 + (c >> 5), rr = r & 15, cc = c & 31, ob = rr * 64 + cc * 2; return st * 1024 + (ob ^ (((ob >> 9) & 1) << 5)); }
__host__ __device__ __forceinline__ void stage_rc(int b, int& R, int& C) { const int st = b / 1024, sb = b % 1024, swz = sb ^ (((sb >> 9) & 1) << 5); R = (st >> 1) * 16 + swz / 64; C = (st & 1) * 32 + (swz % 64) / 2; }
__host__ __device__ __forceinline__ int perm32(int rho) { const int n = rho >> 4, i = rho & 15; return 8 * (i >> 2) + 4 * n + (i & 3); }

struct Unit { int pm, pn; };
struct Gemm { const bf16_t* A; const bf16_t* Bt; int M, N, K; };

struct StaticOrder {
    int nM, nN, nwg, G, c;
    __host__ __device__ void init(int M, int N, int G_, int c_) { nM = M / BM; nN = N / BM; nwg = nM * nN; G = G_; c = c_; }
    __host__ __device__ bool next(int i, Unit& u) const {
        const long L = (long)i * G + c; if (L >= nwg) return false;
        int wgid = (int)L; { const int q = nwg / NXCD, r = nwg % NXCD, xcd = wgid % NXCD, off = wgid / NXCD; wgid = (xcd < r ? xcd * (q + 1) : r * (q + 1) + (xcd - r) * q) + off; }
        const int nig = WGM * nN, gid = wgid / nig, fm = gid * WGM, gsz = (nM - fm) < WGM ? (nM - fm) : WGM;
        u.pm = fm + ((wgid % nig) % gsz); u.pn = (wgid % nig) / gsz; return true;
    }
    __device__ __forceinline__ void a_ready(const Unit&) const {}
    __device__ __forceinline__ void done(const Unit&) const {}
};

__device__ __forceinline__ unsigned cvt_pk_bf16(float lo, float hi) { unsigned r; asm volatile("v_cvt_pk_bf16_f32 %0, %1, %2" : "=v"(r) : "v"(lo), "v"(hi)); return r; }
typedef float f32x2 __attribute__((ext_vector_type(2)));
__device__ __forceinline__ f32x2 gelu_pk(f32x2 v) {
    const f32x2 av = __builtin_elementwise_abs(v), d = av * 0.2316418882f + 1.0f;
    f32x2 t; t.x = __builtin_amdgcn_rcpf(d.x); t.y = __builtin_amdgcn_rcpf(d.y);
    f32x2 q = t * 0.5307027145f + (-0.7265760135f); q = q * t + 0.7107068705f; q = q * t + (-0.142248368f); q = q * t + 0.127414796f; q = q * t;
    const f32x2 s = (v * v) * (-0.72134752044f);
    f32x2 e; e.x = __builtin_amdgcn_exp2f(s.x); e.y = __builtin_amdgcn_exp2f(s.y);
    const f32x2 m = v * (q * e), r = v - m;
    f32x2 o; o.x = v.x < 0.f ? m.x : r.x; o.y = v.y < 0.f ? m.y : r.y; return o;
}

template <int ACT  > struct EpiBf16 {
    static constexpr bool PERM = true, AFTER_DRAIN = false; static_assert(ACT == 0 || ACT == 1 || ACT == 2, "EpiBf16: ACT is 0 (none), 1 (gelu_pk) or 2 (squared relu)");
    bf16_t* O; int ldc; const float* bias; int split_cols; size_t split_stride; float scale0;
    __device__ __forceinline__ void operator()(const f32x4 (&acc)[2][2][4][2], const Unit& u, int wr, int wc, int fr, int fq) const {
        const int row0 = u.pm * BM + wr * 64 + fr; int colt = u.pn * BM; bf16_t* base = O;
        float sc = 1.f; if (split_cols) { const int t = colt / split_cols; base += (size_t)t * split_stride; colt -= t * split_cols; if (t == 0) sc = scale0; }
        const int col0 = colt + wc * 32 + 8 * fq, bcol0 = u.pn * BM + wc * 32 + 8 * fq;
        f32x4 bv[2][2];
#pragma unroll
        for (int bj = 0; bj < 2; ++bj)
#pragma unroll
            for (int n = 0; n < 2; ++n) bv[bj][n] = bias ? *(const f32x4*)(bias + bcol0 + bj * HALF + 4 * n) : (f32x4){0.f, 0.f, 0.f, 0.f};
#pragma unroll
        for (int ai = 0; ai < 2; ++ai)
#pragma unroll
            for (int m = 0; m < 4; ++m) { bf16_t* rowp = base + (size_t)(row0 + ai * HALF + m * 16) * ldc + col0;
#pragma unroll
                for (int bj = 0; bj < 2; ++bj) { f32x4 v0 = acc[ai][bj][m][0] + bv[bj][0], v1 = acc[ai][bj][m][1] + bv[bj][1];
                    if (ACT == 1) { f32x2 a = gelu_pk((f32x2){v0[0], v0[1]}), b = gelu_pk((f32x2){v0[2], v0[3]}), c = gelu_pk((f32x2){v1[0], v1[1]}), d = gelu_pk((f32x2){v1[2], v1[3]});
                        v0 = (f32x4){a.x, a.y, b.x, b.y}; v1 = (f32x4){c.x, c.y, d.x, d.y}; }
                    if (ACT == 2) { v0 = __builtin_elementwise_max(v0, (f32x4){0.f, 0.f, 0.f, 0.f}); v1 = __builtin_elementwise_max(v1, (f32x4){0.f, 0.f, 0.f, 0.f}); v0 = v0 * v0; v1 = v1 * v1; }
                    v0 = v0 * sc; v1 = v1 * sc; u32x4 w; w.x = cvt_pk_bf16(v0[0], v0[1]); w.y = cvt_pk_bf16(v0[2], v0[3]); w.z = cvt_pk_bf16(v1[0], v1[1]); w.w = cvt_pk_bf16(v1[2], v1[3]);
                    *(u32x4*)(rowp + bj * HALF) = w; } }
    }
};
template <bool BASE_F32> struct EpiGateRes {
    static constexpr bool PERM = true, AFTER_DRAIN = false;
    const void* base; bf16_t* out; int ldc; const float* gate;
    __device__ __forceinline__ void operator()(const f32x4 (&acc)[2][2][4][2], const Unit& u, int wr, int wc, int fr, int fq) const {
        const int col0 = u.pn * BM + wc * 32 + 8 * fq;
        const float* gp = gate + (size_t)(u.pm >> 4) * 6144 + col0;
        f32x4 gv[2][2];
#pragma unroll
        for (int bj = 0; bj < 2; ++bj)
#pragma unroll
            for (int n = 0; n < 2; ++n) gv[bj][n] = *(const f32x4*)(gp + bj * HALF + 4 * n);
#pragma unroll
        for (int ai = 0; ai < 2; ++ai)
#pragma unroll
            for (int m = 0; m < 4; ++m) { const size_t off = (size_t)(u.pm * BM + ai * HALF + wr * 64 + m * 16 + fr) * ldc + col0;
#pragma unroll
                for (int bj = 0; bj < 2; ++bj) { f32x4 b0, b1;
                    if (BASE_F32) { const float* bp = (const float*)base + off + bj * HALF; b0 = *(const f32x4*)bp; b1 = *(const f32x4*)(bp + 4); }
                    else { const u32x4 w = *(const u32x4*)((const bf16_t*)base + off + bj * HALF);
                        b0 = (f32x4){__uint_as_float(w.x << 16), __uint_as_float(w.x & 0xffff0000u), __uint_as_float(w.y << 16), __uint_as_float(w.y & 0xffff0000u)};
                        b1 = (f32x4){__uint_as_float(w.z << 16), __uint_as_float(w.z & 0xffff0000u), __uint_as_float(w.w << 16), __uint_as_float(w.w & 0xffff0000u)}; }
                    const f32x4 v0 = b0 + gv[bj][0] * acc[ai][bj][m][0], v1 = b1 + gv[bj][1] * acc[ai][bj][m][1];
                    u32x4 o; o.x = cvt_pk_bf16(v0[0], v0[1]); o.y = cvt_pk_bf16(v0[2], v0[3]); o.z = cvt_pk_bf16(v1[0], v1[1]); o.w = cvt_pk_bf16(v1[2], v1[3]);
                    *(u32x4*)(out + off + bj * HALF) = o; }
                if (m & 1) asm volatile("" ::: "memory"); }
    }
};
template <class Epi, class Sched, bool ALIGN_EPI = false, bool SP2 = false>
__device__ __forceinline__ void gemm_phase(PG8_LAS unsigned char* lds, const Gemm g, const Sched& S, const Epi& E, const int tid) {
    const int wid = __builtin_amdgcn_readfirstlane(tid >> 6), lane = tid & 63, wr = wid >> 2, wc = wid & 3, fr = lane & 15, fq = lane >> 4;
    const int K = g.K, nt = K / BK;
    unsigned voffA[2], voffB[2];
#pragma unroll
    for (int i = 0; i < 2; ++i) { int R, C; stage_rc(tid * 16 + i * 8192, R, C); const int Rb = Epi::PERM ? ((R & ~31) + perm32(R & 31)) : R;
        voffA[i] = (unsigned)(R * K + C) * 2u; voffB[i] = (unsigned)(Rb * K + C) * 2u; }
    const size_t kstep = (size_t)(BK * 2);
    const size_t hstep = (size_t)HALF * K * 2;
    const size_t tstep = 2 * hstep;
    const unsigned ldsw = (unsigned)wid * 1024u;
    const int aoff = lds_byte(wr * 64 + fr, fq * 8), boff = lds_byte(wc * 32 + fr, fq * 8);
#define PG8_SA(b, h) (((b) * 2 + (h)) * HTB)
#define PG8_SB(b, h) ((4 + (b) * 2 + (h)) * HTB)
#define PG8_STAGE(bufoff, gbase, voff) do { _Pragma("unroll") for (int _i = 0; _i < 2; ++_i) \
        __builtin_amdgcn_global_load_lds((const unsigned*)((const char*)(gbase) + (voff)[_i]), (PG8_LAS unsigned*)(lds + (bufoff) + ldsw + _i * 8192), 16, 0, 0); } while (0)
#define PG8_LDA(dst, b, h) do { _Pragma("unroll") for (int m = 0; m < 4; ++m) _Pragma("unroll") for (int k = 0; k < 2; ++k) dst[m][k] = *(const PG8_LAS bf16x8*)(lds + PG8_SA(b, h) + aoff + m * 2048 + k * 1024); } while (0)
#define PG8_LDB(dst, b, h) do { _Pragma("unroll") for (int n = 0; n < 2; ++n) _Pragma("unroll") for (int k = 0; k < 2; ++k) dst[n][k] = *(const PG8_LAS bf16x8*)(lds + PG8_SB(b, h) + boff + n * 2048 + k * 1024); } while (0)
#define PG8_MMA(ai, bj, At, Bt) do { __builtin_amdgcn_s_setprio(1); _Pragma("unroll") for (int m = 0; m < 4; ++m) _Pragma("unroll") for (int n = 0; n < 2; ++n) _Pragma("unroll") for (int k = 0; k < 2; ++k) \
        acc[ai][bj][m][n] = __builtin_amdgcn_mfma_f32_16x16x32_bf16(Bt[n][k], At[m][k], acc[ai][bj][m][n], 0, 0, 0); __builtin_amdgcn_s_setprio(0); } while (0)
#define PG8_WAIT_V(n) asm volatile("s_waitcnt vmcnt(" #n ")" ::: "memory")
#define PG8_WAIT_L(n) asm volatile("s_waitcnt lgkmcnt(" #n ")" ::: "memory")
#define PG8_BAR __builtin_amdgcn_s_barrier()
#define PG8_SCHED __builtin_amdgcn_sched_barrier(0)
    Unit cur, nxt; int ui = 0;
    if (!S.next(0, cur)) return;
    f32x4 acc[2][2][4][2];
#pragma unroll
    for (int a = 0; a < 2; ++a)
#pragma unroll
        for (int b = 0; b < 2; ++b)
#pragma unroll
            for (int m = 0; m < 4; ++m)
#pragma unroll
                for (int n = 0; n < 2; ++n) acc[a][b][m][n] = (f32x4){0.f, 0.f, 0.f, 0.f};
    bf16x8 At[4][2], B0[2][2], B1[2][2];
    const char* cA = (const char*)g.A + (size_t)cur.pm * tstep; const char* cB = (const char*)g.Bt + (size_t)cur.pn * tstep;
    S.a_ready(cur);
    if constexpr (SP2) {
        PG8_STAGE(PG8_SB(0, 0), cB, voffB); PG8_STAGE(PG8_SB(0, 1), cB + hstep, voffB); PG8_STAGE(PG8_SA(0, 0), cA, voffA); PG8_STAGE(PG8_SA(0, 1), cA + hstep, voffA);
        if (wr == 1) PG8_BAR;
        PG8_WAIT_V(2); PG8_BAR;
        PG8_STAGE(PG8_SB(1, 0), cB + kstep, voffB); PG8_STAGE(PG8_SA(1, 0), cA + kstep, voffA); PG8_STAGE(PG8_SB(1, 1), cB + hstep + kstep, voffB);
        PG8_WAIT_V(6); PG8_BAR;
    } else {
        PG8_STAGE(PG8_SB(0, 0), cB, voffB); PG8_STAGE(PG8_SA(0, 0), cA, voffA); PG8_STAGE(PG8_SB(0, 1), cB + hstep, voffB); PG8_STAGE(PG8_SA(0, 1), cA + hstep, voffA);
        if (wr == 1) PG8_BAR;
        PG8_WAIT_V(4); PG8_BAR;
        PG8_STAGE(PG8_SB(1, 0), cB + kstep, voffB); PG8_STAGE(PG8_SA(1, 0), cA + kstep, voffA); PG8_STAGE(PG8_SB(1, 1), cB + hstep + kstep, voffB);
        PG8_WAIT_V(6); PG8_BAR;
    }
    for (;;) {
        const bool has_next = S.next(ui + 1, nxt);
        const char* nA = has_next ? (const char*)g.A + (size_t)nxt.pm * tstep : cA; const char* nB = has_next ? (const char*)g.Bt + (size_t)nxt.pn * tstep : cB;
        for (int t = 0; t < nt; t += 2) {
            const bool last = (t == nt - 2);
            const char* a1 = cA + (size_t)(t + 1) * kstep;
            const char* a2 = last ? nA : cA + (size_t)(t + 2) * kstep; const char* b2 = last ? nB : cB + (size_t)(t + 2) * kstep;
            const char* a3 = a2 + kstep; const char* b3 = b2 + kstep;
            if (last && has_next) S.a_ready(nxt);
            if constexpr (SP2) {
            PG8_LDB(B0, 0, 0); PG8_LDB(B1, 0, 1); PG8_SCHED; PG8_LDA(At, 0, 0); PG8_STAGE(PG8_SA(1, 1), a1 + hstep, voffA);
            PG8_WAIT_V(8); PG8_WAIT_L(0); PG8_BAR; PG8_MMA(0, 0, At, B0); PG8_MMA(0, 1, At, B1); PG8_BAR; PG8_SCHED;
            PG8_LDA(At, 0, 1); PG8_STAGE(PG8_SB(0, 0), b2, voffB); PG8_STAGE(PG8_SB(0, 1), b2 + hstep, voffB); PG8_STAGE(PG8_SA(0, 0), a2, voffA);
            PG8_WAIT_V(8); PG8_WAIT_L(0); PG8_BAR; PG8_MMA(1, 0, At, B0); PG8_MMA(1, 1, At, B1); PG8_BAR; PG8_SCHED;
            PG8_LDB(B0, 1, 0); PG8_LDB(B1, 1, 1); PG8_SCHED; PG8_LDA(At, 1, 0); PG8_STAGE(PG8_SA(0, 1), a2 + hstep, voffA);
            PG8_WAIT_V(8); PG8_WAIT_L(0); PG8_BAR; PG8_MMA(0, 0, At, B0); PG8_MMA(0, 1, At, B1); PG8_BAR; PG8_SCHED;
            PG8_LDA(At, 1, 1); PG8_STAGE(PG8_SB(1, 0), b3, voffB); PG8_STAGE(PG8_SB(1, 1), b3 + hstep, voffB); PG8_STAGE(PG8_SA(1, 0), a3, voffA);
            PG8_WAIT_V(8); PG8_WAIT_L(0); PG8_BAR; PG8_MMA(1, 0, At, B0); PG8_MMA(1, 1, At, B1); PG8_BAR; PG8_SCHED;
            } else {
            PG8_LDB(B0, 0, 0); PG8_SCHED; PG8_LDA(At, 0, 0); PG8_STAGE(PG8_SA(1, 1), a1 + hstep, voffA);
            PG8_WAIT_L(8); PG8_BAR; PG8_WAIT_L(0); PG8_MMA(0, 0, At, B0); PG8_BAR; PG8_SCHED;
            PG8_LDB(B1, 0, 1); PG8_STAGE(PG8_SB(0, 0), b2, voffB);
            PG8_BAR; PG8_WAIT_L(0); PG8_MMA(0, 1, At, B1); PG8_BAR;
            PG8_LDA(At, 0, 1); PG8_STAGE(PG8_SA(0, 0), a2, voffA);
            PG8_BAR; PG8_WAIT_L(0); PG8_MMA(1, 0, At, B0); PG8_BAR; PG8_SCHED;
            PG8_STAGE(PG8_SB(0, 1), b2 + hstep, voffB);
            PG8_WAIT_V(6); PG8_BAR; PG8_MMA(1, 1, At, B1); PG8_BAR;
            PG8_LDB(B0, 1, 0); PG8_SCHED; PG8_LDA(At, 1, 0); PG8_STAGE(PG8_SA(0, 1), a2 + hstep, voffA);
            PG8_WAIT_L(8); PG8_BAR; PG8_WAIT_L(0); PG8_MMA(0, 0, At, B0); PG8_BAR; PG8_SCHED;
            PG8_LDB(B1, 1, 1); PG8_STAGE(PG8_SB(1, 0), b3, voffB);
            PG8_BAR; PG8_WAIT_L(0); PG8_MMA(0, 1, At, B1); PG8_BAR;
            PG8_LDA(At, 1, 1); PG8_STAGE(PG8_SA(1, 0), a3, voffA);
            PG8_BAR; PG8_WAIT_L(0); PG8_MMA(1, 0, At, B0); PG8_BAR; PG8_SCHED;
            PG8_STAGE(PG8_SB(1, 1), b3 + hstep, voffB);
            PG8_WAIT_V(6); PG8_BAR; PG8_MMA(1, 1, At, B1); PG8_BAR;
            }
        }
        if constexpr (ALIGN_EPI) { if (wr == 0) PG8_BAR; }
        if constexpr (!Epi::AFTER_DRAIN) { E(acc, cur, wr, wc, fr, fq); S.done(cur); }
        if (!has_next) break;
#pragma unroll
        for (int a = 0; a < 2; ++a)
#pragma unroll
            for (int b = 0; b < 2; ++b)
#pragma unroll
                for (int m = 0; m < 4; ++m)
#pragma unroll
                    for (int n = 0; n < 2; ++n) acc[a][b][m][n] = (f32x4){0.f, 0.f, 0.f, 0.f};
        cur = nxt; cA = nA; cB = nB; ++ui;
        if constexpr (ALIGN_EPI) { if (wr == 1) PG8_BAR; }
    }
    PG8_WAIT_V(0);
    if constexpr (!ALIGN_EPI) { if (wr == 0) PG8_BAR; }
    PG8_BAR;
    if constexpr (Epi::AFTER_DRAIN) { E.fused(acc, cur, wr, wc, fr, fq, lds, wid, lane); S.done(cur); }
#undef PG8_SA
#undef PG8_SB
#undef PG8_STAGE
#undef PG8_LDA
#undef PG8_LDB
#undef PG8_MMA
#undef PG8_WAIT_V
#undef PG8_WAIT_L
#undef PG8_BAR
#undef PG8_SCHED
}
}
#define LAS __attribute__((address_space(3)))
#define DI __device__ __forceinline__
typedef unsigned short bf16;
typedef unsigned v4u __attribute__((ext_vector_type(4)));
typedef unsigned v2u __attribute__((ext_vector_type(2)));
typedef float f32x4 __attribute__((ext_vector_type(4)));
typedef float f32x2 __attribute__((ext_vector_type(2)));
typedef short bf16x8 __attribute__((ext_vector_type(8)));
typedef __bf16 bf16x2_t __attribute__((ext_vector_type(2)));

#ifndef PHASE_ONLY
#define PHASE_ONLY -1
#endif
#define PH_EN(k) (PHASE_ONLY < 0 || PHASE_ONLY == (k))
#define REP_MOD 1
#define REP_N0 1
#define REP_G1 1
#define REP_PREP 1
#define REP_SCAN 1
#define REP_SGU 1
#define REP_N1 1
#define REP_FF1 1
#define REP_SYNC 0
#ifndef MK_LAUNCHES
#define MK_LAUNCHES 1
#endif

constexpr int NWAVES = 8, NT = 512;
constexpr int BATCH = 8, SEQ = 4096, D = 1024, M = BATCH * SEQ, DEPTH = 4, FF = 4096, INW = 3080, NP = 3072, NMOD = 6144;
constexpr int NPHASE = 2 + 9 * DEPTH;
constexpr size_t MiB = 1u << 20;
constexpr size_t WS_CTL = 0, WS_MOD = 1 * MiB, WS_BA = 2 * MiB, WS_GL = 3 * MiB, WS_WIN = 4 * MiB, WS_WOUT = 10 * MiB, WS_W1 = 12 * MiB, WS_W2 = 20 * MiB,
                 WS_H = 28 * MiB, WS_X = 92 * MiB  , WS_P = 156 * MiB, WS_QD = 348 * MiB, WS_WK = 380 * MiB, WS_KDT = 412 * MiB, WS_AC = 444 * MiB, WS_WSET1 = 460 * MiB, WS_END = 484 * MiB;
DI size_t ws_wset(int l) { return (l & 1) ? WS_WSET1 : WS_WIN; }
constexpr size_t W_OFF_OUT = WS_WOUT - WS_WIN, W_OFF_1 = WS_W1 - WS_WIN, W_OFF_2 = WS_W2 - WS_WIN;
constexpr size_t WS_U = WS_H;
constexpr size_t WS_F = WS_P;
constexpr int LDS_BYTES = 148480;

struct Args { const float* in[19]; float* out; unsigned char* ws; int ph_lo, ph_hi; };

DI float bflo(unsigned u) { return __uint_as_float(u << 16); }
DI float bfhi(unsigned u) { return __uint_as_float(u & 0xffff0000u); }
DI float bf2f(bf16 b) { return __uint_as_float((unsigned)b << 16); }
DI unsigned pk2(float lo, float hi) { f32x2 v = {lo, hi}; bf16x2_t b = __builtin_convertvector(v, bf16x2_t); return __builtin_bit_cast(unsigned, b); }
DI bf16 f2bf(float f) { return (bf16)(pk2(f, 0.f) & 0xffffu); }
template <int CTRL> DI float dpp_f(float v) { return __builtin_bit_cast(float, __builtin_amdgcn_update_dpp(0, __builtin_bit_cast(int, v), CTRL, 0xf, 0xf, false)); }
DI float row16_sum(float v) {
    v += dpp_f<0xB1>(v);
    v += dpp_f<0x4E>(v);
    v += dpp_f<0x141>(v);
    v += dpp_f<0x140>(v);
    return v;
}
DI float wave_sum(float v) { v = row16_sum(v); v += __shfl_xor(v, 16); v += __shfl_xor(v, 32); return v; }
DI float silu_f(float v) { return v * __builtin_amdgcn_rcpf(1.f + __expf(-v)); }
DI float gelu_tanh(float v) { const float u = 1.5957691216057308f * (v + 0.044715f * v * v * v); return v * __builtin_amdgcn_rcpf(1.f + __expf(-u)); }
DI void bar_lds() { asm volatile("s_waitcnt lgkmcnt(0)\n\ts_barrier" ::: "memory"); }
#define GAS __attribute__((address_space(1)))
DI void glds16(const void* gsrc, unsigned lds_dst) { unsigned keep;
    asm volatile("s_mov_b32 %0, m0\n\ts_mov_b32 m0, %2\n\ts_nop 0\n\tglobal_load_lds_dwordx4 %1, off\n\ts_mov_b32 m0, %0" : "=&s"(keep) : "v"(gsrc), "s"(lds_dst) : "memory"); }
DI int pos32(int o) { return 8 * ((o >> 2) & 3) + 4 * (o >> 4) + (o & 3); }
DI bf16x8 pack8(const f32x4& a, const f32x4& b) { v4u p; p.x = pk2(a[0], a[1]); p.y = pk2(a[2], a[3]); p.z = pk2(b[0], b[1]); p.w = pk2(b[2], b[3]); return __builtin_bit_cast(bf16x8, p); }
DI bf16x8 ld16g(const bf16* p) { return *(const bf16x8*)p; }
#define MFMA16(a, b, c) __builtin_amdgcn_mfma_f32_16x16x32_bf16((a), (b), (c), 0, 0, 0)

DI void phase_mod(const Args& a, LAS unsigned char* lds, int tid, int lane, int wave, int bid, int G) {
    LAS float* sc = (LAS float*)lds;
    LAS float* red = sc + 8192;
    const float* c = a.in[1]; const float* w_ada = a.in[2]; const float* b_ada = a.in[3];
    float* mod = (float*)(a.ws + WS_MOD);
    for (int i = tid; i < 8192; i += NT) sc[i] = silu_f(c[i]);
    __syncthreads();
    for (int unit = bid; unit < DEPTH * 96; unit += G) {
        const int l = unit / 96, j0 = (unit % 96) * 64;
        const float* w = w_ada + (size_t)l * D * NMOD + j0 + lane;
        float acc[8];
#pragma unroll
        for (int b = 0; b < 8; ++b) acc[b] = 0.f;
#pragma unroll 8
        for (int k = wave * 128; k < wave * 128 + 128; ++k) {
            const float wv = w[(size_t)k * NMOD];
#pragma unroll
            for (int b = 0; b < 8; ++b) acc[b] += sc[b * 1024 + k] * wv;
        }
#pragma unroll
        for (int b = 0; b < 8; ++b) red[(wave * 8 + b) * 64 + lane] = acc[b];
        __syncthreads();
        { const int b = tid >> 6, j = tid & 63; float s = b_ada[l * NMOD + j0 + j];
#pragma unroll
          for (int w8 = 0; w8 < 8; ++w8) s += red[(w8 * 8 + b) * 64 + j];
          mod[(size_t)(l * 8 + b) * NMOD + j0 + j] = s; }
        __syncthreads();
    }
}

DI void transpose_item(const float* W, int ldw, int K, int nblk, bf16* WT, LAS float* scr, int item, int lane) {
    const int kb = item / nblk, nb = item % nblk, k0 = 64 * kb, n0 = 32 * nb;
#pragma unroll 8
    for (int i = 0; i < 32; ++i) { const int kk = 2 * i + (lane >> 5); scr[kk * 33 + (lane & 31)] = W[(size_t)(k0 + kk) * ldw + n0 + (lane & 31)]; }
    asm volatile("s_waitcnt lgkmcnt(0)" ::: "memory");
    const int c = lane & 7;
#pragma unroll
    for (int j = 0; j < 4; ++j) { const int n = (lane >> 3) + 8 * j; const LAS float* s = scr + (8 * c) * 33 + n;
        v4u o; o.x = pk2(s[0 * 33], s[1 * 33]); o.y = pk2(s[2 * 33], s[3 * 33]); o.z = pk2(s[4 * 33], s[5 * 33]); o.w = pk2(s[6 * 33], s[7 * 33]);
        *(v4u*)(WT + (size_t)(n0 + n) * K + k0 + 8 * c) = o; }
    asm volatile("s_waitcnt lgkmcnt(0)" ::: "memory");
}

DI void convert_weights(const Args& a, int l, LAS unsigned char* scr_base, int wave, int lane, int gw, int NGW) {
    LAS float* scr = (LAS float*)(scr_base + wave * 8448);
    unsigned char* wb = a.ws + ws_wset(l);
    const float* w_in = a.in[5] + (size_t)l * D * INW; const float* w_out = a.in[14] + (size_t)l * D * D;
    const float* w1 = a.in[16] + (size_t)l * D * FF;   const float* w2 = a.in[17] + (size_t)l * FF * D;
    constexpr int I_IN = 16 * 96, I_OUT = 16 * 32, I_1 = 16 * 128, I_2 = 64 * 32, NIT = I_IN + I_OUT + I_1 + I_2;
    for (int it = gw; it < NIT; it += NGW) {
        int r = it;
        if (r < I_IN) { transpose_item(w_in, INW, D, 96, (bf16*)wb, scr, r, lane); continue; } r -= I_IN;
        if (r < I_OUT) { transpose_item(w_out, D, D, 32, (bf16*)(wb + W_OFF_OUT), scr, r, lane); continue; } r -= I_OUT;
        if (r < I_1) { transpose_item(w1, FF, D, 128, (bf16*)(wb + W_OFF_1), scr, r, lane); continue; } r -= I_1;
        transpose_item(w2, D, FF, 32, (bf16*)(wb + W_OFF_2), scr, r, lane);
    }
}

template <int MODE> DI void phase_norm(const Args& a, int l, LAS unsigned char* lds, int tid, int lane, int wave, int bid, int G) {
    constexpr int RB = (MODE == 0) ? 2 : 4;
    const int gw = bid * NWAVES + wave, NGW = G * NWAVES;
    unsigned char* ws = a.ws;
    const bool xf32 = (MODE == 0 && l == 0);
    const float* xin = a.in[0]; const bf16* xbf = (const bf16*)(ws + WS_X);
    const float* gam = (MODE == 0) ? a.in[4] + l * D : (MODE == 1) ? a.in[15] + l * D : a.in[18];
    const float* mod = (const float*)(ws + WS_MOD);
    bf16* H = (bf16*)(ws + WS_H);
    float* BA = (float*)(ws + WS_BA);
    LAS f32x4* w8s = (LAS f32x4*)(lds + 67584);
    if (MODE == 0) {
        const float* w_in = a.in[5] + (size_t)l * D * INW + NP;
        for (int idx = tid; idx < 2048; idx += NT) { const int k = idx >> 1, half = idx & 1;
            w8s[(((k >> 8) * 4 + (k & 3)) * 2 + half) * 64 + ((k & 255) >> 2)] = *(const f32x4*)(w_in + (size_t)k * INW + 4 * half); }
        __syncthreads();
    }
    for (int mb = gw * 16; mb < M; mb += NGW * 16) {
        const int b = mb / SEQ;
        f32x4 ca[4], cb[4];
#pragma unroll
        for (int j = 0; j < 4; ++j) {
            const f32x4 gg = *(const f32x4*)(gam + 4 * lane + 256 * j);
            if (MODE == 2) { ca[j] = gg; cb[j] = (f32x4){0.f, 0.f, 0.f, 0.f}; }
            else { const float* mr = mod + (size_t)(l * 8 + b) * NMOD + (MODE == 0 ? 0 : 3072) + 4 * lane + 256 * j;
                   const f32x4 sh = *(const f32x4*)mr, scl = *(const f32x4*)(mr + 1024); ca[j] = gg * (scl + 1.0f); cb[j] = sh; }
        }
        for (int i0 = 0; i0 < 16; i0 += RB) {
            asm volatile("" ::: "memory");
            f32x4 v[RB][4]; float ss[RB];
#pragma unroll
            for (int rr = 0; rr < RB; ++rr) { const f32x4* xr = (const f32x4*)(xin + (size_t)(mb + i0 + rr) * D) + lane; const v2u* xb = (const v2u*)(xbf + (size_t)(mb + i0 + rr) * D) + lane; float sq = 0.f;
#pragma unroll
                for (int j = 0; j < 4; ++j) { if (xf32) v[rr][j] = xr[64 * j]; else { const v2u w = xb[64 * j]; v[rr][j] = (f32x4){bflo(w.x), bfhi(w.x), bflo(w.y), bfhi(w.y)}; } sq += (v[rr][j].x * v[rr][j].x + v[rr][j].y * v[rr][j].y) + (v[rr][j].z * v[rr][j].z + v[rr][j].w * v[rr][j].w); }
                ss[rr] = sq; }
#pragma unroll
            for (int rr = 0; rr < RB; ++rr) ss[rr] = rsqrtf(wave_sum(ss[rr]) * (1.f / D) + 1e-6f);
#pragma unroll
            for (int rr = 0; rr < RB; ++rr) { const size_t m = (size_t)(mb + i0 + rr);
#pragma unroll
                for (int j = 0; j < 4; ++j) v[rr][j] = v[rr][j] * ss[rr] * ca[j] + cb[j];
                if (MODE == 2) { f32x4* o = (f32x4*)(a.out + m * D) + lane;
#pragma unroll
                    for (int j = 0; j < 4; ++j) o[64 * j] = v[rr][j];
                } else { v2u* o = (v2u*)(H + m * D) + lane;
#pragma unroll
                    for (int j = 0; j < 4; ++j) { v2u w; w.x = pk2(v[rr][j].x, v[rr][j].y); w.y = pk2(v[rr][j].z, v[rr][j].w); o[64 * j] = w; } }
            }
            if (MODE == 0) {
                f32x4 d[RB][2];
#pragma unroll
                for (int rr = 0; rr < RB; ++rr) { d[rr][0] = (f32x4){0.f, 0.f, 0.f, 0.f}; d[rr][1] = (f32x4){0.f, 0.f, 0.f, 0.f}; }
#pragma unroll
                for (int j = 0; j < 4; ++j) { asm volatile("" ::: "memory");
#pragma unroll
                    for (int e = 0; e < 4; ++e) { const f32x4 w0 = w8s[((j * 4 + e) * 2 + 0) * 64 + lane], w1 = w8s[((j * 4 + e) * 2 + 1) * 64 + lane];
#pragma unroll
                        for (int rr = 0; rr < RB; ++rr) { d[rr][0] += w0 * v[rr][j][e]; d[rr][1] += w1 * v[rr][j][e]; } } }
#pragma unroll
                for (int rr = 0; rr < RB; ++rr) {
#pragma unroll
                    for (int e = 0; e < 4; ++e) { d[rr][0][e] = wave_sum(d[rr][0][e]); d[rr][1][e] = wave_sum(d[rr][1][e]); }
                    if (lane == 0) { *(f32x4*)(BA + (size_t)(mb + i0 + rr) * 8) = d[rr][0]; *(f32x4*)(BA + (size_t)(mb + i0 + rr) * 8 + 4) = d[rr][1]; } }
            }
        }
    }
}

DI void phase_prep(const Args& a, int l, LAS unsigned char* lds, int tid, int lane, int wave, int bid, int G) {
    unsigned char* ws = a.ws;
    const bf16* P = (const bf16*)(ws + WS_P);
    const float* BA = (const float*)(ws + WS_BA);
    const float* convw = a.in[10] + (size_t)l * 4 * 1536;
    bf16* QD = (bf16*)(ws + WS_QD); bf16* WKb = (bf16*)(ws + WS_WK); bf16* KDT = (bf16*)(ws + WS_KDT); bf16* AC = (bf16*)(ws + WS_AC);
    float* U = (float*)(ws + WS_U); float* GL = (float*)(ws + WS_GL);
    for (int unit = bid; unit < 2048; unit += G) {
        asm volatile("" : "+v"(lds));
        LAS float* Qf = (LAS float*)lds; LAS float* Kf = Qf + 64 * 132; LAS float* Vf = Kf + 64 * 132;
        LAS bf16* Qb = (LAS bf16*)(lds + 101376); LAS bf16* Kb = Qb + 64 * 136;
        LAS float* gt = (LAS float*)(lds + 136192);
        LAS float* Mm = Qf;
        const int n = unit & 63, bh = unit >> 6, b = bh >> 2; int h = bh & 3;
        asm volatile("" : "+s"(h));
        const int t0 = n * 64; const size_t m0 = (size_t)b * SEQ + t0;
        if (tid < 384) {
            const int cgi = tid % 48, rr = tid / 48, sel = cgi >> 4, d0 = (cgi & 15) * 8;
            const int pc = 1024 + sel * 512 + h * 128 + d0, cc = sel * 512 + h * 128 + d0;
            f32x4 cw[4][2];
#pragma unroll
            for (int j = 0; j < 4; ++j) { cw[j][0] = *(const f32x4*)(convw + j * 1536 + cc); cw[j][1] = *(const f32x4*)(convw + j * 1536 + cc + 4); }
            v4u xr[11];
#pragma unroll
            for (int i = 0; i < 11; ++i) { const int t = rr * 8 + i - 3; const bool ok = (t0 + t) >= 0;
                const bf16* p = P + ((long)m0 + t) * NP + pc; xr[i] = ok ? *(const v4u*)p : (v4u){0u, 0u, 0u, 0u}; }
            LAS float* dst = (sel == 0 ? Qf : sel == 1 ? Kf : Vf) + d0;
#pragma unroll
            for (int i = 0; i < 8; ++i) {
                f32x4 o0 = {0.f, 0.f, 0.f, 0.f}, o1 = {0.f, 0.f, 0.f, 0.f};
#pragma unroll
                for (int j = 0; j < 4; ++j) { const v4u x = xr[i + j];
                    const f32x4 x0 = {bflo(x.x), bfhi(x.x), bflo(x.y), bfhi(x.y)}, x1 = {bflo(x.z), bfhi(x.z), bflo(x.w), bfhi(x.w)};
                    o0 += cw[j][0] * x0; o1 += cw[j][1] * x1; }
#pragma unroll
                for (int e = 0; e < 4; ++e) { o0[e] = silu_f(o0[e]); o1[e] = silu_f(o1[e]); }
                *(LAS f32x4*)(dst + (rr * 8 + i) * 132) = o0; *(LAS f32x4*)(dst + (rr * 8 + i) * 132 + 4) = o1;
                const float sq = row16_sum(((o0[0] * o0[0] + o0[1] * o0[1]) + (o0[2] * o0[2] + o0[3] * o0[3])) + ((o1[0] * o1[0] + o1[1] * o1[1]) + (o1[2] * o1[2] + o1[3] * o1[3])));
                if (sel < 2 && (cgi & 15) == 0) gt[192 + sel * 64 + rr * 8 + i] = sq;
            }
        } else if (wave == 7) {
            const float bb = BA[(m0 + lane) * 8 + h], aa = BA[(m0 + lane) * 8 + 4 + h];
            const float beta = 1.f / (1.f + expf(-bb));
            const float xx = aa + a.in[12][l * 4 + h];
            const float sp = fmaxf(xx, 0.f) + log1pf(expf(-fabsf(xx)));
            float g = -expf(a.in[11][l * 4 + h]) * sp;
#pragma unroll
            for (int off = 1; off < 64; off <<= 1) { const float v = __shfl_up(g, off); if (lane >= off) g += v; }
            { const float gm = expf(g); gt[lane] = beta; gt[64 + lane] = g; gt[128 + lane] = gm; gt[320 + lane] = beta * gm; }
        }
        bar_lds();
        for (int i = 0; i < 8; ++i) {
            const int t = wave * 8 + i;
            f32x2 qv = *(LAS f32x2*)(Qf + t * 132 + 2 * lane), kv = *(LAS f32x2*)(Kf + t * 132 + 2 * lane);
            const float rq = rsqrtf(gt[192 + t] + 1e-6f) * 0.08838834764831845f, rk = rsqrtf(gt[256 + t] + 1e-6f);
            qv = qv * rq; kv = kv * rk;
            *(LAS unsigned*)(Qb + t * 136 + 2 * lane) = pk2(qv.x, qv.y);
            *(LAS unsigned*)(Kb + t * 136 + 2 * lane) = pk2(kv.x, kv.y);
            *(LAS f32x2*)(Kf + t * 132 + 2 * lane) = kv;
            const float gm = gt[128 + t];
            const int d = 2 * lane, dp = (d & ~31) + pos32(d & 31);
            *(unsigned*)(QD + ((size_t)unit * 64 + t) * 128 + dp) = pk2(qv.x * gm, qv.y * gm);
        }
        bar_lds();
        {
            const int which = wave >> 2, mt = wave & 3, r = lane & 15, q = lane >> 4;
            const LAS bf16* Ab = which ? Qb : Kb;
            bf16x8 af[4];
#pragma unroll
            for (int ks = 0; ks < 4; ++ks) af[ks] = *(const LAS bf16x8*)(Ab + (16 * mt + r) * 136 + 32 * ks + 8 * q);
            for (int nt = 0; nt < 4; ++nt) {
                f32x4 acc = {0.f, 0.f, 0.f, 0.f};
                if (nt <= mt) {
#pragma unroll
                    for (int ks = 0; ks < 4; ++ks) { const bf16x8 bfr = *(const LAS bf16x8*)(Kb + (16 * nt + r) * 136 + 32 * ks + 8 * q); acc = MFMA16(af[ks], bfr, acc); }
                }
                const int s = 16 * nt + r; const float gs = gt[64 + s];
#pragma unroll
                for (int i = 0; i < 4; ++i) { const int t = 16 * mt + 4 * q + i;
                    const float dec = __expf(fminf(gt[64 + t] - gs, 0.f));
                    if (which == 0) { if (nt <= mt) Mm[t * 68 + s] = (s < t) ? gt[t] * acc[i] * dec : 0.f; }
                    else { const float v = (s <= t) ? acc[i] * dec : 0.f; AC[((size_t)unit * 64 + t) * 64 + (s & ~31) + pos32(s & 31)] = f2bf(v); }
                }
            }
        }
        bar_lds();
        if (wave < 4) {
            const int part = wave >> 1, c = 64 * (wave & 1) + lane;
            const LAS float* src = (part ? Kf : Vf) + c;
            LAS float* dst = (part ? (LAS float*)Qb : Vf) + c;
            const LAS float* cf = gt + (part ? 320 : 0);
            float X[64];
            f32x4 mr0, mr1, mr2, mr3, mr4, mr5, mr6;
            float rh0, rh1, rh2;
            mr0 = *(const LAS f32x4*)(Mm + 68);
            mr1 = *(const LAS f32x4*)(Mm + 136);
            mr2 = *(const LAS f32x4*)(Mm + 204);
            mr3 = *(const LAS f32x4*)(Mm + 272);
            mr4 = *(const LAS f32x4*)(Mm + 340);
            mr5 = *(const LAS f32x4*)(Mm + 344);
            rh0 = src[0] * cf[0]; rh1 = src[132] * cf[1];
            rh2 = src[264] * cf[2];
            X[0] = rh0; dst[0] = X[0];
            rh0 = src[396] * cf[3];
            { float a0 = rh1, a1 = 0.f, a2 = 0.f, a3 = 0.f;
              mr6 = *(const LAS f32x4*)(Mm + 408);
              __builtin_amdgcn_sched_barrier(0);
              a0 -= mr0[0] * X[0];
              X[1] = (a0 + a1) + (a2 + a3); dst[132] = X[1]; }
            __builtin_amdgcn_sched_barrier(0);
            rh1 = src[528] * cf[4];
            { float a0 = rh2, a1 = 0.f, a2 = 0.f, a3 = 0.f;
              mr0 = *(const LAS f32x4*)(Mm + 412);
              __builtin_amdgcn_sched_barrier(0);
              a0 -= mr1[0] * X[0]; a1 -= mr1[1] * X[1];
              X[2] = (a0 + a1) + (a2 + a3); dst[264] = X[2]; }
            __builtin_amdgcn_sched_barrier(0);
            rh2 = src[660] * cf[5];
            { float a0 = rh0, a1 = 0.f, a2 = 0.f, a3 = 0.f;
              mr1 = *(const LAS f32x4*)(Mm + 476);
              __builtin_amdgcn_sched_barrier(0);
              a0 -= mr2[0] * X[0]; a1 -= mr2[1] * X[1]; a2 -= mr2[2] * X[2];
              X[3] = (a0 + a1) + (a2 + a3); dst[396] = X[3]; }
            __builtin_amdgcn_sched_barrier(0);
            rh0 = src[792] * cf[6];
            { float a0 = rh1, a1 = 0.f, a2 = 0.f, a3 = 0.f;
              mr2 = *(const LAS f32x4*)(Mm + 480);
              __builtin_amdgcn_sched_barrier(0);
              a0 -= mr3[0] * X[0]; a1 -= mr3[1] * X[1]; a2 -= mr3[2] * X[2]; a3 -= mr3[3] * X[3];
              X[4] = (a0 + a1) + (a2 + a3); dst[528] = X[4]; }
            __builtin_amdgcn_sched_barrier(0);
            rh1 = src[924] * cf[7];
            { float a0 = rh2, a1 = 0.f, a2 = 0.f, a3 = 0.f;
              mr3 = *(const LAS f32x4*)(Mm + 544);
              __builtin_amdgcn_sched_barrier(0);
              a0 -= mr4[0] * X[0]; a1 -= mr4[1] * X[1]; a2 -= mr4[2] * X[2]; a3 -= mr4[3] * X[3];
              mr4 = *(const LAS f32x4*)(Mm + 548);
              __builtin_amdgcn_sched_barrier(0);
              a0 -= mr5[0] * X[4];
              X[5] = (a0 + a1) + (a2 + a3); dst[660] = X[5]; }
            __builtin_amdgcn_sched_barrier(0);
            rh2 = src[1056] * cf[8];
            { float a0 = rh0, a1 = 0.f, a2 = 0.f, a3 = 0.f;
              mr5 = *(const LAS f32x4*)(Mm + 612);
              __builtin_amdgcn_sched_barrier(0);
              a0 -= mr6[0] * X[0]; a1 -= mr6[1] * X[1]; a2 -= mr6[2] * X[2]; a3 -= mr6[3] * X[3];
              mr6 = *(const LAS f32x4*)(Mm + 616);
              __builtin_amdgcn_sched_barrier(0);
              a0 -= mr0[0] * X[4]; a1 -= mr0[1] * X[5];
              X[6] = (a0 + a1) + (a2 + a3); dst[792] = X[6]; }
            __builtin_amdgcn_sched_barrier(0);
            rh0 = src[1188] * cf[9];
            { float a0 = rh1, a1 = 0.f, a2 = 0.f, a3 = 0.f;
              mr0 = *(const LAS f32x4*)(Mm + 620);
              __builtin_amdgcn_sched_barrier(0);
              a0 -= mr1[0] * X[0]; a1 -= mr1[1] * X[1]; a2 -= mr1[2] * X[2]; a3 -= mr1[3] * X[3];
              mr1 = *(const LAS f32x4*)(Mm + 680);
              __builtin_amdgcn_sched_barrier(0);
              a0 -= mr2[0] * X[4]; a1 -= mr2[1] * X[5]; a2 -= mr2[2] * X[6];
              X[7] = (a0 + a1) + (a2 + a3); dst[924] = X[7]; }
            __builtin_amdgcn_sched_barrier(0);
            rh1 = src[1320] * cf[10];
            { float a0 = rh2, a1 = 0.f, a2 = 0.f, a3 = 0.f;
              mr2 = *(const LAS f32x4*)(Mm + 684);
              __builtin_amdgcn_sched_barrier(0);
              a0 -= mr3[0] * X[0]; a1 -= mr3[1] * X[1]; a2 -= mr3[2] * X[2]; a3 -= mr3[3] * X[3];
              mr3 = *(const LAS f32x4*)(Mm + 688);
              __builtin_amdgcn_sched_barrier(0);
              a0 -= mr4[0] * X[4]; a1 -= mr4[1] * X[5]; a2 -= mr4[2] * X[6]; a3 -= mr4[3] * X[7];
              X[8] = (a0 + a1) + (a2 + a3); dst[1056] = X[8]; }
            __builtin_amdgcn_sched_barrier(0);
            rh2 = src[1452] * cf[11];
            { float a0 = rh0, a1 = 0.f, a2 = 0.f, a3 = 0.f;
              mr4 = *(const LAS f32x4*)(Mm + 748);
              __builtin_amdgcn_sched_barrier(0);
              a0 -= mr5[0] * X[0]; a1 -= mr5[1] * X[1]; a2 -= mr5[2] * X[2]; a3 -= mr5[3] * X[3];
              mr5 = *(const LAS f32x4*)(Mm + 752);
              __builtin_amdgcn_sched_barrier(0);
              a0 -= mr6[0] * X[4]; a1 -= mr6[1] * X[5]; a2 -= mr6[2] * X[6]; a3 -= mr6[3] * X[7];
              mr6 = *(const LAS f32x4*)(Mm + 756);
              __builtin_amdgcn_sched_barrier(0);
              a0 -= mr0[0] * X[8];
              X[9] = (a0 + a1) + (a2 + a3); dst[1188] = X[9]; }
            __builtin_amdgcn_sched_barrier(0);
            rh0 = src[1584] * cf[12];
            { float a0 = rh1, a1 = 0.f, a2 = 0.f, a3 = 0.f;
              mr0 = *(const LAS f32x4*)(Mm + 816);
              __builtin_amdgcn_sched_barrier(0);
              a0 -= mr1[0] * X[0]; a1 -= mr1[1] * X[1]; a2 -= mr1[2] * X[2]; a3 -= mr1[3] * X[3];
              mr1 = *(const LAS f32x4*)(Mm + 820);
              __builtin_amdgcn_sched_barrier(0);
              a0 -= mr2[0] * X[4]; a1 -= mr2[1] * X[5]; a2 -= mr2[2] * X[6]; a3 -= mr2[3] * X[7];
              mr2 = *(const LAS f32x4*)(Mm + 824);
              __builtin_amdgcn_sched_barrier(0);
              a0 -= mr3[0] * X[8]; a1 -= mr3[1] * X[9];
              X[10] = (a0 + a1) + (a2 + a3); dst[1320] = X[10]; }
            __builtin_amdgcn_sched_barrier(0);
            rh1 = src[1716] * cf[13];
            { float a0 = rh2, a1 = 0.f, a2 = 0.f, a3 = 0.f;
              mr3 = *(const LAS f32x4*)(Mm + 884);
              __builtin_amdgcn_sched_barrier(0);
              a0 -= mr4[0] * X[0]; a1 -= mr4[1] * X[1]; a2 -= mr4[2] * X[2]; a3 -= mr4[3] * X[3];
              mr4 = *(const LAS f32x4*)(Mm + 888);
              __builtin_amdgcn_sched_barrier(0);
              a0 -= mr5[0] * X[4]; a1 -= mr5[1] * X[5]; a2 -= mr5[2] * X[6]; a3 -= mr5[3] * X[7];
              mr5 = *(const LAS f32x4*)(Mm + 892);
              __builtin_amdgcn_sched_barrier(0);
              a0 -= mr6[0] * X[8]; a1 -= mr6[1] * X[9]; a2 -= mr6[2] * X[10];
              X[11] = (a0 + a1) + (a2 + a3); dst[1452] = X[11]; }
            __builtin_amdgcn_sched_barrier(0);
            rh2 = src[1848] * cf[14];
            { float a0 = rh0, a1 = 0.f, a2 = 0.f, a3 = 0.f;
              mr6 = *(const LAS f32x4*)(Mm + 896);
              __builtin_amdgcn_sched_barrier(0);
              a0 -= mr0[0] * X[0]; a1 -= mr0[1] * X[1]; a2 -= mr0[2] * X[2]; a3 -= mr0[3] * X[3];
              mr0 = *(const LAS f32x4*)(Mm + 952);
              __builtin_amdgcn_sched_barrier(0);
              a0 -= mr1[0] * X[4]; a1 -= mr1[1] * X[5]; a2 -= mr1[2] * X[6]; a3 -= mr1[3] * X[7];
              mr1 = *(const LAS f32x4*)(Mm + 956);
              __builtin_amdgcn_sched_barrier(0);
              a0 -= mr2[0] * X[8]; a1 -= mr2[1] * X[9]; a2 -= mr2[2] * X[10]; a3 -= mr2[3] * X[11];
              X[12] = (a0 + a1) + (a2 + a3); dst[1584] = X[12]; }
            __builtin_amdgcn_sched_barrier(0);
            rh0 = src[1980] * cf[15];
            { float a0 = rh1, a1 = 0.f, a2 = 0.f, a3 = 0.f;
              mr2 = *(const LAS f32x4*)(Mm + 960);
              __builtin_amdgcn_sched_barrier(0);
              a0 -= mr3[0] * X[0]; a1 -= mr3[1] * X[1]; a2 -= mr3[2] * X[2]; a3 -= mr3[3] * X[3];
              mr3 = *(const LAS f32x4*)(Mm + 964);
              __builtin_amdgcn_sched_barrier(0);
              a0 -= mr4[0] * X[4]; a1 -= mr4[1] * X[5]; a2 -= mr4[2] * X[6]; a3 -= mr4[3] * X[7];
              mr4 = *(const LAS f32x4*)(Mm + 1020);
              __builtin_amdgcn_sched_barrier(0);
              a0 -= mr5[0] * X[8]; a1 -= mr5[1] * X[9]; a2 -= mr5[2] * X[10]; a3 -= mr5[3] * X[11];
              mr5 = *(const LAS f32x4*)(Mm + 1024);
              __builtin_amdgcn_sched_barrier(0);
              a0 -= mr6[0] * X[12];
              X[13] = (a0 + a1) + (a2 + a3); dst[1716] = X[13]; }
            __builtin_amdgcn_sched_barrier(0);
            rh1 = src[2112] * cf[16];
            { float a0 = rh2, a1 = 0.f, a2 = 0.f, a3 = 0.f;
              mr6 = *(const LAS f32x4*)(Mm + 1028);
              __builtin_amdgcn_sched_barrier(0);
              a0 -= mr0[0] * X[0]; a1 -= mr0[1] * X[1]; a2 -= mr0[2] * X[2]; a3 -= mr0[3] * X[3];
              mr0 = *(const LAS f32x4*)(Mm + 1032);
              __builtin_amdgcn_sched_barrier(0);
              a0 -= mr1[0] * X[4]; a1 -= mr1[1] * X[5]; a2 -= mr1[2] * X[6]; a3 -= mr1[3] * X[7];
              mr1 = *(const LAS f32x4*)(Mm + 1088);
              __builtin_amdgcn_sched_barrier(0);
              a0 -= mr2[0] * X[8]; a1 -= mr2[1] * X[9]; a2 -= mr2[2] * X[10]; a3 -= mr2[3] * X[11];
              mr2 = *(const LAS f32x4*)(Mm + 1092);
              __builtin_amdgcn_sched_barrier(0);
              a0 -= mr3[0] * X[12]; a1 -= mr3[1] * X[13];
              X[14] = (a0 + a1) + (a2 + a3); dst[1848] = X[14]; }
            __builtin_amdgcn_sched_barrier(0);
            rh2 = src[2244] * cf[17];
            { float a0 = rh0, a1 = 0.f, a2 = 0.f, a3 = 0.f;
              mr3 = *(const LAS f32x4*)(Mm + 1096);
              __builtin_amdgcn_sched_barrier(0);
              a0 -= mr4[0] * X[0]; a1 -= mr4[1] * X[1]; a2 -= mr4[2] * X[2]; a3 -= mr4[3] * X[3];
              mr4 = *(const LAS f32x4*)(Mm + 1100);
              __builtin_amdgcn_sched_barrier(0);
              a0 -= mr5[0] * X[4]; a1 -= mr5[1] * X[5]; a2 -= mr5[2] * X[6]; a3 -= mr5[3] * X[7];
              mr5 = *(const LAS f32x4*)(Mm + 1156);
              __builtin_amdgcn_sched_barrier(0);
              a0 -= mr6[0] * X[8]; a1 -= mr6[1] * X[9]; a2 -= mr6[2] * X[10]; a3 -= mr6[3] * X[11];
              mr6 = *(const LAS f32x4*)(Mm + 1160);
              __builtin_amdgcn_sched_barrier(0);
              a0 -= mr0[0] * X[12]; a1 -= mr0[1] * X[13]; a2 -= mr0[2] * X[14];
              X[15] = (a0 + a1) + (a2 + a3); dst[1980] = X[15]; }
            __builtin_amdgcn_sched_barrier(0);
            rh0 = src[2376] * cf[18];
            { float a0 = rh1, a1 = 0.f, a2 = 0.f, a3 = 0.f;
              mr0 = *(const LAS f32x4*)(Mm + 1164);
              __builtin_amdgcn_sched_barrier(0);
              a0 -= mr1[0] * X[0]; a1 -= mr1[1] * X[1]; a2 -= mr1[2] * X[2]; a3 -= mr1[3] * X[3];
              mr1 = *(const LAS f32x4*)(Mm + 1168);
              __builtin_amdgcn_sched_barrier(0);
              a0 -= mr2[0] * X[4]; a1 -= mr2[1] * X[5]; a2 -= mr2[2] * X[6]; a3 -= mr2[3] * X[7];
              mr2 = *(const LAS f32x4*)(Mm + 1172);
              __builtin_amdgcn_sched_barrier(0);
              a0 -= mr3[0] * X[8]; a1 -= mr3[1] * X[9]; a2 -= mr3[2] * X[10]; a3 -= mr3[3] * X[11];
              mr3 = *(const LAS f32x4*)(Mm + 1224);
              __builtin_amdgcn_sched_barrier(0);
              a0 -= mr4[0] * X[12]; a1 -= mr4[1] * X[13]; a2 -= mr4[2] * X[14]; a3 -= mr4[3] * X[15];
              X[16] = (a0 + a1) + (a2 + a3); dst[2112] = X[16]; }
            __builtin_amdgcn_sched_barrier(0);
            rh1 = src[2508] * cf[19];
            { float a0 = rh2, a1 = 0.f, a2 = 0.f, a3 = 0.f;
              mr4 = *(const LAS f32x4*)(Mm + 1228);
              __builtin_amdgcn_sched_barrier(0);
              a0 -= mr5[0] * X[0]; a1 -= mr5[1] * X[1]; a2 -= mr5[2] * X[2]; a3 -= mr5[3] * X[3];
              mr5 = *(const LAS f32x4*)(Mm + 1232);
              __builtin_amdgcn_sched_barrier(0);
              a0 -= mr6[0] * X[4]; a1 -= mr6[1] * X[5]; a2 -= mr6[2] * X[6]; a3 -= mr6[3] * X[7];
              mr6 = *(const LAS f32x4*)(Mm + 1236);
              __builtin_amdgcn_sched_barrier(0);
              a0 -= mr0[0] * X[8]; a1 -= mr0[1] * X[9]; a2 -= mr0[2] * X[10]; a3 -= mr0[3] * X[11];
              mr0 = *(const LAS f32x4*)(Mm + 1240);
              __builtin_amdgcn_sched_barrier(0);
              a0 -= mr1[0] * X[12]; a1 -= mr1[1] * X[13]; a2 -= mr1[2] * X[14]; a3 -= mr1[3] * X[15];
              mr1 = *(const LAS f32x4*)(Mm + 1292);
              __builtin_amdgcn_sched_barrier(0);
              a0 -= mr2[0] * X[16];
              X[17] = (a0 + a1) + (a2 + a3); dst[2244] = X[17]; }
            __builtin_amdgcn_sched_barrier(0);
            rh2 = src[2640] * cf[20];
            { float a0 = rh0, a1 = 0.f, a2 = 0.f, a3 = 0.f;
              mr2 = *(const LAS f32x4*)(Mm + 1296);
              __builtin_amdgcn_sched_barrier(0);
              a0 -= mr3[0] * X[0]; a1 -= mr3[1] * X[1]; a2 -= mr3[2] * X[2]; a3 -= mr3[3] * X[3];
              mr3 = *(const LAS f32x4*)(Mm + 1300);
              __builtin_amdgcn_sched_barrier(0);
              a0 -= mr4[0] * X[4]; a1 -= mr4[1] * X[5]; a2 -= mr4[2] * X[6]; a3 -= mr4[3] * X[7];
              mr4 = *(const LAS f32x4*)(Mm + 1304);
              __builtin_amdgcn_sched_barrier(0);
              a0 -= mr5[0] * X[8]; a1 -= mr5[1] * X[9]; a2 -= mr5[2] * X[10]; a3 -= mr5[3] * X[11];
              mr5 = *(const LAS f32x4*)(Mm + 1308);
              __builtin_amdgcn_sched_barrier(0);
              a0 -= mr6[0] * X[12]; a1 -= mr6[1] * X[13]; a2 -= mr6[2] * X[14]; a3 -= mr6[3] * X[15];
              mr6 = *(const LAS f32x4*)(Mm + 1360);
              __builtin_amdgcn_sched_barrier(0);
              a0 -= mr0[0] * X[16]; a1 -= mr0[1] * X[17];
              X[18] = (a0 + a1) + (a2 + a3); dst[2376] = X[18]; }
            __builtin_amdgcn_sched_barrier(0);
            rh0 = src[2772] * cf[21];
            { float a0 = rh1, a1 = 0.f, a2 = 0.f, a3 = 0.f;
              mr0 = *(const LAS f32x4*)(Mm + 1364);
              __builtin_amdgcn_sched_barrier(0);
              a0 -= mr1[0] * X[0]; a1 -= mr1[1] * X[1]; a2 -= mr1[2] * X[2]; a3 -= mr1[3] * X[3];
              mr1 = *(const LAS f32x4*)(Mm + 1368);
              __builtin_amdgcn_sched_barrier(0);
              a0 -= mr2[0] * X[4]; a1 -= mr2[1] * X[5]; a2 -= mr2[2] * X[6]; a3 -= mr2[3] * X[7];
              mr2 = *(const LAS f32x4*)(Mm + 1372);
              __builtin_amdgcn_sched_barrier(0);
              a0 -= mr3[0] * X[8]; a1 -= mr3[1] * X[9]; a2 -= mr3[2] * X[10]; a3 -= mr3[3] * X[11];
              mr3 = *(const LAS f32x4*)(Mm + 1376);
              __builtin_amdgcn_sched_barrier(0);
              a0 -= mr4[0] * X[12]; a1 -= mr4[1] * X[13]; a2 -= mr4[2] * X[14]; a3 -= mr4[3] * X[15];
              mr4 = *(const LAS f32x4*)(Mm + 1428);
              __builtin_amdgcn_sched_barrier(0);
              a0 -= mr5[0] * X[16]; a1 -= mr5[1] * X[17]; a2 -= mr5[2] * X[18];
              X[19] = (a0 + a1) + (a2 + a3); dst[2508] = X[19]; }
            __builtin_amdgcn_sched_barrier(0);
            rh1 = src[2904] * cf[22];
            { float a0 = rh2, a1 = 0.f, a2 = 0.f, a3 = 0.f;
              mr5 = *(const LAS f32x4*)(Mm + 1432);
              __builtin_amdgcn_sched_barrier(0);
              a0 -= mr6[0] * X[0]; a1 -= mr6[1] * X[1]; a2 -= mr6[2] * X[2]; a3 -= mr6[3] * X[3];
              mr6 = *(const LAS f32x4*)(Mm + 1436);
              __builtin_amdgcn_sched_barrier(0);
              a0 -= mr0[0] * X[4]; a1 -= mr0[1] * X[5]; a2 -= mr0[2] * X[6]; a3 -= mr0[3] * X[7];
              mr0 = *(const LAS f32x4*)(Mm + 1440);
              __builtin_amdgcn_sched_barrier(0);
              a0 -= mr1[0] * X[8]; a1 -= mr1[1] * X[9]; a2 -= mr1[2] * X[10]; a3 -= mr1[3] * X[11];
              mr1 = *(const LAS f32x4*)(Mm + 1444);
              __builtin_amdgcn_sched_barrier(0);
              a0 -= mr2[0] * X[12]; a1 -= mr2[1] * X[13]; a2 -= mr2[2] * X[14]; a3 -= mr2[3] * X[15];
              mr2 = *(const LAS f32x4*)(Mm + 1448);
              __builtin_amdgcn_sched_barrier(0);
              a0 -= mr3[0] * X[16]; a1 -= mr3[1] * X[17]; a2 -= mr3[2] * X[18]; a3 -= mr3[3] * X[19];
              X[20] = (a0 + a1) + (a2 + a3); dst[2640] = X[20]; }
            __builtin_amdgcn_sched_barrier(0);
            rh2 = src[3036] * cf[23];
            { float a0 = rh0, a1 = 0.f, a2 = 0.f, a3 = 0.f;
              mr3 = *(const LAS f32x4*)(Mm + 1496);
              __builtin_amdgcn_sched_barrier(0);
              a0 -= mr4[0] * X[0]; a1 -= mr4[1] * X[1]; a2 -= mr4[2] * X[2]; a3 -= mr4[3] * X[3];
              mr4 = *(const LAS f32x4*)(Mm + 1500);
              __builtin_amdgcn_sched_barrier(0);
              a0 -= mr5[0] * X[4]; a1 -= mr5[1] * X[5]; a2 -= mr5[2] * X[6]; a3 -= mr5[3] * X[7];
              mr5 = *(const LAS f32x4*)(Mm + 1504);
              __builtin_amdgcn_sched_barrier(0);
              a0 -= mr6[0] * X[8]; a1 -= mr6[1] * X[9]; a2 -= mr6[2] * X[10]; a3 -= mr6[3] * X[11];
              mr6 = *(const LAS f32x4*)(Mm + 1508);
              __builtin_amdgcn_sched_barrier(0);
              a0 -= mr0[0] * X[12]; a1 -= mr0[1] * X[13]; a2 -= mr0[2] * X[14]; a3 -= mr0[3] * X[15];
              mr0 = *(const LAS f32x4*)(Mm + 1512);
              __builtin_amdgcn_sched_barrier(0);
              a0 -= mr1[0] * X[16]; a1 -= mr1[1] * X[17]; a2 -= mr1[2] * X[18]; a3 -= mr1[3] * X[19];
              mr1 = *(const LAS f32x4*)(Mm + 1516);
              __builtin_amdgcn_sched_barrier(0);
              a0 -= mr2[0] * X[20];
              X[21] = (a0 + a1) + (a2 + a3); dst[2772] = X[21]; }
            __builtin_amdgcn_sched_barrier(0);
            rh0 = src[3168] * cf[24];
            { float a0 = rh1, a1 = 0.f, a2 = 0.f, a3 = 0.f;
              mr2 = *(const LAS f32x4*)(Mm + 1564);
              __builtin_amdgcn_sched_barrier(0);
              a0 -= mr3[0] * X[0]; a1 -= mr3[1] * X[1]; a2 -= mr3[2] * X[2]; a3 -= mr3[3] * X[3];
              mr3 = *(const LAS f32x4*)(Mm + 1568);
              __builtin_amdgcn_sched_barrier(0);
              a0 -= mr4[0] * X[4]; a1 -= mr4[1] * X[5]; a2 -= mr4[2] * X[6]; a3 -= mr4[3] * X[7];
              mr4 = *(const LAS f32x4*)(Mm + 1572);
              __builtin_amdgcn_sched_barrier(0);
              a0 -= mr5[0] * X[8]; a1 -= mr5[1] * X[9]; a2 -= mr5[2] * X[10]; a3 -= mr5[3] * X[11];
              mr5 = *(const LAS f32x4*)(Mm + 1576);
              __builtin_amdgcn_sched_barrier(0);
              a0 -= mr6[0] * X[12]; a1 -= mr6[1] * X[13]; a2 -= mr6[2] * X[14]; a3 -= mr6[3] * X[15];
              mr6 = *(const LAS f32x4*)(Mm + 1580);
              __builtin_amdgcn_sched_barrier(0);
              a0 -= mr0[0] * X[16]; a1 -= mr0[1] * X[17]; a2 -= mr0[2] * X[18]; a3 -= mr0[3] * X[19];
              mr0 = *(const LAS f32x4*)(Mm + 1584);
              __builtin_amdgcn_sched_barrier(0);
              a0 -= mr1[0] * X[20]; a1 -= mr1[1] * X[21];
              X[22] = (a0 + a1) + (a2 + a3); dst[2904] = X[22]; }
            __builtin_amdgcn_sched_barrier(0);
            rh1 = src[3300] * cf[25];
            { float a0 = rh2, a1 = 0.f, a2 = 0.f, a3 = 0.f;
              mr1 = *(const LAS f32x4*)(Mm + 1632);
              __builtin_amdgcn_sched_barrier(0);
              a0 -= mr2[0] * X[0]; a1 -= mr2[1] * X[1]; a2 -= mr2[2] * X[2]; a3 -= mr2[3] * X[3];
              mr2 = *(const LAS f32x4*)(Mm + 1636);
              __builtin_amdgcn_sched_barrier(0);
              a0 -= mr3[0] * X[4]; a1 -= mr3[1] * X[5]; a2 -= mr3[2] * X[6]; a3 -= mr3[3] * X[7];
              mr3 = *(const LAS f32x4*)(Mm + 1640);
              __builtin_amdgcn_sched_barrier(0);
              a0 -= mr4[0] * X[8]; a1 -= mr4[1] * X[9]; a2 -= mr4[2] * X[10]; a3 -= mr4[3] * X[11];
              mr4 = *(const LAS f32x4*)(Mm + 1644);
              __builtin_amdgcn_sched_barrier(0);
              a0 -= mr5[0] * X[12]; a1 -= mr5[1] * X[13]; a2 -= mr5[2] * X[14]; a3 -= mr5[3] * X[15];
              mr5 = *(const LAS f32x4*)(Mm + 1648);
              __builtin_amdgcn_sched_barrier(0);
              a0 -= mr6[0] * X[16]; a1 -= mr6[1] * X[17]; a2 -= mr6[2] * X[18]; a3 -= mr6[3] * X[19];
              mr6 = *(const LAS f32x4*)(Mm + 1652);
              __builtin_amdgcn_sched_barrier(0);
              a0 -= mr0[0] * X[20]; a1 -= mr0[1] * X[21]; a2 -= mr0[2] * X[22];
              X[23] = (a0 + a1) + (a2 + a3); dst[3036] = X[23]; }
            __builtin_amdgcn_sched_barrier(0);
            rh2 = src[3432] * cf[26];
            { float a0 = rh0, a1 = 0.f, a2 = 0.f, a3 = 0.f;
              mr0 = *(const LAS f32x4*)(Mm + 1700);
              __builtin_amdgcn_sched_barrier(0);
              a0 -= mr1[0] * X[0]; a1 -= mr1[1] * X[1]; a2 -= mr1[2] * X[2]; a3 -= mr1[3] * X[3];
              mr1 = *(const LAS f32x4*)(Mm + 1704);
              __builtin_amdgcn_sched_barrier(0);
              a0 -= mr2[0] * X[4]; a1 -= mr2[1] * X[5]; a2 -= mr2[2] * X[6]; a3 -= mr2[3] * X[7];
              mr2 = *(const LAS f32x4*)(Mm + 1708);
              __builtin_amdgcn_sched_barrier(0);
              a0 -= mr3[0] * X[8]; a1 -= mr3[1] * X[9]; a2 -= mr3[2] * X[10]; a3 -= mr3[3] * X[11];
              mr3 = *(const LAS f32x4*)(Mm + 1712);
              __builtin_amdgcn_sched_barrier(0);
              a0 -= mr4[0] * X[12]; a1 -= mr4[1] * X[13]; a2 -= mr4[2] * X[14]; a3 -= mr4[3] * X[15];
              mr4 = *(const LAS f32x4*)(Mm + 1716);
              __builtin_amdgcn_sched_barrier(0);
              a0 -= mr5[0] * X[16]; a1 -= mr5[1] * X[17]; a2 -= mr5[2] * X[18]; a3 -= mr5[3] * X[19];
              mr5 = *(const LAS f32x4*)(Mm + 1720);
              __builtin_amdgcn_sched_barrier(0);
              a0 -= mr6[0] * X[20]; a1 -= mr6[1] * X[21]; a2 -= mr6[2] * X[22]; a3 -= mr6[3] * X[23];
              X[24] = (a0 + a1) + (a2 + a3); dst[3168] = X[24]; }
            __builtin_amdgcn_sched_barrier(0);
            rh0 = src[3564] * cf[27];
            { float a0 = rh1, a1 = 0.f, a2 = 0.f, a3 = 0.f;
              mr6 = *(const LAS f32x4*)(Mm + 1724);
              __builtin_amdgcn_sched_barrier(0);
              a0 -= mr0[0] * X[0]; a1 -= mr0[1] * X[1]; a2 -= mr0[2] * X[2]; a3 -= mr0[3] * X[3];
              mr0 = *(const LAS f32x4*)(Mm + 1768);
              __builtin_amdgcn_sched_barrier(0);
              a0 -= mr1[0] * X[4]; a1 -= mr1[1] * X[5]; a2 -= mr1[2] * X[6]; a3 -= mr1[3] * X[7];
              mr1 = *(const LAS f32x4*)(Mm + 1772);
              __builtin_amdgcn_sched_barrier(0);
              a0 -= mr2[0] * X[8]; a1 -= mr2[1] * X[9]; a2 -= mr2[2] * X[10]; a3 -= mr2[3] * X[11];
              mr2 = *(const LAS f32x4*)(Mm + 1776);
              __builtin_amdgcn_sched_barrier(0);
              a0 -= mr3[0] * X[12]; a1 -= mr3[1] * X[13]; a2 -= mr3[2] * X[14]; a3 -= mr3[3] * X[15];
              mr3 = *(const LAS f32x4*)(Mm + 1780);
              __builtin_amdgcn_sched_barrier(0);
              a0 -= mr4[0] * X[16]; a1 -= mr4[1] * X[17]; a2 -= mr4[2] * X[18]; a3 -= mr4[3] * X[19];
              mr4 = *(const LAS f32x4*)(Mm + 1784);
              __builtin_amdgcn_sched_barrier(0);
              a0 -= mr5[0] * X[20]; a1 -= mr5[1] * X[21]; a2 -= mr5[2] * X[22]; a3 -= mr5[3] * X[23];
              mr5 = *(const LAS f32x4*)(Mm + 1788);
              __builtin_amdgcn_sched_barrier(0);
              a0 -= mr6[0] * X[24];
              X[25] = (a0 + a1) + (a2 + a3); dst[3300] = X[25]; }
            __builtin_amdgcn_sched_barrier(0);
            rh1 = src[3696] * cf[28];
            { float a0 = rh2, a1 = 0.f, a2 = 0.f, a3 = 0.f;
              mr6 = *(const LAS f32x4*)(Mm + 1792);
              __builtin_amdgcn_sched_barrier(0);
              a0 -= mr0[0] * X[0]; a1 -= mr0[1] * X[1]; a2 -= mr0[2] * X[2]; a3 -= mr0[3] * X[3];
              mr0 = *(const LAS f32x4*)(Mm + 1836);
              __builtin_amdgcn_sched_barrier(0);
              a0 -= mr1[0] * X[4]; a1 -= mr1[1] * X[5]; a2 -= mr1[2] * X[6]; a3 -= mr1[3] * X[7];
              mr1 = *(const LAS f32x4*)(Mm + 1840);
              __builtin_amdgcn_sched_barrier(0);
              a0 -= mr2[0] * X[8]; a1 -= mr2[1] * X[9]; a2 -= mr2[2] * X[10]; a3 -= mr2[3] * X[11];
              mr2 = *(const LAS f32x4*)(Mm + 1844);
              __builtin_amdgcn_sched_barrier(0);
              a0 -= mr3[0] * X[12]; a1 -= mr3[1] * X[13]; a2 -= mr3[2] * X[14]; a3 -= mr3[3] * X[15];
              mr3 = *(const LAS f32x4*)(Mm + 1848);
              __builtin_amdgcn_sched_barrier(0);
              a0 -= mr4[0] * X[16]; a1 -= mr4[1] * X[17]; a2 -= mr4[2] * X[18]; a3 -= mr4[3] * X[19];
              mr4 = *(const LAS f32x4*)(Mm + 1852);
              __builtin_amdgcn_sched_barrier(0);
              a0 -= mr5[0] * X[20]; a1 -= mr5[1] * X[21]; a2 -= mr5[2] * X[22]; a3 -= mr5[3] * X[23];
              mr5 = *(const LAS f32x4*)(Mm + 1856);
              __builtin_amdgcn_sched_barrier(0);
              a0 -= mr6[0] * X[24]; a1 -= mr6[1] * X[25];
              X[26] = (a0 + a1) + (a2 + a3); dst[3432] = X[26]; }
            __builtin_amdgcn_sched_barrier(0);
            rh2 = src[3828] * cf[29];
            { float a0 = rh0, a1 = 0.f, a2 = 0.f, a3 = 0.f;
              mr6 = *(const LAS f32x4*)(Mm + 1860);
              __builtin_amdgcn_sched_barrier(0);
              a0 -= mr0[0] * X[0]; a1 -= mr0[1] * X[1]; a2 -= mr0[2] * X[2]; a3 -= mr0[3] * X[3];
              mr0 = *(const LAS f32x4*)(Mm + 1904);
              __builtin_amdgcn_sched_barrier(0);
              a0 -= mr1[0] * X[4]; a1 -= mr1[1] * X[5]; a2 -= mr1[2] * X[6]; a3 -= mr1[3] * X[7];
              mr1 = *(const LAS f32x4*)(Mm + 1908);
              __builtin_amdgcn_sched_barrier(0);
              a0 -= mr2[0] * X[8]; a1 -= mr2[1] * X[9]; a2 -= mr2[2] * X[10]; a3 -= mr2[3] * X[11];
              mr2 = *(const LAS f32x4*)(Mm + 1912);
              __builtin_amdgcn_sched_barrier(0);
              a0 -= mr3[0] * X[12]; a1 -= mr3[1] * X[13]; a2 -= mr3[2] * X[14]; a3 -= mr3[3] * X[15];
              mr3 = *(const LAS f32x4*)(Mm + 1916);
              __builtin_amdgcn_sched_barrier(0);
              a0 -= mr4[0] * X[16]; a1 -= mr4[1] * X[17]; a2 -= mr4[2] * X[18]; a3 -= mr4[3] * X[19];
              mr4 = *(const LAS f32x4*)(Mm + 1920);
              __builtin_amdgcn_sched_barrier(0);
              a0 -= mr5[0] * X[20]; a1 -= mr5[1] * X[21]; a2 -= mr5[2] * X[22]; a3 -= mr5[3] * X[23];
              mr5 = *(const LAS f32x4*)(Mm + 1924);
              __builtin_amdgcn_sched_barrier(0);
              a0 -= mr6[0] * X[24]; a1 -= mr6[1] * X[25]; a2 -= mr6[2] * X[26];
              X[27] = (a0 + a1) + (a2 + a3); dst[3564] = X[27]; }
            __builtin_amdgcn_sched_barrier(0);
            rh0 = src[3960] * cf[30];
            { float a0 = rh1, a1 = 0.f, a2 = 0.f, a3 = 0.f;
              mr6 = *(const LAS f32x4*)(Mm + 1928);
              __builtin_amdgcn_sched_barrier(0);
              a0 -= mr0[0] * X[0]; a1 -= mr0[1] * X[1]; a2 -= mr0[2] * X[2]; a3 -= mr0[3] * X[3];
              mr0 = *(const LAS f32x4*)(Mm + 1972);
              __builtin_amdgcn_sched_barrier(0);
              a0 -= mr1[0] * X[4]; a1 -= mr1[1] * X[5]; a2 -= mr1[2] * X[6]; a3 -= mr1[3] * X[7];
              mr1 = *(const LAS f32x4*)(Mm + 1976);
              __builtin_amdgcn_sched_barrier(0);
              a0 -= mr2[0] * X[8]; a1 -= mr2[1] * X[9]; a2 -= mr2[2] * X[10]; a3 -= mr2[3] * X[11];
              mr2 = *(const LAS f32x4*)(Mm + 1980);
              __builtin_amdgcn_sched_barrier(0);
              a0 -= mr3[0] * X[12]; a1 -= mr3[1] * X[13]; a2 -= mr3[2] * X[14]; a3 -= mr3[3] * X[15];
              mr3 = *(const LAS f32x4*)(Mm + 1984);
              __builtin_amdgcn_sched_barrier(0);
              a0 -= mr4[0] * X[16]; a1 -= mr4[1] * X[17]; a2 -= mr4[2] * X[18]; a3 -= mr4[3] * X[19];
              mr4 = *(const LAS f32x4*)(Mm + 1988);
              __builtin_amdgcn_sched_barrier(0);
              a0 -= mr5[0] * X[20]; a1 -= mr5[1] * X[21]; a2 -= mr5[2] * X[22]; a3 -= mr5[3] * X[23];
              mr5 = *(const LAS f32x4*)(Mm + 1992);
              __builtin_amdgcn_sched_barrier(0);
              a0 -= mr6[0] * X[24]; a1 -= mr6[1] * X[25]; a2 -= mr6[2] * X[26]; a3 -= mr6[3] * X[27];
              X[28] = (a0 + a1) + (a2 + a3); dst[3696] = X[28]; }
            __builtin_amdgcn_sched_barrier(0);
            rh1 = src[4092] * cf[31];
            { float a0 = rh2, a1 = 0.f, a2 = 0.f, a3 = 0.f;
              mr6 = *(const LAS f32x4*)(Mm + 1996);
              __builtin_amdgcn_sched_barrier(0);
              a0 -= mr0[0] * X[0]; a1 -= mr0[1] * X[1]; a2 -= mr0[2] * X[2]; a3 -= mr0[3] * X[3];
              mr0 = *(const LAS f32x4*)(Mm + 2000);
              __builtin_amdgcn_sched_barrier(0);
              a0 -= mr1[0] * X[4]; a1 -= mr1[1] * X[5]; a2 -= mr1[2] * X[6]; a3 -= mr1[3] * X[7];
              mr1 = *(const LAS f32x4*)(Mm + 2040);
              __builtin_amdgcn_sched_barrier(0);
              a0 -= mr2[0] * X[8]; a1 -= mr2[1] * X[9]; a2 -= mr2[2] * X[10]; a3 -= mr2[3] * X[11];
              mr2 = *(const LAS f32x4*)(Mm + 2044);
              __builtin_amdgcn_sched_barrier(0);
              a0 -= mr3[0] * X[12]; a1 -= mr3[1] * X[13]; a2 -= mr3[2] * X[14]; a3 -= mr3[3] * X[15];
              mr3 = *(const LAS f32x4*)(Mm + 2048);
              __builtin_amdgcn_sched_barrier(0);
              a0 -= mr4[0] * X[16]; a1 -= mr4[1] * X[17]; a2 -= mr4[2] * X[18]; a3 -= mr4[3] * X[19];
              mr4 = *(const LAS f32x4*)(Mm + 2052);
              __builtin_amdgcn_sched_barrier(0);
              a0 -= mr5[0] * X[20]; a1 -= mr5[1] * X[21]; a2 -= mr5[2] * X[22]; a3 -= mr5[3] * X[23];
              mr5 = *(const LAS f32x4*)(Mm + 2056);
              __builtin_amdgcn_sched_barrier(0);
              a0 -= mr6[0] * X[24]; a1 -= mr6[1] * X[25]; a2 -= mr6[2] * X[26]; a3 -= mr6[3] * X[27];
              mr6 = *(const LAS f32x4*)(Mm + 2060);
              __builtin_amdgcn_sched_barrier(0);
              a0 -= mr0[0] * X[28];
              X[29] = (a0 + a1) + (a2 + a3); dst[3828] = X[29]; }
            __builtin_amdgcn_sched_barrier(0);
            rh2 = src[4224] * cf[32];
            { float a0 = rh0, a1 = 0.f, a2 = 0.f, a3 = 0.f;
              mr0 = *(const LAS f32x4*)(Mm + 2064);
              __builtin_amdgcn_sched_barrier(0);
              a0 -= mr1[0] * X[0]; a1 -= mr1[1] * X[1]; a2 -= mr1[2] * X[2]; a3 -= mr1[3] * X[3];
              mr1 = *(const LAS f32x4*)(Mm + 2068);
              __builtin_amdgcn_sched_barrier(0);
              a0 -= mr2[0] * X[4]; a1 -= mr2[1] * X[5]; a2 -= mr2[2] * X[6]; a3 -= mr2[3] * X[7];
              mr2 = *(const LAS f32x4*)(Mm + 2108);
              __builtin_amdgcn_sched_barrier(0);
              a0 -= mr3[0] * X[8]; a1 -= mr3[1] * X[9]; a2 -= mr3[2] * X[10]; a3 -= mr3[3] * X[11];
              mr3 = *(const LAS f32x4*)(Mm + 2112);
              __builtin_amdgcn_sched_barrier(0);
              a0 -= mr4[0] * X[12]; a1 -= mr4[1] * X[13]; a2 -= mr4[2] * X[14]; a3 -= mr4[3] * X[15];
              mr4 = *(const LAS f32x4*)(Mm + 2116);
              __builtin_amdgcn_sched_barrier(0);
              a0 -= mr5[0] * X[16]; a1 -= mr5[1] * X[17]; a2 -= mr5[2] * X[18]; a3 -= mr5[3] * X[19];
              mr5 = *(const LAS f32x4*)(Mm + 2120);
              __builtin_amdgcn_sched_barrier(0);
              a0 -= mr6[0] * X[20]; a1 -= mr6[1] * X[21]; a2 -= mr6[2] * X[22]; a3 -= mr6[3] * X[23];
              mr6 = *(const LAS f32x4*)(Mm + 2124);
              __builtin_amdgcn_sched_barrier(0);
              a0 -= mr0[0] * X[24]; a1 -= mr0[1] * X[25]; a2 -= mr0[2] * X[26]; a3 -= mr0[3] * X[27];
              mr0 = *(const LAS f32x4*)(Mm + 2128);
              __builtin_amdgcn_sched_barrier(0);
              a0 -= mr1[0] * X[28]; a1 -= mr1[1] * X[29];
              X[30] = (a0 + a1) + (a2 + a3); dst[3960] = X[30]; }
            __builtin_amdgcn_sched_barrier(0);
            rh0 = src[4356] * cf[33];
            { float a0 = rh1, a1 = 0.f, a2 = 0.f, a3 = 0.f;
              mr1 = *(const LAS f32x4*)(Mm + 2132);
              __builtin_amdgcn_sched_barrier(0);
              a0 -= mr2[0] * X[0]; a1 -= mr2[1] * X[1]; a2 -= mr2[2] * X[2]; a3 -= mr2[3] * X[3];
              mr2 = *(const LAS f32x4*)(Mm + 2136);
              __builtin_amdgcn_sched_barrier(0);
              a0 -= mr3[0] * X[4]; a1 -= mr3[1] * X[5]; a2 -= mr3[2] * X[6]; a3 -= mr3[3] * X[7];
              mr3 = *(const LAS f32x4*)(Mm + 2176);
              __builtin_amdgcn_sched_barrier(0);
              a0 -= mr4[0] * X[8]; a1 -= mr4[1] * X[9]; a2 -= mr4[2] * X[10]; a3 -= mr4[3] * X[11];
              mr4 = *(const LAS f32x4*)(Mm + 2180);
              __builtin_amdgcn_sched_barrier(0);
              a0 -= mr5[0] * X[12]; a1 -= mr5[1] * X[13]; a2 -= mr5[2] * X[14]; a3 -= mr5[3] * X[15];
              mr5 = *(const LAS f32x4*)(Mm + 2184);
              __builtin_amdgcn_sched_barrier(0);
              a0 -= mr6[0] * X[16]; a1 -= mr6[1] * X[17]; a2 -= mr6[2] * X[18]; a3 -= mr6[3] * X[19];
              mr6 = *(const LAS f32x4*)(Mm + 2188);
              __builtin_amdgcn_sched_barrier(0);
              a0 -= mr0[0] * X[20]; a1 -= mr0[1] * X[21]; a2 -= mr0[2] * X[22]; a3 -= mr0[3] * X[23];
              mr0 = *(const LAS f32x4*)(Mm + 2192);
              __builtin_amdgcn_sched_barrier(0);
              a0 -= mr1[0] * X[24]; a1 -= mr1[1] * X[25]; a2 -= mr1[2] * X[26]; a3 -= mr1[3] * X[27];
              mr1 = *(const LAS f32x4*)(Mm + 2196);
              __builtin_amdgcn_sched_barrier(0);
              a0 -= mr2[0] * X[28]; a1 -= mr2[1] * X[29]; a2 -= mr2[2] * X[30];
              X[31] = (a0 + a1) + (a2 + a3); dst[4092] = X[31]; }
            __builtin_amdgcn_sched_barrier(0);
            rh1 = src[4488] * cf[34];
            { float a0 = rh2, a1 = 0.f, a2 = 0.f, a3 = 0.f;
              mr2 = *(const LAS f32x4*)(Mm + 2200);
              __builtin_amdgcn_sched_barrier(0);
              a0 -= mr3[0] * X[0]; a1 -= mr3[1] * X[1]; a2 -= mr3[2] * X[2]; a3 -= mr3[3] * X[3];
              mr3 = *(const LAS f32x4*)(Mm + 2204);
              __builtin_amdgcn_sched_barrier(0);
              a0 -= mr4[0] * X[4]; a1 -= mr4[1] * X[5]; a2 -= mr4[2] * X[6]; a3 -= mr4[3] * X[7];
              mr4 = *(const LAS f32x4*)(Mm + 2244);
              __builtin_amdgcn_sched_barrier(0);
              a0 -= mr5[0] * X[8]; a1 -= mr5[1] * X[9]; a2 -= mr5[2] * X[10]; a3 -= mr5[3] * X[11];
              mr5 = *(const LAS f32x4*)(Mm + 2248);
              __builtin_amdgcn_sched_barrier(0);
              a0 -= mr6[0] * X[12]; a1 -= mr6[1] * X[13]; a2 -= mr6[2] * X[14]; a3 -= mr6[3] * X[15];
              mr6 = *(const LAS f32x4*)(Mm + 2252);
              __builtin_amdgcn_sched_barrier(0);
              a0 -= mr0[0] * X[16]; a1 -= mr0[1] * X[17]; a2 -= mr0[2] * X[18]; a3 -= mr0[3] * X[19];
              mr0 = *(const LAS f32x4*)(Mm + 2256);
              __builtin_amdgcn_sched_barrier(0);
              a0 -= mr1[0] * X[20]; a1 -= mr1[1] * X[21]; a2 -= mr1[2] * X[22]; a3 -= mr1[3] * X[23];
              mr1 = *(const LAS f32x4*)(Mm + 2260);
              __builtin_amdgcn_sched_barrier(0);
              a0 -= mr2[0] * X[24]; a1 -= mr2[1] * X[25]; a2 -= mr2[2] * X[26]; a3 -= mr2[3] * X[27];
              mr2 = *(const LAS f32x4*)(Mm + 2264);
              __builtin_amdgcn_sched_barrier(0);
              a0 -= mr3[0] * X[28]; a1 -= mr3[1] * X[29]; a2 -= mr3[2] * X[30]; a3 -= mr3[3] * X[31];
              X[32] = (a0 + a1) + (a2 + a3); dst[4224] = X[32]; }
            __builtin_amdgcn_sched_barrier(0);
            rh2 = src[4620] * cf[35];
            { float a0 = rh0, a1 = 0.f, a2 = 0.f, a3 = 0.f;
              mr3 = *(const LAS f32x4*)(Mm + 2268);
              __builtin_amdgcn_sched_barrier(0);
              a0 -= mr4[0] * X[0]; a1 -= mr4[1] * X[1]; a2 -= mr4[2] * X[2]; a3 -= mr4[3] * X[3];
              mr4 = *(const LAS f32x4*)(Mm + 2272);
              __builtin_amdgcn_sched_barrier(0);
              a0 -= mr5[0] * X[4]; a1 -= mr5[1] * X[5]; a2 -= mr5[2] * X[6]; a3 -= mr5[3] * X[7];
              mr5 = *(const LAS f32x4*)(Mm + 2276);
              __builtin_amdgcn_sched_barrier(0);
              a0 -= mr6[0] * X[8]; a1 -= mr6[1] * X[9]; a2 -= mr6[2] * X[10]; a3 -= mr6[3] * X[11];
              mr6 = *(const LAS f32x4*)(Mm + 2312);
              __builtin_amdgcn_sched_barrier(0);
              a0 -= mr0[0] * X[12]; a1 -= mr0[1] * X[13]; a2 -= mr0[2] * X[14]; a3 -= mr0[3] * X[15];
              mr0 = *(const LAS f32x4*)(Mm + 2316);
              __builtin_amdgcn_sched_barrier(0);
              a0 -= mr1[0] * X[16]; a1 -= mr1[1] * X[17]; a2 -= mr1[2] * X[18]; a3 -= mr1[3] * X[19];
              mr1 = *(const LAS f32x4*)(Mm + 2320);
              __builtin_amdgcn_sched_barrier(0);
              a0 -= mr2[0] * X[20]; a1 -= mr2[1] * X[21]; a2 -= mr2[2] * X[22]; a3 -= mr2[3] * X[23];
              mr2 = *(const LAS f32x4*)(Mm + 2324);
              __builtin_amdgcn_sched_barrier(0);
              a0 -= mr3[0] * X[24]; a1 -= mr3[1] * X[25]; a2 -= mr3[2] * X[26]; a3 -= mr3[3] * X[27];
              mr3 = *(const LAS f32x4*)(Mm + 2328);
              __builtin_amdgcn_sched_barrier(0);
              a0 -= mr4[0] * X[28]; a1 -= mr4[1] * X[29]; a2 -= mr4[2] * X[30]; a3 -= mr4[3] * X[31];
              mr4 = *(const LAS f32x4*)(Mm + 2332);
              __builtin_amdgcn_sched_barrier(0);
              a0 -= mr5[0] * X[32];
              X[33] = (a0 + a1) + (a2 + a3); dst[4356] = X[33]; }
            __builtin_amdgcn_sched_barrier(0);
            rh0 = src[4752] * cf[36];
            { float a0 = rh1, a1 = 0.f, a2 = 0.f, a3 = 0.f;
              mr5 = *(const LAS f32x4*)(Mm + 2336);
              __builtin_amdgcn_sched_barrier(0);
              a0 -= mr6[0] * X[0]; a1 -= mr6[1] * X[1]; a2 -= mr6[2] * X[2]; a3 -= mr6[3] * X[3];
              mr6 = *(const LAS f32x4*)(Mm + 2340);
              __builtin_amdgcn_sched_barrier(0);
              a0 -= mr0[0] * X[4]; a1 -= mr0[1] * X[5]; a2 -= mr0[2] * X[6]; a3 -= mr0[3] * X[7];
              mr0 = *(const LAS f32x4*)(Mm + 2344);
              __builtin_amdgcn_sched_barrier(0);
              a0 -= mr1[0] * X[8]; a1 -= mr1[1] * X[9]; a2 -= mr1[2] * X[10]; a3 -= mr1[3] * X[11];
              mr1 = *(const LAS f32x4*)(Mm + 2380);
              __builtin_amdgcn_sched_barrier(0);
              a0 -= mr2[0] * X[12]; a1 -= mr2[1] * X[13]; a2 -= mr2[2] * X[14]; a3 -= mr2[3] * X[15];
              mr2 = *(const LAS f32x4*)(Mm + 2384);
              __builtin_amdgcn_sched_barrier(0);
              a0 -= mr3[0] * X[16]; a1 -= mr3[1] * X[17]; a2 -= mr3[2] * X[18]; a3 -= mr3[3] * X[19];
              mr3 = *(const LAS f32x4*)(Mm + 2388);
              __builtin_amdgcn_sched_barrier(0);
              a0 -= mr4[0] * X[20]; a1 -= mr4[1] * X[21]; a2 -= mr4[2] * X[22]; a3 -= mr4[3] * X[23];
              mr4 = *(const LAS f32x4*)(Mm + 2392);
              __builtin_amdgcn_sched_barrier(0);
              a0 -= mr5[0] * X[24]; a1 -= mr5[1] * X[25]; a2 -= mr5[2] * X[26]; a3 -= mr5[3] * X[27];
              mr5 = *(const LAS f32x4*)(Mm + 2396);
              __builtin_amdgcn_sched_barrier(0);
              a0 -= mr6[0] * X[28]; a1 -= mr6[1] * X[29]; a2 -= mr6[2] * X[30]; a3 -= mr6[3] * X[31];
              mr6 = *(const LAS f32x4*)(Mm + 2400);
              __builtin_amdgcn_sched_barrier(0);
              a0 -= mr0[0] * X[32]; a1 -= mr0[1] * X[33];
              X[34] = (a0 + a1) + (a2 + a3); dst[4488] = X[34]; }
            __builtin_amdgcn_sched_barrier(0);
            rh1 = src[4884] * cf[37];
            { float a0 = rh2, a1 = 0.f, a2 = 0.f, a3 = 0.f;
              mr0 = *(const LAS f32x4*)(Mm + 2404);
              __builtin_amdgcn_sched_barrier(0);
              a0 -= mr1[0] * X[0]; a1 -= mr1[1] * X[1]; a2 -= mr1[2] * X[2]; a3 -= mr1[3] * X[3];
              mr1 = *(const LAS f32x4*)(Mm + 2408);
              __builtin_amdgcn_sched_barrier(0);
              a0 -= mr2[0] * X[4]; a1 -= mr2[1] * X[5]; a2 -= mr2[2] * X[6]; a3 -= mr2[3] * X[7];
              mr2 = *(const LAS f32x4*)(Mm + 2412);
              __builtin_amdgcn_sched_barrier(0);
              a0 -= mr3[0] * X[8]; a1 -= mr3[1] * X[9]; a2 -= mr3[2] * X[10]; a3 -= mr3[3] * X[11];
              mr3 = *(const LAS f32x4*)(Mm + 2448);
              __builtin_amdgcn_sched_barrier(0);
              a0 -= mr4[0] * X[12]; a1 -= mr4[1] * X[13]; a2 -= mr4[2] * X[14]; a3 -= mr4[3] * X[15];
              mr4 = *(const LAS f32x4*)(Mm + 2452);
              __builtin_amdgcn_sched_barrier(0);
              a0 -= mr5[0] * X[16]; a1 -= mr5[1] * X[17]; a2 -= mr5[2] * X[18]; a3 -= mr5[3] * X[19];
              mr5 = *(const LAS f32x4*)(Mm + 2456);
              __builtin_amdgcn_sched_barrier(0);
              a0 -= mr6[0] * X[20]; a1 -= mr6[1] * X[21]; a2 -= mr6[2] * X[22]; a3 -= mr6[3] * X[23];
              mr6 = *(const LAS f32x4*)(Mm + 2460);
              __builtin_amdgcn_sched_barrier(0);
              a0 -= mr0[0] * X[24]; a1 -= mr0[1] * X[25]; a2 -= mr0[2] * X[26]; a3 -= mr0[3] * X[27];
              mr0 = *(const LAS f32x4*)(Mm + 2464);
              __builtin_amdgcn_sched_barrier(0);
              a0 -= mr1[0] * X[28]; a1 -= mr1[1] * X[29]; a2 -= mr1[2] * X[30]; a3 -= mr1[3] * X[31];
              mr1 = *(const LAS f32x4*)(Mm + 2468);
              __builtin_amdgcn_sched_barrier(0);
              a0 -= mr2[0] * X[32]; a1 -= mr2[1] * X[33]; a2 -= mr2[2] * X[34];
              X[35] = (a0 + a1) + (a2 + a3); dst[4620] = X[35]; }
            __builtin_amdgcn_sched_barrier(0);
            rh2 = src[5016] * cf[38];
            { float a0 = rh0, a1 = 0.f, a2 = 0.f, a3 = 0.f;
              mr2 = *(const LAS f32x4*)(Mm + 2472);
              __builtin_amdgcn_sched_barrier(0);
              a0 -= mr3[0] * X[0]; a1 -= mr3[1] * X[1]; a2 -= mr3[2] * X[2]; a3 -= mr3[3] * X[3];
              mr3 = *(const LAS f32x4*)(Mm + 2476);
              __builtin_amdgcn_sched_barrier(0);
              a0 -= mr4[0] * X[4]; a1 -= mr4[1] * X[5]; a2 -= mr4[2] * X[6]; a3 -= mr4[3] * X[7];
              mr4 = *(const LAS f32x4*)(Mm + 2480);
              __builtin_amdgcn_sched_barrier(0);
              a0 -= mr5[0] * X[8]; a1 -= mr5[1] * X[9]; a2 -= mr5[2] * X[10]; a3 -= mr5[3] * X[11];
              mr5 = *(const LAS f32x4*)(Mm + 2516);
              __builtin_amdgcn_sched_barrier(0);
              a0 -= mr6[0] * X[12]; a1 -= mr6[1] * X[13]; a2 -= mr6[2] * X[14]; a3 -= mr6[3] * X[15];
              mr6 = *(const LAS f32x4*)(Mm + 2520);
              __builtin_amdgcn_sched_barrier(0);
              a0 -= mr0[0] * X[16]; a1 -= mr0[1] * X[17]; a2 -= mr0[2] * X[18]; a3 -= mr0[3] * X[19];
              mr0 = *(const LAS f32x4*)(Mm + 2524);
              __builtin_amdgcn_sched_barrier(0);
              a0 -= mr1[0] * X[20]; a1 -= mr1[1] * X[21]; a2 -= mr1[2] * X[22]; a3 -= mr1[3] * X[23];
              mr1 = *(const LAS f32x4*)(Mm + 2528);
              __builtin_amdgcn_sched_barrier(0);
              a0 -= mr2[0] * X[24]; a1 -= mr2[1] * X[25]; a2 -= mr2[2] * X[26]; a3 -= mr2[3] * X[27];
              mr2 = *(const LAS f32x4*)(Mm + 2532);
              __builtin_amdgcn_sched_barrier(0);
              a0 -= mr3[0] * X[28]; a1 -= mr3[1] * X[29]; a2 -= mr3[2] * X[30]; a3 -= mr3[3] * X[31];
              mr3 = *(const LAS f32x4*)(Mm + 2536);
              __builtin_amdgcn_sched_barrier(0);
              a0 -= mr4[0] * X[32]; a1 -= mr4[1] * X[33]; a2 -= mr4[2] * X[34]; a3 -= mr4[3] * X[35];
              X[36] = (a0 + a1) + (a2 + a3); dst[4752] = X[36]; }
            __builtin_amdgcn_sched_barrier(0);
            rh0 = src[5148] * cf[39];
            { float a0 = rh1, a1 = 0.f, a2 = 0.f, a3 = 0.f;
              mr4 = *(const LAS f32x4*)(Mm + 2540);
              __builtin_amdgcn_sched_barrier(0);
              a0 -= mr5[0] * X[0]; a1 -= mr5[1] * X[1]; a2 -= mr5[2] * X[2]; a3 -= mr5[3] * X[3];
              mr5 = *(const LAS f32x4*)(Mm + 2544);
              __builtin_amdgcn_sched_barrier(0);
              a0 -= mr6[0] * X[4]; a1 -= mr6[1] * X[5]; a2 -= mr6[2] * X[6]; a3 -= mr6[3] * X[7];
              mr6 = *(const LAS f32x4*)(Mm + 2548);
              __builtin_amdgcn_sched_barrier(0);
              a0 -= mr0[0] * X[8]; a1 -= mr0[1] * X[9]; a2 -= mr0[2] * X[10]; a3 -= mr0[3] * X[11];
              mr0 = *(const LAS f32x4*)(Mm + 2552);
              __builtin_amdgcn_sched_barrier(0);
              a0 -= mr1[0] * X[12]; a1 -= mr1[1] * X[13]; a2 -= mr1[2] * X[14]; a3 -= mr1[3] * X[15];
              mr1 = *(const LAS f32x4*)(Mm + 2584);
              __builtin_amdgcn_sched_barrier(0);
              a0 -= mr2[0] * X[16]; a1 -= mr2[1] * X[17]; a2 -= mr2[2] * X[18]; a3 -= mr2[3] * X[19];
              mr2 = *(const LAS f32x4*)(Mm + 2588);
              __builtin_amdgcn_sched_barrier(0);
              a0 -= mr3[0] * X[20]; a1 -= mr3[1] * X[21]; a2 -= mr3[2] * X[22]; a3 -= mr3[3] * X[23];
              mr3 = *(const LAS f32x4*)(Mm + 2592);
              __builtin_amdgcn_sched_barrier(0);
              a0 -= mr4[0] * X[24]; a1 -= mr4[1] * X[25]; a2 -= mr4[2] * X[26]; a3 -= mr4[3] * X[27];
              mr4 = *(const LAS f32x4*)(Mm + 2596);
              __builtin_amdgcn_sched_barrier(0);
              a0 -= mr5[0] * X[28]; a1 -= mr5[1] * X[29]; a2 -= mr5[2] * X[30]; a3 -= mr5[3] * X[31];
              mr5 = *(const LAS f32x4*)(Mm + 2600);
              __builtin_amdgcn_sched_barrier(0);
              a0 -= mr6[0] * X[32]; a1 -= mr6[1] * X[33]; a2 -= mr6[2] * X[34]; a3 -= mr6[3] * X[35];
              mr6 = *(const LAS f32x4*)(Mm + 2604);
              __builtin_amdgcn_sched_barrier(0);
              a0 -= mr0[0] * X[36];
              X[37] = (a0 + a1) + (a2 + a3); dst[4884] = X[37]; }
            __builtin_amdgcn_sched_barrier(0);
            rh1 = src[5280] * cf[40];
            { float a0 = rh2, a1 = 0.f, a2 = 0.f, a3 = 0.f;
              mr0 = *(const LAS f32x4*)(Mm + 2608);
              __builtin_amdgcn_sched_barrier(0);
              a0 -= mr1[0] * X[0]; a1 -= mr1[1] * X[1]; a2 -= mr1[2] * X[2]; a3 -= mr1[3] * X[3];
              mr1 = *(const LAS f32x4*)(Mm + 2612);
              __builtin_amdgcn_sched_barrier(0);
              a0 -= mr2[0] * X[4]; a1 -= mr2[1] * X[5]; a2 -= mr2[2] * X[6]; a3 -= mr2[3] * X[7];
              mr2 = *(const LAS f32x4*)(Mm + 2616);
              __builtin_amdgcn_sched_barrier(0);
              a0 -= mr3[0] * X[8]; a1 -= mr3[1] * X[9]; a2 -= mr3[2] * X[10]; a3 -= mr3[3] * X[11];
              mr3 = *(const LAS f32x4*)(Mm + 2620);
              __builtin_amdgcn_sched_barrier(0);
              a0 -= mr4[0] * X[12]; a1 -= mr4[1] * X[13]; a2 -= mr4[2] * X[14]; a3 -= mr4[3] * X[15];
              mr4 = *(const LAS f32x4*)(Mm + 2652);
              __builtin_amdgcn_sched_barrier(0);
              a0 -= mr5[0] * X[16]; a1 -= mr5[1] * X[17]; a2 -= mr5[2] * X[18]; a3 -= mr5[3] * X[19];
              mr5 = *(const LAS f32x4*)(Mm + 2656);
              __builtin_amdgcn_sched_barrier(0);
              a0 -= mr6[0] * X[20]; a1 -= mr6[1] * X[21]; a2 -= mr6[2] * X[22]; a3 -= mr6[3] * X[23];
              mr6 = *(const LAS f32x4*)(Mm + 2660);
              __builtin_amdgcn_sched_barrier(0);
              a0 -= mr0[0] * X[24]; a1 -= mr0[1] * X[25]; a2 -= mr0[2] * X[26]; a3 -= mr0[3] * X[27];
              mr0 = *(const LAS f32x4*)(Mm + 2664);
              __builtin_amdgcn_sched_barrier(0);
              a0 -= mr1[0] * X[28]; a1 -= mr1[1] * X[29]; a2 -= mr1[2] * X[30]; a3 -= mr1[3] * X[31];
              mr1 = *(const LAS f32x4*)(Mm + 2668);
              __builtin_amdgcn_sched_barrier(0);
              a0 -= mr2[0] * X[32]; a1 -= mr2[1] * X[33]; a2 -= mr2[2] * X[34]; a3 -= mr2[3] * X[35];
              mr2 = *(const LAS f32x4*)(Mm + 2672);
              __builtin_amdgcn_sched_barrier(0);
              a0 -= mr3[0] * X[36]; a1 -= mr3[1] * X[37];
              X[38] = (a0 + a1) + (a2 + a3); dst[5016] = X[38]; }
            __builtin_amdgcn_sched_barrier(0);
            rh2 = src[5412] * cf[41];
            { float a0 = rh0, a1 = 0.f, a2 = 0.f, a3 = 0.f;
              mr3 = *(const LAS f32x4*)(Mm + 2676);
              __builtin_amdgcn_sched_barrier(0);
              a0 -= mr4[0] * X[0]; a1 -= mr4[1] * X[1]; a2 -= mr4[2] * X[2]; a3 -= mr4[3] * X[3];
              mr4 = *(const LAS f32x4*)(Mm + 2680);
              __builtin_amdgcn_sched_barrier(0);
              a0 -= mr5[0] * X[4]; a1 -= mr5[1] * X[5]; a2 -= mr5[2] * X[6]; a3 -= mr5[3] * X[7];
              mr5 = *(const LAS f32x4*)(Mm + 2684);
              __builtin_amdgcn_sched_barrier(0);
              a0 -= mr6[0] * X[8]; a1 -= mr6[1] * X[9]; a2 -= mr6[2] * X[10]; a3 -= mr6[3] * X[11];
              mr6 = *(const LAS f32x4*)(Mm + 2688);
              __builtin_amdgcn_sched_barrier(0);
              a0 -= mr0[0] * X[12]; a1 -= mr0[1] * X[13]; a2 -= mr0[2] * X[14]; a3 -= mr0[3] * X[15];
              mr0 = *(const LAS f32x4*)(Mm + 2720);
              __builtin_amdgcn_sched_barrier(0);
              a0 -= mr1[0] * X[16]; a1 -= mr1[1] * X[17]; a2 -= mr1[2] * X[18]; a3 -= mr1[3] * X[19];
              mr1 = *(const LAS f32x4*)(Mm + 2724);
              __builtin_amdgcn_sched_barrier(0);
              a0 -= mr2[0] * X[20]; a1 -= mr2[1] * X[21]; a2 -= mr2[2] * X[22]; a3 -= mr2[3] * X[23];
              mr2 = *(const LAS f32x4*)(Mm + 2728);
              __builtin_amdgcn_sched_barrier(0);
              a0 -= mr3[0] * X[24]; a1 -= mr3[1] * X[25]; a2 -= mr3[2] * X[26]; a3 -= mr3[3] * X[27];
              mr3 = *(const LAS f32x4*)(Mm + 2732);
              __builtin_amdgcn_sched_barrier(0);
              a0 -= mr4[0] * X[28]; a1 -= mr4[1] * X[29]; a2 -= mr4[2] * X[30]; a3 -= mr4[3] * X[31];
              mr4 = *(const LAS f32x4*)(Mm + 2736);
              __builtin_amdgcn_sched_barrier(0);
              a0 -= mr5[0] * X[32]; a1 -= mr5[1] * X[33]; a2 -= mr5[2] * X[34]; a3 -= mr5[3] * X[35];
              mr5 = *(const LAS f32x4*)(Mm + 2740);
              __builtin_amdgcn_sched_barrier(0);
              a0 -= mr6[0] * X[36]; a1 -= mr6[1] * X[37]; a2 -= mr6[2] * X[38];
              X[39] = (a0 + a1) + (a2 + a3); dst[5148] = X[39]; }
            __builtin_amdgcn_sched_barrier(0);
            rh0 = src[5544] * cf[42];
            { float a0 = rh1, a1 = 0.f, a2 = 0.f, a3 = 0.f;
              mr6 = *(const LAS f32x4*)(Mm + 2744);
              __builtin_amdgcn_sched_barrier(0);
              a0 -= mr0[0] * X[0]; a1 -= mr0[1] * X[1]; a2 -= mr0[2] * X[2]; a3 -= mr0[3] * X[3];
              mr0 = *(const LAS f32x4*)(Mm + 2748);
              __builtin_amdgcn_sched_barrier(0);
              a0 -= mr1[0] * X[4]; a1 -= mr1[1] * X[5]; a2 -= mr1[2] * X[6]; a3 -= mr1[3] * X[7];
              mr1 = *(const LAS f32x4*)(Mm + 2752);
              __builtin_amdgcn_sched_barrier(0);
              a0 -= mr2[0] * X[8]; a1 -= mr2[1] * X[9]; a2 -= mr2[2] * X[10]; a3 -= mr2[3] * X[11];
              mr2 = *(const LAS f32x4*)(Mm + 2756);
              __builtin_amdgcn_sched_barrier(0);
              a0 -= mr3[0] * X[12]; a1 -= mr3[1] * X[13]; a2 -= mr3[2] * X[14]; a3 -= mr3[3] * X[15];
              mr3 = *(const LAS f32x4*)(Mm + 2788);
              __builtin_amdgcn_sched_barrier(0);
              a0 -= mr4[0] * X[16]; a1 -= mr4[1] * X[17]; a2 -= mr4[2] * X[18]; a3 -= mr4[3] * X[19];
              mr4 = *(const LAS f32x4*)(Mm + 2792);
              __builtin_amdgcn_sched_barrier(0);
              a0 -= mr5[0] * X[20]; a1 -= mr5[1] * X[21]; a2 -= mr5[2] * X[22]; a3 -= mr5[3] * X[23];
              mr5 = *(const LAS f32x4*)(Mm + 2796);
              __builtin_amdgcn_sched_barrier(0);
              a0 -= mr6[0] * X[24]; a1 -= mr6[1] * X[25]; a2 -= mr6[2] * X[26]; a3 -= mr6[3] * X[27];
              mr6 = *(const LAS f32x4*)(Mm + 2800);
              __builtin_amdgcn_sched_barrier(0);
              a0 -= mr0[0] * X[28]; a1 -= mr0[1] * X[29]; a2 -= mr0[2] * X[30]; a3 -= mr0[3] * X[31];
              mr0 = *(const LAS f32x4*)(Mm + 2804);
              __builtin_amdgcn_sched_barrier(0);
              a0 -= mr1[0] * X[32]; a1 -= mr1[1] * X[33]; a2 -= mr1[2] * X[34]; a3 -= mr1[3] * X[35];
              mr1 = *(const LAS f32x4*)(Mm + 2808);
              __builtin_amdgcn_sched_barrier(0);
              a0 -= mr2[0] * X[36]; a1 -= mr2[1] * X[37]; a2 -= mr2[2] * X[38]; a3 -= mr2[3] * X[39];
              X[40] = (a0 + a1) + (a2 + a3); dst[5280] = X[40]; }
            __builtin_amdgcn_sched_barrier(0);
            rh1 = src[5676] * cf[43];
            { float a0 = rh2, a1 = 0.f, a2 = 0.f, a3 = 0.f;
              mr2 = *(const LAS f32x4*)(Mm + 2812);
              __builtin_amdgcn_sched_barrier(0);
              a0 -= mr3[0] * X[0]; a1 -= mr3[1] * X[1]; a2 -= mr3[2] * X[2]; a3 -= mr3[3] * X[3];
              mr3 = *(const LAS f32x4*)(Mm + 2816);
              __builtin_amdgcn_sched_barrier(0);
              a0 -= mr4[0] * X[4]; a1 -= mr4[1] * X[5]; a2 -= mr4[2] * X[6]; a3 -= mr4[3] * X[7];
              mr4 = *(const LAS f32x4*)(Mm + 2820);
              __builtin_amdgcn_sched_barrier(0);
              a0 -= mr5[0] * X[8]; a1 -= mr5[1] * X[9]; a2 -= mr5[2] * X[10]; a3 -= mr5[3] * X[11];
              mr5 = *(const LAS f32x4*)(Mm + 2824);
              __builtin_amdgcn_sched_barrier(0);
              a0 -= mr6[0] * X[12]; a1 -= mr6[1] * X[13]; a2 -= mr6[2] * X[14]; a3 -= mr6[3] * X[15];
              mr6 = *(const LAS f32x4*)(Mm + 2828);
              __builtin_amdgcn_sched_barrier(0);
              a0 -= mr0[0] * X[16]; a1 -= mr0[1] * X[17]; a2 -= mr0[2] * X[18]; a3 -= mr0[3] * X[19];
              mr0 = *(const LAS f32x4*)(Mm + 2856);
              __builtin_amdgcn_sched_barrier(0);
              a0 -= mr1[0] * X[20]; a1 -= mr1[1] * X[21]; a2 -= mr1[2] * X[22]; a3 -= mr1[3] * X[23];
              mr1 = *(const LAS f32x4*)(Mm + 2860);
              __builtin_amdgcn_sched_barrier(0);
              a0 -= mr2[0] * X[24]; a1 -= mr2[1] * X[25]; a2 -= mr2[2] * X[26]; a3 -= mr2[3] * X[27];
              mr2 = *(const LAS f32x4*)(Mm + 2864);
              __builtin_amdgcn_sched_barrier(0);
              a0 -= mr3[0] * X[28]; a1 -= mr3[1] * X[29]; a2 -= mr3[2] * X[30]; a3 -= mr3[3] * X[31];
              mr3 = *(const LAS f32x4*)(Mm + 2868);
              __builtin_amdgcn_sched_barrier(0);
              a0 -= mr4[0] * X[32]; a1 -= mr4[1] * X[33]; a2 -= mr4[2] * X[34]; a3 -= mr4[3] * X[35];
              mr4 = *(const LAS f32x4*)(Mm + 2872);
              __builtin_amdgcn_sched_barrier(0);
              a0 -= mr5[0] * X[36]; a1 -= mr5[1] * X[37]; a2 -= mr5[2] * X[38]; a3 -= mr5[3] * X[39];
              mr5 = *(const LAS f32x4*)(Mm + 2876);
              __builtin_amdgcn_sched_barrier(0);
              a0 -= mr6[0] * X[40];
              X[41] = (a0 + a1) + (a2 + a3); dst[5412] = X[41]; }
            __builtin_amdgcn_sched_barrier(0);
            rh2 = src[5808] * cf[44];
            { float a0 = rh0, a1 = 0.f, a2 = 0.f, a3 = 0.f;
              mr6 = *(const LAS f32x4*)(Mm + 2880);
              __builtin_amdgcn_sched_barrier(0);
              a0 -= mr0[0] * X[0]; a1 -= mr0[1] * X[1]; a2 -= mr0[2] * X[2]; a3 -= mr0[3] * X[3];
              mr0 = *(const LAS f32x4*)(Mm + 2884);
              __builtin_amdgcn_sched_barrier(0);
              a0 -= mr1[0] * X[4]; a1 -= mr1[1] * X[5]; a2 -= mr1[2] * X[6]; a3 -= mr1[3] * X[7];
              mr1 = *(const LAS f32x4*)(Mm + 2888);
              __builtin_amdgcn_sched_barrier(0);
              a0 -= mr2[0] * X[8]; a1 -= mr2[1] * X[9]; a2 -= mr2[2] * X[10]; a3 -= mr2[3] * X[11];
              mr2 = *(const LAS f32x4*)(Mm + 2892);
              __builtin_amdgcn_sched_barrier(0);
              a0 -= mr3[0] * X[12]; a1 -= mr3[1] * X[13]; a2 -= mr3[2] * X[14]; a3 -= mr3[3] * X[15];
              mr3 = *(const LAS f32x4*)(Mm + 2896);
              __builtin_amdgcn_sched_barrier(0);
              a0 -= mr4[0] * X[16]; a1 -= mr4[1] * X[17]; a2 -= mr4[2] * X[18]; a3 -= mr4[3] * X[19];
              mr4 = *(const LAS f32x4*)(Mm + 2924);
              __builtin_amdgcn_sched_barrier(0);
              a0 -= mr5[0] * X[20]; a1 -= mr5[1] * X[21]; a2 -= mr5[2] * X[22]; a3 -= mr5[3] * X[23];
              mr5 = *(const LAS f32x4*)(Mm + 2928);
              __builtin_amdgcn_sched_barrier(0);
              a0 -= mr6[0] * X[24]; a1 -= mr6[1] * X[25]; a2 -= mr6[2] * X[26]; a3 -= mr6[3] * X[27];
              mr6 = *(const LAS f32x4*)(Mm + 2932);
              __builtin_amdgcn_sched_barrier(0);
              a0 -= mr0[0] * X[28]; a1 -= mr0[1] * X[29]; a2 -= mr0[2] * X[30]; a3 -= mr0[3] * X[31];
              mr0 = *(const LAS f32x4*)(Mm + 2936);
              __builtin_amdgcn_sched_barrier(0);
              a0 -= mr1[0] * X[32]; a1 -= mr1[1] * X[33]; a2 -= mr1[2] * X[34]; a3 -= mr1[3] * X[35];
              mr1 = *(const LAS f32x4*)(Mm + 2940);
              __builtin_amdgcn_sched_barrier(0);
              a0 -= mr2[0] * X[36]; a1 -= mr2[1] * X[37]; a2 -= mr2[2] * X[38]; a3 -= mr2[3] * X[39];
              mr2 = *(const LAS f32x4*)(Mm + 2944);
              __builtin_amdgcn_sched_barrier(0);
              a0 -= mr3[0] * X[40]; a1 -= mr3[1] * X[41];
              X[42] = (a0 + a1) + (a2 + a3); dst[5544] = X[42]; }
            __builtin_amdgcn_sched_barrier(0);
            rh0 = src[5940] * cf[45];
            { float a0 = rh1, a1 = 0.f, a2 = 0.f, a3 = 0.f;
              mr3 = *(const LAS f32x4*)(Mm + 2948);
              __builtin_amdgcn_sched_barrier(0);
              a0 -= mr4[0] * X[0]; a1 -= mr4[1] * X[1]; a2 -= mr4[2] * X[2]; a3 -= mr4[3] * X[3];
              mr4 = *(const LAS f32x4*)(Mm + 2952);
              __builtin_amdgcn_sched_barrier(0);
              a0 -= mr5[0] * X[4]; a1 -= mr5[1] * X[5]; a2 -= mr5[2] * X[6]; a3 -= mr5[3] * X[7];
              mr5 = *(const LAS f32x4*)(Mm + 2956);
              __builtin_amdgcn_sched_barrier(0);
              a0 -= mr6[0] * X[8]; a1 -= mr6[1] * X[9]; a2 -= mr6[2] * X[10]; a3 -= mr6[3] * X[11];
              mr6 = *(const LAS f32x4*)(Mm + 2960);
              __builtin_amdgcn_sched_barrier(0);
              a0 -= mr0[0] * X[12]; a1 -= mr0[1] * X[13]; a2 -= mr0[2] * X[14]; a3 -= mr0[3] * X[15];
              mr0 = *(const LAS f32x4*)(Mm + 2964);
              __builtin_amdgcn_sched_barrier(0);
              a0 -= mr1[0] * X[16]; a1 -= mr1[1] * X[17]; a2 -= mr1[2] * X[18]; a3 -= mr1[3] * X[19];
              mr1 = *(const LAS f32x4*)(Mm + 2992);
              __builtin_amdgcn_sched_barrier(0);
              a0 -= mr2[0] * X[20]; a1 -= mr2[1] * X[21]; a2 -= mr2[2] * X[22]; a3 -= mr2[3] * X[23];
              mr2 = *(const LAS f32x4*)(Mm + 2996);
              __builtin_amdgcn_sched_barrier(0);
              a0 -= mr3[0] * X[24]; a1 -= mr3[1] * X[25]; a2 -= mr3[2] * X[26]; a3 -= mr3[3] * X[27];
              mr3 = *(const LAS f32x4*)(Mm + 3000);
              __builtin_amdgcn_sched_barrier(0);
              a0 -= mr4[0] * X[28]; a1 -= mr4[1] * X[29]; a2 -= mr4[2] * X[30]; a3 -= mr4[3] * X[31];
              mr4 = *(const LAS f32x4*)(Mm + 3004);
              __builtin_amdgcn_sched_barrier(0);
              a0 -= mr5[0] * X[32]; a1 -= mr5[1] * X[33]; a2 -= mr5[2] * X[34]; a3 -= mr5[3] * X[35];
              mr5 = *(const LAS f32x4*)(Mm + 3008);
              __builtin_amdgcn_sched_barrier(0);
              a0 -= mr6[0] * X[36]; a1 -= mr6[1] * X[37]; a2 -= mr6[2] * X[38]; a3 -= mr6[3] * X[39];
              mr6 = *(const LAS f32x4*)(Mm + 3012);
              __builtin_amdgcn_sched_barrier(0);
              a0 -= mr0[0] * X[40]; a1 -= mr0[1] * X[41]; a2 -= mr0[2] * X[42];
              X[43] = (a0 + a1) + (a2 + a3); dst[5676] = X[43]; }
            __builtin_amdgcn_sched_barrier(0);
            rh1 = src[6072] * cf[46];
            { float a0 = rh2, a1 = 0.f, a2 = 0.f, a3 = 0.f;
              mr0 = *(const LAS f32x4*)(Mm + 3016);
              __builtin_amdgcn_sched_barrier(0);
              a0 -= mr1[0] * X[0]; a1 -= mr1[1] * X[1]; a2 -= mr1[2] * X[2]; a3 -= mr1[3] * X[3];
              mr1 = *(const LAS f32x4*)(Mm + 3020);
              __builtin_amdgcn_sched_barrier(0);
              a0 -= mr2[0] * X[4]; a1 -= mr2[1] * X[5]; a2 -= mr2[2] * X[6]; a3 -= mr2[3] * X[7];
              mr2 = *(const LAS f32x4*)(Mm + 3024);
              __builtin_amdgcn_sched_barrier(0);
              a0 -= mr3[0] * X[8]; a1 -= mr3[1] * X[9]; a2 -= mr3[2] * X[10]; a3 -= mr3[3] * X[11];
              mr3 = *(const LAS f32x4*)(Mm + 3028);
              __builtin_amdgcn_sched_barrier(0);
              a0 -= mr4[0] * X[12]; a1 -= mr4[1] * X[13]; a2 -= mr4[2] * X[14]; a3 -= mr4[3] * X[15];
              mr4 = *(const LAS f32x4*)(Mm + 3032);
              __builtin_amdgcn_sched_barrier(0);
              a0 -= mr5[0] * X[16]; a1 -= mr5[1] * X[17]; a2 -= mr5[2] * X[18]; a3 -= mr5[3] * X[19];
              mr5 = *(const LAS f32x4*)(Mm + 3060);
              __builtin_amdgcn_sched_barrier(0);
              a0 -= mr6[0] * X[20]; a1 -= mr6[1] * X[21]; a2 -= mr6[2] * X[22]; a3 -= mr6[3] * X[23];
              mr6 = *(const LAS f32x4*)(Mm + 3064);
              __builtin_amdgcn_sched_barrier(0);
              a0 -= mr0[0] * X[24]; a1 -= mr0[1] * X[25]; a2 -= mr0[2] * X[26]; a3 -= mr0[3] * X[27];
              mr0 = *(const LAS f32x4*)(Mm + 3068);
              __builtin_amdgcn_sched_barrier(0);
              a0 -= mr1[0] * X[28]; a1 -= mr1[1] * X[29]; a2 -= mr1[2] * X[30]; a3 -= mr1[3] * X[31];
              mr1 = *(const LAS f32x4*)(Mm + 3072);
              __builtin_amdgcn_sched_barrier(0);
              a0 -= mr2[0] * X[32]; a1 -= mr2[1] * X[33]; a2 -= mr2[2] * X[34]; a3 -= mr2[3] * X[35];
              mr2 = *(const LAS f32x4*)(Mm + 3076);
              __builtin_amdgcn_sched_barrier(0);
              a0 -= mr3[0] * X[36]; a1 -= mr3[1] * X[37]; a2 -= mr3[2] * X[38]; a3 -= mr3[3] * X[39];
              mr3 = *(const LAS f32x4*)(Mm + 3080);
              __builtin_amdgcn_sched_barrier(0);
              a0 -= mr4[0] * X[40]; a1 -= mr4[1] * X[41]; a2 -= mr4[2] * X[42]; a3 -= mr4[3] * X[43];
              X[44] = (a0 + a1) + (a2 + a3); dst[5808] = X[44]; }
            __builtin_amdgcn_sched_barrier(0);
            rh2 = src[6204] * cf[47];
            { float a0 = rh0, a1 = 0.f, a2 = 0.f, a3 = 0.f;
              mr4 = *(const LAS f32x4*)(Mm + 3084);
              __builtin_amdgcn_sched_barrier(0);
              a0 -= mr5[0] * X[0]; a1 -= mr5[1] * X[1]; a2 -= mr5[2] * X[2]; a3 -= mr5[3] * X[3];
              mr5 = *(const LAS f32x4*)(Mm + 3088);
              __builtin_amdgcn_sched_barrier(0);
              a0 -= mr6[0] * X[4]; a1 -= mr6[1] * X[5]; a2 -= mr6[2] * X[6]; a3 -= mr6[3] * X[7];
              mr6 = *(const LAS f32x4*)(Mm + 3092);
              __builtin_amdgcn_sched_barrier(0);
              a0 -= mr0[0] * X[8]; a1 -= mr0[1] * X[9]; a2 -= mr0[2] * X[10]; a3 -= mr0[3] * X[11];
              mr0 = *(const LAS f32x4*)(Mm + 3096);
              __builtin_amdgcn_sched_barrier(0);
              a0 -= mr1[0] * X[12]; a1 -= mr1[1] * X[13]; a2 -= mr1[2] * X[14]; a3 -= mr1[3] * X[15];
              mr1 = *(const LAS f32x4*)(Mm + 3100);
              __builtin_amdgcn_sched_barrier(0);
              a0 -= mr2[0] * X[16]; a1 -= mr2[1] * X[17]; a2 -= mr2[2] * X[18]; a3 -= mr2[3] * X[19];
              mr2 = *(const LAS f32x4*)(Mm + 3104);
              __builtin_amdgcn_sched_barrier(0);
              a0 -= mr3[0] * X[20]; a1 -= mr3[1] * X[21]; a2 -= mr3[2] * X[22]; a3 -= mr3[3] * X[23];
              mr3 = *(const LAS f32x4*)(Mm + 3128);
              __builtin_amdgcn_sched_barrier(0);
              a0 -= mr4[0] * X[24]; a1 -= mr4[1] * X[25]; a2 -= mr4[2] * X[26]; a3 -= mr4[3] * X[27];
              mr4 = *(const LAS f32x4*)(Mm + 3132);
              __builtin_amdgcn_sched_barrier(0);
              a0 -= mr5[0] * X[28]; a1 -= mr5[1] * X[29]; a2 -= mr5[2] * X[30]; a3 -= mr5[3] * X[31];
              mr5 = *(const LAS f32x4*)(Mm + 3136);
              __builtin_amdgcn_sched_barrier(0);
              a0 -= mr6[0] * X[32]; a1 -= mr6[1] * X[33]; a2 -= mr6[2] * X[34]; a3 -= mr6[3] * X[35];
              mr6 = *(const LAS f32x4*)(Mm + 3140);
              __builtin_amdgcn_sched_barrier(0);
              a0 -= mr0[0] * X[36]; a1 -= mr0[1] * X[37]; a2 -= mr0[2] * X[38]; a3 -= mr0[3] * X[39];
              mr0 = *(const LAS f32x4*)(Mm + 3144);
              __builtin_amdgcn_sched_barrier(0);
              a0 -= mr1[0] * X[40]; a1 -= mr1[1] * X[41]; a2 -= mr1[2] * X[42]; a3 -= mr1[3] * X[43];
              mr1 = *(const LAS f32x4*)(Mm + 3148);
              __builtin_amdgcn_sched_barrier(0);
              a0 -= mr2[0] * X[44];
              X[45] = (a0 + a1) + (a2 + a3); dst[5940] = X[45]; }
            __builtin_amdgcn_sched_barrier(0);
            rh0 = src[6336] * cf[48];
            { float a0 = rh1, a1 = 0.f, a2 = 0.f, a3 = 0.f;
              mr2 = *(const LAS f32x4*)(Mm + 3152);
              __builtin_amdgcn_sched_barrier(0);
              a0 -= mr3[0] * X[0]; a1 -= mr3[1] * X[1]; a2 -= mr3[2] * X[2]; a3 -= mr3[3] * X[3];
              mr3 = *(const LAS f32x4*)(Mm + 3156);
              __builtin_amdgcn_sched_barrier(0);
              a0 -= mr4[0] * X[4]; a1 -= mr4[1] * X[5]; a2 -= mr4[2] * X[6]; a3 -= mr4[3] * X[7];
              mr4 = *(const LAS f32x4*)(Mm + 3160);
              __builtin_amdgcn_sched_barrier(0);
              a0 -= mr5[0] * X[8]; a1 -= mr5[1] * X[9]; a2 -= mr5[2] * X[10]; a3 -= mr5[3] * X[11];
              mr5 = *(const LAS f32x4*)(Mm + 3164);
              __builtin_amdgcn_sched_barrier(0);
              a0 -= mr6[0] * X[12]; a1 -= mr6[1] * X[13]; a2 -= mr6[2] * X[14]; a3 -= mr6[3] * X[15];
              mr6 = *(const LAS f32x4*)(Mm + 3168);
              __builtin_amdgcn_sched_barrier(0);
              a0 -= mr0[0] * X[16]; a1 -= mr0[1] * X[17]; a2 -= mr0[2] * X[18]; a3 -= mr0[3] * X[19];
              mr0 = *(const LAS f32x4*)(Mm + 3172);
              __builtin_amdgcn_sched_barrier(0);
              a0 -= mr1[0] * X[20]; a1 -= mr1[1] * X[21]; a2 -= mr1[2] * X[22]; a3 -= mr1[3] * X[23];
              mr1 = *(const LAS f32x4*)(Mm + 3196);
              __builtin_amdgcn_sched_barrier(0);
              a0 -= mr2[0] * X[24]; a1 -= mr2[1] * X[25]; a2 -= mr2[2] * X[26]; a3 -= mr2[3] * X[27];
              mr2 = *(const LAS f32x4*)(Mm + 3200);
              __builtin_amdgcn_sched_barrier(0);
              a0 -= mr3[0] * X[28]; a1 -= mr3[1] * X[29]; a2 -= mr3[2] * X[30]; a3 -= mr3[3] * X[31];
              mr3 = *(const LAS f32x4*)(Mm + 3204);
              __builtin_amdgcn_sched_barrier(0);
              a0 -= mr4[0] * X[32]; a1 -= mr4[1] * X[33]; a2 -= mr4[2] * X[34]; a3 -= mr4[3] * X[35];
              mr4 = *(const LAS f32x4*)(Mm + 3208);
              __builtin_amdgcn_sched_barrier(0);
              a0 -= mr5[0] * X[36]; a1 -= mr5[1] * X[37]; a2 -= mr5[2] * X[38]; a3 -= mr5[3] * X[39];
              mr5 = *(const LAS f32x4*)(Mm + 3212);
              __builtin_amdgcn_sched_barrier(0);
              a0 -= mr6[0] * X[40]; a1 -= mr6[1] * X[41]; a2 -= mr6[2] * X[42]; a3 -= mr6[3] * X[43];
              mr6 = *(const LAS f32x4*)(Mm + 3216);
              __builtin_amdgcn_sched_barrier(0);
              a0 -= mr0[0] * X[44]; a1 -= mr0[1] * X[45];
              X[46] = (a0 + a1) + (a2 + a3); dst[6072] = X[46]; }
            __builtin_amdgcn_sched_barrier(0);
            rh1 = src[6468] * cf[49];
            { float a0 = rh2, a1 = 0.f, a2 = 0.f, a3 = 0.f;
              mr0 = *(const LAS f32x4*)(Mm + 3220);
              __builtin_amdgcn_sched_barrier(0);
              a0 -= mr1[0] * X[0]; a1 -= mr1[1] * X[1]; a2 -= mr1[2] * X[2]; a3 -= mr1[3] * X[3];
              mr1 = *(const LAS f32x4*)(Mm + 3224);
              __builtin_amdgcn_sched_barrier(0);
              a0 -= mr2[0] * X[4]; a1 -= mr2[1] * X[5]; a2 -= mr2[2] * X[6]; a3 -= mr2[3] * X[7];
              mr2 = *(const LAS f32x4*)(Mm + 3228);
              __builtin_amdgcn_sched_barrier(0);
              a0 -= mr3[0] * X[8]; a1 -= mr3[1] * X[9]; a2 -= mr3[2] * X[10]; a3 -= mr3[3] * X[11];
              mr3 = *(const LAS f32x4*)(Mm + 3232);
              __builtin_amdgcn_sched_barrier(0);
              a0 -= mr4[0] * X[12]; a1 -= mr4[1] * X[13]; a2 -= mr4[2] * X[14]; a3 -= mr4[3] * X[15];
              mr4 = *(const LAS f32x4*)(Mm + 3236);
              __builtin_amdgcn_sched_barrier(0);
              a0 -= mr5[0] * X[16]; a1 -= mr5[1] * X[17]; a2 -= mr5[2] * X[18]; a3 -= mr5[3] * X[19];
              mr5 = *(const LAS f32x4*)(Mm + 3240);
              __builtin_amdgcn_sched_barrier(0);
              a0 -= mr6[0] * X[20]; a1 -= mr6[1] * X[21]; a2 -= mr6[2] * X[22]; a3 -= mr6[3] * X[23];
              mr6 = *(const LAS f32x4*)(Mm + 3264);
              __builtin_amdgcn_sched_barrier(0);
              a0 -= mr0[0] * X[24]; a1 -= mr0[1] * X[25]; a2 -= mr0[2] * X[26]; a3 -= mr0[3] * X[27];
              mr0 = *(const LAS f32x4*)(Mm + 3268);
              __builtin_amdgcn_sched_barrier(0);
              a0 -= mr1[0] * X[28]; a1 -= mr1[1] * X[29]; a2 -= mr1[2] * X[30]; a3 -= mr1[3] * X[31];
              mr1 = *(const LAS f32x4*)(Mm + 3272);
              __builtin_amdgcn_sched_barrier(0);
              a0 -= mr2[0] * X[32]; a1 -= mr2[1] * X[33]; a2 -= mr2[2] * X[34]; a3 -= mr2[3] * X[35];
              mr2 = *(const LAS f32x4*)(Mm + 3276);
              __builtin_amdgcn_sched_barrier(0);
              a0 -= mr3[0] * X[36]; a1 -= mr3[1] * X[37]; a2 -= mr3[2] * X[38]; a3 -= mr3[3] * X[39];
              mr3 = *(const LAS f32x4*)(Mm + 3280);
              __builtin_amdgcn_sched_barrier(0);
              a0 -= mr4[0] * X[40]; a1 -= mr4[1] * X[41]; a2 -= mr4[2] * X[42]; a3 -= mr4[3] * X[43];
              mr4 = *(const LAS f32x4*)(Mm + 3284);
              __builtin_amdgcn_sched_barrier(0);
              a0 -= mr5[0] * X[44]; a1 -= mr5[1] * X[45]; a2 -= mr5[2] * X[46];
              X[47] = (a0 + a1) + (a2 + a3); dst[6204] = X[47]; }
            __builtin_amdgcn_sched_barrier(0);
            rh2 = src[6600] * cf[50];
            { float a0 = rh0, a1 = 0.f, a2 = 0.f, a3 = 0.f;
              mr5 = *(const LAS f32x4*)(Mm + 3288);
              __builtin_amdgcn_sched_barrier(0);
              a0 -= mr6[0] * X[0]; a1 -= mr6[1] * X[1]; a2 -= mr6[2] * X[2]; a3 -= mr6[3] * X[3];
              mr6 = *(const LAS f32x4*)(Mm + 3292);
              __builtin_amdgcn_sched_barrier(0);
              a0 -= mr0[0] * X[4]; a1 -= mr0[1] * X[5]; a2 -= mr0[2] * X[6]; a3 -= mr0[3] * X[7];
              mr0 = *(const LAS f32x4*)(Mm + 3296);
              __builtin_amdgcn_sched_barrier(0);
              a0 -= mr1[0] * X[8]; a1 -= mr1[1] * X[9]; a2 -= mr1[2] * X[10]; a3 -= mr1[3] * X[11];
              mr1 = *(const LAS f32x4*)(Mm + 3300);
              __builtin_amdgcn_sched_barrier(0);
              a0 -= mr2[0] * X[12]; a1 -= mr2[1] * X[13]; a2 -= mr2[2] * X[14]; a3 -= mr2[3] * X[15];
              mr2 = *(const LAS f32x4*)(Mm + 3304);
              __builtin_amdgcn_sched_barrier(0);
              a0 -= mr3[0] * X[16]; a1 -= mr3[1] * X[17]; a2 -= mr3[2] * X[18]; a3 -= mr3[3] * X[19];
              mr3 = *(const LAS f32x4*)(Mm + 3308);
              __builtin_amdgcn_sched_barrier(0);
              a0 -= mr4[0] * X[20]; a1 -= mr4[1] * X[21]; a2 -= mr4[2] * X[22]; a3 -= mr4[3] * X[23];
              mr4 = *(const LAS f32x4*)(Mm + 3332);
              __builtin_amdgcn_sched_barrier(0);
              a0 -= mr5[0] * X[24]; a1 -= mr5[1] * X[25]; a2 -= mr5[2] * X[26]; a3 -= mr5[3] * X[27];
              mr5 = *(const LAS f32x4*)(Mm + 3336);
              __builtin_amdgcn_sched_barrier(0);
              a0 -= mr6[0] * X[28]; a1 -= mr6[1] * X[29]; a2 -= mr6[2] * X[30]; a3 -= mr6[3] * X[31];
              mr6 = *(const LAS f32x4*)(Mm + 3340);
              __builtin_amdgcn_sched_barrier(0);
              a0 -= mr0[0] * X[32]; a1 -= mr0[1] * X[33]; a2 -= mr0[2] * X[34]; a3 -= mr0[3] * X[35];
              mr0 = *(const LAS f32x4*)(Mm + 3344);
              __builtin_amdgcn_sched_barrier(0);
              a0 -= mr1[0] * X[36]; a1 -= mr1[1] * X[37]; a2 -= mr1[2] * X[38]; a3 -= mr1[3] * X[39];
              mr1 = *(const LAS f32x4*)(Mm + 3348);
              __builtin_amdgcn_sched_barrier(0);
              a0 -= mr2[0] * X[40]; a1 -= mr2[1] * X[41]; a2 -= mr2[2] * X[42]; a3 -= mr2[3] * X[43];
              mr2 = *(const LAS f32x4*)(Mm + 3352);
              __builtin_amdgcn_sched_barrier(0);
              a0 -= mr3[0] * X[44]; a1 -= mr3[1] * X[45]; a2 -= mr3[2] * X[46]; a3 -= mr3[3] * X[47];
              X[48] = (a0 + a1) + (a2 + a3); dst[6336] = X[48]; }
            __builtin_amdgcn_sched_barrier(0);
            rh0 = src[6732] * cf[51];
            { float a0 = rh1, a1 = 0.f, a2 = 0.f, a3 = 0.f;
              mr3 = *(const LAS f32x4*)(Mm + 3356);
              __builtin_amdgcn_sched_barrier(0);
              a0 -= mr4[0] * X[0]; a1 -= mr4[1] * X[1]; a2 -= mr4[2] * X[2]; a3 -= mr4[3] * X[3];
              mr4 = *(const LAS f32x4*)(Mm + 3360);
              __builtin_amdgcn_sched_barrier(0);
              a0 -= mr5[0] * X[4]; a1 -= mr5[1] * X[5]; a2 -= mr5[2] * X[6]; a3 -= mr5[3] * X[7];
              mr5 = *(const LAS f32x4*)(Mm + 3364);
              __builtin_amdgcn_sched_barrier(0);
              a0 -= mr6[0] * X[8]; a1 -= mr6[1] * X[9]; a2 -= mr6[2] * X[10]; a3 -= mr6[3] * X[11];
              mr6 = *(const LAS f32x4*)(Mm + 3368);
              __builtin_amdgcn_sched_barrier(0);
              a0 -= mr0[0] * X[12]; a1 -= mr0[1] * X[13]; a2 -= mr0[2] * X[14]; a3 -= mr0[3] * X[15];
              mr0 = *(const LAS f32x4*)(Mm + 3372);
              __builtin_amdgcn_sched_barrier(0);
              a0 -= mr1[0] * X[16]; a1 -= mr1[1] * X[17]; a2 -= mr1[2] * X[18]; a3 -= mr1[3] * X[19];
              mr1 = *(const LAS f32x4*)(Mm + 3376);
              __builtin_amdgcn_sched_barrier(0);
              a0 -= mr2[0] * X[20]; a1 -= mr2[1] * X[21]; a2 -= mr2[2] * X[22]; a3 -= mr2[3] * X[23];
              mr2 = *(const LAS f32x4*)(Mm + 3380);
              __builtin_amdgcn_sched_barrier(0);
              a0 -= mr3[0] * X[24]; a1 -= mr3[1] * X[25]; a2 -= mr3[2] * X[26]; a3 -= mr3[3] * X[27];
              mr3 = *(const LAS f32x4*)(Mm + 3400);
              __builtin_amdgcn_sched_barrier(0);
              a0 -= mr4[0] * X[28]; a1 -= mr4[1] * X[29]; a2 -= mr4[2] * X[30]; a3 -= mr4[3] * X[31];
              mr4 = *(const LAS f32x4*)(Mm + 3404);
              __builtin_amdgcn_sched_barrier(0);
              a0 -= mr5[0] * X[32]; a1 -= mr5[1] * X[33]; a2 -= mr5[2] * X[34]; a3 -= mr5[3] * X[35];
              mr5 = *(const LAS f32x4*)(Mm + 3408);
              __builtin_amdgcn_sched_barrier(0);
              a0 -= mr6[0] * X[36]; a1 -= mr6[1] * X[37]; a2 -= mr6[2] * X[38]; a3 -= mr6[3] * X[39];
              mr6 = *(const LAS f32x4*)(Mm + 3412);
              __builtin_amdgcn_sched_barrier(0);
              a0 -= mr0[0] * X[40]; a1 -= mr0[1] * X[41]; a2 -= mr0[2] * X[42]; a3 -= mr0[3] * X[43];
              mr0 = *(const LAS f32x4*)(Mm + 3416);
              __builtin_amdgcn_sched_barrier(0);
              a0 -= mr1[0] * X[44]; a1 -= mr1[1] * X[45]; a2 -= mr1[2] * X[46]; a3 -= mr1[3] * X[47];
              mr1 = *(const LAS f32x4*)(Mm + 3420);
              __builtin_amdgcn_sched_barrier(0);
              a0 -= mr2[0] * X[48];
              X[49] = (a0 + a1) + (a2 + a3); dst[6468] = X[49]; }
            __builtin_amdgcn_sched_barrier(0);
            rh1 = src[6864] * cf[52];
            { float a0 = rh2, a1 = 0.f, a2 = 0.f, a3 = 0.f;
              mr2 = *(const LAS f32x4*)(Mm + 3424);
              __builtin_amdgcn_sched_barrier(0);
              a0 -= mr3[0] * X[0]; a1 -= mr3[1] * X[1]; a2 -= mr3[2] * X[2]; a3 -= mr3[3] * X[3];
              mr3 = *(const LAS f32x4*)(Mm + 3428);
              __builtin_amdgcn_sched_barrier(0);
              a0 -= mr4[0] * X[4]; a1 -= mr4[1] * X[5]; a2 -= mr4[2] * X[6]; a3 -= mr4[3] * X[7];
              mr4 = *(const LAS f32x4*)(Mm + 3432);
              __builtin_amdgcn_sched_barrier(0);
              a0 -= mr5[0] * X[8]; a1 -= mr5[1] * X[9]; a2 -= mr5[2] * X[10]; a3 -= mr5[3] * X[11];
              mr5 = *(const LAS f32x4*)(Mm + 3436);
              __builtin_amdgcn_sched_barrier(0);
              a0 -= mr6[0] * X[12]; a1 -= mr6[1] * X[13]; a2 -= mr6[2] * X[14]; a3 -= mr6[3] * X[15];
              mr6 = *(const LAS f32x4*)(Mm + 3440);
              __builtin_amdgcn_sched_barrier(0);
              a0 -= mr0[0] * X[16]; a1 -= mr0[1] * X[17]; a2 -= mr0[2] * X[18]; a3 -= mr0[3] * X[19];
              mr0 = *(const LAS f32x4*)(Mm + 3444);
              __builtin_amdgcn_sched_barrier(0);
              a0 -= mr1[0] * X[20]; a1 -= mr1[1] * X[21]; a2 -= mr1[2] * X[22]; a3 -= mr1[3] * X[23];
              mr1 = *(const LAS f32x4*)(Mm + 3448);
              __builtin_amdgcn_sched_barrier(0);
              a0 -= mr2[0] * X[24]; a1 -= mr2[1] * X[25]; a2 -= mr2[2] * X[26]; a3 -= mr2[3] * X[27];
              mr2 = *(const LAS f32x4*)(Mm + 3468);
              __builtin_amdgcn_sched_barrier(0);
              a0 -= mr3[0] * X[28]; a1 -= mr3[1] * X[29]; a2 -= mr3[2] * X[30]; a3 -= mr3[3] * X[31];
              mr3 = *(const LAS f32x4*)(Mm + 3472);
              __builtin_amdgcn_sched_barrier(0);
              a0 -= mr4[0] * X[32]; a1 -= mr4[1] * X[33]; a2 -= mr4[2] * X[34]; a3 -= mr4[3] * X[35];
              mr4 = *(const LAS f32x4*)(Mm + 3476);
              __builtin_amdgcn_sched_barrier(0);
              a0 -= mr5[0] * X[36]; a1 -= mr5[1] * X[37]; a2 -= mr5[2] * X[38]; a3 -= mr5[3] * X[39];
              mr5 = *(const LAS f32x4*)(Mm + 3480);
              __builtin_amdgcn_sched_barrier(0);
              a0 -= mr6[0] * X[40]; a1 -= mr6[1] * X[41]; a2 -= mr6[2] * X[42]; a3 -= mr6[3] * X[43];
              mr6 = *(const LAS f32x4*)(Mm + 3484);
              __builtin_amdgcn_sched_barrier(0);
              a0 -= mr0[0] * X[44]; a1 -= mr0[1] * X[45]; a2 -= mr0[2] * X[46]; a3 -= mr0[3] * X[47];
              mr0 = *(const LAS f32x4*)(Mm + 3488);
              __builtin_amdgcn_sched_barrier(0);
              a0 -= mr1[0] * X[48]; a1 -= mr1[1] * X[49];
              X[50] = (a0 + a1) + (a2 + a3); dst[6600] = X[50]; }
            __builtin_amdgcn_sched_barrier(0);
            rh2 = src[6996] * cf[53];
            { float a0 = rh0, a1 = 0.f, a2 = 0.f, a3 = 0.f;
              mr1 = *(const LAS f32x4*)(Mm + 3492);
              __builtin_amdgcn_sched_barrier(0);
              a0 -= mr2[0] * X[0]; a1 -= mr2[1] * X[1]; a2 -= mr2[2] * X[2]; a3 -= mr2[3] * X[3];
              mr2 = *(const LAS f32x4*)(Mm + 3496);
              __builtin_amdgcn_sched_barrier(0);
              a0 -= mr3[0] * X[4]; a1 -= mr3[1] * X[5]; a2 -= mr3[2] * X[6]; a3 -= mr3[3] * X[7];
              mr3 = *(const LAS f32x4*)(Mm + 3500);
              __builtin_amdgcn_sched_barrier(0);
              a0 -= mr4[0] * X[8]; a1 -= mr4[1] * X[9]; a2 -= mr4[2] * X[10]; a3 -= mr4[3] * X[11];
              mr4 = *(const LAS f32x4*)(Mm + 3504);
              __builtin_amdgcn_sched_barrier(0);
              a0 -= mr5[0] * X[12]; a1 -= mr5[1] * X[13]; a2 -= mr5[2] * X[14]; a3 -= mr5[3] * X[15];
              mr5 = *(const LAS f32x4*)(Mm + 3508);
              __builtin_amdgcn_sched_barrier(0);
              a0 -= mr6[0] * X[16]; a1 -= mr6[1] * X[17]; a2 -= mr6[2] * X[18]; a3 -= mr6[3] * X[19];
              mr6 = *(const LAS f32x4*)(Mm + 3512);
              __builtin_amdgcn_sched_barrier(0);
              a0 -= mr0[0] * X[20]; a1 -= mr0[1] * X[21]; a2 -= mr0[2] * X[22]; a3 -= mr0[3] * X[23];
              mr0 = *(const LAS f32x4*)(Mm + 3516);
              __builtin_amdgcn_sched_barrier(0);
              a0 -= mr1[0] * X[24]; a1 -= mr1[1] * X[25]; a2 -= mr1[2] * X[26]; a3 -= mr1[3] * X[27];
              mr1 = *(const LAS f32x4*)(Mm + 3536);
              __builtin_amdgcn_sched_barrier(0);
              a0 -= mr2[0] * X[28]; a1 -= mr2[1] * X[29]; a2 -= mr2[2] * X[30]; a3 -= mr2[3] * X[31];
              mr2 = *(const LAS f32x4*)(Mm + 3540);
              __builtin_amdgcn_sched_barrier(0);
              a0 -= mr3[0] * X[32]; a1 -= mr3[1] * X[33]; a2 -= mr3[2] * X[34]; a3 -= mr3[3] * X[35];
              mr3 = *(const LAS f32x4*)(Mm + 3544);
              __builtin_amdgcn_sched_barrier(0);
              a0 -= mr4[0] * X[36]; a1 -= mr4[1] * X[37]; a2 -= mr4[2] * X[38]; a3 -= mr4[3] * X[39];
              mr4 = *(const LAS f32x4*)(Mm + 3548);
              __builtin_amdgcn_sched_barrier(0);
              a0 -= mr5[0] * X[40]; a1 -= mr5[1] * X[41]; a2 -= mr5[2] * X[42]; a3 -= mr5[3] * X[43];
              mr5 = *(const LAS f32x4*)(Mm + 3552);
              __builtin_amdgcn_sched_barrier(0);
              a0 -= mr6[0] * X[44]; a1 -= mr6[1] * X[45]; a2 -= mr6[2] * X[46]; a3 -= mr6[3] * X[47];
              mr6 = *(const LAS f32x4*)(Mm + 3556);
              __builtin_amdgcn_sched_barrier(0);
              a0 -= mr0[0] * X[48]; a1 -= mr0[1] * X[49]; a2 -= mr0[2] * X[50];
              X[51] = (a0 + a1) + (a2 + a3); dst[6732] = X[51]; }
            __builtin_amdgcn_sched_barrier(0);
            rh0 = src[7128] * cf[54];
            { float a0 = rh1, a1 = 0.f, a2 = 0.f, a3 = 0.f;
              mr0 = *(const LAS f32x4*)(Mm + 3560);
              __builtin_amdgcn_sched_barrier(0);
              a0 -= mr1[0] * X[0]; a1 -= mr1[1] * X[1]; a2 -= mr1[2] * X[2]; a3 -= mr1[3] * X[3];
              mr1 = *(const LAS f32x4*)(Mm + 3564);
              __builtin_amdgcn_sched_barrier(0);
              a0 -= mr2[0] * X[4]; a1 -= mr2[1] * X[5]; a2 -= mr2[2] * X[6]; a3 -= mr2[3] * X[7];
              mr2 = *(const LAS f32x4*)(Mm + 3568);
              __builtin_amdgcn_sched_barrier(0);
              a0 -= mr3[0] * X[8]; a1 -= mr3[1] * X[9]; a2 -= mr3[2] * X[10]; a3 -= mr3[3] * X[11];
              mr3 = *(const LAS f32x4*)(Mm + 3572);
              __builtin_amdgcn_sched_barrier(0);
              a0 -= mr4[0] * X[12]; a1 -= mr4[1] * X[13]; a2 -= mr4[2] * X[14]; a3 -= mr4[3] * X[15];
              mr4 = *(const LAS f32x4*)(Mm + 3576);
              __builtin_amdgcn_sched_barrier(0);
              a0 -= mr5[0] * X[16]; a1 -= mr5[1] * X[17]; a2 -= mr5[2] * X[18]; a3 -= mr5[3] * X[19];
              mr5 = *(const LAS f32x4*)(Mm + 3580);
              __builtin_amdgcn_sched_barrier(0);
              a0 -= mr6[0] * X[20]; a1 -= mr6[1] * X[21]; a2 -= mr6[2] * X[22]; a3 -= mr6[3] * X[23];
              mr6 = *(const LAS f32x4*)(Mm + 3584);
              __builtin_amdgcn_sched_barrier(0);
              a0 -= mr0[0] * X[24]; a1 -= mr0[1] * X[25]; a2 -= mr0[2] * X[26]; a3 -= mr0[3] * X[27];
              mr0 = *(const LAS f32x4*)(Mm + 3604);
              __builtin_amdgcn_sched_barrier(0);
              a0 -= mr1[0] * X[28]; a1 -= mr1[1] * X[29]; a2 -= mr1[2] * X[30]; a3 -= mr1[3] * X[31];
              mr1 = *(const LAS f32x4*)(Mm + 3608);
              __builtin_amdgcn_sched_barrier(0);
              a0 -= mr2[0] * X[32]; a1 -= mr2[1] * X[33]; a2 -= mr2[2] * X[34]; a3 -= mr2[3] * X[35];
              mr2 = *(const LAS f32x4*)(Mm + 3612);
              __builtin_amdgcn_sched_barrier(0);
              a0 -= mr3[0] * X[36]; a1 -= mr3[1] * X[37]; a2 -= mr3[2] * X[38]; a3 -= mr3[3] * X[39];
              mr3 = *(const LAS f32x4*)(Mm + 3616);
              __builtin_amdgcn_sched_barrier(0);
              a0 -= mr4[0] * X[40]; a1 -= mr4[1] * X[41]; a2 -= mr4[2] * X[42]; a3 -= mr4[3] * X[43];
              mr4 = *(const LAS f32x4*)(Mm + 3620);
              __builtin_amdgcn_sched_barrier(0);
              a0 -= mr5[0] * X[44]; a1 -= mr5[1] * X[45]; a2 -= mr5[2] * X[46]; a3 -= mr5[3] * X[47];
              mr5 = *(const LAS f32x4*)(Mm + 3624);
              __builtin_amdgcn_sched_barrier(0);
              a0 -= mr6[0] * X[48]; a1 -= mr6[1] * X[49]; a2 -= mr6[2] * X[50]; a3 -= mr6[3] * X[51];
              X[52] = (a0 + a1) + (a2 + a3); dst[6864] = X[52]; }
            __builtin_amdgcn_sched_barrier(0);
            rh1 = src[7260] * cf[55];
            { float a0 = rh2, a1 = 0.f, a2 = 0.f, a3 = 0.f;
              mr6 = *(const LAS f32x4*)(Mm + 3628);
              __builtin_amdgcn_sched_barrier(0);
              a0 -= mr0[0] * X[0]; a1 -= mr0[1] * X[1]; a2 -= mr0[2] * X[2]; a3 -= mr0[3] * X[3];
              mr0 = *(const LAS f32x4*)(Mm + 3632);
              __builtin_amdgcn_sched_barrier(0);
              a0 -= mr1[0] * X[4]; a1 -= mr1[1] * X[5]; a2 -= mr1[2] * X[6]; a3 -= mr1[3] * X[7];
              mr1 = *(const LAS f32x4*)(Mm + 3636);
              __builtin_amdgcn_sched_barrier(0);
              a0 -= mr2[0] * X[8]; a1 -= mr2[1] * X[9]; a2 -= mr2[2] * X[10]; a3 -= mr2[3] * X[11];
              mr2 = *(const LAS f32x4*)(Mm + 3640);
              __builtin_amdgcn_sched_barrier(0);
              a0 -= mr3[0] * X[12]; a1 -= mr3[1] * X[13]; a2 -= mr3[2] * X[14]; a3 -= mr3[3] * X[15];
              mr3 = *(const LAS f32x4*)(Mm + 3644);
              __builtin_amdgcn_sched_barrier(0);
              a0 -= mr4[0] * X[16]; a1 -= mr4[1] * X[17]; a2 -= mr4[2] * X[18]; a3 -= mr4[3] * X[19];
              mr4 = *(const LAS f32x4*)(Mm + 3648);
              __builtin_amdgcn_sched_barrier(0);
              a0 -= mr5[0] * X[20]; a1 -= mr5[1] * X[21]; a2 -= mr5[2] * X[22]; a3 -= mr5[3] * X[23];
              mr5 = *(const LAS f32x4*)(Mm + 3652);
              __builtin_amdgcn_sched_barrier(0);
              a0 -= mr6[0] * X[24]; a1 -= mr6[1] * X[25]; a2 -= mr6[2] * X[26]; a3 -= mr6[3] * X[27];
              mr6 = *(const LAS f32x4*)(Mm + 3656);
              __builtin_amdgcn_sched_barrier(0);
              a0 -= mr0[0] * X[28]; a1 -= mr0[1] * X[29]; a2 -= mr0[2] * X[30]; a3 -= mr0[3] * X[31];
              mr0 = *(const LAS f32x4*)(Mm + 3672);
              __builtin_amdgcn_sched_barrier(0);
              a0 -= mr1[0] * X[32]; a1 -= mr1[1] * X[33]; a2 -= mr1[2] * X[34]; a3 -= mr1[3] * X[35];
              mr1 = *(const LAS f32x4*)(Mm + 3676);
              __builtin_amdgcn_sched_barrier(0);
              a0 -= mr2[0] * X[36]; a1 -= mr2[1] * X[37]; a2 -= mr2[2] * X[38]; a3 -= mr2[3] * X[39];
              mr2 = *(const LAS f32x4*)(Mm + 3680);
              __builtin_amdgcn_sched_barrier(0);
              a0 -= mr3[0] * X[40]; a1 -= mr3[1] * X[41]; a2 -= mr3[2] * X[42]; a3 -= mr3[3] * X[43];
              mr3 = *(const LAS f32x4*)(Mm + 3684);
              __builtin_amdgcn_sched_barrier(0);
              a0 -= mr4[0] * X[44]; a1 -= mr4[1] * X[45]; a2 -= mr4[2] * X[46]; a3 -= mr4[3] * X[47];
              mr4 = *(const LAS f32x4*)(Mm + 3688);
              __builtin_amdgcn_sched_barrier(0);
              a0 -= mr5[0] * X[48]; a1 -= mr5[1] * X[49]; a2 -= mr5[2] * X[50]; a3 -= mr5[3] * X[51];
              mr5 = *(const LAS f32x4*)(Mm + 3692);
              __builtin_amdgcn_sched_barrier(0);
              a0 -= mr6[0] * X[52];
              X[53] = (a0 + a1) + (a2 + a3); dst[6996] = X[53]; }
            __builtin_amdgcn_sched_barrier(0);
            rh2 = src[7392] * cf[56];
            { float a0 = rh0, a1 = 0.f, a2 = 0.f, a3 = 0.f;
              mr6 = *(const LAS f32x4*)(Mm + 3696);
              __builtin_amdgcn_sched_barrier(0);
              a0 -= mr0[0] * X[0]; a1 -= mr0[1] * X[1]; a2 -= mr0[2] * X[2]; a3 -= mr0[3] * X[3];
              mr0 = *(const LAS f32x4*)(Mm + 3700);
              __builtin_amdgcn_sched_barrier(0);
              a0 -= mr1[0] * X[4]; a1 -= mr1[1] * X[5]; a2 -= mr1[2] * X[6]; a3 -= mr1[3] * X[7];
              mr1 = *(const LAS f32x4*)(Mm + 3704);
              __builtin_amdgcn_sched_barrier(0);
              a0 -= mr2[0] * X[8]; a1 -= mr2[1] * X[9]; a2 -= mr2[2] * X[10]; a3 -= mr2[3] * X[11];
              mr2 = *(const LAS f32x4*)(Mm + 3708);
              __builtin_amdgcn_sched_barrier(0);
              a0 -= mr3[0] * X[12]; a1 -= mr3[1] * X[13]; a2 -= mr3[2] * X[14]; a3 -= mr3[3] * X[15];
              mr3 = *(const LAS f32x4*)(Mm + 3712);
              __builtin_amdgcn_sched_barrier(0);
              a0 -= mr4[0] * X[16]; a1 -= mr4[1] * X[17]; a2 -= mr4[2] * X[18]; a3 -= mr4[3] * X[19];
              mr4 = *(const LAS f32x4*)(Mm + 3716);
              __builtin_amdgcn_sched_barrier(0);
              a0 -= mr5[0] * X[20]; a1 -= mr5[1] * X[21]; a2 -= mr5[2] * X[22]; a3 -= mr5[3] * X[23];
              mr5 = *(const LAS f32x4*)(Mm + 3720);
              __builtin_amdgcn_sched_barrier(0);
              a0 -= mr6[0] * X[24]; a1 -= mr6[1] * X[25]; a2 -= mr6[2] * X[26]; a3 -= mr6[3] * X[27];
              mr6 = *(const LAS f32x4*)(Mm + 3724);
              __builtin_amdgcn_sched_barrier(0);
              a0 -= mr0[0] * X[28]; a1 -= mr0[1] * X[29]; a2 -= mr0[2] * X[30]; a3 -= mr0[3] * X[31];
              mr0 = *(const LAS f32x4*)(Mm + 3740);
              __builtin_amdgcn_sched_barrier(0);
              a0 -= mr1[0] * X[32]; a1 -= mr1[1] * X[33]; a2 -= mr1[2] * X[34]; a3 -= mr1[3] * X[35];
              mr1 = *(const LAS f32x4*)(Mm + 3744);
              __builtin_amdgcn_sched_barrier(0);
              a0 -= mr2[0] * X[36]; a1 -= mr2[1] * X[37]; a2 -= mr2[2] * X[38]; a3 -= mr2[3] * X[39];
              mr2 = *(const LAS f32x4*)(Mm + 3748);
              __builtin_amdgcn_sched_barrier(0);
              a0 -= mr3[0] * X[40]; a1 -= mr3[1] * X[41]; a2 -= mr3[2] * X[42]; a3 -= mr3[3] * X[43];
              mr3 = *(const LAS f32x4*)(Mm + 3752);
              __builtin_amdgcn_sched_barrier(0);
              a0 -= mr4[0] * X[44]; a1 -= mr4[1] * X[45]; a2 -= mr4[2] * X[46]; a3 -= mr4[3] * X[47];
              mr4 = *(const LAS f32x4*)(Mm + 3756);
              __builtin_amdgcn_sched_barrier(0);
              a0 -= mr5[0] * X[48]; a1 -= mr5[1] * X[49]; a2 -= mr5[2] * X[50]; a3 -= mr5[3] * X[51];
              mr5 = *(const LAS f32x4*)(Mm + 3760);
              __builtin_amdgcn_sched_barrier(0);
              a0 -= mr6[0] * X[52]; a1 -= mr6[1] * X[53];
              X[54] = (a0 + a1) + (a2 + a3); dst[7128] = X[54]; }
            __builtin_amdgcn_sched_barrier(0);
            rh0 = src[7524] * cf[57];
            { float a0 = rh1, a1 = 0.f, a2 = 0.f, a3 = 0.f;
              mr6 = *(const LAS f32x4*)(Mm + 3764);
              __builtin_amdgcn_sched_barrier(0);
              a0 -= mr0[0] * X[0]; a1 -= mr0[1] * X[1]; a2 -= mr0[2] * X[2]; a3 -= mr0[3] * X[3];
              mr0 = *(const LAS f32x4*)(Mm + 3768);
              __builtin_amdgcn_sched_barrier(0);
              a0 -= mr1[0] * X[4]; a1 -= mr1[1] * X[5]; a2 -= mr1[2] * X[6]; a3 -= mr1[3] * X[7];
              mr1 = *(const LAS f32x4*)(Mm + 3772);
              __builtin_amdgcn_sched_barrier(0);
              a0 -= mr2[0] * X[8]; a1 -= mr2[1] * X[9]; a2 -= mr2[2] * X[10]; a3 -= mr2[3] * X[11];
              mr2 = *(const LAS f32x4*)(Mm + 3776);
              __builtin_amdgcn_sched_barrier(0);
              a0 -= mr3[0] * X[12]; a1 -= mr3[1] * X[13]; a2 -= mr3[2] * X[14]; a3 -= mr3[3] * X[15];
              mr3 = *(const LAS f32x4*)(Mm + 3780);
              __builtin_amdgcn_sched_barrier(0);
              a0 -= mr4[0] * X[16]; a1 -= mr4[1] * X[17]; a2 -= mr4[2] * X[18]; a3 -= mr4[3] * X[19];
              mr4 = *(const LAS f32x4*)(Mm + 3784);
              __builtin_amdgcn_sched_barrier(0);
              a0 -= mr5[0] * X[20]; a1 -= mr5[1] * X[21]; a2 -= mr5[2] * X[22]; a3 -= mr5[3] * X[23];
              mr5 = *(const LAS f32x4*)(Mm + 3788);
              __builtin_amdgcn_sched_barrier(0);
              a0 -= mr6[0] * X[24]; a1 -= mr6[1] * X[25]; a2 -= mr6[2] * X[26]; a3 -= mr6[3] * X[27];
              mr6 = *(const LAS f32x4*)(Mm + 3792);
              __builtin_amdgcn_sched_barrier(0);
              a0 -= mr0[0] * X[28]; a1 -= mr0[1] * X[29]; a2 -= mr0[2] * X[30]; a3 -= mr0[3] * X[31];
              mr0 = *(const LAS f32x4*)(Mm + 3808);
              __builtin_amdgcn_sched_barrier(0);
              a0 -= mr1[0] * X[32]; a1 -= mr1[1] * X[33]; a2 -= mr1[2] * X[34]; a3 -= mr1[3] * X[35];
              mr1 = *(const LAS f32x4*)(Mm + 3812);
              __builtin_amdgcn_sched_barrier(0);
              a0 -= mr2[0] * X[36]; a1 -= mr2[1] * X[37]; a2 -= mr2[2] * X[38]; a3 -= mr2[3] * X[39];
              mr2 = *(const LAS f32x4*)(Mm + 3816);
              __builtin_amdgcn_sched_barrier(0);
              a0 -= mr3[0] * X[40]; a1 -= mr3[1] * X[41]; a2 -= mr3[2] * X[42]; a3 -= mr3[3] * X[43];
              mr3 = *(const LAS f32x4*)(Mm + 3820);
              __builtin_amdgcn_sched_barrier(0);
              a0 -= mr4[0] * X[44]; a1 -= mr4[1] * X[45]; a2 -= mr4[2] * X[46]; a3 -= mr4[3] * X[47];
              mr4 = *(const LAS f32x4*)(Mm + 3824);
              __builtin_amdgcn_sched_barrier(0);
              a0 -= mr5[0] * X[48]; a1 -= mr5[1] * X[49]; a2 -= mr5[2] * X[50]; a3 -= mr5[3] * X[51];
              mr5 = *(const LAS f32x4*)(Mm + 3828);
              __builtin_amdgcn_sched_barrier(0);
              a0 -= mr6[0] * X[52]; a1 -= mr6[1] * X[53]; a2 -= mr6[2] * X[54];
              X[55] = (a0 + a1) + (a2 + a3); dst[7260] = X[55]; }
            __builtin_amdgcn_sched_barrier(0);
            rh1 = src[7656] * cf[58];
            { float a0 = rh2, a1 = 0.f, a2 = 0.f, a3 = 0.f;
              mr6 = *(const LAS f32x4*)(Mm + 3832);
              __builtin_amdgcn_sched_barrier(0);
              a0 -= mr0[0] * X[0]; a1 -= mr0[1] * X[1]; a2 -= mr0[2] * X[2]; a3 -= mr0[3] * X[3];
              mr0 = *(const LAS f32x4*)(Mm + 3836);
              __builtin_amdgcn_sched_barrier(0);
              a0 -= mr1[0] * X[4]; a1 -= mr1[1] * X[5]; a2 -= mr1[2] * X[6]; a3 -= mr1[3] * X[7];
              mr1 = *(const LAS f32x4*)(Mm + 3840);
              __builtin_amdgcn_sched_barrier(0);
              a0 -= mr2[0] * X[8]; a1 -= mr2[1] * X[9]; a2 -= mr2[2] * X[10]; a3 -= mr2[3] * X[11];
              mr2 = *(const LAS f32x4*)(Mm + 3844);
              __builtin_amdgcn_sched_barrier(0);
              a0 -= mr3[0] * X[12]; a1 -= mr3[1] * X[13]; a2 -= mr3[2] * X[14]; a3 -= mr3[3] * X[15];
              mr3 = *(const LAS f32x4*)(Mm + 3848);
              __builtin_amdgcn_sched_barrier(0);
              a0 -= mr4[0] * X[16]; a1 -= mr4[1] * X[17]; a2 -= mr4[2] * X[18]; a3 -= mr4[3] * X[19];
              mr4 = *(const LAS f32x4*)(Mm + 3852);
              __builtin_amdgcn_sched_barrier(0);
              a0 -= mr5[0] * X[20]; a1 -= mr5[1] * X[21]; a2 -= mr5[2] * X[22]; a3 -= mr5[3] * X[23];
              mr5 = *(const LAS f32x4*)(Mm + 3856);
              __builtin_amdgcn_sched_barrier(0);
              a0 -= mr6[0] * X[24]; a1 -= mr6[1] * X[25]; a2 -= mr6[2] * X[26]; a3 -= mr6[3] * X[27];
              mr6 = *(const LAS f32x4*)(Mm + 3860);
              __builtin_amdgcn_sched_barrier(0);
              a0 -= mr0[0] * X[28]; a1 -= mr0[1] * X[29]; a2 -= mr0[2] * X[30]; a3 -= mr0[3] * X[31];
              mr0 = *(const LAS f32x4*)(Mm + 3876);
              __builtin_amdgcn_sched_barrier(0);
              a0 -= mr1[0] * X[32]; a1 -= mr1[1] * X[33]; a2 -= mr1[2] * X[34]; a3 -= mr1[3] * X[35];
              mr1 = *(const LAS f32x4*)(Mm + 3880);
              __builtin_amdgcn_sched_barrier(0);
              a0 -= mr2[0] * X[36]; a1 -= mr2[1] * X[37]; a2 -= mr2[2] * X[38]; a3 -= mr2[3] * X[39];
              mr2 = *(const LAS f32x4*)(Mm + 3884);
              __builtin_amdgcn_sched_barrier(0);
              a0 -= mr3[0] * X[40]; a1 -= mr3[1] * X[41]; a2 -= mr3[2] * X[42]; a3 -= mr3[3] * X[43];
              mr3 = *(const LAS f32x4*)(Mm + 3888);
              __builtin_amdgcn_sched_barrier(0);
              a0 -= mr4[0] * X[44]; a1 -= mr4[1] * X[45]; a2 -= mr4[2] * X[46]; a3 -= mr4[3] * X[47];
              mr4 = *(const LAS f32x4*)(Mm + 3892);
              __builtin_amdgcn_sched_barrier(0);
              a0 -= mr5[0] * X[48]; a1 -= mr5[1] * X[49]; a2 -= mr5[2] * X[50]; a3 -= mr5[3] * X[51];
              mr5 = *(const LAS f32x4*)(Mm + 3896);
              __builtin_amdgcn_sched_barrier(0);
              a0 -= mr6[0] * X[52]; a1 -= mr6[1] * X[53]; a2 -= mr6[2] * X[54]; a3 -= mr6[3] * X[55];
              X[56] = (a0 + a1) + (a2 + a3); dst[7392] = X[56]; }
            __builtin_amdgcn_sched_barrier(0);
            rh2 = src[7788] * cf[59];
            { float a0 = rh0, a1 = 0.f, a2 = 0.f, a3 = 0.f;
              mr6 = *(const LAS f32x4*)(Mm + 3900);
              __builtin_amdgcn_sched_barrier(0);
              a0 -= mr0[0] * X[0]; a1 -= mr0[1] * X[1]; a2 -= mr0[2] * X[2]; a3 -= mr0[3] * X[3];
              mr0 = *(const LAS f32x4*)(Mm + 3904);
              __builtin_amdgcn_sched_barrier(0);
              a0 -= mr1[0] * X[4]; a1 -= mr1[1] * X[5]; a2 -= mr1[2] * X[6]; a3 -= mr1[3] * X[7];
              mr1 = *(const LAS f32x4*)(Mm + 3908);
              __builtin_amdgcn_sched_barrier(0);
              a0 -= mr2[0] * X[8]; a1 -= mr2[1] * X[9]; a2 -= mr2[2] * X[10]; a3 -= mr2[3] * X[11];
              mr2 = *(const LAS f32x4*)(Mm + 3912);
              __builtin_amdgcn_sched_barrier(0);
              a0 -= mr3[0] * X[12]; a1 -= mr3[1] * X[13]; a2 -= mr3[2] * X[14]; a3 -= mr3[3] * X[15];
              mr3 = *(const LAS f32x4*)(Mm + 3916);
              __builtin_amdgcn_sched_barrier(0);
              a0 -= mr4[0] * X[16]; a1 -= mr4[1] * X[17]; a2 -= mr4[2] * X[18]; a3 -= mr4[3] * X[19];
              mr4 = *(const LAS f32x4*)(Mm + 3920);
              __builtin_amdgcn_sched_barrier(0);
              a0 -= mr5[0] * X[20]; a1 -= mr5[1] * X[21]; a2 -= mr5[2] * X[22]; a3 -= mr5[3] * X[23];
              mr5 = *(const LAS f32x4*)(Mm + 3924);
              __builtin_amdgcn_sched_barrier(0);
              a0 -= mr6[0] * X[24]; a1 -= mr6[1] * X[25]; a2 -= mr6[2] * X[26]; a3 -= mr6[3] * X[27];
              mr6 = *(const LAS f32x4*)(Mm + 3928);
              __builtin_amdgcn_sched_barrier(0);
              a0 -= mr0[0] * X[28]; a1 -= mr0[1] * X[29]; a2 -= mr0[2] * X[30]; a3 -= mr0[3] * X[31];
              mr0 = *(const LAS f32x4*)(Mm + 3932);
              __builtin_amdgcn_sched_barrier(0);
              a0 -= mr1[0] * X[32]; a1 -= mr1[1] * X[33]; a2 -= mr1[2] * X[34]; a3 -= mr1[3] * X[35];
              mr1 = *(const LAS f32x4*)(Mm + 3944);
              __builtin_amdgcn_sched_barrier(0);
              a0 -= mr2[0] * X[36]; a1 -= mr2[1] * X[37]; a2 -= mr2[2] * X[38]; a3 -= mr2[3] * X[39];
              mr2 = *(const LAS f32x4*)(Mm + 3948);
              __builtin_amdgcn_sched_barrier(0);
              a0 -= mr3[0] * X[40]; a1 -= mr3[1] * X[41]; a2 -= mr3[2] * X[42]; a3 -= mr3[3] * X[43];
              mr3 = *(const LAS f32x4*)(Mm + 3952);
              __builtin_amdgcn_sched_barrier(0);
              a0 -= mr4[0] * X[44]; a1 -= mr4[1] * X[45]; a2 -= mr4[2] * X[46]; a3 -= mr4[3] * X[47];
              mr4 = *(const LAS f32x4*)(Mm + 3956);
              __builtin_amdgcn_sched_barrier(0);
              a0 -= mr5[0] * X[48]; a1 -= mr5[1] * X[49]; a2 -= mr5[2] * X[50]; a3 -= mr5[3] * X[51];
              mr5 = *(const LAS f32x4*)(Mm + 3960);
              __builtin_amdgcn_sched_barrier(0);
              a0 -= mr6[0] * X[52]; a1 -= mr6[1] * X[53]; a2 -= mr6[2] * X[54]; a3 -= mr6[3] * X[55];
              mr6 = *(const LAS f32x4*)(Mm + 3964);
              __builtin_amdgcn_sched_barrier(0);
              a0 -= mr0[0] * X[56];
              X[57] = (a0 + a1) + (a2 + a3); dst[7524] = X[57]; }
            __builtin_amdgcn_sched_barrier(0);
            rh0 = src[7920] * cf[60];
            { float a0 = rh1, a1 = 0.f, a2 = 0.f, a3 = 0.f;
              mr0 = *(const LAS f32x4*)(Mm + 3968);
              __builtin_amdgcn_sched_barrier(0);
              a0 -= mr1[0] * X[0]; a1 -= mr1[1] * X[1]; a2 -= mr1[2] * X[2]; a3 -= mr1[3] * X[3];
              mr1 = *(const LAS f32x4*)(Mm + 3972);
              __builtin_amdgcn_sched_barrier(0);
              a0 -= mr2[0] * X[4]; a1 -= mr2[1] * X[5]; a2 -= mr2[2] * X[6]; a3 -= mr2[3] * X[7];
              mr2 = *(const LAS f32x4*)(Mm + 3976);
              __builtin_amdgcn_sched_barrier(0);
              a0 -= mr3[0] * X[8]; a1 -= mr3[1] * X[9]; a2 -= mr3[2] * X[10]; a3 -= mr3[3] * X[11];
              mr3 = *(const LAS f32x4*)(Mm + 3980);
              __builtin_amdgcn_sched_barrier(0);
              a0 -= mr4[0] * X[12]; a1 -= mr4[1] * X[13]; a2 -= mr4[2] * X[14]; a3 -= mr4[3] * X[15];
              mr4 = *(const LAS f32x4*)(Mm + 3984);
              __builtin_amdgcn_sched_barrier(0);
              a0 -= mr5[0] * X[16]; a1 -= mr5[1] * X[17]; a2 -= mr5[2] * X[18]; a3 -= mr5[3] * X[19];
              mr5 = *(const LAS f32x4*)(Mm + 3988);
              __builtin_amdgcn_sched_barrier(0);
              a0 -= mr6[0] * X[20]; a1 -= mr6[1] * X[21]; a2 -= mr6[2] * X[22]; a3 -= mr6[3] * X[23];
              mr6 = *(const LAS f32x4*)(Mm + 3992);
              __builtin_amdgcn_sched_barrier(0);
              a0 -= mr0[0] * X[24]; a1 -= mr0[1] * X[25]; a2 -= mr0[2] * X[26]; a3 -= mr0[3] * X[27];
              mr0 = *(const LAS f32x4*)(Mm + 3996);
              __builtin_amdgcn_sched_barrier(0);
              a0 -= mr1[0] * X[28]; a1 -= mr1[1] * X[29]; a2 -= mr1[2] * X[30]; a3 -= mr1[3] * X[31];
              mr1 = *(const LAS f32x4*)(Mm + 4000);
              __builtin_amdgcn_sched_barrier(0);
              a0 -= mr2[0] * X[32]; a1 -= mr2[1] * X[33]; a2 -= mr2[2] * X[34]; a3 -= mr2[3] * X[35];
              mr2 = *(const LAS f32x4*)(Mm + 4012);
              __builtin_amdgcn_sched_barrier(0);
              a0 -= mr3[0] * X[36]; a1 -= mr3[1] * X[37]; a2 -= mr3[2] * X[38]; a3 -= mr3[3] * X[39];
              mr3 = *(const LAS f32x4*)(Mm + 4016);
              __builtin_amdgcn_sched_barrier(0);
              a0 -= mr4[0] * X[40]; a1 -= mr4[1] * X[41]; a2 -= mr4[2] * X[42]; a3 -= mr4[3] * X[43];
              mr4 = *(const LAS f32x4*)(Mm + 4020);
              __builtin_amdgcn_sched_barrier(0);
              a0 -= mr5[0] * X[44]; a1 -= mr5[1] * X[45]; a2 -= mr5[2] * X[46]; a3 -= mr5[3] * X[47];
              mr5 = *(const LAS f32x4*)(Mm + 4024);
              __builtin_amdgcn_sched_barrier(0);
              a0 -= mr6[0] * X[48]; a1 -= mr6[1] * X[49]; a2 -= mr6[2] * X[50]; a3 -= mr6[3] * X[51];
              mr6 = *(const LAS f32x4*)(Mm + 4028);
              __builtin_amdgcn_sched_barrier(0);
              a0 -= mr0[0] * X[52]; a1 -= mr0[1] * X[53]; a2 -= mr0[2] * X[54]; a3 -= mr0[3] * X[55];
              mr0 = *(const LAS f32x4*)(Mm + 4032);
              __builtin_amdgcn_sched_barrier(0);
              a0 -= mr1[0] * X[56]; a1 -= mr1[1] * X[57];
              X[58] = (a0 + a1) + (a2 + a3); dst[7656] = X[58]; }
            __builtin_amdgcn_sched_barrier(0);
            rh1 = src[8052] * cf[61];
            { float a0 = rh2, a1 = 0.f, a2 = 0.f, a3 = 0.f;
              mr1 = *(const LAS f32x4*)(Mm + 4036);
              __builtin_amdgcn_sched_barrier(0);
              a0 -= mr2[0] * X[0]; a1 -= mr2[1] * X[1]; a2 -= mr2[2] * X[2]; a3 -= mr2[3] * X[3];
              mr2 = *(const LAS f32x4*)(Mm + 4040);
              __builtin_amdgcn_sched_barrier(0);
              a0 -= mr3[0] * X[4]; a1 -= mr3[1] * X[5]; a2 -= mr3[2] * X[6]; a3 -= mr3[3] * X[7];
              mr3 = *(const LAS f32x4*)(Mm + 4044);
              __builtin_amdgcn_sched_barrier(0);
              a0 -= mr4[0] * X[8]; a1 -= mr4[1] * X[9]; a2 -= mr4[2] * X[10]; a3 -= mr4[3] * X[11];
              mr4 = *(const LAS f32x4*)(Mm + 4048);
              __builtin_amdgcn_sched_barrier(0);
              a0 -= mr5[0] * X[12]; a1 -= mr5[1] * X[13]; a2 -= mr5[2] * X[14]; a3 -= mr5[3] * X[15];
              mr5 = *(const LAS f32x4*)(Mm + 4052);
              __builtin_amdgcn_sched_barrier(0);
              a0 -= mr6[0] * X[16]; a1 -= mr6[1] * X[17]; a2 -= mr6[2] * X[18]; a3 -= mr6[3] * X[19];
              mr6 = *(const LAS f32x4*)(Mm + 4056);
              __builtin_amdgcn_sched_barrier(0);
              a0 -= mr0[0] * X[20]; a1 -= mr0[1] * X[21]; a2 -= mr0[2] * X[22]; a3 -= mr0[3] * X[23];
              mr0 = *(const LAS f32x4*)(Mm + 4060);
              __builtin_amdgcn_sched_barrier(0);
              a0 -= mr1[0] * X[24]; a1 -= mr1[1] * X[25]; a2 -= mr1[2] * X[26]; a3 -= mr1[3] * X[27];
              mr1 = *(const LAS f32x4*)(Mm + 4064);
              __builtin_amdgcn_sched_barrier(0);
              a0 -= mr2[0] * X[28]; a1 -= mr2[1] * X[29]; a2 -= mr2[2] * X[30]; a3 -= mr2[3] * X[31];
              mr2 = *(const LAS f32x4*)(Mm + 4068);
              __builtin_amdgcn_sched_barrier(0);
              a0 -= mr3[0] * X[32]; a1 -= mr3[1] * X[33]; a2 -= mr3[2] * X[34]; a3 -= mr3[3] * X[35];
              mr3 = *(const LAS f32x4*)(Mm + 4080);
              __builtin_amdgcn_sched_barrier(0);
              a0 -= mr4[0] * X[36]; a1 -= mr4[1] * X[37]; a2 -= mr4[2] * X[38]; a3 -= mr4[3] * X[39];
              mr4 = *(const LAS f32x4*)(Mm + 4084);
              __builtin_amdgcn_sched_barrier(0);
              a0 -= mr5[0] * X[40]; a1 -= mr5[1] * X[41]; a2 -= mr5[2] * X[42]; a3 -= mr5[3] * X[43];
              mr5 = *(const LAS f32x4*)(Mm + 4088);
              __builtin_amdgcn_sched_barrier(0);
              a0 -= mr6[0] * X[44]; a1 -= mr6[1] * X[45]; a2 -= mr6[2] * X[46]; a3 -= mr6[3] * X[47];
              mr6 = *(const LAS f32x4*)(Mm + 4092);
              __builtin_amdgcn_sched_barrier(0);
              a0 -= mr0[0] * X[48]; a1 -= mr0[1] * X[49]; a2 -= mr0[2] * X[50]; a3 -= mr0[3] * X[51];
              mr0 = *(const LAS f32x4*)(Mm + 4096);
              __builtin_amdgcn_sched_barrier(0);
              a0 -= mr1[0] * X[52]; a1 -= mr1[1] * X[53]; a2 -= mr1[2] * X[54]; a3 -= mr1[3] * X[55];
              mr1 = *(const LAS f32x4*)(Mm + 4100);
              __builtin_amdgcn_sched_barrier(0);
              a0 -= mr2[0] * X[56]; a1 -= mr2[1] * X[57]; a2 -= mr2[2] * X[58];
              X[59] = (a0 + a1) + (a2 + a3); dst[7788] = X[59]; }
            __builtin_amdgcn_sched_barrier(0);
            rh2 = src[8184] * cf[62];
            { float a0 = rh0, a1 = 0.f, a2 = 0.f, a3 = 0.f;
              mr2 = *(const LAS f32x4*)(Mm + 4104);
              __builtin_amdgcn_sched_barrier(0);
              a0 -= mr3[0] * X[0]; a1 -= mr3[1] * X[1]; a2 -= mr3[2] * X[2]; a3 -= mr3[3] * X[3];
              mr3 = *(const LAS f32x4*)(Mm + 4108);
              __builtin_amdgcn_sched_barrier(0);
              a0 -= mr4[0] * X[4]; a1 -= mr4[1] * X[5]; a2 -= mr4[2] * X[6]; a3 -= mr4[3] * X[7];
              mr4 = *(const LAS f32x4*)(Mm + 4112);
              __builtin_amdgcn_sched_barrier(0);
              a0 -= mr5[0] * X[8]; a1 -= mr5[1] * X[9]; a2 -= mr5[2] * X[10]; a3 -= mr5[3] * X[11];
              mr5 = *(const LAS f32x4*)(Mm + 4116);
              __builtin_amdgcn_sched_barrier(0);
              a0 -= mr6[0] * X[12]; a1 -= mr6[1] * X[13]; a2 -= mr6[2] * X[14]; a3 -= mr6[3] * X[15];
              mr6 = *(const LAS f32x4*)(Mm + 4120);
              __builtin_amdgcn_sched_barrier(0);
              a0 -= mr0[0] * X[16]; a1 -= mr0[1] * X[17]; a2 -= mr0[2] * X[18]; a3 -= mr0[3] * X[19];
              mr0 = *(const LAS f32x4*)(Mm + 4124);
              __builtin_amdgcn_sched_barrier(0);
              a0 -= mr1[0] * X[20]; a1 -= mr1[1] * X[21]; a2 -= mr1[2] * X[22]; a3 -= mr1[3] * X[23];
              mr1 = *(const LAS f32x4*)(Mm + 4128);
              __builtin_amdgcn_sched_barrier(0);
              a0 -= mr2[0] * X[24]; a1 -= mr2[1] * X[25]; a2 -= mr2[2] * X[26]; a3 -= mr2[3] * X[27];
              mr2 = *(const LAS f32x4*)(Mm + 4132);
              __builtin_amdgcn_sched_barrier(0);
              a0 -= mr3[0] * X[28]; a1 -= mr3[1] * X[29]; a2 -= mr3[2] * X[30]; a3 -= mr3[3] * X[31];
              mr3 = *(const LAS f32x4*)(Mm + 4136);
              __builtin_amdgcn_sched_barrier(0);
              a0 -= mr4[0] * X[32]; a1 -= mr4[1] * X[33]; a2 -= mr4[2] * X[34]; a3 -= mr4[3] * X[35];
              mr4 = *(const LAS f32x4*)(Mm + 4148);
              __builtin_amdgcn_sched_barrier(0);
              a0 -= mr5[0] * X[36]; a1 -= mr5[1] * X[37]; a2 -= mr5[2] * X[38]; a3 -= mr5[3] * X[39];
              mr5 = *(const LAS f32x4*)(Mm + 4152);
              __builtin_amdgcn_sched_barrier(0);
              a0 -= mr6[0] * X[40]; a1 -= mr6[1] * X[41]; a2 -= mr6[2] * X[42]; a3 -= mr6[3] * X[43];
              mr6 = *(const LAS f32x4*)(Mm + 4156);
              __builtin_amdgcn_sched_barrier(0);
              a0 -= mr0[0] * X[44]; a1 -= mr0[1] * X[45]; a2 -= mr0[2] * X[46]; a3 -= mr0[3] * X[47];
              mr0 = *(const LAS f32x4*)(Mm + 4160);
              __builtin_amdgcn_sched_barrier(0);
              a0 -= mr1[0] * X[48]; a1 -= mr1[1] * X[49]; a2 -= mr1[2] * X[50]; a3 -= mr1[3] * X[51];
              mr1 = *(const LAS f32x4*)(Mm + 4164);
              __builtin_amdgcn_sched_barrier(0);
              a0 -= mr2[0] * X[52]; a1 -= mr2[1] * X[53]; a2 -= mr2[2] * X[54]; a3 -= mr2[3] * X[55];
              mr2 = *(const LAS f32x4*)(Mm + 4168);
              __builtin_amdgcn_sched_barrier(0);
              a0 -= mr3[0] * X[56]; a1 -= mr3[1] * X[57]; a2 -= mr3[2] * X[58]; a3 -= mr3[3] * X[59];
              X[60] = (a0 + a1) + (a2 + a3); dst[7920] = X[60]; }
            __builtin_amdgcn_sched_barrier(0);
            rh0 = src[8316] * cf[63];
            { float a0 = rh1, a1 = 0.f, a2 = 0.f, a3 = 0.f;
              mr3 = *(const LAS f32x4*)(Mm + 4172);
              __builtin_amdgcn_sched_barrier(0);
              a0 -= mr4[0] * X[0]; a1 -= mr4[1] * X[1]; a2 -= mr4[2] * X[2]; a3 -= mr4[3] * X[3];
              mr4 = *(const LAS f32x4*)(Mm + 4176);
              __builtin_amdgcn_sched_barrier(0);
              a0 -= mr5[0] * X[4]; a1 -= mr5[1] * X[5]; a2 -= mr5[2] * X[6]; a3 -= mr5[3] * X[7];
              mr5 = *(const LAS f32x4*)(Mm + 4180);
              __builtin_amdgcn_sched_barrier(0);
              a0 -= mr6[0] * X[8]; a1 -= mr6[1] * X[9]; a2 -= mr6[2] * X[10]; a3 -= mr6[3] * X[11];
              mr6 = *(const LAS f32x4*)(Mm + 4184);
              __builtin_amdgcn_sched_barrier(0);
              a0 -= mr0[0] * X[12]; a1 -= mr0[1] * X[13]; a2 -= mr0[2] * X[14]; a3 -= mr0[3] * X[15];
              mr0 = *(const LAS f32x4*)(Mm + 4188);
              __builtin_amdgcn_sched_barrier(0);
              a0 -= mr1[0] * X[16]; a1 -= mr1[1] * X[17]; a2 -= mr1[2] * X[18]; a3 -= mr1[3] * X[19];
              mr1 = *(const LAS f32x4*)(Mm + 4192);
              __builtin_amdgcn_sched_barrier(0);
              a0 -= mr2[0] * X[20]; a1 -= mr2[1] * X[21]; a2 -= mr2[2] * X[22]; a3 -= mr2[3] * X[23];
              mr2 = *(const LAS f32x4*)(Mm + 4196);
              __builtin_amdgcn_sched_barrier(0);
              a0 -= mr3[0] * X[24]; a1 -= mr3[1] * X[25]; a2 -= mr3[2] * X[26]; a3 -= mr3[3] * X[27];
              mr3 = *(const LAS f32x4*)(Mm + 4200);
              __builtin_amdgcn_sched_barrier(0);
              a0 -= mr4[0] * X[28]; a1 -= mr4[1] * X[29]; a2 -= mr4[2] * X[30]; a3 -= mr4[3] * X[31];
              mr4 = *(const LAS f32x4*)(Mm + 4204);
              __builtin_amdgcn_sched_barrier(0);
              a0 -= mr5[0] * X[32]; a1 -= mr5[1] * X[33]; a2 -= mr5[2] * X[34]; a3 -= mr5[3] * X[35];
              mr5 = *(const LAS f32x4*)(Mm + 4208);
              __builtin_amdgcn_sched_barrier(0);
              a0 -= mr6[0] * X[36]; a1 -= mr6[1] * X[37]; a2 -= mr6[2] * X[38]; a3 -= mr6[3] * X[39];
              mr6 = *(const LAS f32x4*)(Mm + 4216);
              __builtin_amdgcn_sched_barrier(0);
              a0 -= mr0[0] * X[40]; a1 -= mr0[1] * X[41]; a2 -= mr0[2] * X[42]; a3 -= mr0[3] * X[43];
              mr0 = *(const LAS f32x4*)(Mm + 4220);
              __builtin_amdgcn_sched_barrier(0);
              a0 -= mr1[0] * X[44]; a1 -= mr1[1] * X[45]; a2 -= mr1[2] * X[46]; a3 -= mr1[3] * X[47];
              mr1 = *(const LAS f32x4*)(Mm + 4224);
              __builtin_amdgcn_sched_barrier(0);
              a0 -= mr2[0] * X[48]; a1 -= mr2[1] * X[49]; a2 -= mr2[2] * X[50]; a3 -= mr2[3] * X[51];
              mr2 = *(const LAS f32x4*)(Mm + 4228);
              __builtin_amdgcn_sched_barrier(0);
              a0 -= mr3[0] * X[52]; a1 -= mr3[1] * X[53]; a2 -= mr3[2] * X[54]; a3 -= mr3[3] * X[55];
              mr3 = *(const LAS f32x4*)(Mm + 4232);
              __builtin_amdgcn_sched_barrier(0);
              a0 -= mr4[0] * X[56]; a1 -= mr4[1] * X[57]; a2 -= mr4[2] * X[58]; a3 -= mr4[3] * X[59];
              mr4 = *(const LAS f32x4*)(Mm + 4236);
              __builtin_amdgcn_sched_barrier(0);
              a0 -= mr5[0] * X[60];
              X[61] = (a0 + a1) + (a2 + a3); dst[8052] = X[61]; }
            __builtin_amdgcn_sched_barrier(0);
            { float a0 = rh2, a1 = 0.f, a2 = 0.f, a3 = 0.f;
              mr5 = *(const LAS f32x4*)(Mm + 4240);
              __builtin_amdgcn_sched_barrier(0);
              a0 -= mr6[0] * X[0]; a1 -= mr6[1] * X[1]; a2 -= mr6[2] * X[2]; a3 -= mr6[3] * X[3];
              mr6 = *(const LAS f32x4*)(Mm + 4244);
              __builtin_amdgcn_sched_barrier(0);
              a0 -= mr0[0] * X[4]; a1 -= mr0[1] * X[5]; a2 -= mr0[2] * X[6]; a3 -= mr0[3] * X[7];
              mr0 = *(const LAS f32x4*)(Mm + 4248);
              __builtin_amdgcn_sched_barrier(0);
              a0 -= mr1[0] * X[8]; a1 -= mr1[1] * X[9]; a2 -= mr1[2] * X[10]; a3 -= mr1[3] * X[11];
              mr1 = *(const LAS f32x4*)(Mm + 4252);
              __builtin_amdgcn_sched_barrier(0);
              a0 -= mr2[0] * X[12]; a1 -= mr2[1] * X[13]; a2 -= mr2[2] * X[14]; a3 -= mr2[3] * X[15];
              mr2 = *(const LAS f32x4*)(Mm + 4256);
              __builtin_amdgcn_sched_barrier(0);
              a0 -= mr3[0] * X[16]; a1 -= mr3[1] * X[17]; a2 -= mr3[2] * X[18]; a3 -= mr3[3] * X[19];
              mr3 = *(const LAS f32x4*)(Mm + 4260);
              __builtin_amdgcn_sched_barrier(0);
              a0 -= mr4[0] * X[20]; a1 -= mr4[1] * X[21]; a2 -= mr4[2] * X[22]; a3 -= mr4[3] * X[23];
              mr4 = *(const LAS f32x4*)(Mm + 4264);
              __builtin_amdgcn_sched_barrier(0);
              a0 -= mr5[0] * X[24]; a1 -= mr5[1] * X[25]; a2 -= mr5[2] * X[26]; a3 -= mr5[3] * X[27];
              mr5 = *(const LAS f32x4*)(Mm + 4268);
              __builtin_amdgcn_sched_barrier(0);
              a0 -= mr6[0] * X[28]; a1 -= mr6[1] * X[29]; a2 -= mr6[2] * X[30]; a3 -= mr6[3] * X[31];
              mr6 = *(const LAS f32x4*)(Mm + 4272);
              __builtin_amdgcn_sched_barrier(0);
              a0 -= mr0[0] * X[32]; a1 -= mr0[1] * X[33]; a2 -= mr0[2] * X[34]; a3 -= mr0[3] * X[35];
              mr0 = *(const LAS f32x4*)(Mm + 4276);
              __builtin_amdgcn_sched_barrier(0);
              a0 -= mr1[0] * X[36]; a1 -= mr1[1] * X[37]; a2 -= mr1[2] * X[38]; a3 -= mr1[3] * X[39];
              mr1 = *(const LAS f32x4*)(Mm + 4284);
              __builtin_amdgcn_sched_barrier(0);
              a0 -= mr2[0] * X[40]; a1 -= mr2[1] * X[41]; a2 -= mr2[2] * X[42]; a3 -= mr2[3] * X[43];
              mr2 = *(const LAS f32x4*)(Mm + 4288);
              __builtin_amdgcn_sched_barrier(0);
              a0 -= mr3[0] * X[44]; a1 -= mr3[1] * X[45]; a2 -= mr3[2] * X[46]; a3 -= mr3[3] * X[47];
              mr3 = *(const LAS f32x4*)(Mm + 4292);
              __builtin_amdgcn_sched_barrier(0);
              a0 -= mr4[0] * X[48]; a1 -= mr4[1] * X[49]; a2 -= mr4[2] * X[50]; a3 -= mr4[3] * X[51];
              mr4 = *(const LAS f32x4*)(Mm + 4296);
              __builtin_amdgcn_sched_barrier(0);
              a0 -= mr5[0] * X[52]; a1 -= mr5[1] * X[53]; a2 -= mr5[2] * X[54]; a3 -= mr5[3] * X[55];
              mr5 = *(const LAS f32x4*)(Mm + 4300);
              __builtin_amdgcn_sched_barrier(0);
              a0 -= mr6[0] * X[56]; a1 -= mr6[1] * X[57]; a2 -= mr6[2] * X[58]; a3 -= mr6[3] * X[59];
              mr6 = *(const LAS f32x4*)(Mm + 4304);
              __builtin_amdgcn_sched_barrier(0);
              a0 -= mr0[0] * X[60]; a1 -= mr0[1] * X[61];
              X[62] = (a0 + a1) + (a2 + a3); dst[8184] = X[62]; }
            __builtin_amdgcn_sched_barrier(0);
            { float a0 = rh0, a1 = 0.f, a2 = 0.f, a3 = 0.f;
              mr0 = *(const LAS f32x4*)(Mm + 4308);
              __builtin_amdgcn_sched_barrier(0);
              a0 -= mr1[0] * X[0]; a1 -= mr1[1] * X[1]; a2 -= mr1[2] * X[2]; a3 -= mr1[3] * X[3];
              mr1 = *(const LAS f32x4*)(Mm + 4312);
              __builtin_amdgcn_sched_barrier(0);
              a0 -= mr2[0] * X[4]; a1 -= mr2[1] * X[5]; a2 -= mr2[2] * X[6]; a3 -= mr2[3] * X[7];
              mr2 = *(const LAS f32x4*)(Mm + 4316);
              __builtin_amdgcn_sched_barrier(0);
              a0 -= mr3[0] * X[8]; a1 -= mr3[1] * X[9]; a2 -= mr3[2] * X[10]; a3 -= mr3[3] * X[11];
              mr3 = *(const LAS f32x4*)(Mm + 4320);
              __builtin_amdgcn_sched_barrier(0);
              a0 -= mr4[0] * X[12]; a1 -= mr4[1] * X[13]; a2 -= mr4[2] * X[14]; a3 -= mr4[3] * X[15];
              mr4 = *(const LAS f32x4*)(Mm + 4324);
              __builtin_amdgcn_sched_barrier(0);
              a0 -= mr5[0] * X[16]; a1 -= mr5[1] * X[17]; a2 -= mr5[2] * X[18]; a3 -= mr5[3] * X[19];
              mr5 = *(const LAS f32x4*)(Mm + 4328);
              __builtin_amdgcn_sched_barrier(0);
              a0 -= mr6[0] * X[20]; a1 -= mr6[1] * X[21]; a2 -= mr6[2] * X[22]; a3 -= mr6[3] * X[23];
              mr6 = *(const LAS f32x4*)(Mm + 4332);
              __builtin_amdgcn_sched_barrier(0);
              a0 -= mr0[0] * X[24]; a1 -= mr0[1] * X[25]; a2 -= mr0[2] * X[26]; a3 -= mr0[3] * X[27];
              mr0 = *(const LAS f32x4*)(Mm + 4336);
              __builtin_amdgcn_sched_barrier(0);
              a0 -= mr1[0] * X[28]; a1 -= mr1[1] * X[29]; a2 -= mr1[2] * X[30]; a3 -= mr1[3] * X[31];
              mr1 = *(const LAS f32x4*)(Mm + 4340);
              __builtin_amdgcn_sched_barrier(0);
              a0 -= mr2[0] * X[32]; a1 -= mr2[1] * X[33]; a2 -= mr2[2] * X[34]; a3 -= mr2[3] * X[35];
              mr2 = *(const LAS f32x4*)(Mm + 4344);
              __builtin_amdgcn_sched_barrier(0);
              a0 -= mr3[0] * X[36]; a1 -= mr3[1] * X[37]; a2 -= mr3[2] * X[38]; a3 -= mr3[3] * X[39];
              __builtin_amdgcn_sched_barrier(0);
              a0 -= mr4[0] * X[40]; a1 -= mr4[1] * X[41]; a2 -= mr4[2] * X[42]; a3 -= mr4[3] * X[43];
              __builtin_amdgcn_sched_barrier(0);
              a0 -= mr5[0] * X[44]; a1 -= mr5[1] * X[45]; a2 -= mr5[2] * X[46]; a3 -= mr5[3] * X[47];
              __builtin_amdgcn_sched_barrier(0);
              a0 -= mr6[0] * X[48]; a1 -= mr6[1] * X[49]; a2 -= mr6[2] * X[50]; a3 -= mr6[3] * X[51];
              __builtin_amdgcn_sched_barrier(0);
              a0 -= mr0[0] * X[52]; a1 -= mr0[1] * X[53]; a2 -= mr0[2] * X[54]; a3 -= mr0[3] * X[55];
              __builtin_amdgcn_sched_barrier(0);
              a0 -= mr1[0] * X[56]; a1 -= mr1[1] * X[57]; a2 -= mr1[2] * X[58]; a3 -= mr1[3] * X[59];
              __builtin_amdgcn_sched_barrier(0);
              a0 -= mr2[0] * X[60]; a1 -= mr2[1] * X[61]; a2 -= mr2[2] * X[62];
              X[63] = (a0 + a1) + (a2 + a3); dst[8316] = X[63]; }
            __builtin_amdgcn_sched_barrier(0);
        } else {
            const int t2 = tid - 256; const float glast = gt[64 + 63];
#pragma unroll
            for (int i = 0; i < 4; ++i) { const int task = t2 + 256 * i, d = task & 127, gq = task >> 7, g = gq >> 2, q = gq & 3;
                float v[8];
#pragma unroll
                for (int e = 0; e < 4; ++e) { const int ta = 32 * g + 4 * q + e, tb = ta + 16;
                    v[e] = Kf[ta * 132 + d] * __expf(glast - gt[64 + ta]); v[4 + e] = Kf[tb * 132 + d] * __expf(glast - gt[64 + tb]); }
                v4u o; o.x = pk2(v[0], v[1]); o.y = pk2(v[2], v[3]); o.z = pk2(v[4], v[5]); o.w = pk2(v[6], v[7]);
                *(v4u*)(KDT + ((size_t)unit * 128 + d) * 64 + 32 * g + 8 * q) = o; }
            if (t2 == 0) GL[unit] = expf(glast);
        }
        bar_lds();
#pragma unroll
        for (int i = 0; i < 4; ++i) { const int idx = tid + NT * i, t = idx >> 5, c4 = (idx & 31) * 4;
            *(f32x4*)(U + ((size_t)unit * 64 + t) * 128 + c4) = *(const LAS f32x4*)(Vf + t * 132 + c4); }
#pragma unroll
        for (int i = 0; i < 2; ++i) { const int idx = tid + NT * i, t = idx >> 4, c8 = (idx & 15) * 8;
            const LAS float* wf = (const LAS float*)Qb + t * 132 + (c8 & ~31) + ((c8 & 31) >> 1);
            const f32x4 lo = *(const LAS f32x4*)wf, hi = *(const LAS f32x4*)(wf + 16);
            v4u o; o.x = pk2(lo[0], lo[1]); o.y = pk2(lo[2], lo[3]); o.z = pk2(hi[0], hi[1]); o.w = pk2(hi[2], hi[3]);
            *(v4u*)(WKb + ((size_t)unit * 64 + t) * 128 + c8) = o; }
        bar_lds();
    }
}

DI void phase_mix(const Args& a, int l, LAS unsigned char* lds, int tid, int lane, int wave, int bid, int G) {
    unsigned char* ws = a.ws;
    const bf16* P = (const bf16*)(ws + WS_P);
    bf16* MIX = (bf16*)a.out;
    const int r = lane & 15, q = lane >> 4;
    if (bid < 64) {
        const char* QDc = (const char*)(ws + WS_QD); const char* WKc = (const char*)(ws + WS_WK); const char* KDTc = (const char*)(ws + WS_KDT); const char* ACc = (const char*)(ws + WS_AC);
        const float* U = (const float*)(ws + WS_U); const float* GL = (const float*)(ws + WS_GL);
        const int bh = bid >> 1, h = bh & 3, b = bh >> 2, col = 64 * (bid & 1) + 16 * (wave & 3) + r; const bool act = wave < 4;
        constexpr int SBUF = 73728;
        const float glv = GL[(size_t)bh * 64 + lane];
        const unsigned ldsbase = (unsigned)__builtin_amdgcn_readfirstlane((int)(unsigned)(size_t)lds);
        unsigned o256[2], o128[2], ra[4], rk[2], ou[2];
        const char* Uc = (const char*)U + (bid & 1) * 256;
#pragma unroll
        for (int i = 0; i < 2; ++i) { const int sl = (wave + 8 * i) * 64 + lane;
            { const int row = sl >> 4, kc = (sl & 15) ^ (row & 15); o256[i] = (unsigned)(row * 256 + kc * 16); }
            { const int row = sl >> 3, kc = (sl & 7) ^ ((row >> 1) & 7); o128[i] = (unsigned)(row * 128 + kc * 16); }
            ou[i] = (unsigned)((sl >> 4) * 512 + (sl & 15) * 16); }
#pragma unroll
        for (int ks = 0; ks < 4; ++ks) ra[ks] = (unsigned)(r * 256 + (((4 * ks + q) ^ r) << 4));
#pragma unroll
        for (int ks = 0; ks < 2; ++ks) rk[ks] = (unsigned)(r * 128 + (((4 * ks + q) ^ (r >> 1)) << 4));
#define SC_GLDS(gp, loff) glds16((const void*)(gp), ldsbase + (unsigned)(loff))
#define SC_STAGE(n_, b_) do { const size_t un_ = (size_t)bh * 64 + (n_); const int lb_ = (b_) * SBUF + wave * 1024; \
            SC_GLDS(WKc + un_ * 16384 + o256[0], lb_); SC_GLDS(WKc + un_ * 16384 + o256[1], lb_ + 8192); \
            SC_GLDS(QDc + un_ * 16384 + o256[0], lb_ + 16384); SC_GLDS(QDc + un_ * 16384 + o256[1], lb_ + 16384 + 8192); \
            SC_GLDS(KDTc + un_ * 16384 + o128[0], lb_ + 32768); SC_GLDS(KDTc + un_ * 16384 + o128[1], lb_ + 32768 + 8192); \
            SC_GLDS(ACc + un_ * 8192 + o128[0], lb_ + 49152); \
            SC_GLDS(Uc + un_ * 32768 + ou[0], lb_ + 57344); SC_GLDS(Uc + un_ * 32768 + ou[1], lb_ + 57344 + 8192); } while (0)
        f32x4 S[8];
#pragma unroll
        for (int mt = 0; mt < 8; ++mt) S[mt] = (f32x4){0.f, 0.f, 0.f, 0.f};
        SC_STAGE(0, 0);
        asm volatile("s_waitcnt vmcnt(0)" ::: "memory"); __syncthreads();
        bf16* Og = (bf16*)(ws + WS_P) + (size_t)b * SEQ * NP + 1024 + h * 128 + col;
        f32x4 ovp[4];
#pragma unroll
        for (int mt = 0; mt < 4; ++mt) ovp[mt] = (f32x4){0.f, 0.f, 0.f, 0.f};
        for (int n = 0; n <= 64; ++n) {
            const int cur = n & 1;
            if (n == 64) break;
            if (n + 1 < 64) SC_STAGE(n + 1, cur ^ 1);
            if (act) {
            const LAS unsigned char* sb = lds + cur * SBUF;
            bf16x8 fa[16], fb[16], fc[8]; float ul[16];
#pragma unroll
            for (int mt = 0; mt < 4; ++mt)
#pragma unroll
                for (int ks = 0; ks < 4; ++ks) fa[mt * 4 + ks] = *(const LAS bf16x8*)(sb + mt * 4096 + ra[ks]);
#pragma unroll
            for (int mt = 0; mt < 4; ++mt)
#pragma unroll
                for (int ks = 0; ks < 4; ++ks) fb[mt * 4 + ks] = *(const LAS bf16x8*)(sb + 16384 + mt * 4096 + ra[ks]);
            bf16x8 Sb[4];
#pragma unroll
            for (int ks = 0; ks < 4; ++ks) Sb[ks] = pack8(S[2 * ks], S[2 * ks + 1]);
            __builtin_amdgcn_sched_barrier(0);
            f32x4 wv[4], ov[4];
#pragma unroll
            for (int mt = 0; mt < 4; ++mt) { f32x4 acc = {0.f, 0.f, 0.f, 0.f};
#pragma unroll
                for (int ks = 0; ks < 4; ++ks) acc = MFMA16(fa[mt * 4 + ks], Sb[ks], acc);
                wv[mt] = acc; }
#pragma unroll
            for (int mt = 0; mt < 4; ++mt) { const LAS float* up = (const LAS float*)(sb + 57344 + (16 * mt + 4 * q) * 256 + (16 * (wave & 3) + r) * 4);
#pragma unroll
                for (int i = 0; i < 4; ++i) ul[mt * 4 + i] = up[i * 64];
#pragma unroll
                for (int ks = 0; ks < 2; ++ks) fc[mt * 2 + ks] = *(const LAS bf16x8*)(sb + 49152 + mt * 2048 + rk[ks]); }
            __builtin_amdgcn_sched_barrier(0);
#pragma unroll
            for (int mt = 0; mt < 4; ++mt) { f32x4 acc = {0.f, 0.f, 0.f, 0.f};
#pragma unroll
                for (int ks = 0; ks < 4; ++ks) acc = MFMA16(fb[mt * 4 + ks], Sb[ks], acc);
                ov[mt] = acc; }
#pragma unroll
            for (int mt = 0; mt < 8; ++mt)
#pragma unroll
                for (int ks = 0; ks < 2; ++ks) fa[mt * 2 + ks] = *(const LAS bf16x8*)(sb + 32768 + mt * 2048 + rk[ks]);
            __builtin_amdgcn_sched_barrier(0);
#pragma unroll
            for (int mt = 0; mt < 4; ++mt)
#pragma unroll
                for (int i = 0; i < 4; ++i) wv[mt][i] = ul[mt * 4 + i] - wv[mt][i];
            bf16x8 Wb[2];
#pragma unroll
            for (int ks = 0; ks < 2; ++ks) Wb[ks] = pack8(wv[2 * ks], wv[2 * ks + 1]);
#pragma unroll
            for (int mt = 0; mt < 4; ++mt)
#pragma unroll
                for (int ks = 0; ks < 2; ++ks) ov[mt] = MFMA16(fc[mt * 2 + ks], Wb[ks], ov[mt]);
            const float gl = __builtin_bit_cast(float, __builtin_amdgcn_readlane(__builtin_bit_cast(int, glv), n));
#pragma unroll
            for (int mt = 0; mt < 8; ++mt) { S[mt] = S[mt] * gl;
#pragma unroll
                for (int ks = 0; ks < 2; ++ks) S[mt] = MFMA16(fa[mt * 2 + ks], Wb[ks], S[mt]); }
            { GAS bf16* og = (GAS bf16*)(Og + (size_t)(n * 64 + 4 * q) * NP);
#pragma unroll
              for (int mt = 0; mt < 4; ++mt)
#pragma unroll
                  for (int i = 0; i < 4; ++i) og[(size_t)(16 * mt + i) * NP] = f2bf(ov[mt][i]); }
            asm volatile("s_waitcnt vmcnt(16) lgkmcnt(0)\n\ts_barrier" ::: "memory");
            } else {
            asm volatile("s_waitcnt vmcnt(0) lgkmcnt(0)\n\ts_barrier" ::: "memory");
            }
        }
#undef SC_STAGE
#undef SC_GLDS
    } else {
        const float* lng = a.in[6] + l * 512; const float* lnb = a.in[7] + l * 512;
        const float* sw = a.in[8] + (size_t)l * 4 * 128 * 128; const float* sb = a.in[9] + l * 4 * 128;
        LAS float* stat = (LAS float*)lds;
        LAS bf16* vnT = (LAS bf16*)(lds + 1024);
        for (int unit = bid - 64; unit < 256; unit += G - 64) {
            const int b = unit >> 5, n = unit & 31; const size_t m0 = (size_t)b * SEQ + n * 128;
            { const int row = tid >> 2, part = tid & 3; const bf16* src = P + (m0 + row) * NP + 512 + part * 128;
              float s = 0.f, s2 = 0.f;
#pragma unroll 4
              for (int i = 0; i < 16; ++i) { const v4u x = *(const v4u*)(src + 8 * i);
                  const float g0 = gelu_tanh(bflo(x.x)), g1 = gelu_tanh(bfhi(x.x)), g2 = gelu_tanh(bflo(x.y)), g3 = gelu_tanh(bfhi(x.y)),
                              g4 = gelu_tanh(bflo(x.z)), g5 = gelu_tanh(bfhi(x.z)), g6 = gelu_tanh(bflo(x.w)), g7 = gelu_tanh(bfhi(x.w));
                  s += ((g0 + g1) + (g2 + g3)) + ((g4 + g5) + (g6 + g7));
                  s2 += ((g0 * g0 + g1 * g1) + (g2 * g2 + g3 * g3)) + ((g4 * g4 + g5 * g5) + (g6 * g6 + g7 * g7)); }
              s += __shfl_xor(s, 1); s += __shfl_xor(s, 2); s2 += __shfl_xor(s2, 1); s2 += __shfl_xor(s2, 2);
              const float mean = s * (1.f / 512.f), var = fmaxf(s2 * (1.f / 512.f) - mean * mean, 0.f);
              if (part == 0) { stat[2 * row] = mean; stat[2 * row + 1] = rsqrtf(var + 1e-5f); } }
            bar_lds();
            for (int h = 0; h < 4; ++h) {
                LAS bf16* vt = vnT + (h & 1) * (128 * 136);
                const float* Wm = sw + ((size_t)h * 128 + 16 * wave + r) * 128;
                f32x4 wq[4][2];
#pragma unroll
                for (int ks = 0; ks < 4; ++ks) { wq[ks][0] = *(const f32x4*)(Wm + 32 * ks + 8 * q); wq[ks][1] = *(const f32x4*)(Wm + 32 * ks + 8 * q + 4); }
                bf16 uq[4][8];
#pragma unroll
                for (int i = 0; i < 4; ++i)
#pragma unroll
                    for (int nt = 0; nt < 8; ++nt) uq[i][nt] = P[(m0 + 16 * wave + 4 * q + i) * NP + h * 128 + 16 * nt + r];
#pragma unroll
                for (int i = 0; i < 4; ++i) { const int task = tid + NT * i, s = task & 127, dg = task >> 7;
                    const v4u x = *(const v4u*)(P + (m0 + s) * NP + 512 + h * 128 + dg * 8);
                    const float mean = stat[2 * s], rstd = stat[2 * s + 1];
                    const f32x4 g0 = *(const f32x4*)(lng + h * 128 + dg * 8), g1 = *(const f32x4*)(lng + h * 128 + dg * 8 + 4);
                    const f32x4 b0 = *(const f32x4*)(lnb + h * 128 + dg * 8), b1 = *(const f32x4*)(lnb + h * 128 + dg * 8 + 4);
                    const float xv[8] = {bflo(x.x), bfhi(x.x), bflo(x.y), bfhi(x.y), bflo(x.z), bfhi(x.z), bflo(x.w), bfhi(x.w)};
#pragma unroll
                    for (int e = 0; e < 8; ++e) { const float gg = e < 4 ? g0[e & 3] : g1[e & 3], bb = e < 4 ? b0[e & 3] : b1[e & 3];
                        vt[(dg * 8 + e) * 136 + s] = f2bf((gelu_tanh(xv[e]) - mean) * rstd * gg + bb); } }
                bar_lds();
                f32x4 acc[8];
#pragma unroll
                for (int nt = 0; nt < 8; ++nt) acc[nt] = (f32x4){0.f, 0.f, 0.f, 0.f};
                const int tA = 16 * wave + r;
#pragma unroll
                for (int ks = 0; ks < 4; ++ks) { if (ks > (wave >> 1)) break;
                    const int s0 = 32 * ks + 8 * q;
                    f32x4 w0 = wq[ks][0], w1 = wq[ks][1];
#pragma unroll
                    for (int e = 0; e < 4; ++e) { if (s0 + e > tA) w0[e] = 0.f; if (s0 + 4 + e > tA) w1[e] = 0.f; }
                    const bf16x8 af = pack8(w0, w1);
#pragma unroll
                    for (int nt = 0; nt < 8; ++nt) acc[nt] = MFMA16(af, *(const LAS bf16x8*)(vt + (16 * nt + r) * 136 + s0), acc[nt]);
                }
#pragma unroll
                for (int i = 0; i < 4; ++i) { const int t = 16 * wave + 4 * q + i; const float bs = sb[h * 128 + t];
#pragma unroll
                    for (int nt = 0; nt < 8; ++nt) { const int d = 16 * nt + r;
                        const float uu = bf2f(uq[i][nt]);
                        MIX[(m0 + t) * D + h * 128 + d] = f2bf(gelu_tanh(uu) * (acc[nt][i] + bs)); } }
            }
            bar_lds();
        }
        if (l + 1 < DEPTH && bid >= 128) convert_weights(a, l + 1, lds + 73728, wave, lane, (bid - 128) * NWAVES + wave, (G - 128) * NWAVES);
    }
}

DI void phase_gnorm(const Args& a, int l, int tid, int lane, int wave, int bid, int G) {
    const bf16* P = (const bf16*)(a.ws + WS_P); bf16* MIX = (bf16*)a.out;
    const float* ngp = a.in[13] + l * 128 + (lane & 15) * 8;
    const f32x4 g0 = *(const f32x4*)ngp, g1 = *(const f32x4*)(ngp + 4);
    for (int m = bid * NWAVES + wave; m < M; m += G * NWAVES) {
        const v4u ob = *(const v4u*)(P + (size_t)m * NP + 1024 + lane * 8), zb = *(const v4u*)(P + (size_t)m * NP + 2560 + lane * 8);
        f32x4 o0 = {bflo(ob.x), bfhi(ob.x), bflo(ob.y), bfhi(ob.y)}, o1 = {bflo(ob.z), bfhi(ob.z), bflo(ob.w), bfhi(ob.w)};
        const f32x4 z0 = {bflo(zb.x), bfhi(zb.x), bflo(zb.y), bfhi(zb.y)}, z1 = {bflo(zb.z), bfhi(zb.z), bflo(zb.w), bfhi(zb.w)};
        float ss = ((o0[0] * o0[0] + o0[1] * o0[1]) + (o0[2] * o0[2] + o0[3] * o0[3])) + ((o1[0] * o1[0] + o1[1] * o1[1]) + (o1[2] * o1[2] + o1[3] * o1[3]));
        ss = row16_sum(ss);
        const float rstd = rsqrtf(ss * (1.f / 128.f) + 1e-6f);
        o0 = o0 * rstd * g0; o1 = o1 * rstd * g1;
        v4u w; w.x = pk2(o0[0] * silu_f(z0[0]), o0[1] * silu_f(z0[1])); w.y = pk2(o0[2] * silu_f(z0[2]), o0[3] * silu_f(z0[3]));
        w.z = pk2(o1[0] * silu_f(z1[0]), o1[1] * silu_f(z1[1])); w.w = pk2(o1[2] * silu_f(z1[2]), o1[3] * silu_f(z1[3]));
        *(v4u*)(MIX + (size_t)m * D + 512 + lane * 8) = w;
    }
}

#define XB_TMO      128
#define XB_XCNT(j)  (256  + 64 * (j))
#define XB_XSUB(j)  (1280 + 64 * (j))
#define XB_XGEN(j)  (2304 + 64 * (j))
#define XB_TOP      3328
#define XB_TOPGEN   3392
#define XCD_BAR_WORDS 3456
#define XB_SPIN_CAP (1u << 18)

__device__ __forceinline__ unsigned xb_ld(unsigned* p)              { return __hip_atomic_load(p, __ATOMIC_RELAXED, __HIP_MEMORY_SCOPE_AGENT); }
__device__ __forceinline__ unsigned xb_add(unsigned* p, unsigned v) { return __hip_atomic_fetch_add(p, v, __ATOMIC_RELAXED, __HIP_MEMORY_SCOPE_AGENT); }
__device__ __forceinline__ unsigned xb_xcc_id() { return (unsigned)__builtin_amdgcn_s_getreg((3 << 11) | 20) & 0xFu; }
#define XB_SPIN(cond, bar) do { unsigned _sp = 0; while (cond) { __builtin_amdgcn_s_sleep(1); \
    if ((++_sp & 255u) == 0u) { if (xb_ld(&(bar)[XB_TMO])) break; if (_sp > XB_SPIN_CAP) { atomicAdd(&(bar)[XB_TMO], 1u); break; } } } } while (0)

struct XcdBarrier {
    unsigned* bar; unsigned x;
    volatile LAS unsigned* st;
};

__device__ __forceinline__ XcdBarrier xcd_barrier_post(unsigned* bar, volatile LAS unsigned* st) {
    XcdBarrier b; b.bar = bar; b.x = xb_xcc_id(); b.st = st;
    if (threadIdx.x == 0) (void)xb_add(&bar[XB_XCNT(b.x)], 1u);
    return b;
}
__device__ __forceinline__ void xcd_barrier_complete(unsigned* bar, unsigned x, unsigned& nloc, unsigned& nx) {
    const unsigned G = gridDim.x * gridDim.y * gridDim.z;
    unsigned sum, cnt, mine, sp = 0u;
    for (;;) {
        sum = 0u; cnt = 0u; mine = 0u;
#pragma unroll
        for (unsigned j = 0; j < 16; ++j) { const unsigned c = xb_ld(&bar[XB_XCNT(j)]); sum += c; cnt += (c > 0u) ? 1u : 0u; mine = (j == x) ? c : mine; }
        if (sum == G) break;
        __builtin_amdgcn_s_sleep(1);
        if ((++sp & 255u) == 0u) { if (xb_ld(&bar[XB_TMO])) break; if (sp > XB_SPIN_CAP) { atomicAdd(&bar[XB_TMO], 1u); break; } }
    }
    nloc = mine > 0u ? mine : 1u; nx = cnt > 0u ? cnt : 1u;
}

__device__ __forceinline__ void xcd_barrier(const XcdBarrier& b) {
    asm volatile("s_waitcnt vmcnt(0)" ::: "memory");
    __syncthreads();
    if (threadIdx.x == 0) {
        unsigned* bar = b.bar;
        __builtin_amdgcn_s_waitcnt(0);
        unsigned nloc = b.st[0], nx = b.st[1];
        if (nloc == 0u) { xcd_barrier_complete(bar, b.x, nloc, nx); b.st[0] = nloc; b.st[1] = nx; }
        const unsigned old = xb_add(&bar[XB_XSUB(b.x)], 1u);
        const unsigned gen = old / nloc;
        if (old + 1u == (gen + 1u) * nloc) {
            __builtin_amdgcn_fence(__ATOMIC_RELEASE, "agent");
            asm volatile("s_waitcnt vmcnt(0)" ::: "memory");
            const unsigned og = xb_add(&bar[XB_TOP], 1u);
            const unsigned tg = og / nx;
            if (og + 1u == (tg + 1u) * nx) xb_add(&bar[XB_TOPGEN], 1u);
            else XB_SPIN(xb_ld(&bar[XB_TOPGEN]) == tg, bar);
            __builtin_amdgcn_fence(__ATOMIC_ACQUIRE, "agent");
            xb_add(&bar[XB_XGEN(b.x)], 1u);
            asm volatile("s_waitcnt vmcnt(0)" ::: "memory");
        } else {
            XB_SPIN(xb_ld(&bar[XB_XGEN(b.x)]) == gen, bar);
            __builtin_amdgcn_fence(__ATOMIC_ACQUIRE, "agent");
            asm volatile("s_waitcnt vmcnt(0)" ::: "memory");
        }
    }
    __syncthreads();
}

__global__ void __launch_bounds__(NT, 2) mk_fwd(Args a_in) {
    extern __shared__ __attribute__((aligned(16))) unsigned char lds_raw[];
    LAS unsigned char* lds = (LAS unsigned char*)lds_raw;
    cg::grid_group grid = cg::this_grid();
    volatile LAS unsigned* bst = (volatile LAS unsigned*)(lds + LDS_BYTES - 64);
    if (threadIdx.x < 2) bst[threadIdx.x] = 0u;
    __syncthreads();
    XcdBarrier xbar = xcd_barrier_post((unsigned*)(a_in.ws + WS_CTL), bst);
    int rep = 0;
    for (int ph = a_in.ph_lo; ph < a_in.ph_hi; ) {
        int tid = threadIdx.x; asm volatile("" : "+v"(tid));
        const int lane = tid & 63, wave = __builtin_amdgcn_readfirstlane(tid >> 6);
        int bid = blockIdx.x, G = gridDim.x; asm volatile("" : "+s"(bid)); asm volatile("" : "+s"(G));
        Args a = a_in; asm volatile("" : "+s"(a.ws)); asm volatile("" : "+s"(a.out));
        unsigned char* ws = a.ws;
        const float* mod = (const float*)(ws + WS_MOD);
        if (ph == 0) { if (PH_EN(8)) { phase_mod(a, lds, tid, lane, wave, bid, G); convert_weights(a, 0, lds + 49152, wave, lane, bid * NWAVES + wave, G * NWAVES); } }
        else if (ph == NPHASE - 1) { if (PH_EN(9)) phase_norm<2>(a, 0, lds, tid, lane, wave, bid, G); }
        else {
            const int l = (ph - 1) / 9, s0 = (ph - 1) % 9, s = s0 <= 3 ? s0 : s0 - 1;
            if (s0 == 4) { if (PH_EN(10)) phase_gnorm(a, l, tid, lane, wave, bid, G); }
            else if (s == 0) { if (PH_EN(0)) phase_norm<0>(a, l, lds, tid, lane, wave, bid, G); }
            else if (s == 1) { if (PH_EN(1)) {
                pg8::Gemm g{(const bf16*)(ws + WS_H), (const bf16*)(ws + ws_wset(l)), M, NP, D}; pg8::StaticOrder S; S.init(M, NP, G, bid);
                pg8::EpiBf16<0> E{(bf16*)(ws + WS_P), NP, nullptr, 0, 0, 1.f};
                pg8::gemm_phase<pg8::EpiBf16<0>, pg8::StaticOrder, true, true>(lds, g, S, E, tid);
            } }
            else if (s == 2) { if (PH_EN(2)) phase_prep(a, l, lds, tid, lane, wave, bid, G); }
            else if (s == 3) { if (PH_EN(3) && rep < (bid < 64 ? REP_SCAN : REP_SGU)) phase_mix(a, l, lds, tid, lane, wave, bid, G); }
            else if (s == 4) { if (PH_EN(4)) {
                pg8::Gemm g{(const bf16*)a.out, (const bf16*)(ws + ws_wset(l) + W_OFF_OUT), M, D, D}; pg8::StaticOrder S; S.init(M, D, G, bid);
                if (l == 0) { pg8::EpiGateRes<true> E{(const void*)a.in[0], (bf16*)(ws + WS_X), D, mod + 2048};
                    pg8::gemm_phase<pg8::EpiGateRes<true>, pg8::StaticOrder, true, true>(lds, g, S, E, tid); }
                else { pg8::EpiGateRes<false> E{(const void*)(ws + WS_X), (bf16*)(ws + WS_X), D, mod + (size_t)l * 8 * NMOD + 2048};
                    pg8::gemm_phase<pg8::EpiGateRes<false>, pg8::StaticOrder, true, true>(lds, g, S, E, tid); }
            } }
            else if (s == 5) { if (PH_EN(5)) phase_norm<1>(a, l, lds, tid, lane, wave, bid, G); }
            else if (s == 6) { if (PH_EN(6)) {
                pg8::Gemm g{(const bf16*)(ws + WS_H), (const bf16*)(ws + ws_wset(l) + W_OFF_1), M, FF, D}; pg8::StaticOrder S; S.init(M, FF, G, bid);
                pg8::EpiBf16<2> E{(bf16*)(ws + WS_F), FF, nullptr, 0, 0, 1.f};
                pg8::gemm_phase<pg8::EpiBf16<2>, pg8::StaticOrder, true, true>(lds, g, S, E, tid);
            } }
            else { if (PH_EN(7)) {
                pg8::Gemm g{(const bf16*)(ws + WS_F), (const bf16*)(ws + ws_wset(l) + W_OFF_2), M, D, FF}; pg8::StaticOrder S; S.init(M, D, G, bid);
                pg8::EpiGateRes<false> E{(const void*)(ws + WS_X), (bf16*)(ws + WS_X), D, mod + (size_t)l * 8 * NMOD + 5120};
                pg8::gemm_phase<pg8::EpiGateRes<false>, pg8::StaticOrder, true, true>(lds, g, S, E, tid);
            } }
        }
        { const int s9 = (ph - 1) % 9; const int sx = (ph == 0) ? 8 : (ph == NPHASE - 1) ? 9 : s9 == 4 ? 10 : s9 < 4 ? s9 : s9 - 1;
          const int reps = sx == 8 ? REP_MOD : sx == 0 ? REP_N0 : sx == 1 ? REP_G1 : sx == 2 ? REP_PREP : sx == 3 ? (REP_SCAN > REP_SGU ? REP_SCAN : REP_SGU) : sx == 5 ? REP_N1 : sx == 6 ? REP_FF1 : 1;
          const bool again = rep + 1 < reps;
          if (again || ph + 1 < a_in.ph_hi) { if (a_in.ph_lo < 0) grid.sync();   xcd_barrier(xbar); for (int i = 0; i < REP_SYNC; ++i) xcd_barrier(xbar); }
          if (again) ++rep; else { rep = 0; ++ph; } }
    }
}

extern "C" void kernel_launch(void* const* d_in, const int* in_sizes, int n_in, void* d_out, int out_size, void* d_ws, size_t ws_size, hipStream_t stream) {
    static int grid = 0;
    if (grid == 0) {
        if (n_in != 19 || in_sizes[0] != M * D || out_size != M * D || ws_size < WS_END) {
            fprintf(stderr, "kernel_launch: unexpected problem: n_in %d in0 %d out %d ws %zu (need %zu)\n", n_in, n_in > 0 ? in_sizes[0] : -1, out_size, ws_size, (size_t)WS_END); grid = -1; return; }
        int dev = 0, cus = 0, per_cu = 0;
        if (hipGetDevice(&dev) != hipSuccess || hipDeviceGetAttribute(&cus, hipDeviceAttributeMultiprocessorCount, dev) != hipSuccess) { fprintf(stderr, "kernel_launch: device query failed\n"); grid = -1; return; }
        if (hipFuncSetAttribute((const void*)mk_fwd, hipFuncAttributeMaxDynamicSharedMemorySize, LDS_BYTES) != hipSuccess) { fprintf(stderr, "kernel_launch: hipFuncSetAttribute failed\n"); grid = -1; return; }
        if (hipOccupancyMaxActiveBlocksPerMultiprocessor(&per_cu, (const void*)mk_fwd, NT, LDS_BYTES) != hipSuccess || per_cu < 1) { fprintf(stderr, "kernel_launch: occupancy query gives %d\n", per_cu); per_cu = 1; }
        (void)hipGetLastError();
        grid = cus * per_cu;
        if (grid > 256) grid = 256;
        if (grid < 64) { fprintf(stderr, "kernel_launch: grid %d too small\n", grid); grid = -1; return; }
    }
    if (grid < 0) return;
    if (hipMemsetAsync((char*)d_ws + WS_CTL, 0, 16384, stream) != hipSuccess) { fprintf(stderr, "kernel_launch: memset of the barrier words failed\n"); return; }
    Args a{};
    for (int i = 0; i < 19; ++i) a.in[i] = (const float*)d_in[i];
    a.out = (float*)d_out; a.ws = (unsigned char*)d_ws;
#if MK_LAUNCHES == 1
    a.ph_lo = 0; a.ph_hi = NPHASE;
    { void* args[] = {&a};
      hipError_t e = hipLaunchCooperativeKernel((const void*)mk_fwd, dim3(grid), dim3(NT), args, LDS_BYTES, stream);
      if (e != hipSuccess) fprintf(stderr, "kernel_launch: cooperative launch failed: %s (grid %d)\n", hipGetErrorString(e), grid); }
#else
    for (int ph = 0; ph < NPHASE; ++ph) {
        a.ph_lo = ph; a.ph_hi = ph + 1;
        void* args[] = {&a};
        hipError_t e = hipLaunchCooperativeKernel((const void*)mk_fwd, dim3(grid), dim3(NT), args, LDS_BYTES, stream);
        if (e != hipSuccess) { fprintf(stderr, "kernel_launch: launch of phase %d failed: %s (grid %d)\n", ph, hipGetErrorString(e), grid); break; }
    }
#endif
}
```

```cpp
#include <hip/hip_runtime.h>
#include <hip/hip_cooperative_groups.h>
#include <cstdio>
#include <cstdint>
namespace cg = cooperative_groups;
namespace pg8 {
#define PG8_LAS __attribute__((address_space(3)))
typedef unsigned short bf16_t;
typedef short bf16x8 __attribute__((ext_vector_type(8)));
typedef float f32x4 __attribute__((ext_vector_type(4)));
typedef unsigned u32x4 __attribute__((ext_vector_type(4)));
constexpr int BM = 256, BK = 64, HALF = 128, HTB = HALF * BK * 2  , STAGE_BYTES = 8 * HTB, NXCD = 8, WGM = 8;

__host__ __device__ __forceinline__ int lds_byte(int r, int c) { const int st = (r >> 4) * 2 + (c >> 5), rr = r & 15, cc = c & 31, ob = rr * 64 + cc * 2; return st * 1024 + (ob ^ (((ob >> 9) & 1) << 5)); }
__host__ __device__ __forceinline__ void stage_rc(int b, int& R, int& C) { const int st = b / 1024, sb = b % 1024, swz = sb ^ (((sb >> 9) & 1) << 5); R = (st >> 1) * 16 + swz / 64; C = (st & 1) * 32 + (swz % 64) / 2; }
__host__ __device__ __forceinline__ int perm32(int rho) { const int n = rho >> 4, i = rho & 15; return 8 * (i >> 2) + 4 * n + (i & 3); }

struct Unit { int pm, pn; };
struct Gemm { const bf16_t* A; const bf16_t* Bt; int M, N, K; };

struct StaticOrder {
    int nM, nN, nwg, G, c;
    __host__ __device__ void init(int M, int N, int G_, int c_) { nM = M / BM; nN = N / BM; nwg = nM * nN; G = G_; c = c_; }
    __host__ __device__ bool next(int i, Unit& u) const {
        const long L = (long)i * G + c; if (L >= nwg) return false;
        int wgid = (int)L; { const int q = nwg / NXCD, r = nwg % NXCD, xcd = wgid % NXCD, off = wgid / NXCD; wgid = (xcd < r ? xcd * (q + 1) : r * (q + 1) + (xcd - r) * q) + off; }
        const int nig = WGM * nN, gid = wgid / nig, fm = gid * WGM, gsz = (nM - fm) < WGM ? (nM - fm) : WGM;
        u.pm = fm + ((wgid % nig) % gsz); u.pn = (wgid % nig) / gsz; return true;
    }
    __device__ __forceinline__ void a_ready(const Unit&) const {}
    __device__ __forceinline__ void done(const Unit&) const {}
};

__device__ __forceinline__ unsigned cvt_pk_bf16(float lo, float hi) { unsigned r; asm volatile("v_cvt_pk_bf16_f32 %0, %1, %2" : "=v"(r) : "v"(lo), "v"(hi)); return r; }
typedef float f32x2 __attribute__((ext_vector_type(2)));
__device__ __forceinline__ f32x2 gelu_pk(f32x2 v) {
    const f32x2 av = __builtin_elementwise_abs(v), d = av * 0.2316418882f + 1.0f;
    f32x2 t; t.x = __builtin_amdgcn_rcpf(d.x); t.y = __builtin_amdgcn_rcpf(d.y);
    f32x2 q = t * 0.5307027145f + (-0.7265760135f); q = q * t + 0.7107068705f; q = q * t + (-0.142248368f); q = q * t + 0.127414796f; q = q * t;
    const f32x2 s = (v * v) * (-0.72134752044f);
    f32x2 e; e.x = __builtin_amdgcn_exp2f(s.x); e.y = __builtin_amdgcn_exp2f(s.y);
    const f32x2 m = v * (q * e), r = v - m;
    f32x2 o; o.x = v.x < 0.f ? m.x : r.x; o.y = v.y < 0.f ? m.y : r.y; return o;
}

template <int ACT  > struct EpiBf16 {
    static constexpr bool PERM = true, AFTER_DRAIN = false; static_assert(ACT == 0 || ACT == 1 || ACT == 2, "EpiBf16: ACT is 0 (none), 1 (gelu_pk) or 2 (squared relu)");
    bf16_t* O; int ldc; const float* bias; int split_cols; size_t split_stride; float scale0;
    __device__ __forceinline__ void operator()(const f32x4 (&acc)[2][2][4][2], const Unit& u, int wr, int wc, int fr, int fq) const {
        const int row0 = u.pm * BM + wr * 64 + fr; int colt = u.pn * BM; bf16_t* base = O;
        float sc = 1.f; if (split_cols) { const int t = colt / split_cols; base += (size_t)t * split_stride; colt -= t * split_cols; if (t == 0) sc = scale0; }
        const int col0 = colt + wc * 32 + 8 * fq, bcol0 = u.pn * BM + wc * 32 + 8 * fq;
        f32x4 bv[2][2];
#pragma unroll
        for (int bj = 0; bj < 2; ++bj)
#pragma unroll
            for (int n = 0; n < 2; ++n) bv[bj][n] = bias ? *(const f32x4*)(bias + bcol0 + bj * HALF + 4 * n) : (f32x4){0.f, 0.f, 0.f, 0.f};
#pragma unroll
        for (int ai = 0; ai < 2; ++ai)
#pragma unroll
            for (int m = 0; m < 4; ++m) { bf16_t* rowp = base + (size_t)(row0 + ai * HALF + m * 16) * ldc + col0;
#pragma unroll
                for (int bj = 0; bj < 2; ++bj) { f32x4 v0 = acc[ai][bj][m][0] + bv[bj][0], v1 = acc[ai][bj][m][1] + bv[bj][1];
                    if (ACT == 1) { f32x2 a = gelu_pk((f32x2){v0[0], v0[1]}), b = gelu_pk((f32x2){v0[2], v0[3]}), c = gelu_pk((f32x2){v1[0], v1[1]}), d = gelu_pk((f32x2){v1[2], v1[3]});
                        v0 = (f32x4){a.x, a.y, b.x, b.y}; v1 = (f32x4){c.x, c.y, d.x, d.y}; }
                    if (ACT == 2) { v0 = __builtin_elementwise_max(v0, (f32x4){0.f, 0.f, 0.f, 0.f}); v1 = __builtin_elementwise_max(v1, (f32x4){0.f, 0.f, 0.f, 0.f}); v0 = v0 * v0; v1 = v1 * v1; }
                    v0 = v0 * sc; v1 = v1 * sc; u32x4 w; w.x = cvt_pk_bf16(v0[0], v0[1]); w.y = cvt_pk_bf16(v0[2], v0[3]); w.z = cvt_pk_bf16(v1[0], v1[1]); w.w = cvt_pk_bf16(v1[2], v1[3]);
                    *(u32x4*)(rowp + bj * HALF) = w; } }
    }
};
template <bool BASE_F32> struct EpiGateRes {
    static constexpr bool PERM = true, AFTER_DRAIN = false;
    const void* base; bf16_t* out; int ldc; const float* gate;
    __device__ __forceinline__ void operator()(const f32x4 (&acc)[2][2][4][2], const Unit& u, int wr, int wc, int fr, int fq) const {
        const int col0 = u.pn * BM + wc * 32 + 8 * fq;
        const float* gp = gate + (size_t)(u.pm >> 4) * 6144 + col0;
        f32x4 gv[2][2];
#pragma unroll
        for (int bj = 0; bj < 2; ++bj)
#pragma unroll
            for (int n = 0; n < 2; ++n) gv[bj][n] = *(const f32x4*)(gp + bj * HALF + 4 * n);
#pragma unroll
        for (int ai = 0; ai < 2; ++ai)
#pragma unroll
            for (int m = 0; m < 4; ++m) { const size_t off = (size_t)(u.pm * BM + ai * HALF + wr * 64 + m * 16 + fr) * ldc + col0;
#pragma unroll
                for (int bj = 0; bj < 2; ++bj) { f32x4 b0, b1;
                    if (BASE_F32) { const float* bp = (const float*)base + off + bj * HALF; b0 = *(const f32x4*)bp; b1 = *(const f32x4*)(bp + 4); }
                    else { const u32x4 w = *(const u32x4*)((const bf16_t*)base + off + bj * HALF);
                        b0 = (f32x4){__uint_as_float(w.x << 16), __uint_as_float(w.x & 0xffff0000u), __uint_as_float(w.y << 16), __uint_as_float(w.y & 0xffff0000u)};
                        b1 = (f32x4){__uint_as_float(w.z << 16), __uint_as_float(w.z & 0xffff0000u), __uint_as_float(w.w << 16), __uint_as_float(w.w & 0xffff0000u)}; }
                    const f32x4 v0 = b0 + gv[bj][0] * acc[ai][bj][m][0], v1 = b1 + gv[bj][1] * acc[ai][bj][m][1];
                    u32x4 o; o.x = cvt_pk_bf16(v0[0], v0[1]); o.y = cvt_pk_bf16(v0[2], v0[3]); o.z = cvt_pk_bf16(v1[0], v1[1]); o.w = cvt_pk_bf16(v1[2], v1[3]);
                    *(u32x4*)(out + off + bj * HALF) = o; }
                if (m & 1) asm volatile("" ::: "memory"); }
    }
};
template <class Epi, class Sched, bool ALIGN_EPI = false, bool SP2 = false>
__device__ __forceinline__ void gemm_phase(PG8_LAS unsigned char* lds, const Gemm g, const Sched& S, const Epi& E, const int tid) {
    const int wid = __builtin_amdgcn_readfirstlane(tid >> 6), lane = tid & 63, wr = wid >> 2, wc = wid & 3, fr = lane & 15, fq = lane >> 4;
    const int K = g.K, nt = K / BK;
    unsigned voffA[2], voffB[2];
#pragma unroll
    for (int i = 0; i < 2; ++i) { int R, C; stage_rc(tid * 16 + i * 8192, R, C); const int Rb = Epi::PERM ? ((R & ~31) + perm32(R & 31)) : R;
        voffA[i] = (unsigned)(R * K + C) * 2u; voffB[i] = (unsigned)(Rb * K + C) * 2u; }
    const size_t kstep = (size_t)(BK * 2);
    const size_t hstep = (size_t)HALF * K * 2;
    const size_t tstep = 2 * hstep;
    const unsigned ldsw = (unsigned)wid * 1024u;
    const int aoff = lds_byte(wr * 64 + fr, fq * 8), boff = lds_byte(wc * 32 + fr, fq * 8);
#define PG8_SA(b, h) (((b) * 2 + (h)) * HTB)
#define PG8_SB(b, h) ((4 + (b) * 2 + (h)) * HTB)
#define PG8_STAGE(bufoff, gbase, voff) do { _Pragma("unroll") for (int _i = 0; _i < 2; ++_i) \
        __builtin_amdgcn_global_load_lds((const unsigned*)((const char*)(gbase) + (voff)[_i]), (PG8_LAS unsigned*)(lds + (bufoff) + ldsw + _i * 8192), 16, 0, 0); } while (0)
#define PG8_LDA(dst, b, h) do { _Pragma("unroll") for (int m = 0; m < 4; ++m) _Pragma("unroll") for (int k = 0; k < 2; ++k) dst[m][k] = *(const PG8_LAS bf16x8*)(lds + PG8_SA(b, h) + aoff + m * 2048 + k * 1024); } while (0)
#define PG8_LDB(dst, b, h) do { _Pragma("unroll") for (int n = 0; n < 2; ++n) _Pragma("unroll") for (int k = 0; k < 2; ++k) dst[n][k] = *(const PG8_LAS bf16x8*)(lds + PG8_SB(b, h) + boff + n * 2048 + k * 1024); } while (0)
#define PG8_MMA(ai, bj, At, Bt) do { __builtin_amdgcn_s_setprio(1); _Pragma("unroll") for (int m = 0; m < 4; ++m) _Pragma("unroll") for (int n = 0; n < 2; ++n) _Pragma("unroll") for (int k = 0; k < 2; ++k) \
        acc[ai][bj][m][n] = __builtin_amdgcn_mfma_f32_16x16x32_bf16(Bt[n][k], At[m][k], acc[ai][bj][m][n], 0, 0, 0); __builtin_amdgcn_s_setprio(0); } while (0)
#define PG8_WAIT_V(n) asm volatile("s_waitcnt vmcnt(" #n ")" ::: "memory")
#define PG8_WAIT_L(n) asm volatile("s_waitcnt lgkmcnt(" #n ")" ::: "memory")
#define PG8_BAR __builtin_amdgcn_s_barrier()
#define PG8_SCHED __builtin_amdgcn_sched_barrier(0)
    Unit cur, nxt; int ui = 0;
    if (!S.next(0, cur)) return;
    f32x4 acc[2][2][4][2];
#pragma unroll
    for (int a = 0; a < 2; ++a)
#pragma unroll
        for (int b = 0; b < 2; ++b)
#pragma unroll
            for (int m = 0; m < 4; ++m)
#pragma unroll
                for (int n = 0; n < 2; ++n) acc[a][b][m][n] = (f32x4){0.f, 0.f, 0.f, 0.f};
    bf16x8 At[4][2], B0[2][2], B1[2][2];
    const char* cA = (const char*)g.A + (size_t)cur.pm * tstep; const char* cB = (const char*)g.Bt + (size_t)cur.pn * tstep;
    S.a_ready(cur);
    if constexpr (SP2) {
        PG8_STAGE(PG8_SB(0, 0), cB, voffB); PG8_STAGE(PG8_SB(0, 1), cB + hstep, voffB); PG8_STAGE(PG8_SA(0, 0), cA, voffA); PG8_STAGE(PG8_SA(0, 1), cA + hstep, voffA);
        if (wr == 1) PG8_BAR;
        PG8_WAIT_V(2); PG8_BAR;
        PG8_STAGE(PG8_SB(1, 0), cB + kstep, voffB); PG8_STAGE(PG8_SA(1, 0), cA + kstep, voffA); PG8_STAGE(PG8_SB(1, 1), cB + hstep + kstep, voffB);
        PG8_WAIT_V(6); PG8_BAR;
    } else {
        PG8_STAGE(PG8_SB(0, 0), cB, voffB); PG8_STAGE(PG8_SA(0, 0), cA, voffA); PG8_STAGE(PG8_SB(0, 1), cB + hstep, voffB); PG8_STAGE(PG8_SA(0, 1), cA + hstep, voffA);
        if (wr == 1) PG8_BAR;
        PG8_WAIT_V(4); PG8_BAR;
        PG8_STAGE(PG8_SB(1, 0), cB + kstep, voffB); PG8_STAGE(PG8_SA(1, 0), cA + kstep, voffA); PG8_STAGE(PG8_SB(1, 1), cB + hstep + kstep, voffB);
        PG8_WAIT_V(6); PG8_BAR;
    }
    for (;;) {
        const bool has_next = S.next(ui + 1, nxt);
        const char* nA = has_next ? (const char*)g.A + (size_t)nxt.pm * tstep : cA; const char* nB = has_next ? (const char*)g.Bt + (size_t)nxt.pn * tstep : cB;
        for (int t = 0; t < nt; t += 2) {
            const bool last = (t == nt - 2);
            const char* a1 = cA + (size_t)(t + 1) * kstep;
            const char* a2 = last ? nA : cA + (size_t)(t + 2) * kstep; const char* b2 = last ? nB : cB + (size_t)(t + 2) * kstep;
            const char* a3 = a2 + kstep; const char* b3 = b2 + kstep;
            if (last && has_next) S.a_ready(nxt);
            if constexpr (SP2) {
            PG8_LDB(B0, 0, 0); PG8_LDB(B1, 0, 1); PG8_SCHED; PG8_LDA(At, 0, 0); PG8_STAGE(PG8_SA(1, 1), a1 + hstep, voffA);
            PG8_WAIT_V(8); PG8_WAIT_L(0); PG8_BAR; PG8_MMA(0, 0, At, B0); PG8_MMA(0, 1, At, B1); PG8_BAR; PG8_SCHED;
            PG8_LDA(At, 0, 1); PG8_STAGE(PG8_SB(0, 0), b2, voffB); PG8_STAGE(PG8_SB(0, 1), b2 + hstep, voffB); PG8_STAGE(PG8_SA(0, 0), a2, voffA);
            PG8_WAIT_V(8); PG8_WAIT_L(0); PG8_BAR; PG8_MMA(1, 0, At, B0); PG8_MMA(1, 1, At, B1); PG8_BAR; PG8_SCHED;
            PG8_LDB(B0, 1, 0); PG8_LDB(B1, 1, 1); PG8_SCHED; PG8_LDA(At, 1, 0); PG8_STAGE(PG8_SA(0, 1), a2 + hstep, voffA);
            PG8_WAIT_V(8); PG8_WAIT_L(0); PG8_BAR; PG8_MMA(0, 0, At, B0); PG8_MMA(0, 1, At, B1); PG8_BAR; PG8_SCHED;
            PG8_LDA(At, 1, 1); PG8_STAGE(PG8_SB(1, 0), b3, voffB); PG8_STAGE(PG8_SB(1, 1), b3 + hstep, voffB); PG8_STAGE(PG8_SA(1, 0), a3, voffA);
            PG8_WAIT_V(8); PG8_WAIT_L(0); PG8_BAR; PG8_MMA(1, 0, At, B0); PG8_MMA(1, 1, At, B1); PG8_BAR; PG8_SCHED;
            } else {
            PG8_LDB(B0, 0, 0); PG8_SCHED; PG8_LDA(At, 0, 0); PG8_STAGE(PG8_SA(1, 1), a1 + hstep, voffA);
            PG8_WAIT_L(8); PG8_BAR; PG8_WAIT_L(0); PG8_MMA(0, 0, At, B0); PG8_BAR; PG8_SCHED;
            PG8_LDB(B1, 0, 1); PG8_STAGE(PG8_SB(0, 0), b2, voffB);
            PG8_BAR; PG8_WAIT_L(0); PG8_MMA(0, 1, At, B1); PG8_BAR;
            PG8_LDA(At, 0, 1); PG8_STAGE(PG8_SA(0, 0), a2, voffA);
            PG8_BAR; PG8_WAIT_L(0); PG8_MMA(1, 0, At, B0); PG8_BAR; PG8_SCHED;
            PG8_STAGE(PG8_SB(0, 1), b2 + hstep, voffB);
            PG8_WAIT_V(6); PG8_BAR; PG8_MMA(1, 1, At, B1); PG8_BAR;
            PG8_LDB(B0, 1, 0); PG8_SCHED; PG8_LDA(At, 1, 0); PG8_STAGE(PG8_SA(0, 1), a2 + hstep, voffA);
            PG8_WAIT_L(8); PG8_BAR; PG8_WAIT_L(0); PG8_MMA(0, 0, At, B0); PG8_BAR; PG8_SCHED;
            PG8_LDB(B1, 1, 1); PG8_STAGE(PG8_SB(1, 0), b3, voffB);
            PG8_BAR; PG8_WAIT_L(0); PG8_MMA(0, 1, At, B1); PG8_BAR;
            PG8_LDA(At, 1, 1); PG8_STAGE(PG8_SA(1, 0), a3, voffA);
            PG8_BAR; PG8_WAIT_L(0); PG8_MMA(1, 0, At, B0); PG8_BAR; PG8_SCHED;
            PG8_STAGE(PG8_SB(1, 1), b3 + hstep, voffB);
            PG8_WAIT_V(6); PG8_BAR; PG8_MMA(1, 1, At, B1); PG8_BAR;
            }
        }
        if constexpr (ALIGN_EPI) { if (wr == 0) PG8_BAR; }
        if constexpr (!Epi::AFTER_DRAIN) { E(acc, cur, wr, wc, fr, fq); S.done(cur); }
        if (!has_next) break;
#pragma unroll
        for (int a = 0; a < 2; ++a)
#pragma unroll
            for (int b = 0; b < 2; ++b)
#pragma unroll
                for (int m = 0; m < 4; ++m)
#pragma unroll
                    for (int n = 0; n < 2; ++n) acc[a][b][m][n] = (f32x4){0.f, 0.f, 0.f, 0.f};
        cur = nxt; cA = nA; cB = nB; ++ui;
        if constexpr (ALIGN_EPI) { if (wr == 1) PG8_BAR; }
    }
    PG8_WAIT_V(0);
    if constexpr (!ALIGN_EPI) { if (wr == 0) PG8_BAR; }
    PG8_BAR;
    if constexpr (Epi::AFTER_DRAIN) { E.fused(acc, cur, wr, wc, fr, fq, lds, wid, lane); S.done(cur); }
#undef PG8_SA
#undef PG8_SB
#undef PG8_STAGE
#undef PG8_LDA
#undef PG8_LDB
#undef PG8_MMA
#undef PG8_WAIT_V
#undef PG8_WAIT_L
#undef PG8_BAR
#undef PG8_SCHED
}
}
#define LAS __attribute__((address_space(3)))
#define DI __device__ __forceinline__
typedef unsigned short bf16;
typedef unsigned v4u __attribute__((ext_vector_type(4)));
typedef unsigned v2u __attribute__((ext_vector_type(2)));
typedef float f32x4 __attribute__((ext_vector_type(4)));
typedef float f32x2 __attribute__((ext_vector_type(2)));
typedef short bf16x8 __attribute__((ext_vector_type(8)));
typedef __bf16 bf16x2_t __attribute__((ext_vector_type(2)));

#ifndef PHASE_ONLY
#define PHASE_ONLY -1
#endif
#define PH_EN(k) (PHASE_ONLY < 0 || PHASE_ONLY == (k))
#define REP_MOD 1
#define REP_N0 1
#define REP_G1 1
#define REP_PREP 1
#define REP_SCAN 1
#define REP_SGU 1
#define REP_N1 1
#define REP_FF1 1
#define REP_SYNC 0
#ifndef MK_LAUNCHES
#define MK_LAUNCHES 1
#endif

constexpr int NWAVES = 8, NT = 512;
constexpr int BATCH = 8, SEQ = 4096, D = 1024, M = BATCH * SEQ, DEPTH = 4, FF = 4096, INW = 3080, NP = 3072, NMOD = 6144;
constexpr int NPHASE = 2 + 9 * DEPTH;
constexpr size_t MiB = 1u << 20;
constexpr size_t WS_CTL = 0, WS_MOD = 1 * MiB, WS_BA = 2 * MiB, WS_GL = 3 * MiB, WS_WIN = 4 * MiB, WS_WOUT = 10 * MiB, WS_W1 = 12 * MiB, WS_W2 = 20 * MiB,
                 WS_H = 28 * MiB, WS_X = 92 * MiB  , WS_P = 156 * MiB, WS_QD = 348 * MiB, WS_WK = 380 * MiB, WS_KDT = 412 * MiB, WS_AC = 444 * MiB, WS_WSET1 = 460 * MiB, WS_END = 484 * MiB;
DI size_t ws_wset(int l) { return (l & 1) ? WS_WSET1 : WS_WIN; }
constexpr size_t W_OFF_OUT = WS_WOUT - WS_WIN, W_OFF_1 = WS_W1 - WS_WIN, W_OFF_2 = WS_W2 - WS_WIN;
constexpr size_t WS_U = WS_H;
constexpr size_t WS_F = WS_P;
constexpr int LDS_BYTES = 148480;

struct Args { const float* in[19]; float* out; unsigned char* ws; int ph_lo, ph_hi; };

DI float bflo(unsigned u) { return __uint_as_float(u << 16); }
DI float bfhi(unsigned u) { return __uint_as_float(u & 0xffff0000u); }
DI float bf2f(bf16 b) { return __uint_as_float((unsigned)b << 16); }
DI unsigned pk2(float lo, float hi) { f32x2 v = {lo, hi}; bf16x2_t b = __builtin_convertvector(v, bf16x2_t); return __builtin_bit_cast(unsigned, b); }
DI bf16 f2bf(float f) { return (bf16)(pk2(f, 0.f) & 0xffffu); }
template <int CTRL> DI float dpp_f(float v) { return __builtin_bit_cast(float, __builtin_amdgcn_update_dpp(0, __builtin_bit_cast(int, v), CTRL, 0xf, 0xf, false)); }
DI float row16_sum(float v) {
    v += dpp_f<0xB1>(v);
    v += dpp_f<0x4E>(v);
    v += dpp_f<0x141>(v);
    v += dpp_f<0x140>(v);
    return v;
}
template <int CTRL, int RMASK> DI float dpp_rm(float v) { return __builtin_bit_cast(float, __builtin_amdgcn_update_dpp(0, __builtin_bit_cast(int, v), CTRL, RMASK, 0xf, false)); }
DI float wave_sum(float v) {
    v = row16_sum(v);
    v += dpp_rm<0x142, 0xa>(v);
    v += dpp_rm<0x143, 0xc>(v);
    return __builtin_bit_cast(float, __builtin_amdgcn_readlane(__builtin_bit_cast(int, v), 63));
}
DI float silu_f(float v) { return v * __builtin_amdgcn_rcpf(1.f + __expf(-v)); }
DI float gelu_tanh(float v) { const float u = 1.5957691216057308f * (v + 0.044715f * v * v * v); return v * __builtin_amdgcn_rcpf(1.f + __expf(-u)); }
DI void bar_lds() { asm volatile("s_waitcnt lgkmcnt(0)\n\ts_barrier" ::: "memory"); }
#define GAS __attribute__((address_space(1)))
DI void glds16(const void* gsrc, unsigned lds_dst) { unsigned keep;
    asm volatile("s_mov_b32 %0, m0\n\ts_mov_b32 m0, %2\n\ts_nop 0\n\tglobal_load_lds_dwordx4 %1, off\n\ts_mov_b32 m0, %0" : "=&s"(keep) : "v"(gsrc), "s"(lds_dst) : "memory"); }
DI int pos32(int o) { return 8 * ((o >> 2) & 3) + 4 * (o >> 4) + (o & 3); }
DI bf16x8 pack8(const f32x4& a, const f32x4& b) { v4u p; p.x = pk2(a[0], a[1]); p.y = pk2(a[2], a[3]); p.z = pk2(b[0], b[1]); p.w = pk2(b[2], b[3]); return __builtin_bit_cast(bf16x8, p); }
DI bf16x8 ld16g(const bf16* p) { return *(const bf16x8*)p; }
#define MFMA16(a, b, c) __builtin_amdgcn_mfma_f32_16x16x32_bf16((a), (b), (c), 0, 0, 0)

DI void phase_mod(const Args& a, LAS unsigned char* lds, int tid, int lane, int wave, int bid, int G) {
    LAS float* sc = (LAS float*)lds;
    LAS float* red = sc + 8192;
    const float* c = a.in[1]; const float* w_ada = a.in[2]; const float* b_ada = a.in[3];
    float* mod = (float*)(a.ws + WS_MOD);
    for (int i = tid; i < 8192; i += NT) sc[i] = silu_f(c[i]);
    __syncthreads();
    for (int unit = bid; unit < DEPTH * 96; unit += G) {
        const int l = unit / 96, j0 = (unit % 96) * 64;
        const float* w = w_ada + (size_t)l * D * NMOD + j0 + lane;
        float acc[8];
#pragma unroll
        for (int b = 0; b < 8; ++b) acc[b] = 0.f;
#pragma unroll 8
        for (int k = wave * 128; k < wave * 128 + 128; ++k) {
            const float wv = w[(size_t)k * NMOD];
#pragma unroll
            for (int b = 0; b < 8; ++b) acc[b] += sc[b * 1024 + k] * wv;
        }
#pragma unroll
        for (int b = 0; b < 8; ++b) red[(wave * 8 + b) * 64 + lane] = acc[b];
        __syncthreads();
        { const int b = tid >> 6, j = tid & 63; float s = b_ada[l * NMOD + j0 + j];
#pragma unroll
          for (int w8 = 0; w8 < 8; ++w8) s += red[(w8 * 8 + b) * 64 + j];
          mod[(size_t)(l * 8 + b) * NMOD + j0 + j] = s; }
        __syncthreads();
    }
}

DI void transpose_item(const float* W, int ldw, int K, int nblk, bf16* WT, LAS float* scr, int item, int lane) {
    const int kb = item / nblk, nb = item % nblk, k0 = 64 * kb, n0 = 32 * nb;
#pragma unroll 8
    for (int i = 0; i < 32; ++i) { const int kk = 2 * i + (lane >> 5); scr[kk * 33 + (lane & 31)] = W[(size_t)(k0 + kk) * ldw + n0 + (lane & 31)]; }
    asm volatile("s_waitcnt lgkmcnt(0)" ::: "memory");
    const int c = lane & 7;
#pragma unroll
    for (int j = 0; j < 4; ++j) { const int n = (lane >> 3) + 8 * j; const LAS float* s = scr + (8 * c) * 33 + n;
        v4u o; o.x = pk2(s[0 * 33], s[1 * 33]); o.y = pk2(s[2 * 33], s[3 * 33]); o.z = pk2(s[4 * 33], s[5 * 33]); o.w = pk2(s[6 * 33], s[7 * 33]);
        *(v4u*)(WT + (size_t)(n0 + n) * K + k0 + 8 * c) = o; }
    asm volatile("s_waitcnt lgkmcnt(0)" ::: "memory");
}

DI void convert_weights(const Args& a, int l, LAS unsigned char* scr_base, int wave, int lane, int gw, int NGW) {
    LAS float* scr = (LAS float*)(scr_base + wave * 8448);
    unsigned char* wb = a.ws + ws_wset(l);
    const float* w_in = a.in[5] + (size_t)l * D * INW; const float* w_out = a.in[14] + (size_t)l * D * D;
    const float* w1 = a.in[16] + (size_t)l * D * FF;   const float* w2 = a.in[17] + (size_t)l * FF * D;
    constexpr int I_IN = 16 * 96, I_OUT = 16 * 32, I_1 = 16 * 128, I_2 = 64 * 32, NIT = I_IN + I_OUT + I_1 + I_2;
    for (int it = gw; it < NIT; it += NGW) {
        int r = it;
        if (r < I_IN) { transpose_item(w_in, INW, D, 96, (bf16*)wb, scr, r, lane); continue; } r -= I_IN;
        if (r < I_OUT) { transpose_item(w_out, D, D, 32, (bf16*)(wb + W_OFF_OUT), scr, r, lane); continue; } r -= I_OUT;
        if (r < I_1) { transpose_item(w1, FF, D, 128, (bf16*)(wb + W_OFF_1), scr, r, lane); continue; } r -= I_1;
        transpose_item(w2, D, FF, 32, (bf16*)(wb + W_OFF_2), scr, r, lane);
    }
}

template <int MODE> DI void phase_norm(const Args& a, int l, LAS unsigned char* lds, int tid, int lane, int wave, int bid, int G) {
    constexpr int RB = (MODE == 0) ? 2 : 4;
    const int gw = bid * NWAVES + wave, NGW = G * NWAVES;
    unsigned char* ws = a.ws;
    const bool xf32 = (MODE == 0 && l == 0);
    const float* xin = a.in[0]; const bf16* xbf = (const bf16*)(ws + WS_X);
    const float* gam = (MODE == 0) ? a.in[4] + l * D : (MODE == 1) ? a.in[15] + l * D : a.in[18];
    const float* mod = (const float*)(ws + WS_MOD);
    bf16* H = (bf16*)(ws + WS_H);
    float* BA = (float*)(ws + WS_BA);
    LAS f32x4* w8s = (LAS f32x4*)(lds + 67584);
    if (MODE == 0) {
        const float* w_in = a.in[5] + (size_t)l * D * INW + NP;
        for (int idx = tid; idx < 2048; idx += NT) { const int k = idx >> 1, half = idx & 1;
            w8s[(((k >> 8) * 4 + (k & 3)) * 2 + half) * 64 + ((k & 255) >> 2)] = *(const f32x4*)(w_in + (size_t)k * INW + 4 * half); }
        __syncthreads();
    }
    for (int mb = gw * 16; mb < M; mb += NGW * 16) {
        const int b = mb / SEQ;
        f32x4 ca[4], cb[4];
#pragma unroll
        for (int j = 0; j < 4; ++j) {
            const f32x4 gg = *(const f32x4*)(gam + 4 * lane + 256 * j);
            if (MODE == 2) { ca[j] = gg; cb[j] = (f32x4){0.f, 0.f, 0.f, 0.f}; }
            else { const float* mr = mod + (size_t)(l * 8 + b) * NMOD + (MODE == 0 ? 0 : 3072) + 4 * lane + 256 * j;
                   const f32x4 sh = *(const f32x4*)mr, scl = *(const f32x4*)(mr + 1024); ca[j] = gg * (scl + 1.0f); cb[j] = sh; }
        }
        for (int i0 = 0; i0 < 16; i0 += RB) {
            asm volatile("" ::: "memory");
            f32x4 v[RB][4]; float ss[RB];
#pragma unroll
            for (int rr = 0; rr < RB; ++rr) { const f32x4* xr = (const f32x4*)(xin + (size_t)(mb + i0 + rr) * D) + lane; const v2u* xb = (const v2u*)(xbf + (size_t)(mb + i0 + rr) * D) + lane; float sq = 0.f;
#pragma unroll
                for (int j = 0; j < 4; ++j) { if (xf32) v[rr][j] = xr[64 * j]; else { const v2u w = xb[64 * j]; v[rr][j] = (f32x4){bflo(w.x), bfhi(w.x), bflo(w.y), bfhi(w.y)}; } sq += (v[rr][j].x * v[rr][j].x + v[rr][j].y * v[rr][j].y) + (v[rr][j].z * v[rr][j].z + v[rr][j].w * v[rr][j].w); }
                ss[rr] = sq; }
#pragma unroll
            for (int rr = 0; rr < RB; ++rr) ss[rr] = rsqrtf(wave_sum(ss[rr]) * (1.f / D) + 1e-6f);
#pragma unroll
            for (int rr = 0; rr < RB; ++rr) { const size_t m = (size_t)(mb + i0 + rr);
#pragma unroll
                for (int j = 0; j < 4; ++j) v[rr][j] = v[rr][j] * ss[rr] * ca[j] + cb[j];
                if (MODE == 2) { f32x4* o = (f32x4*)(a.out + m * D) + lane;
#pragma unroll
                    for (int j = 0; j < 4; ++j) o[64 * j] = v[rr][j];
                } else { v2u* o = (v2u*)(H + m * D) + lane;
#pragma unroll
                    for (int j = 0; j < 4; ++j) { v2u w; w.x = pk2(v[rr][j].x, v[rr][j].y); w.y = pk2(v[rr][j].z, v[rr][j].w); o[64 * j] = w; } }
            }
            if (MODE == 0) {
                f32x4 d[RB][2];
#pragma unroll
                for (int rr = 0; rr < RB; ++rr) { d[rr][0] = (f32x4){0.f, 0.f, 0.f, 0.f}; d[rr][1] = (f32x4){0.f, 0.f, 0.f, 0.f}; }
#pragma unroll
                for (int j = 0; j < 4; ++j) { asm volatile("" ::: "memory");
#pragma unroll
                    for (int e = 0; e < 4; ++e) { const f32x4 w0 = w8s[((j * 4 + e) * 2 + 0) * 64 + lane], w1 = w8s[((j * 4 + e) * 2 + 1) * 64 + lane];
#pragma unroll
                        for (int rr = 0; rr < RB; ++rr) { d[rr][0] += w0 * v[rr][j][e]; d[rr][1] += w1 * v[rr][j][e]; } } }
#pragma unroll
                for (int rr = 0; rr < RB; ++rr) {
#pragma unroll
                    for (int e = 0; e < 4; ++e) { d[rr][0][e] = wave_sum(d[rr][0][e]); d[rr][1][e] = wave_sum(d[rr][1][e]); }
                    if (lane == 0) { *(f32x4*)(BA + (size_t)(mb + i0 + rr) * 8) = d[rr][0]; *(f32x4*)(BA + (size_t)(mb + i0 + rr) * 8 + 4) = d[rr][1]; } }
            }
        }
    }
}

DI void phase_prep(const Args& a, int l, LAS unsigned char* lds, int tid, int lane, int wave, int bid, int G) {
    unsigned char* ws = a.ws;
    const bf16* P = (const bf16*)(ws + WS_P);
    const float* BA = (const float*)(ws + WS_BA);
    const float* convw = a.in[10] + (size_t)l * 4 * 1536;
    bf16* QD = (bf16*)(ws + WS_QD); bf16* WKb = (bf16*)(ws + WS_WK); bf16* KDT = (bf16*)(ws + WS_KDT); bf16* AC = (bf16*)(ws + WS_AC);
    float* U = (float*)(ws + WS_U); float* GL = (float*)(ws + WS_GL);
    for (int unit = bid; unit < 2048; unit += G) {
        asm volatile("" : "+v"(lds));
        LAS float* Qf = (LAS float*)lds; LAS float* Kf = Qf + 64 * 132; LAS float* Vf = Kf + 64 * 132;
        LAS bf16* Qb = (LAS bf16*)(lds + 101376); LAS bf16* Kb = Qb + 64 * 136;
        LAS float* gt = (LAS float*)(lds + 136192);
        LAS float* Mm = Qf;
        const int n = unit & 63, bh = unit >> 6, b = bh >> 2; int h = bh & 3;
        asm volatile("" : "+s"(h));
        const int t0 = n * 64; const size_t m0 = (size_t)b * SEQ + t0;
        if (tid < 384) {
            const int cgi = tid % 48, rr = tid / 48, sel = cgi >> 4, d0 = (cgi & 15) * 8;
            const int pc = 1024 + sel * 512 + h * 128 + d0, cc = sel * 512 + h * 128 + d0;
            f32x4 cw[4][2];
#pragma unroll
            for (int j = 0; j < 4; ++j) { cw[j][0] = *(const f32x4*)(convw + j * 1536 + cc); cw[j][1] = *(const f32x4*)(convw + j * 1536 + cc + 4); }
            v4u xr[11];
#pragma unroll
            for (int i = 0; i < 11; ++i) { const int t = rr * 8 + i - 3; const bool ok = (t0 + t) >= 0;
                const bf16* p = P + ((long)m0 + t) * NP + pc; xr[i] = ok ? *(const v4u*)p : (v4u){0u, 0u, 0u, 0u}; }
            LAS float* dst = (sel == 0 ? Qf : sel == 1 ? Kf : Vf) + d0;
#pragma unroll
            for (int i = 0; i < 8; ++i) {
                f32x4 o0 = {0.f, 0.f, 0.f, 0.f}, o1 = {0.f, 0.f, 0.f, 0.f};
#pragma unroll
                for (int j = 0; j < 4; ++j) { const v4u x = xr[i + j];
                    const f32x4 x0 = {bflo(x.x), bfhi(x.x), bflo(x.y), bfhi(x.y)}, x1 = {bflo(x.z), bfhi(x.z), bflo(x.w), bfhi(x.w)};
                    o0 += cw[j][0] * x0; o1 += cw[j][1] * x1; }
#pragma unroll
                for (int e = 0; e < 4; ++e) { o0[e] = silu_f(o0[e]); o1[e] = silu_f(o1[e]); }
                *(LAS f32x4*)(dst + (rr * 8 + i) * 132) = o0; *(LAS f32x4*)(dst + (rr * 8 + i) * 132 + 4) = o1;
                const float sq = row16_sum(((o0[0] * o0[0] + o0[1] * o0[1]) + (o0[2] * o0[2] + o0[3] * o0[3])) + ((o1[0] * o1[0] + o1[1] * o1[1]) + (o1[2] * o1[2] + o1[3] * o1[3])));
                if (sel < 2 && (cgi & 15) == 0) gt[192 + sel * 64 + rr * 8 + i] = sq;
            }
        } else if (wave == 7) {
            const float bb = BA[(m0 + lane) * 8 + h], aa = BA[(m0 + lane) * 8 + 4 + h];
            const float beta = 1.f / (1.f + expf(-bb));
            const float xx = aa + a.in[12][l * 4 + h];
            const float sp = fmaxf(xx, 0.f) + log1pf(expf(-fabsf(xx)));
            float g = -expf(a.in[11][l * 4 + h]) * sp;
#pragma unroll
            for (int off = 1; off < 64; off <<= 1) { const float v = __shfl_up(g, off); if (lane >= off) g += v; }
            { const float gm = expf(g); gt[lane] = beta; gt[64 + lane] = g; gt[128 + lane] = gm; gt[320 + lane] = beta * gm; }
        }
        bar_lds();
        for (int i = 0; i < 8; ++i) {
            const int t = wave * 8 + i;
            f32x2 qv = *(LAS f32x2*)(Qf + t * 132 + 2 * lane), kv = *(LAS f32x2*)(Kf + t * 132 + 2 * lane);
            const float rq = rsqrtf(gt[192 + t] + 1e-6f) * 0.08838834764831845f, rk = rsqrtf(gt[256 + t] + 1e-6f);
            qv = qv * rq; kv = kv * rk;
            *(LAS unsigned*)(Qb + t * 136 + 2 * lane) = pk2(qv.x, qv.y);
            *(LAS unsigned*)(Kb + t * 136 + 2 * lane) = pk2(kv.x, kv.y);
            *(LAS f32x2*)(Kf + t * 132 + 2 * lane) = kv;
            const float gm = gt[128 + t];
            const int d = 2 * lane, dp = (d & ~31) + pos32(d & 31);
            *(unsigned*)(QD + ((size_t)unit * 64 + t) * 128 + dp) = pk2(qv.x * gm, qv.y * gm);
        }
        bar_lds();
        {
            const int which = wave >> 2, mt = wave & 3, r = lane & 15, q = lane >> 4;
            const LAS bf16* Ab = which ? Qb : Kb;
            bf16x8 af[4];
#pragma unroll
            for (int ks = 0; ks < 4; ++ks) af[ks] = *(const LAS bf16x8*)(Ab + (16 * mt + r) * 136 + 32 * ks + 8 * q);
            for (int nt = 0; nt < 4; ++nt) {
                f32x4 acc = {0.f, 0.f, 0.f, 0.f};
                if (nt <= mt) {
#pragma unroll
                    for (int ks = 0; ks < 4; ++ks) { const bf16x8 bfr = *(const LAS bf16x8*)(Kb + (16 * nt + r) * 136 + 32 * ks + 8 * q); acc = MFMA16(af[ks], bfr, acc); }
                }
                const int s = 16 * nt + r; const float gs = gt[64 + s];
#pragma unroll
                for (int i = 0; i < 4; ++i) { const int t = 16 * mt + 4 * q + i;
                    const float dec = __expf(fminf(gt[64 + t] - gs, 0.f));
                    if (which == 0) { if (nt <= mt) Mm[t * 68 + s] = (s < t) ? gt[t] * acc[i] * dec : 0.f; }
                    else { const float v = (s <= t) ? acc[i] * dec : 0.f; AC[((size_t)unit * 64 + t) * 64 + (s & ~31) + pos32(s & 31)] = f2bf(v); }
                }
            }
        }
        bar_lds();
        if (wave < 4) {
            const int part = wave >> 1, c = 64 * (wave & 1) + lane;
            const LAS float* src = (part ? Kf : Vf) + c;
            LAS float* dst = (part ? (LAS float*)Qb : Vf) + c;
            const LAS float* cf = gt + (part ? 320 : 0);
            __builtin_amdgcn_s_setprio(2);
            float X[64];
            f32x4 mr0, mr1, mr2, mr3, mr4, mr5, mr6;
            float rh0, rh1, rh2;
            mr0 = *(const LAS f32x4*)(Mm + 68);
            mr1 = *(const LAS f32x4*)(Mm + 136);
            mr2 = *(const LAS f32x4*)(Mm + 204);
            mr3 = *(const LAS f32x4*)(Mm + 272);
            mr4 = *(const LAS f32x4*)(Mm + 340);
            mr5 = *(const LAS f32x4*)(Mm + 344);
            rh0 = src[0] * cf[0]; rh1 = src[132] * cf[1];
            rh2 = src[264] * cf[2];
            X[0] = rh0; dst[0] = X[0];
            rh0 = src[396] * cf[3];
            { float a0 = rh1, a1 = 0.f, a2 = 0.f, a3 = 0.f;
              mr6 = *(const LAS f32x4*)(Mm + 408);
              __builtin_amdgcn_sched_barrier(0);
              a0 -= mr0[0] * X[0];
              X[1] = (a0 + a1) + (a2 + a3); dst[132] = X[1]; }
            __builtin_amdgcn_sched_barrier(0);
            rh1 = src[528] * cf[4];
            { float a0 = rh2, a1 = 0.f, a2 = 0.f, a3 = 0.f;
              mr0 = *(const LAS f32x4*)(Mm + 412);
              __builtin_amdgcn_sched_barrier(0);
              a0 -= mr1[0] * X[0]; a1 -= mr1[1] * X[1];
              X[2] = (a0 + a1) + (a2 + a3); dst[264] = X[2]; }
            __builtin_amdgcn_sched_barrier(0);
            rh2 = src[660] * cf[5];
            { float a0 = rh0, a1 = 0.f, a2 = 0.f, a3 = 0.f;
              mr1 = *(const LAS f32x4*)(Mm + 476);
              __builtin_amdgcn_sched_barrier(0);
              a0 -= mr2[0] * X[0]; a1 -= mr2[1] * X[1]; a2 -= mr2[2] * X[2];
              X[3] = (a0 + a1) + (a2 + a3); dst[396] = X[3]; }
            __builtin_amdgcn_sched_barrier(0);
            rh0 = src[792] * cf[6];
            { float a0 = rh1, a1 = 0.f, a2 = 0.f, a3 = 0.f;
              mr2 = *(const LAS f32x4*)(Mm + 480);
              __builtin_amdgcn_sched_barrier(0);
              a0 -= mr3[0] * X[0]; a1 -= mr3[1] * X[1]; a2 -= mr3[2] * X[2]; a3 -= mr3[3] * X[3];
              X[4] = (a0 + a1) + (a2 + a3); dst[528] = X[4]; }
            __builtin_amdgcn_sched_barrier(0);
            rh1 = src[924] * cf[7];
            { float a0 = rh2, a1 = 0.f, a2 = 0.f, a3 = 0.f;
              mr3 = *(const LAS f32x4*)(Mm + 544);
              __builtin_amdgcn_sched_barrier(0);
              a0 -= mr4[0] * X[0]; a1 -= mr4[1] * X[1]; a2 -= mr4[2] * X[2]; a3 -= mr4[3] * X[3];
              mr4 = *(const LAS f32x4*)(Mm + 548);
              __builtin_amdgcn_sched_barrier(0);
              a0 -= mr5[0] * X[4];
              X[5] = (a0 + a1) + (a2 + a3); dst[660] = X[5]; }
            __builtin_amdgcn_sched_barrier(0);
            rh2 = src[1056] * cf[8];
            { float a0 = rh0, a1 = 0.f, a2 = 0.f, a3 = 0.f;
              mr5 = *(const LAS f32x4*)(Mm + 612);
              __builtin_amdgcn_sched_barrier(0);
              a0 -= mr6[0] * X[0]; a1 -= mr6[1] * X[1]; a2 -= mr6[2] * X[2]; a3 -= mr6[3] * X[3];
              mr6 = *(const LAS f32x4*)(Mm + 616);
              __builtin_amdgcn_sched_barrier(0);
              a0 -= mr0[0] * X[4]; a1 -= mr0[1] * X[5];
              X[6] = (a0 + a1) + (a2 + a3); dst[792] = X[6]; }
            __builtin_amdgcn_sched_barrier(0);
            rh0 = src[1188] * cf[9];
            { float a0 = rh1, a1 = 0.f, a2 = 0.f, a3 = 0.f;
              mr0 = *(const LAS f32x4*)(Mm + 620);
              __builtin_amdgcn_sched_barrier(0);
              a0 -= mr1[0] * X[0]; a1 -= mr1[1] * X[1]; a2 -= mr1[2] * X[2]; a3 -= mr1[3] * X[3];
              mr1 = *(const LAS f32x4*)(Mm + 680);
              __builtin_amdgcn_sched_barrier(0);
              a0 -= mr2[0] * X[4]; a1 -= mr2[1] * X[5]; a2 -= mr2[2] * X[6];
              X[7] = (a0 + a1) + (a2 + a3); dst[924] = X[7]; }
            __builtin_amdgcn_sched_barrier(0);
            rh1 = src[1320] * cf[10];
            { float a0 = rh2, a1 = 0.f, a2 = 0.f, a3 = 0.f;
              mr2 = *(const LAS f32x4*)(Mm + 684);
              __builtin_amdgcn_sched_barrier(0);
              a0 -= mr3[0] * X[0]; a1 -= mr3[1] * X[1]; a2 -= mr3[2] * X[2]; a3 -= mr3[3] * X[3];
              mr3 = *(const LAS f32x4*)(Mm + 688);
              __builtin_amdgcn_sched_barrier(0);
              a0 -= mr4[0] * X[4]; a1 -= mr4[1] * X[5]; a2 -= mr4[2] * X[6]; a3 -= mr4[3] * X[7];
              X[8] = (a0 + a1) + (a2 + a3); dst[1056] = X[8]; }
            __builtin_amdgcn_sched_barrier(0);
            rh2 = src[1452] * cf[11];
            { float a0 = rh0, a1 = 0.f, a2 = 0.f, a3 = 0.f;
              mr4 = *(const LAS f32x4*)(Mm + 748);
              __builtin_amdgcn_sched_barrier(0);
              a0 -= mr5[0] * X[0]; a1 -= mr5[1] * X[1]; a2 -= mr5[2] * X[2]; a3 -= mr5[3] * X[3];
              mr5 = *(const LAS f32x4*)(Mm + 752);
              __builtin_amdgcn_sched_barrier(0);
              a0 -= mr6[0] * X[4]; a1 -= mr6[1] * X[5]; a2 -= mr6[2] * X[6]; a3 -= mr6[3] * X[7];
              mr6 = *(const LAS f32x4*)(Mm + 756);
              __builtin_amdgcn_sched_barrier(0);
              a0 -= mr0[0] * X[8];
              X[9] = (a0 + a1) + (a2 + a3); dst[1188] = X[9]; }
            __builtin_amdgcn_sched_barrier(0);
            rh0 = src[1584] * cf[12];
            { float a0 = rh1, a1 = 0.f, a2 = 0.f, a3 = 0.f;
              mr0 = *(const LAS f32x4*)(Mm + 816);
              __builtin_amdgcn_sched_barrier(0);
              a0 -= mr1[0] * X[0]; a1 -= mr1[1] * X[1]; a2 -= mr1[2] * X[2]; a3 -= mr1[3] * X[3];
              mr1 = *(const LAS f32x4*)(Mm + 820);
              __builtin_amdgcn_sched_barrier(0);
              a0 -= mr2[0] * X[4]; a1 -= mr2[1] * X[5]; a2 -= mr2[2] * X[6]; a3 -= mr2[3] * X[7];
              mr2 = *(const LAS f32x4*)(Mm + 824);
              __builtin_amdgcn_sched_barrier(0);
              a0 -= mr3[0] * X[8]; a1 -= mr3[1] * X[9];
              X[10] = (a0 + a1) + (a2 + a3); dst[1320] = X[10]; }
            __builtin_amdgcn_sched_barrier(0);
            rh1 = src[1716] * cf[13];
            { float a0 = rh2, a1 = 0.f, a2 = 0.f, a3 = 0.f;
              mr3 = *(const LAS f32x4*)(Mm + 884);
              __builtin_amdgcn_sched_barrier(0);
              a0 -= mr4[0] * X[0]; a1 -= mr4[1] * X[1]; a2 -= mr4[2] * X[2]; a3 -= mr4[3] * X[3];
              mr4 = *(const LAS f32x4*)(Mm + 888);
              __builtin_amdgcn_sched_barrier(0);
              a0 -= mr5[0] * X[4]; a1 -= mr5[1] * X[5]; a2 -= mr5[2] * X[6]; a3 -= mr5[3] * X[7];
              mr5 = *(const LAS f32x4*)(Mm + 892);
              __builtin_amdgcn_sched_barrier(0);
              a0 -= mr6[0] * X[8]; a1 -= mr6[1] * X[9]; a2 -= mr6[2] * X[10];
              X[11] = (a0 + a1) + (a2 + a3); dst[1452] = X[11]; }
            __builtin_amdgcn_sched_barrier(0);
            rh2 = src[1848] * cf[14];
            { float a0 = rh0, a1 = 0.f, a2 = 0.f, a3 = 0.f;
              mr6 = *(const LAS f32x4*)(Mm + 896);
              __builtin_amdgcn_sched_barrier(0);
              a0 -= mr0[0] * X[0]; a1 -= mr0[1] * X[1]; a2 -= mr0[2] * X[2]; a3 -= mr0[3] * X[3];
              mr0 = *(const LAS f32x4*)(Mm + 952);
              __builtin_amdgcn_sched_barrier(0);
              a0 -= mr1[0] * X[4]; a1 -= mr1[1] * X[5]; a2 -= mr1[2] * X[6]; a3 -= mr1[3] * X[7];
              mr1 = *(const LAS f32x4*)(Mm + 956);
              __builtin_amdgcn_sched_barrier(0);
              a0 -= mr2[0] * X[8]; a1 -= mr2[1] * X[9]; a2 -= mr2[2] * X[10]; a3 -= mr2[3] * X[11];
              X[12] = (a0 + a1) + (a2 + a3); dst[1584] = X[12]; }
            __builtin_amdgcn_sched_barrier(0);
            rh0 = src[1980] * cf[15];
            { float a0 = rh1, a1 = 0.f, a2 = 0.f, a3 = 0.f;
              mr2 = *(const LAS f32x4*)(Mm + 960);
              __builtin_amdgcn_sched_barrier(0);
              a0 -= mr3[0] * X[0]; a1 -= mr3[1] * X[1]; a2 -= mr3[2] * X[2]; a3 -= mr3[3] * X[3];
              mr3 = *(const LAS f32x4*)(Mm + 964);
              __builtin_amdgcn_sched_barrier(0);
              a0 -= mr4[0] * X[4]; a1 -= mr4[1] * X[5]; a2 -= mr4[2] * X[6]; a3 -= mr4[3] * X[7];
              mr4 = *(const LAS f32x4*)(Mm + 1020);
              __builtin_amdgcn_sched_barrier(0);
              a0 -= mr5[0] * X[8]; a1 -= mr5[1] * X[9]; a2 -= mr5[2] * X[10]; a3 -= mr5[3] * X[11];
              mr5 = *(const LAS f32x4*)(Mm + 1024);
              __builtin_amdgcn_sched_barrier(0);
              a0 -= mr6[0] * X[12];
              X[13] = (a0 + a1) + (a2 + a3); dst[1716] = X[13]; }
            __builtin_amdgcn_sched_barrier(0);
            rh1 = src[2112] * cf[16];
            { float a0 = rh2, a1 = 0.f, a2 = 0.f, a3 = 0.f;
              mr6 = *(const LAS f32x4*)(Mm + 1028);
              __builtin_amdgcn_sched_barrier(0);
              a0 -= mr0[0] * X[0]; a1 -= mr0[1] * X[1]; a2 -= mr0[2] * X[2]; a3 -= mr0[3] * X[3];
              mr0 = *(const LAS f32x4*)(Mm + 1032);
              __builtin_amdgcn_sched_barrier(0);
              a0 -= mr1[0] * X[4]; a1 -= mr1[1] * X[5]; a2 -= mr1[2] * X[6]; a3 -= mr1[3] * X[7];
              mr1 = *(const LAS f32x4*)(Mm + 1088);
              __builtin_amdgcn_sched_barrier(0);
              a0 -= mr2[0] * X[8]; a1 -= mr2[1] * X[9]; a2 -= mr2[2] * X[10]; a3 -= mr2[3] * X[11];
              mr2 = *(const LAS f32x4*)(Mm + 1092);
              __builtin_amdgcn_sched_barrier(0);
              a0 -= mr3[0] * X[12]; a1 -= mr3[1] * X[13];
              X[14] = (a0 + a1) + (a2 + a3); dst[1848] = X[14]; }
            __builtin_amdgcn_sched_barrier(0);
            rh2 = src[2244] * cf[17];
            { float a0 = rh0, a1 = 0.f, a2 = 0.f, a3 = 0.f;
              mr3 = *(const LAS f32x4*)(Mm + 1096);
              __builtin_amdgcn_sched_barrier(0);
              a0 -= mr4[0] * X[0]; a1 -= mr4[1] * X[1]; a2 -= mr4[2] * X[2]; a3 -= mr4[3] * X[3];
              mr4 = *(const LAS f32x4*)(Mm + 1100);
              __builtin_amdgcn_sched_barrier(0);
              a0 -= mr5[0] * X[4]; a1 -= mr5[1] * X[5]; a2 -= mr5[2] * X[6]; a3 -= mr5[3] * X[7];
              mr5 = *(const LAS f32x4*)(Mm + 1156);
              __builtin_amdgcn_sched_barrier(0);
              a0 -= mr6[0] * X[8]; a1 -= mr6[1] * X[9]; a2 -= mr6[2] * X[10]; a3 -= mr6[3] * X[11];
              mr6 = *(const LAS f32x4*)(Mm + 1160);
              __builtin_amdgcn_sched_barrier(0);
              a0 -= mr0[0] * X[12]; a1 -= mr0[1] * X[13]; a2 -= mr0[2] * X[14];
              X[15] = (a0 + a1) + (a2 + a3); dst[1980] = X[15]; }
            __builtin_amdgcn_sched_barrier(0);
            rh0 = src[2376] * cf[18];
            { float a0 = rh1, a1 = 0.f, a2 = 0.f, a3 = 0.f;
              mr0 = *(const LAS f32x4*)(Mm + 1164);
              __builtin_amdgcn_sched_barrier(0);
              a0 -= mr1[0] * X[0]; a1 -= mr1[1] * X[1]; a2 -= mr1[2] * X[2]; a3 -= mr1[3] * X[3];
              mr1 = *(const LAS f32x4*)(Mm + 1168);
              __builtin_amdgcn_sched_barrier(0);
              a0 -= mr2[0] * X[4]; a1 -= mr2[1] * X[5]; a2 -= mr2[2] * X[6]; a3 -= mr2[3] * X[7];
              mr2 = *(const LAS f32x4*)(Mm + 1172);
              __builtin_amdgcn_sched_barrier(0);
              a0 -= mr3[0] * X[8]; a1 -= mr3[1] * X[9]; a2 -= mr3[2] * X[10]; a3 -= mr3[3] * X[11];
              mr3 = *(const LAS f32x4*)(Mm + 1224);
              __builtin_amdgcn_sched_barrier(0);
              a0 -= mr4[0] * X[12]; a1 -= mr4[1] * X[13]; a2 -= mr4[2] * X[14]; a3 -= mr4[3] * X[15];
              X[16] = (a0 + a1) + (a2 + a3); dst[2112] = X[16]; }
            __builtin_amdgcn_sched_barrier(0);
            rh1 = src[2508] * cf[19];
            { float a0 = rh2, a1 = 0.f, a2 = 0.f, a3 = 0.f;
              mr4 = *(const LAS f32x4*)(Mm + 1228);
              __builtin_amdgcn_sched_barrier(0);
              a0 -= mr5[0] * X[0]; a1 -= mr5[1] * X[1]; a2 -= mr5[2] * X[2]; a3 -= mr5[3] * X[3];
              mr5 = *(const LAS f32x4*)(Mm + 1232);
              __builtin_amdgcn_sched_barrier(0);
              a0 -= mr6[0] * X[4]; a1 -= mr6[1] * X[5]; a2 -= mr6[2] * X[6]; a3 -= mr6[3] * X[7];
              mr6 = *(const LAS f32x4*)(Mm + 1236);
              __builtin_amdgcn_sched_barrier(0);
              a0 -= mr0[0] * X[8]; a1 -= mr0[1] * X[9]; a2 -= mr0[2] * X[10]; a3 -= mr0[3] * X[11];
              mr0 = *(const LAS f32x4*)(Mm + 1240);
              __builtin_amdgcn_sched_barrier(0);
              a0 -= mr1[0] * X[12]; a1 -= mr1[1] * X[13]; a2 -= mr1[2] * X[14]; a3 -= mr1[3] * X[15];
              mr1 = *(const LAS f32x4*)(Mm + 1292);
              __builtin_amdgcn_sched_barrier(0);
              a0 -= mr2[0] * X[16];
              X[17] = (a0 + a1) + (a2 + a3); dst[2244] = X[17]; }
            __builtin_amdgcn_sched_barrier(0);
            rh2 = src[2640] * cf[20];
            { float a0 = rh0, a1 = 0.f, a2 = 0.f, a3 = 0.f;
              mr2 = *(const LAS f32x4*)(Mm + 1296);
              __builtin_amdgcn_sched_barrier(0);
              a0 -= mr3[0] * X[0]; a1 -= mr3[1] * X[1]; a2 -= mr3[2] * X[2]; a3 -= mr3[3] * X[3];
              mr3 = *(const LAS f32x4*)(Mm + 1300);
              __builtin_amdgcn_sched_barrier(0);
              a0 -= mr4[0] * X[4]; a1 -= mr4[1] * X[5]; a2 -= mr4[2] * X[6]; a3 -= mr4[3] * X[7];
              mr4 = *(const LAS f32x4*)(Mm + 1304);
              __builtin_amdgcn_sched_barrier(0);
              a0 -= mr5[0] * X[8]; a1 -= mr5[1] * X[9]; a2 -= mr5[2] * X[10]; a3 -= mr5[3] * X[11];
              mr5 = *(const LAS f32x4*)(Mm + 1308);
              __builtin_amdgcn_sched_barrier(0);
              a0 -= mr6[0] * X[12]; a1 -= mr6[1] * X[13]; a2 -= mr6[2] * X[14]; a3 -= mr6[3] * X[15];
              mr6 = *(const LAS f32x4*)(Mm + 1360);
              __builtin_amdgcn_sched_barrier(0);
              a0 -= mr0[0] * X[16]; a1 -= mr0[1] * X[17];
              X[18] = (a0 + a1) + (a2 + a3); dst[2376] = X[18]; }
            __builtin_amdgcn_sched_barrier(0);
            rh0 = src[2772] * cf[21];
            { float a0 = rh1, a1 = 0.f, a2 = 0.f, a3 = 0.f;
              mr0 = *(const LAS f32x4*)(Mm + 1364);
              __builtin_amdgcn_sched_barrier(0);
              a0 -= mr1[0] * X[0]; a1 -= mr1[1] * X[1]; a2 -= mr1[2] * X[2]; a3 -= mr1[3] * X[3];
              mr1 = *(const LAS f32x4*)(Mm + 1368);
              __builtin_amdgcn_sched_barrier(0);
              a0 -= mr2[0] * X[4]; a1 -= mr2[1] * X[5]; a2 -= mr2[2] * X[6]; a3 -= mr2[3] * X[7];
              mr2 = *(const LAS f32x4*)(Mm + 1372);
              __builtin_amdgcn_sched_barrier(0);
              a0 -= mr3[0] * X[8]; a1 -= mr3[1] * X[9]; a2 -= mr3[2] * X[10]; a3 -= mr3[3] * X[11];
              mr3 = *(const LAS f32x4*)(Mm + 1376);
              __builtin_amdgcn_sched_barrier(0);
              a0 -= mr4[0] * X[12]; a1 -= mr4[1] * X[13]; a2 -= mr4[2] * X[14]; a3 -= mr4[3] * X[15];
              mr4 = *(const LAS f32x4*)(Mm + 1428);
              __builtin_amdgcn_sched_barrier(0);
              a0 -= mr5[0] * X[16]; a1 -= mr5[1] * X[17]; a2 -= mr5[2] * X[18];
              X[19] = (a0 + a1) + (a2 + a3); dst[2508] = X[19]; }
            __builtin_amdgcn_sched_barrier(0);
            rh1 = src[2904] * cf[22];
            { float a0 = rh2, a1 = 0.f, a2 = 0.f, a3 = 0.f;
              mr5 = *(const LAS f32x4*)(Mm + 1432);
              __builtin_amdgcn_sched_barrier(0);
              a0 -= mr6[0] * X[0]; a1 -= mr6[1] * X[1]; a2 -= mr6[2] * X[2]; a3 -= mr6[3] * X[3];
              mr6 = *(const LAS f32x4*)(Mm + 1436);
              __builtin_amdgcn_sched_barrier(0);
              a0 -= mr0[0] * X[4]; a1 -= mr0[1] * X[5]; a2 -= mr0[2] * X[6]; a3 -= mr0[3] * X[7];
              mr0 = *(const LAS f32x4*)(Mm + 1440);
              __builtin_amdgcn_sched_barrier(0);
              a0 -= mr1[0] * X[8]; a1 -= mr1[1] * X[9]; a2 -= mr1[2] * X[10]; a3 -= mr1[3] * X[11];
              mr1 = *(const LAS f32x4*)(Mm + 1444);
              __builtin_amdgcn_sched_barrier(0);
              a0 -= mr2[0] * X[12]; a1 -= mr2[1] * X[13]; a2 -= mr2[2] * X[14]; a3 -= mr2[3] * X[15];
              mr2 = *(const LAS f32x4*)(Mm + 1448);
              __builtin_amdgcn_sched_barrier(0);
              a0 -= mr3[0] * X[16]; a1 -= mr3[1] * X[17]; a2 -= mr3[2] * X[18]; a3 -= mr3[3] * X[19];
              X[20] = (a0 + a1) + (a2 + a3); dst[2640] = X[20]; }
            __builtin_amdgcn_sched_barrier(0);
            rh2 = src[3036] * cf[23];
            { float a0 = rh0, a1 = 0.f, a2 = 0.f, a3 = 0.f;
              mr3 = *(const LAS f32x4*)(Mm + 1496);
              __builtin_amdgcn_sched_barrier(0);
              a0 -= mr4[0] * X[0]; a1 -= mr4[1] * X[1]; a2 -= mr4[2] * X[2]; a3 -= mr4[3] * X[3];
              mr4 = *(const LAS f32x4*)(Mm + 1500);
              __builtin_amdgcn_sched_barrier(0);
              a0 -= mr5[0] * X[4]; a1 -= mr5[1] * X[5]; a2 -= mr5[2] * X[6]; a3 -= mr5[3] * X[7];
              mr5 = *(const LAS f32x4*)(Mm + 1504);
              __builtin_amdgcn_sched_barrier(0);
              a0 -= mr6[0] * X[8]; a1 -= mr6[1] * X[9]; a2 -= mr6[2] * X[10]; a3 -= mr6[3] * X[11];
              mr6 = *(const LAS f32x4*)(Mm + 1508);
              __builtin_amdgcn_sched_barrier(0);
              a0 -= mr0[0] * X[12]; a1 -= mr0[1] * X[13]; a2 -= mr0[2] * X[14]; a3 -= mr0[3] * X[15];
              mr0 = *(const LAS f32x4*)(Mm + 1512);
              __builtin_amdgcn_sched_barrier(0);
              a0 -= mr1[0] * X[16]; a1 -= mr1[1] * X[17]; a2 -= mr1[2] * X[18]; a3 -= mr1[3] * X[19];
              mr1 = *(const LAS f32x4*)(Mm + 1516);
              __builtin_amdgcn_sched_barrier(0);
              a0 -= mr2[0] * X[20];
              X[21] = (a0 + a1) + (a2 + a3); dst[2772] = X[21]; }
            __builtin_amdgcn_sched_barrier(0);
            rh0 = src[3168] * cf[24];
            { float a0 = rh1, a1 = 0.f, a2 = 0.f, a3 = 0.f;
              mr2 = *(const LAS f32x4*)(Mm + 1564);
              __builtin_amdgcn_sched_barrier(0);
              a0 -= mr3[0] * X[0]; a1 -= mr3[1] * X[1]; a2 -= mr3[2] * X[2]; a3 -= mr3[3] * X[3];
              mr3 = *(const LAS f32x4*)(Mm + 1568);
              __builtin_amdgcn_sched_barrier(0);
              a0 -= mr4[0] * X[4]; a1 -= mr4[1] * X[5]; a2 -= mr4[2] * X[6]; a3 -= mr4[3] * X[7];
              mr4 = *(const LAS f32x4*)(Mm + 1572);
              __builtin_amdgcn_sched_barrier(0);
              a0 -= mr5[0] * X[8]; a1 -= mr5[1] * X[9]; a2 -= mr5[2] * X[10]; a3 -= mr5[3] * X[11];
              mr5 = *(const LAS f32x4*)(Mm + 1576);
              __builtin_amdgcn_sched_barrier(0);
              a0 -= mr6[0] * X[12]; a1 -= mr6[1] * X[13]; a2 -= mr6[2] * X[14]; a3 -= mr6[3] * X[15];
              mr6 = *(const LAS f32x4*)(Mm + 1580);
              __builtin_amdgcn_sched_barrier(0);
              a0 -= mr0[0] * X[16]; a1 -= mr0[1] * X[17]; a2 -= mr0[2] * X[18]; a3 -= mr0[3] * X[19];
              mr0 = *(const LAS f32x4*)(Mm + 1584);
              __builtin_amdgcn_sched_barrier(0);
              a0 -= mr1[0] * X[20]; a1 -= mr1[1] * X[21];
              X[22] = (a0 + a1) + (a2 + a3); dst[2904] = X[22]; }
            __builtin_amdgcn_sched_barrier(0);
            rh1 = src[3300] * cf[25];
            { float a0 = rh2, a1 = 0.f, a2 = 0.f, a3 = 0.f;
              mr1 = *(const LAS f32x4*)(Mm + 1632);
              __builtin_amdgcn_sched_barrier(0);
              a0 -= mr2[0] * X[0]; a1 -= mr2[1] * X[1]; a2 -= mr2[2] * X[2]; a3 -= mr2[3] * X[3];
              mr2 = *(const LAS f32x4*)(Mm + 1636);
              __builtin_amdgcn_sched_barrier(0);
              a0 -= mr3[0] * X[4]; a1 -= mr3[1] * X[5]; a2 -= mr3[2] * X[6]; a3 -= mr3[3] * X[7];
              mr3 = *(const LAS f32x4*)(Mm + 1640);
              __builtin_amdgcn_sched_barrier(0);
              a0 -= mr4[0] * X[8]; a1 -= mr4[1] * X[9]; a2 -= mr4[2] * X[10]; a3 -= mr4[3] * X[11];
              mr4 = *(const LAS f32x4*)(Mm + 1644);
              __builtin_amdgcn_sched_barrier(0);
              a0 -= mr5[0] * X[12]; a1 -= mr5[1] * X[13]; a2 -= mr5[2] * X[14]; a3 -= mr5[3] * X[15];
              mr5 = *(const LAS f32x4*)(Mm + 1648);
              __builtin_amdgcn_sched_barrier(0);
              a0 -= mr6[0] * X[16]; a1 -= mr6[1] * X[17]; a2 -= mr6[2] * X[18]; a3 -= mr6[3] * X[19];
              mr6 = *(const LAS f32x4*)(Mm + 1652);
              __builtin_amdgcn_sched_barrier(0);
              a0 -= mr0[0] * X[20]; a1 -= mr0[1] * X[21]; a2 -= mr0[2] * X[22];
              X[23] = (a0 + a1) + (a2 + a3); dst[3036] = X[23]; }
            __builtin_amdgcn_sched_barrier(0);
            rh2 = src[3432] * cf[26];
            { float a0 = rh0, a1 = 0.f, a2 = 0.f, a3 = 0.f;
              mr0 = *(const LAS f32x4*)(Mm + 1700);
              __builtin_amdgcn_sched_barrier(0);
              a0 -= mr1[0] * X[0]; a1 -= mr1[1] * X[1]; a2 -= mr1[2] * X[2]; a3 -= mr1[3] * X[3];
              mr1 = *(const LAS f32x4*)(Mm + 1704);
              __builtin_amdgcn_sched_barrier(0);
              a0 -= mr2[0] * X[4]; a1 -= mr2[1] * X[5]; a2 -= mr2[2] * X[6]; a3 -= mr2[3] * X[7];
              mr2 = *(const LAS f32x4*)(Mm + 1708);
              __builtin_amdgcn_sched_barrier(0);
              a0 -= mr3[0] * X[8]; a1 -= mr3[1] * X[9]; a2 -= mr3[2] * X[10]; a3 -= mr3[3] * X[11];
              mr3 = *(const LAS f32x4*)(Mm + 1712);
              __builtin_amdgcn_sched_barrier(0);
              a0 -= mr4[0] * X[12]; a1 -= mr4[1] * X[13]; a2 -= mr4[2] * X[14]; a3 -= mr4[3] * X[15];
              mr4 = *(const LAS f32x4*)(Mm + 1716);
              __builtin_amdgcn_sched_barrier(0);
              a0 -= mr5[0] * X[16]; a1 -= mr5[1] * X[17]; a2 -= mr5[2] * X[18]; a3 -= mr5[3] * X[19];
              mr5 = *(const LAS f32x4*)(Mm + 1720);
              __builtin_amdgcn_sched_barrier(0);
              a0 -= mr6[0] * X[20]; a1 -= mr6[1] * X[21]; a2 -= mr6[2] * X[22]; a3 -= mr6[3] * X[23];
              X[24] = (a0 + a1) + (a2 + a3); dst[3168] = X[24]; }
            __builtin_amdgcn_sched_barrier(0);
            rh0 = src[3564] * cf[27];
            { float a0 = rh1, a1 = 0.f, a2 = 0.f, a3 = 0.f;
              mr6 = *(const LAS f32x4*)(Mm + 1724);
              __builtin_amdgcn_sched_barrier(0);
              a0 -= mr0[0] * X[0]; a1 -= mr0[1] * X[1]; a2 -= mr0[2] * X[2]; a3 -= mr0[3] * X[3];
              mr0 = *(const LAS f32x4*)(Mm + 1768);
              __builtin_amdgcn_sched_barrier(0);
              a0 -= mr1[0] * X[4]; a1 -= mr1[1] * X[5]; a2 -= mr1[2] * X[6]; a3 -= mr1[3] * X[7];
              mr1 = *(const LAS f32x4*)(Mm + 1772);
              __builtin_amdgcn_sched_barrier(0);
              a0 -= mr2[0] * X[8]; a1 -= mr2[1] * X[9]; a2 -= mr2[2] * X[10]; a3 -= mr2[3] * X[11];
              mr2 = *(const LAS f32x4*)(Mm + 1776);
              __builtin_amdgcn_sched_barrier(0);
              a0 -= mr3[0] * X[12]; a1 -= mr3[1] * X[13]; a2 -= mr3[2] * X[14]; a3 -= mr3[3] * X[15];
              mr3 = *(const LAS f32x4*)(Mm + 1780);
              __builtin_amdgcn_sched_barrier(0);
              a0 -= mr4[0] * X[16]; a1 -= mr4[1] * X[17]; a2 -= mr4[2] * X[18]; a3 -= mr4[3] * X[19];
              mr4 = *(const LAS f32x4*)(Mm + 1784);
              __builtin_amdgcn_sched_barrier(0);
              a0 -= mr5[0] * X[20]; a1 -= mr5[1] * X[21]; a2 -= mr5[2] * X[22]; a3 -= mr5[3] * X[23];
              mr5 = *(const LAS f32x4*)(Mm + 1788);
              __builtin_amdgcn_sched_barrier(0);
              a0 -= mr6[0] * X[24];
              X[25] = (a0 + a1) + (a2 + a3); dst[3300] = X[25]; }
            __builtin_amdgcn_sched_barrier(0);
            rh1 = src[3696] * cf[28];
            { float a0 = rh2, a1 = 0.f, a2 = 0.f, a3 = 0.f;
              mr6 = *(const LAS f32x4*)(Mm + 1792);
              __builtin_amdgcn_sched_barrier(0);
              a0 -= mr0[0] * X[0]; a1 -= mr0[1] * X[1]; a2 -= mr0[2] * X[2]; a3 -= mr0[3] * X[3];
              mr0 = *(const LAS f32x4*)(Mm + 1836);
              __builtin_amdgcn_sched_barrier(0);
              a0 -= mr1[0] * X[4]; a1 -= mr1[1] * X[5]; a2 -= mr1[2] * X[6]; a3 -= mr1[3] * X[7];
              mr1 = *(const LAS f32x4*)(Mm + 1840);
              __builtin_amdgcn_sched_barrier(0);
              a0 -= mr2[0] * X[8]; a1 -= mr2[1] * X[9]; a2 -= mr2[2] * X[10]; a3 -= mr2[3] * X[11];
              mr2 = *(const LAS f32x4*)(Mm + 1844);
              __builtin_amdgcn_sched_barrier(0);
              a0 -= mr3[0] * X[12]; a1 -= mr3[1] * X[13]; a2 -= mr3[2] * X[14]; a3 -= mr3[3] * X[15];
              mr3 = *(const LAS f32x4*)(Mm + 1848);
              __builtin_amdgcn_sched_barrier(0);
              a0 -= mr4[0] * X[16]; a1 -= mr4[1] * X[17]; a2 -= mr4[2] * X[18]; a3 -= mr4[3] * X[19];
              mr4 = *(const LAS f32x4*)(Mm + 1852);
              __builtin_amdgcn_sched_barrier(0);
              a0 -= mr5[0] * X[20]; a1 -= mr5[1] * X[21]; a2 -= mr5[2] * X[22]; a3 -= mr5[3] * X[23];
              mr5 = *(const LAS f32x4*)(Mm + 1856);
              __builtin_amdgcn_sched_barrier(0);
              a0 -= mr6[0] * X[24]; a1 -= mr6[1] * X[25];
              X[26] = (a0 + a1) + (a2 + a3); dst[3432] = X[26]; }
            __builtin_amdgcn_sched_barrier(0);
            rh2 = src[3828] * cf[29];
            { float a0 = rh0, a1 = 0.f, a2 = 0.f, a3 = 0.f;
              mr6 = *(const LAS f32x4*)(Mm + 1860);
              __builtin_amdgcn_sched_barrier(0);
              a0 -= mr0[0] * X[0]; a1 -= mr0[1] * X[1]; a2 -= mr0[2] * X[2]; a3 -= mr0[3] * X[3];
              mr0 = *(const LAS f32x4*)(Mm + 1904);
              __builtin_amdgcn_sched_barrier(0);
              a0 -= mr1[0] * X[4]; a1 -= mr1[1] * X[5]; a2 -= mr1[2] * X[6]; a3 -= mr1[3] * X[7];
              mr1 = *(const LAS f32x4*)(Mm + 1908);
              __builtin_amdgcn_sched_barrier(0);
              a0 -= mr2[0] * X[8]; a1 -= mr2[1] * X[9]; a2 -= mr2[2] * X[10]; a3 -= mr2[3] * X[11];
              mr2 = *(const LAS f32x4*)(Mm + 1912);
              __builtin_amdgcn_sched_barrier(0);
              a0 -= mr3[0] * X[12]; a1 -= mr3[1] * X[13]; a2 -= mr3[2] * X[14]; a3 -= mr3[3] * X[15];
              mr3 = *(const LAS f32x4*)(Mm + 1916);
              __builtin_amdgcn_sched_barrier(0);
              a0 -= mr4[0] * X[16]; a1 -= mr4[1] * X[17]; a2 -= mr4[2] * X[18]; a3 -= mr4[3] * X[19];
              mr4 = *(const LAS f32x4*)(Mm + 1920);
              __builtin_amdgcn_sched_barrier(0);
              a0 -= mr5[0] * X[20]; a1 -= mr5[1] * X[21]; a2 -= mr5[2] * X[22]; a3 -= mr5[3] * X[23];
              mr5 = *(const LAS f32x4*)(Mm + 1924);
              __builtin_amdgcn_sched_barrier(0);
              a0 -= mr6[0] * X[24]; a1 -= mr6[1] * X[25]; a2 -= mr6[2] * X[26];
              X[27] = (a0 + a1) + (a2 + a3); dst[3564] = X[27]; }
            __builtin_amdgcn_sched_barrier(0);
            rh0 = src[3960] * cf[30];
            { float a0 = rh1, a1 = 0.f, a2 = 0.f, a3 = 0.f;
              mr6 = *(const LAS f32x4*)(Mm + 1928);
              __builtin_amdgcn_sched_barrier(0);
              a0 -= mr0[0] * X[0]; a1 -= mr0[1] * X[1]; a2 -= mr0[2] * X[2]; a3 -= mr0[3] * X[3];
              mr0 = *(const LAS f32x4*)(Mm + 1972);
              __builtin_amdgcn_sched_barrier(0);
              a0 -= mr1[0] * X[4]; a1 -= mr1[1] * X[5]; a2 -= mr1[2] * X[6]; a3 -= mr1[3] * X[7];
              mr1 = *(const LAS f32x4*)(Mm + 1976);
              __builtin_amdgcn_sched_barrier(0);
              a0 -= mr2[0] * X[8]; a1 -= mr2[1] * X[9]; a2 -= mr2[2] * X[10]; a3 -= mr2[3] * X[11];
              mr2 = *(const LAS f32x4*)(Mm + 1980);
              __builtin_amdgcn_sched_barrier(0);
              a0 -= mr3[0] * X[12]; a1 -= mr3[1] * X[13]; a2 -= mr3[2] * X[14]; a3 -= mr3[3] * X[15];
              mr3 = *(const LAS f32x4*)(Mm + 1984);
              __builtin_amdgcn_sched_barrier(0);
              a0 -= mr4[0] * X[16]; a1 -= mr4[1] * X[17]; a2 -= mr4[2] * X[18]; a3 -= mr4[3] * X[19];
              mr4 = *(const LAS f32x4*)(Mm + 1988);
              __builtin_amdgcn_sched_barrier(0);
              a0 -= mr5[0] * X[20]; a1 -= mr5[1] * X[21]; a2 -= mr5[2] * X[22]; a3 -= mr5[3] * X[23];
              mr5 = *(const LAS f32x4*)(Mm + 1992);
              __builtin_amdgcn_sched_barrier(0);
              a0 -= mr6[0] * X[24]; a1 -= mr6[1] * X[25]; a2 -= mr6[2] * X[26]; a3 -= mr6[3] * X[27];
              X[28] = (a0 + a1) + (a2 + a3); dst[3696] = X[28]; }
            __builtin_amdgcn_sched_barrier(0);
            rh1 = src[4092] * cf[31];
            { float a0 = rh2, a1 = 0.f, a2 = 0.f, a3 = 0.f;
              mr6 = *(const LAS f32x4*)(Mm + 1996);
              __builtin_amdgcn_sched_barrier(0);
              a0 -= mr0[0] * X[0]; a1 -= mr0[1] * X[1]; a2 -= mr0[2] * X[2]; a3 -= mr0[3] * X[3];
              mr0 = *(const LAS f32x4*)(Mm + 2000);
              __builtin_amdgcn_sched_barrier(0);
              a0 -= mr1[0] * X[4]; a1 -= mr1[1] * X[5]; a2 -= mr1[2] * X[6]; a3 -= mr1[3] * X[7];
              mr1 = *(const LAS f32x4*)(Mm + 2040);
              __builtin_amdgcn_sched_barrier(0);
              a0 -= mr2[0] * X[8]; a1 -= mr2[1] * X[9]; a2 -= mr2[2] * X[10]; a3 -= mr2[3] * X[11];
              mr2 = *(const LAS f32x4*)(Mm + 2044);
              __builtin_amdgcn_sched_barrier(0);
              a0 -= mr3[0] * X[12]; a1 -= mr3[1] * X[13]; a2 -= mr3[2] * X[14]; a3 -= mr3[3] * X[15];
              mr3 = *(const LAS f32x4*)(Mm + 2048);
              __builtin_amdgcn_sched_barrier(0);
              a0 -= mr4[0] * X[16]; a1 -= mr4[1] * X[17]; a2 -= mr4[2] * X[18]; a3 -= mr4[3] * X[19];
              mr4 = *(const LAS f32x4*)(Mm + 2052);
              __builtin_amdgcn_sched_barrier(0);
              a0 -= mr5[0] * X[20]; a1 -= mr5[1] * X[21]; a2 -= mr5[2] * X[22]; a3 -= mr5[3] * X[23];
              mr5 = *(const LAS f32x4*)(Mm + 2056);
              __builtin_amdgcn_sched_barrier(0);
              a0 -= mr6[0] * X[24]; a1 -= mr6[1] * X[25]; a2 -= mr6[2] * X[26]; a3 -= mr6[3] * X[27];
              mr6 = *(const LAS f32x4*)(Mm + 2060);
              __builtin_amdgcn_sched_barrier(0);
              a0 -= mr0[0] * X[28];
              X[29] = (a0 + a1) + (a2 + a3); dst[3828] = X[29]; }
            __builtin_amdgcn_sched_barrier(0);
            rh2 = src[4224] * cf[32];
            { float a0 = rh0, a1 = 0.f, a2 = 0.f, a3 = 0.f;
              mr0 = *(const LAS f32x4*)(Mm + 2064);
              __builtin_amdgcn_sched_barrier(0);
              a0 -= mr1[0] * X[0]; a1 -= mr1[1] * X[1]; a2 -= mr1[2] * X[2]; a3 -= mr1[3] * X[3];
              mr1 = *(const LAS f32x4*)(Mm + 2068);
              __builtin_amdgcn_sched_barrier(0);
              a0 -= mr2[0] * X[4]; a1 -= mr2[1] * X[5]; a2 -= mr2[2] * X[6]; a3 -= mr2[3] * X[7];
              mr2 = *(const LAS f32x4*)(Mm + 2108);
              __builtin_amdgcn_sched_barrier(0);
              a0 -= mr3[0] * X[8]; a1 -= mr3[1] * X[9]; a2 -= mr3[2] * X[10]; a3 -= mr3[3] * X[11];
              mr3 = *(const LAS f32x4*)(Mm + 2112);
              __builtin_amdgcn_sched_barrier(0);
              a0 -= mr4[0] * X[12]; a1 -= mr4[1] * X[13]; a2 -= mr4[2] * X[14]; a3 -= mr4[3] * X[15];
              mr4 = *(const LAS f32x4*)(Mm + 2116);
              __builtin_amdgcn_sched_barrier(0);
              a0 -= mr5[0] * X[16]; a1 -= mr5[1] * X[17]; a2 -= mr5[2] * X[18]; a3 -= mr5[3] * X[19];
              mr5 = *(const LAS f32x4*)(Mm + 2120);
              __builtin_amdgcn_sched_barrier(0);
              a0 -= mr6[0] * X[20]; a1 -= mr6[1] * X[21]; a2 -= mr6[2] * X[22]; a3 -= mr6[3] * X[23];
              mr6 = *(const LAS f32x4*)(Mm + 2124);
              __builtin_amdgcn_sched_barrier(0);
              a0 -= mr0[0] * X[24]; a1 -= mr0[1] * X[25]; a2 -= mr0[2] * X[26]; a3 -= mr0[3] * X[27];
              mr0 = *(const LAS f32x4*)(Mm + 2128);
              __builtin_amdgcn_sched_barrier(0);
              a0 -= mr1[0] * X[28]; a1 -= mr1[1] * X[29];
              X[30] = (a0 + a1) + (a2 + a3); dst[3960] = X[30]; }
            __builtin_amdgcn_sched_barrier(0);
            rh0 = src[4356] * cf[33];
            { float a0 = rh1, a1 = 0.f, a2 = 0.f, a3 = 0.f;
              mr1 = *(const LAS f32x4*)(Mm + 2132);
              __builtin_amdgcn_sched_barrier(0);
              a0 -= mr2[0] * X[0]; a1 -= mr2[1] * X[1]; a2 -= mr2[2] * X[2]; a3 -= mr2[3] * X[3];
              mr2 = *(const LAS f32x4*)(Mm + 2136);
              __builtin_amdgcn_sched_barrier(0);
              a0 -= mr3[0] * X[4]; a1 -= mr3[1] * X[5]; a2 -= mr3[2] * X[6]; a3 -= mr3[3] * X[7];
              mr3 = *(const LAS f32x4*)(Mm + 2176);
              __builtin_amdgcn_sched_barrier(0);
              a0 -= mr4[0] * X[8]; a1 -= mr4[1] * X[9]; a2 -= mr4[2] * X[10]; a3 -= mr4[3] * X[11];
              mr4 = *(const LAS f32x4*)(Mm + 2180);
              __builtin_amdgcn_sched_barrier(0);
              a0 -= mr5[0] * X[12]; a1 -= mr5[1] * X[13]; a2 -= mr5[2] * X[14]; a3 -= mr5[3] * X[15];
              mr5 = *(const LAS f32x4*)(Mm + 2184);
              __builtin_amdgcn_sched_barrier(0);
              a0 -= mr6[0] * X[16]; a1 -= mr6[1] * X[17]; a2 -= mr6[2] * X[18]; a3 -= mr6[3] * X[19];
              mr6 = *(const LAS f32x4*)(Mm + 2188);
              __builtin_amdgcn_sched_barrier(0);
              a0 -= mr0[0] * X[20]; a1 -= mr0[1] * X[21]; a2 -= mr0[2] * X[22]; a3 -= mr0[3] * X[23];
              mr0 = *(const LAS f32x4*)(Mm + 2192);
              __builtin_amdgcn_sched_barrier(0);
              a0 -= mr1[0] * X[24]; a1 -= mr1[1] * X[25]; a2 -= mr1[2] * X[26]; a3 -= mr1[3] * X[27];
              mr1 = *(const LAS f32x4*)(Mm + 2196);
              __builtin_amdgcn_sched_barrier(0);
              a0 -= mr2[0] * X[28]; a1 -= mr2[1] * X[29]; a2 -= mr2[2] * X[30];
              X[31] = (a0 + a1) + (a2 + a3); dst[4092] = X[31]; }
            __builtin_amdgcn_sched_barrier(0);
            rh1 = src[4488] * cf[34];
            { float a0 = rh2, a1 = 0.f, a2 = 0.f, a3 = 0.f;
              mr2 = *(const LAS f32x4*)(Mm + 2200);
              __builtin_amdgcn_sched_barrier(0);
              a0 -= mr3[0] * X[0]; a1 -= mr3[1] * X[1]; a2 -= mr3[2] * X[2]; a3 -= mr3[3] * X[3];
              mr3 = *(const LAS f32x4*)(Mm + 2204);
              __builtin_amdgcn_sched_barrier(0);
              a0 -= mr4[0] * X[4]; a1 -= mr4[1] * X[5]; a2 -= mr4[2] * X[6]; a3 -= mr4[3] * X[7];
              mr4 = *(const LAS f32x4*)(Mm + 2244);
              __builtin_amdgcn_sched_barrier(0);
              a0 -= mr5[0] * X[8]; a1 -= mr5[1] * X[9]; a2 -= mr5[2] * X[10]; a3 -= mr5[3] * X[11];
              mr5 = *(const LAS f32x4*)(Mm + 2248);
              __builtin_amdgcn_sched_barrier(0);
              a0 -= mr6[0] * X[12]; a1 -= mr6[1] * X[13]; a2 -= mr6[2] * X[14]; a3 -= mr6[3] * X[15];
              mr6 = *(const LAS f32x4*)(Mm + 2252);
              __builtin_amdgcn_sched_barrier(0);
              a0 -= mr0[0] * X[16]; a1 -= mr0[1] * X[17]; a2 -= mr0[2] * X[18]; a3 -= mr0[3] * X[19];
              mr0 = *(const LAS f32x4*)(Mm + 2256);
              __builtin_amdgcn_sched_barrier(0);
              a0 -= mr1[0] * X[20]; a1 -= mr1[1] * X[21]; a2 -= mr1[2] * X[22]; a3 -= mr1[3] * X[23];
              mr1 = *(const LAS f32x4*)(Mm + 2260);
              __builtin_amdgcn_sched_barrier(0);
              a0 -= mr2[0] * X[24]; a1 -= mr2[1] * X[25]; a2 -= mr2[2] * X[26]; a3 -= mr2[3] * X[27];
              mr2 = *(const LAS f32x4*)(Mm + 2264);
              __builtin_amdgcn_sched_barrier(0);
              a0 -= mr3[0] * X[28]; a1 -= mr3[1] * X[29]; a2 -= mr3[2] * X[30]; a3 -= mr3[3] * X[31];
              X[32] = (a0 + a1) + (a2 + a3); dst[4224] = X[32]; }
            __builtin_amdgcn_sched_barrier(0);
            rh2 = src[4620] * cf[35];
            { float a0 = rh0, a1 = 0.f, a2 = 0.f, a3 = 0.f;
              mr3 = *(const LAS f32x4*)(Mm + 2268);
              __builtin_amdgcn_sched_barrier(0);
              a0 -= mr4[0] * X[0]; a1 -= mr4[1] * X[1]; a2 -= mr4[2] * X[2]; a3 -= mr4[3] * X[3];
              mr4 = *(const LAS f32x4*)(Mm + 2272);
              __builtin_amdgcn_sched_barrier(0);
              a0 -= mr5[0] * X[4]; a1 -= mr5[1] * X[5]; a2 -= mr5[2] * X[6]; a3 -= mr5[3] * X[7];
              mr5 = *(const LAS f32x4*)(Mm + 2276);
              __builtin_amdgcn_sched_barrier(0);
              a0 -= mr6[0] * X[8]; a1 -= mr6[1] * X[9]; a2 -= mr6[2] * X[10]; a3 -= mr6[3] * X[11];
              mr6 = *(const LAS f32x4*)(Mm + 2312);
              __builtin_amdgcn_sched_barrier(0);
              a0 -= mr0[0] * X[12]; a1 -= mr0[1] * X[13]; a2 -= mr0[2] * X[14]; a3 -= mr0[3] * X[15];
              mr0 = *(const LAS f32x4*)(Mm + 2316);
              __builtin_amdgcn_sched_barrier(0);
              a0 -= mr1[0] * X[16]; a1 -= mr1[1] * X[17]; a2 -= mr1[2] * X[18]; a3 -= mr1[3] * X[19];
              mr1 = *(const LAS f32x4*)(Mm + 2320);
              __builtin_amdgcn_sched_barrier(0);
              a0 -= mr2[0] * X[20]; a1 -= mr2[1] * X[21]; a2 -= mr2[2] * X[22]; a3 -= mr2[3] * X[23];
              mr2 = *(const LAS f32x4*)(Mm + 2324);
              __builtin_amdgcn_sched_barrier(0);
              a0 -= mr3[0] * X[24]; a1 -= mr3[1] * X[25]; a2 -= mr3[2] * X[26]; a3 -= mr3[3] * X[27];
              mr3 = *(const LAS f32x4*)(Mm + 2328);
              __builtin_amdgcn_sched_barrier(0);
              a0 -= mr4[0] * X[28]; a1 -= mr4[1] * X[29]; a2 -= mr4[2] * X[30]; a3 -= mr4[3] * X[31];
              mr4 = *(const LAS f32x4*)(Mm + 2332);
              __builtin_amdgcn_sched_barrier(0);
              a0 -= mr5[0] * X[32];
              X[33] = (a0 + a1) + (a2 + a3); dst[4356] = X[33]; }
            __builtin_amdgcn_sched_barrier(0);
            rh0 = src[4752] * cf[36];
            { float a0 = rh1, a1 = 0.f, a2 = 0.f, a3 = 0.f;
              mr5 = *(const LAS f32x4*)(Mm + 2336);
              __builtin_amdgcn_sched_barrier(0);
              a0 -= mr6[0] * X[0]; a1 -= mr6[1] * X[1]; a2 -= mr6[2] * X[2]; a3 -= mr6[3] * X[3];
              mr6 = *(const LAS f32x4*)(Mm + 2340);
              __builtin_amdgcn_sched_barrier(0);
              a0 -= mr0[0] * X[4]; a1 -= mr0[1] * X[5]; a2 -= mr0[2] * X[6]; a3 -= mr0[3] * X[7];
              mr0 = *(const LAS f32x4*)(Mm + 2344);
              __builtin_amdgcn_sched_barrier(0);
              a0 -= mr1[0] * X[8]; a1 -= mr1[1] * X[9]; a2 -= mr1[2] * X[10]; a3 -= mr1[3] * X[11];
              mr1 = *(const LAS f32x4*)(Mm + 2380);
              __builtin_amdgcn_sched_barrier(0);
              a0 -= mr2[0] * X[12]; a1 -= mr2[1] * X[13]; a2 -= mr2[2] * X[14]; a3 -= mr2[3] * X[15];
              mr2 = *(const LAS f32x4*)(Mm + 2384);
              __builtin_amdgcn_sched_barrier(0);
              a0 -= mr3[0] * X[16]; a1 -= mr3[1] * X[17]; a2 -= mr3[2] * X[18]; a3 -= mr3[3] * X[19];
              mr3 = *(const LAS f32x4*)(Mm + 2388);
              __builtin_amdgcn_sched_barrier(0);
              a0 -= mr4[0] * X[20]; a1 -= mr4[1] * X[21]; a2 -= mr4[2] * X[22]; a3 -= mr4[3] * X[23];
              mr4 = *(const LAS f32x4*)(Mm + 2392);
              __builtin_amdgcn_sched_barrier(0);
              a0 -= mr5[0] * X[24]; a1 -= mr5[1] * X[25]; a2 -= mr5[2] * X[26]; a3 -= mr5[3] * X[27];
              mr5 = *(const LAS f32x4*)(Mm + 2396);
              __builtin_amdgcn_sched_barrier(0);
              a0 -= mr6[0] * X[28]; a1 -= mr6[1] * X[29]; a2 -= mr6[2] * X[30]; a3 -= mr6[3] * X[31];
              mr6 = *(const LAS f32x4*)(Mm + 2400);
              __builtin_amdgcn_sched_barrier(0);
              a0 -= mr0[0] * X[32]; a1 -= mr0[1] * X[33];
              X[34] = (a0 + a1) + (a2 + a3); dst[4488] = X[34]; }
            __builtin_amdgcn_sched_barrier(0);
            rh1 = src[4884] * cf[37];
            { float a0 = rh2, a1 = 0.f, a2 = 0.f, a3 = 0.f;
              mr0 = *(const LAS f32x4*)(Mm + 2404);
              __builtin_amdgcn_sched_barrier(0);
              a0 -= mr1[0] * X[0]; a1 -= mr1[1] * X[1]; a2 -= mr1[2] * X[2]; a3 -= mr1[3] * X[3];
              mr1 = *(const LAS f32x4*)(Mm + 2408);
              __builtin_amdgcn_sched_barrier(0);
              a0 -= mr2[0] * X[4]; a1 -= mr2[1] * X[5]; a2 -= mr2[2] * X[6]; a3 -= mr2[3] * X[7];
              mr2 = *(const LAS f32x4*)(Mm + 2412);
              __builtin_amdgcn_sched_barrier(0);
              a0 -= mr3[0] * X[8]; a1 -= mr3[1] * X[9]; a2 -= mr3[2] * X[10]; a3 -= mr3[3] * X[11];
              mr3 = *(const LAS f32x4*)(Mm + 2448);
              __builtin_amdgcn_sched_barrier(0);
              a0 -= mr4[0] * X[12]; a1 -= mr4[1] * X[13]; a2 -= mr4[2] * X[14]; a3 -= mr4[3] * X[15];
              mr4 = *(const LAS f32x4*)(Mm + 2452);
              __builtin_amdgcn_sched_barrier(0);
              a0 -= mr5[0] * X[16]; a1 -= mr5[1] * X[17]; a2 -= mr5[2] * X[18]; a3 -= mr5[3] * X[19];
              mr5 = *(const LAS f32x4*)(Mm + 2456);
              __builtin_amdgcn_sched_barrier(0);
              a0 -= mr6[0] * X[20]; a1 -= mr6[1] * X[21]; a2 -= mr6[2] * X[22]; a3 -= mr6[3] * X[23];
              mr6 = *(const LAS f32x4*)(Mm + 2460);
              __builtin_amdgcn_sched_barrier(0);
              a0 -= mr0[0] * X[24]; a1 -= mr0[1] * X[25]; a2 -= mr0[2] * X[26]; a3 -= mr0[3] * X[27];
              mr0 = *(const LAS f32x4*)(Mm + 2464);
              __builtin_amdgcn_sched_barrier(0);
              a0 -= mr1[0] * X[28]; a1 -= mr1[1] * X[29]; a2 -= mr1[2] * X[30]; a3 -= mr1[3] * X[31];
              mr1 = *(const LAS f32x4*)(Mm + 2468);
              __builtin_amdgcn_sched_barrier(0);
              a0 -= mr2[0] * X[32]; a1 -= mr2[1] * X[33]; a2 -= mr2[2] * X[34];
              X[35] = (a0 + a1) + (a2 + a3); dst[4620] = X[35]; }
            __builtin_amdgcn_sched_barrier(0);
            rh2 = src[5016] * cf[38];
            { float a0 = rh0, a1 = 0.f, a2 = 0.f, a3 = 0.f;
              mr2 = *(const LAS f32x4*)(Mm + 2472);
              __builtin_amdgcn_sched_barrier(0);
              a0 -= mr3[0] * X[0]; a1 -= mr3[1] * X[1]; a2 -= mr3[2] * X[2]; a3 -= mr3[3] * X[3];
              mr3 = *(const LAS f32x4*)(Mm + 2476);
              __builtin_amdgcn_sched_barrier(0);
              a0 -= mr4[0] * X[4]; a1 -= mr4[1] * X[5]; a2 -= mr4[2] * X[6]; a3 -= mr4[3] * X[7];
              mr4 = *(const LAS f32x4*)(Mm + 2480);
              __builtin_amdgcn_sched_barrier(0);
              a0 -= mr5[0] * X[8]; a1 -= mr5[1] * X[9]; a2 -= mr5[2] * X[10]; a3 -= mr5[3] * X[11];
              mr5 = *(const LAS f32x4*)(Mm + 2516);
              __builtin_amdgcn_sched_barrier(0);
              a0 -= mr6[0] * X[12]; a1 -= mr6[1] * X[13]; a2 -= mr6[2] * X[14]; a3 -= mr6[3] * X[15];
              mr6 = *(const LAS f32x4*)(Mm + 2520);
              __builtin_amdgcn_sched_barrier(0);
              a0 -= mr0[0] * X[16]; a1 -= mr0[1] * X[17]; a2 -= mr0[2] * X[18]; a3 -= mr0[3] * X[19];
              mr0 = *(const LAS f32x4*)(Mm + 2524);
              __builtin_amdgcn_sched_barrier(0);
              a0 -= mr1[0] * X[20]; a1 -= mr1[1] * X[21]; a2 -= mr1[2] * X[22]; a3 -= mr1[3] * X[23];
              mr1 = *(const LAS f32x4*)(Mm + 2528);
              __builtin_amdgcn_sched_barrier(0);
              a0 -= mr2[0] * X[24]; a1 -= mr2[1] * X[25]; a2 -= mr2[2] * X[26]; a3 -= mr2[3] * X[27];
              mr2 = *(const LAS f32x4*)(Mm + 2532);
              __builtin_amdgcn_sched_barrier(0);
              a0 -= mr3[0] * X[28]; a1 -= mr3[1] * X[29]; a2 -= mr3[2] * X[30]; a3 -= mr3[3] * X[31];
              mr3 = *(const LAS f32x4*)(Mm + 2536);
              __builtin_amdgcn_sched_barrier(0);
              a0 -= mr4[0] * X[32]; a1 -= mr4[1] * X[33]; a2 -= mr4[2] * X[34]; a3 -= mr4[3] * X[35];
              X[36] = (a0 + a1) + (a2 + a3); dst[4752] = X[36]; }
            __builtin_amdgcn_sched_barrier(0);
            rh0 = src[5148] * cf[39];
            { float a0 = rh1, a1 = 0.f, a2 = 0.f, a3 = 0.f;
              mr4 = *(const LAS f32x4*)(Mm + 2540);
              __builtin_amdgcn_sched_barrier(0);
              a0 -= mr5[0] * X[0]; a1 -= mr5[1] * X[1]; a2 -= mr5[2] * X[2]; a3 -= mr5[3] * X[3];
              mr5 = *(const LAS f32x4*)(Mm + 2544);
              __builtin_amdgcn_sched_barrier(0);
              a0 -= mr6[0] * X[4]; a1 -= mr6[1] * X[5]; a2 -= mr6[2] * X[6]; a3 -= mr6[3] * X[7];
              mr6 = *(const LAS f32x4*)(Mm + 2548);
              __builtin_amdgcn_sched_barrier(0);
              a0 -= mr0[0] * X[8]; a1 -= mr0[1] * X[9]; a2 -= mr0[2] * X[10]; a3 -= mr0[3] * X[11];
              mr0 = *(const LAS f32x4*)(Mm + 2552);
              __builtin_amdgcn_sched_barrier(0);
              a0 -= mr1[0] * X[12]; a1 -= mr1[1] * X[13]; a2 -= mr1[2] * X[14]; a3 -= mr1[3] * X[15];
              mr1 = *(const LAS f32x4*)(Mm + 2584);
              __builtin_amdgcn_sched_barrier(0);
              a0 -= mr2[0] * X[16]; a1 -= mr2[1] * X[17]; a2 -= mr2[2] * X[18]; a3 -= mr2[3] * X[19];
              mr2 = *(const LAS f32x4*)(Mm + 2588);
              __builtin_amdgcn_sched_barrier(0);
              a0 -= mr3[0] * X[20]; a1 -= mr3[1] * X[21]; a2 -= mr3[2] * X[22]; a3 -= mr3[3] * X[23];
              mr3 = *(const LAS f32x4*)(Mm + 2592);
              __builtin_amdgcn_sched_barrier(0);
              a0 -= mr4[0] * X[24]; a1 -= mr4[1] * X[25]; a2 -= mr4[2] * X[26]; a3 -= mr4[3] * X[27];
              mr4 = *(const LAS f32x4*)(Mm + 2596);
              __builtin_amdgcn_sched_barrier(0);
              a0 -= mr5[0] * X[28]; a1 -= mr5[1] * X[29]; a2 -= mr5[2] * X[30]; a3 -= mr5[3] * X[31];
              mr5 = *(const LAS f32x4*)(Mm + 2600);
              __builtin_amdgcn_sched_barrier(0);
              a0 -= mr6[0] * X[32]; a1 -= mr6[1] * X[33]; a2 -= mr6[2] * X[34]; a3 -= mr6[3] * X[35];
              mr6 = *(const LAS f32x4*)(Mm + 2604);
              __builtin_amdgcn_sched_barrier(0);
              a0 -= mr0[0] * X[36];
              X[37] = (a0 + a1) + (a2 + a3); dst[4884] = X[37]; }
            __builtin_amdgcn_sched_barrier(0);
            rh1 = src[5280] * cf[40];
            { float a0 = rh2, a1 = 0.f, a2 = 0.f, a3 = 0.f;
              mr0 = *(const LAS f32x4*)(Mm + 2608);
              __builtin_amdgcn_sched_barrier(0);
              a0 -= mr1[0] * X[0]; a1 -= mr1[1] * X[1]; a2 -= mr1[2] * X[2]; a3 -= mr1[3] * X[3];
              mr1 = *(const LAS f32x4*)(Mm + 2612);
              __builtin_amdgcn_sched_barrier(0);
              a0 -= mr2[0] * X[4]; a1 -= mr2[1] * X[5]; a2 -= mr2[2] * X[6]; a3 -= mr2[3] * X[7];
              mr2 = *(const LAS f32x4*)(Mm + 2616);
              __builtin_amdgcn_sched_barrier(0);
              a0 -= mr3[0] * X[8]; a1 -= mr3[1] * X[9]; a2 -= mr3[2] * X[10]; a3 -= mr3[3] * X[11];
              mr3 = *(const LAS f32x4*)(Mm + 2620);
              __builtin_amdgcn_sched_barrier(0);
              a0 -= mr4[0] * X[12]; a1 -= mr4[1] * X[13]; a2 -= mr4[2] * X[14]; a3 -= mr4[3] * X[15];
              mr4 = *(const LAS f32x4*)(Mm + 2652);
              __builtin_amdgcn_sched_barrier(0);
              a0 -= mr5[0] * X[16]; a1 -= mr5[1] * X[17]; a2 -= mr5[2] * X[18]; a3 -= mr5[3] * X[19];
              mr5 = *(const LAS f32x4*)(Mm + 2656);
              __builtin_amdgcn_sched_barrier(0);
              a0 -= mr6[0] * X[20]; a1 -= mr6[1] * X[21]; a2 -= mr6[2] * X[22]; a3 -= mr6[3] * X[23];
              mr6 = *(const LAS f32x4*)(Mm + 2660);
              __builtin_amdgcn_sched_barrier(0);
              a0 -= mr0[0] * X[24]; a1 -= mr0[1] * X[25]; a2 -= mr0[2] * X[26]; a3 -= mr0[3] * X[27];
              mr0 = *(const LAS f32x4*)(Mm + 2664);
              __builtin_amdgcn_sched_barrier(0);
              a0 -= mr1[0] * X[28]; a1 -= mr1[1] * X[29]; a2 -= mr1[2] * X[30]; a3 -= mr1[3] * X[31];
              mr1 = *(const LAS f32x4*)(Mm + 2668);
              __builtin_amdgcn_sched_barrier(0);
              a0 -= mr2[0] * X[32]; a1 -= mr2[1] * X[33]; a2 -= mr2[2] * X[34]; a3 -= mr2[3] * X[35];
              mr2 = *(const LAS f32x4*)(Mm + 2672);
              __builtin_amdgcn_sched_barrier(0);
              a0 -= mr3[0] * X[36]; a1 -= mr3[1] * X[37];
              X[38] = (a0 + a1) + (a2 + a3); dst[5016] = X[38]; }
            __builtin_amdgcn_sched_barrier(0);
            rh2 = src[5412] * cf[41];
            { float a0 = rh0, a1 = 0.f, a2 = 0.f, a3 = 0.f;
              mr3 = *(const LAS f32x4*)(Mm + 2676);
              __builtin_amdgcn_sched_barrier(0);
              a0 -= mr4[0] * X[0]; a1 -= mr4[1] * X[1]; a2 -= mr4[2] * X[2]; a3 -= mr4[3] * X[3];
              mr4 = *(const LAS f32x4*)(Mm + 2680);
              __builtin_amdgcn_sched_barrier(0);
              a0 -= mr5[0] * X[4]; a1 -= mr5[1] * X[5]; a2 -= mr5[2] * X[6]; a3 -= mr5[3] * X[7];
              mr5 = *(const LAS f32x4*)(Mm + 2684);
              __builtin_amdgcn_sched_barrier(0);
              a0 -= mr6[0] * X[8]; a1 -= mr6[1] * X[9]; a2 -= mr6[2] * X[10]; a3 -= mr6[3] * X[11];
              mr6 = *(const LAS f32x4*)(Mm + 2688);
              __builtin_amdgcn_sched_barrier(0);
              a0 -= mr0[0] * X[12]; a1 -= mr0[1] * X[13]; a2 -= mr0[2] * X[14]; a3 -= mr0[3] * X[15];
              mr0 = *(const LAS f32x4*)(Mm + 2720);
              __builtin_amdgcn_sched_barrier(0);
              a0 -= mr1[0] * X[16]; a1 -= mr1[1] * X[17]; a2 -= mr1[2] * X[18]; a3 -= mr1[3] * X[19];
              mr1 = *(const LAS f32x4*)(Mm + 2724);
              __builtin_amdgcn_sched_barrier(0);
              a0 -= mr2[0] * X[20]; a1 -= mr2[1] * X[21]; a2 -= mr2[2] * X[22]; a3 -= mr2[3] * X[23];
              mr2 = *(const LAS f32x4*)(Mm + 2728);
              __builtin_amdgcn_sched_barrier(0);
              a0 -= mr3[0] * X[24]; a1 -= mr3[1] * X[25]; a2 -= mr3[2] * X[26]; a3 -= mr3[3] * X[27];
              mr3 = *(const LAS f32x4*)(Mm + 2732);
              __builtin_amdgcn_sched_barrier(0);
              a0 -= mr4[0] * X[28]; a1 -= mr4[1] * X[29]; a2 -= mr4[2] * X[30]; a3 -= mr4[3] * X[31];
              mr4 = *(const LAS f32x4*)(Mm + 2736);
              __builtin_amdgcn_sched_barrier(0);
              a0 -= mr5[0] * X[32]; a1 -= mr5[1] * X[33]; a2 -= mr5[2] * X[34]; a3 -= mr5[3] * X[35];
              mr5 = *(const LAS f32x4*)(Mm + 2740);
              __builtin_amdgcn_sched_barrier(0);
              a0 -= mr6[0] * X[36]; a1 -= mr6[1] * X[37]; a2 -= mr6[2] * X[38];
              X[39] = (a0 + a1) + (a2 + a3); dst[5148] = X[39]; }
            __builtin_amdgcn_sched_barrier(0);
            rh0 = src[5544] * cf[42];
            { float a0 = rh1, a1 = 0.f, a2 = 0.f, a3 = 0.f;
              mr6 = *(const LAS f32x4*)(Mm + 2744);
              __builtin_amdgcn_sched_barrier(0);
              a0 -= mr0[0] * X[0]; a1 -= mr0[1] * X[1]; a2 -= mr0[2] * X[2]; a3 -= mr0[3] * X[3];
              mr0 = *(const LAS f32x4*)(Mm + 2748);
              __builtin_amdgcn_sched_barrier(0);
              a0 -= mr1[0] * X[4]; a1 -= mr1[1] * X[5]; a2 -= mr1[2] * X[6]; a3 -= mr1[3] * X[7];
              mr1 = *(const LAS f32x4*)(Mm + 2752);
              __builtin_amdgcn_sched_barrier(0);
              a0 -= mr2[0] * X[8]; a1 -= mr2[1] * X[9]; a2 -= mr2[2] * X[10]; a3 -= mr2[3] * X[11];
              mr2 = *(const LAS f32x4*)(Mm + 2756);
              __builtin_amdgcn_sched_barrier(0);
              a0 -= mr3[0] * X[12]; a1 -= mr3[1] * X[13]; a2 -= mr3[2] * X[14]; a3 -= mr3[3] * X[15];
              mr3 = *(const LAS f32x4*)(Mm + 2788);
              __builtin_amdgcn_sched_barrier(0);
              a0 -= mr4[0] * X[16]; a1 -= mr4[1] * X[17]; a2 -= mr4[2] * X[18]; a3 -= mr4[3] * X[19];
              mr4 = *(const LAS f32x4*)(Mm + 2792);
              __builtin_amdgcn_sched_barrier(0);
              a0 -= mr5[0] * X[20]; a1 -= mr5[1] * X[21]; a2 -= mr5[2] * X[22]; a3 -= mr5[3] * X[23];
              mr5 = *(const LAS f32x4*)(Mm + 2796);
              __builtin_amdgcn_sched_barrier(0);
              a0 -= mr6[0] * X[24]; a1 -= mr6[1] * X[25]; a2 -= mr6[2] * X[26]; a3 -= mr6[3] * X[27];
              mr6 = *(const LAS f32x4*)(Mm + 2800);
              __builtin_amdgcn_sched_barrier(0);
              a0 -= mr0[0] * X[28]; a1 -= mr0[1] * X[29]; a2 -= mr0[2] * X[30]; a3 -= mr0[3] * X[31];
              mr0 = *(const LAS f32x4*)(Mm + 2804);
              __builtin_amdgcn_sched_barrier(0);
              a0 -= mr1[0] * X[32]; a1 -= mr1[1] * X[33]; a2 -= mr1[2] * X[34]; a3 -= mr1[3] * X[35];
              mr1 = *(const LAS f32x4*)(Mm + 2808);
              __builtin_amdgcn_sched_barrier(0);
              a0 -= mr2[0] * X[36]; a1 -= mr2[1] * X[37]; a2 -= mr2[2] * X[38]; a3 -= mr2[3] * X[39];
              X[40] = (a0 + a1) + (a2 + a3); dst[5280] = X[40]; }
            __builtin_amdgcn_sched_barrier(0);
            rh1 = src[5676] * cf[43];
            { float a0 = rh2, a1 = 0.f, a2 = 0.f, a3 = 0.f;
              mr2 = *(const LAS f32x4*)(Mm + 2812);
              __builtin_amdgcn_sched_barrier(0);
              a0 -= mr3[0] * X[0]; a1 -= mr3[1] * X[1]; a2 -= mr3[2] * X[2]; a3 -= mr3[3] * X[3];
              mr3 = *(const LAS f32x4*)(Mm + 2816);
              __builtin_amdgcn_sched_barrier(0);
              a0 -= mr4[0] * X[4]; a1 -= mr4[1] * X[5]; a2 -= mr4[2] * X[6]; a3 -= mr4[3] * X[7];
              mr4 = *(const LAS f32x4*)(Mm + 2820);
              __builtin_amdgcn_sched_barrier(0);
              a0 -= mr5[0] * X[8]; a1 -= mr5[1] * X[9]; a2 -= mr5[2] * X[10]; a3 -= mr5[3] * X[11];
              mr5 = *(const LAS f32x4*)(Mm + 2824);
              __builtin_amdgcn_sched_barrier(0);
              a0 -= mr6[0] * X[12]; a1 -= mr6[1] * X[13]; a2 -= mr6[2] * X[14]; a3 -= mr6[3] * X[15];
              mr6 = *(const LAS f32x4*)(Mm + 2828);
              __builtin_amdgcn_sched_barrier(0);
              a0 -= mr0[0] * X[16]; a1 -= mr0[1] * X[17]; a2 -= mr0[2] * X[18]; a3 -= mr0[3] * X[19];
              mr0 = *(const LAS f32x4*)(Mm + 2856);
              __builtin_amdgcn_sched_barrier(0);
              a0 -= mr1[0] * X[20]; a1 -= mr1[1] * X[21]; a2 -= mr1[2] * X[22]; a3 -= mr1[3] * X[23];
              mr1 = *(const LAS f32x4*)(Mm + 2860);
              __builtin_amdgcn_sched_barrier(0);
              a0 -= mr2[0] * X[24]; a1 -= mr2[1] * X[25]; a2 -= mr2[2] * X[26]; a3 -= mr2[3] * X[27];
              mr2 = *(const LAS f32x4*)(Mm + 2864);
              __builtin_amdgcn_sched_barrier(0);
              a0 -= mr3[0] * X[28]; a1 -= mr3[1] * X[29]; a2 -= mr3[2] * X[30]; a3 -= mr3[3] * X[31];
              mr3 = *(const LAS f32x4*)(Mm + 2868);
              __builtin_amdgcn_sched_barrier(0);
              a0 -= mr4[0] * X[32]; a1 -= mr4[1] * X[33]; a2 -= mr4[2] * X[34]; a3 -= mr4[3] * X[35];
              mr4 = *(const LAS f32x4*)(Mm + 2872);
              __builtin_amdgcn_sched_barrier(0);
              a0 -= mr5[0] * X[36]; a1 -= mr5[1] * X[37]; a2 -= mr5[2] * X[38]; a3 -= mr5[3] * X[39];
              mr5 = *(const LAS f32x4*)(Mm + 2876);
              __builtin_amdgcn_sched_barrier(0);
              a0 -= mr6[0] * X[40];
              X[41] = (a0 + a1) + (a2 + a3); dst[5412] = X[41]; }
            __builtin_amdgcn_sched_barrier(0);
            rh2 = src[5808] * cf[44];
            { float a0 = rh0, a1 = 0.f, a2 = 0.f, a3 = 0.f;
              mr6 = *(const LAS f32x4*)(Mm + 2880);
              __builtin_amdgcn_sched_barrier(0);
              a0 -= mr0[0] * X[0]; a1 -= mr0[1] * X[1]; a2 -= mr0[2] * X[2]; a3 -= mr0[3] * X[3];
              mr0 = *(const LAS f32x4*)(Mm + 2884);
              __builtin_amdgcn_sched_barrier(0);
              a0 -= mr1[0] * X[4]; a1 -= mr1[1] * X[5]; a2 -= mr1[2] * X[6]; a3 -= mr1[3] * X[7];
              mr1 = *(const LAS f32x4*)(Mm + 2888);
              __builtin_amdgcn_sched_barrier(0);
              a0 -= mr2[0] * X[8]; a1 -= mr2[1] * X[9]; a2 -= mr2[2] * X[10]; a3 -= mr2[3] * X[11];
              mr2 = *(const LAS f32x4*)(Mm + 2892);
              __builtin_amdgcn_sched_barrier(0);
              a0 -= mr3[0] * X[12]; a1 -= mr3[1] * X[13]; a2 -= mr3[2] * X[14]; a3 -= mr3[3] * X[15];
              mr3 = *(const LAS f32x4*)(Mm + 2896);
              __builtin_amdgcn_sched_barrier(0);
              a0 -= mr4[0] * X[16]; a1 -= mr4[1] * X[17]; a2 -= mr4[2] * X[18]; a3 -= mr4[3] * X[19];
              mr4 = *(const LAS f32x4*)(Mm + 2924);
              __builtin_amdgcn_sched_barrier(0);
              a0 -= mr5[0] * X[20]; a1 -= mr5[1] * X[21]; a2 -= mr5[2] * X[22]; a3 -= mr5[3] * X[23];
              mr5 = *(const LAS f32x4*)(Mm + 2928);
              __builtin_amdgcn_sched_barrier(0);
              a0 -= mr6[0] * X[24]; a1 -= mr6[1] * X[25]; a2 -= mr6[2] * X[26]; a3 -= mr6[3] * X[27];
              mr6 = *(const LAS f32x4*)(Mm + 2932);
              __builtin_amdgcn_sched_barrier(0);
              a0 -= mr0[0] * X[28]; a1 -= mr0[1] * X[29]; a2 -= mr0[2] * X[30]; a3 -= mr0[3] * X[31];
              mr0 = *(const LAS f32x4*)(Mm + 2936);
              __builtin_amdgcn_sched_barrier(0);
              a0 -= mr1[0] * X[32]; a1 -= mr1[1] * X[33]; a2 -= mr1[2] * X[34]; a3 -= mr1[3] * X[35];
              mr1 = *(const LAS f32x4*)(Mm + 2940);
              __builtin_amdgcn_sched_barrier(0);
              a0 -= mr2[0] * X[36]; a1 -= mr2[1] * X[37]; a2 -= mr2[2] * X[38]; a3 -= mr2[3] * X[39];
              mr2 = *(const LAS f32x4*)(Mm + 2944);
              __builtin_amdgcn_sched_barrier(0);
              a0 -= mr3[0] * X[40]; a1 -= mr3[1] * X[41];
              X[42] = (a0 + a1) + (a2 + a3); dst[5544] = X[42]; }
            __builtin_amdgcn_sched_barrier(0);
            rh0 = src[5940] * cf[45];
            { float a0 = rh1, a1 = 0.f, a2 = 0.f, a3 = 0.f;
              mr3 = *(const LAS f32x4*)(Mm + 2948);
              __builtin_amdgcn_sched_barrier(0);
              a0 -= mr4[0] * X[0]; a1 -= mr4[1] * X[1]; a2 -= mr4[2] * X[2]; a3 -= mr4[3] * X[3];
              mr4 = *(const LAS f32x4*)(Mm + 2952);
              __builtin_amdgcn_sched_barrier(0);
              a0 -= mr5[0] * X[4]; a1 -= mr5[1] * X[5]; a2 -= mr5[2] * X[6]; a3 -= mr5[3] * X[7];
              mr5 = *(const LAS f32x4*)(Mm + 2956);
              __builtin_amdgcn_sched_barrier(0);
              a0 -= mr6[0] * X[8]; a1 -= mr6[1] * X[9]; a2 -= mr6[2] * X[10]; a3 -= mr6[3] * X[11];
              mr6 = *(const LAS f32x4*)(Mm + 2960);
              __builtin_amdgcn_sched_barrier(0);
              a0 -= mr0[0] * X[12]; a1 -= mr0[1] * X[13]; a2 -= mr0[2] * X[14]; a3 -= mr0[3] * X[15];
              mr0 = *(const LAS f32x4*)(Mm + 2964);
              __builtin_amdgcn_sched_barrier(0);
              a0 -= mr1[0] * X[16]; a1 -= mr1[1] * X[17]; a2 -= mr1[2] * X[18]; a3 -= mr1[3] * X[19];
              mr1 = *(const LAS f32x4*)(Mm + 2992);
              __builtin_amdgcn_sched_barrier(0);
              a0 -= mr2[0] * X[20]; a1 -= mr2[1] * X[21]; a2 -= mr2[2] * X[22]; a3 -= mr2[3] * X[23];
              mr2 = *(const LAS f32x4*)(Mm + 2996);
              __builtin_amdgcn_sched_barrier(0);
              a0 -= mr3[0] * X[24]; a1 -= mr3[1] * X[25]; a2 -= mr3[2] * X[26]; a3 -= mr3[3] * X[27];
              mr3 = *(const LAS f32x4*)(Mm + 3000);
              __builtin_amdgcn_sched_barrier(0);
              a0 -= mr4[0] * X[28]; a1 -= mr4[1] * X[29]; a2 -= mr4[2] * X[30]; a3 -= mr4[3] * X[31];
              mr4 = *(const LAS f32x4*)(Mm + 3004);
              __builtin_amdgcn_sched_barrier(0);
              a0 -= mr5[0] * X[32]; a1 -= mr5[1] * X[33]; a2 -= mr5[2] * X[34]; a3 -= mr5[3] * X[35];
              mr5 = *(const LAS f32x4*)(Mm + 3008);
              __builtin_amdgcn_sched_barrier(0);
              a0 -= mr6[0] * X[36]; a1 -= mr6[1] * X[37]; a2 -= mr6[2] * X[38]; a3 -= mr6[3] * X[39];
              mr6 = *(const LAS f32x4*)(Mm + 3012);
              __builtin_amdgcn_sched_barrier(0);
              a0 -= mr0[0] * X[40]; a1 -= mr0[1] * X[41]; a2 -= mr0[2] * X[42];
              X[43] = (a0 + a1) + (a2 + a3); dst[5676] = X[43]; }
            __builtin_amdgcn_sched_barrier(0);
            rh1 = src[6072] * cf[46];
            { float a0 = rh2, a1 = 0.f, a2 = 0.f, a3 = 0.f;
              mr0 = *(const LAS f32x4*)(Mm + 3016);
              __builtin_amdgcn_sched_barrier(0);
              a0 -= mr1[0] * X[0]; a1 -= mr1[1] * X[1]; a2 -= mr1[2] * X[2]; a3 -= mr1[3] * X[3];
              mr1 = *(const LAS f32x4*)(Mm + 3020);
              __builtin_amdgcn_sched_barrier(0);
              a0 -= mr2[0] * X[4]; a1 -= mr2[1] * X[5]; a2 -= mr2[2] * X[6]; a3 -= mr2[3] * X[7];
              mr2 = *(const LAS f32x4*)(Mm + 3024);
              __builtin_amdgcn_sched_barrier(0);
              a0 -= mr3[0] * X[8]; a1 -= mr3[1] * X[9]; a2 -= mr3[2] * X[10]; a3 -= mr3[3] * X[11];
              mr3 = *(const LAS f32x4*)(Mm + 3028);
              __builtin_amdgcn_sched_barrier(0);
              a0 -= mr4[0] * X[12]; a1 -= mr4[1] * X[13]; a2 -= mr4[2] * X[14]; a3 -= mr4[3] * X[15];
              mr4 = *(const LAS f32x4*)(Mm + 3032);
              __builtin_amdgcn_sched_barrier(0);
              a0 -= mr5[0] * X[16]; a1 -= mr5[1] * X[17]; a2 -= mr5[2] * X[18]; a3 -= mr5[3] * X[19];
              mr5 = *(const LAS f32x4*)(Mm + 3060);
              __builtin_amdgcn_sched_barrier(0);
              a0 -= mr6[0] * X[20]; a1 -= mr6[1] * X[21]; a2 -= mr6[2] * X[22]; a3 -= mr6[3] * X[23];
              mr6 = *(const LAS f32x4*)(Mm + 3064);
              __builtin_amdgcn_sched_barrier(0);
              a0 -= mr0[0] * X[24]; a1 -= mr0[1] * X[25]; a2 -= mr0[2] * X[26]; a3 -= mr0[3] * X[27];
              mr0 = *(const LAS f32x4*)(Mm + 3068);
              __builtin_amdgcn_sched_barrier(0);
              a0 -= mr1[0] * X[28]; a1 -= mr1[1] * X[29]; a2 -= mr1[2] * X[30]; a3 -= mr1[3] * X[31];
              mr1 = *(const LAS f32x4*)(Mm + 3072);
              __builtin_amdgcn_sched_barrier(0);
              a0 -= mr2[0] * X[32]; a1 -= mr2[1] * X[33]; a2 -= mr2[2] * X[34]; a3 -= mr2[3] * X[35];
              mr2 = *(const LAS f32x4*)(Mm + 3076);
              __builtin_amdgcn_sched_barrier(0);
              a0 -= mr3[0] * X[36]; a1 -= mr3[1] * X[37]; a2 -= mr3[2] * X[38]; a3 -= mr3[3] * X[39];
              mr3 = *(const LAS f32x4*)(Mm + 3080);
              __builtin_amdgcn_sched_barrier(0);
              a0 -= mr4[0] * X[40]; a1 -= mr4[1] * X[41]; a2 -= mr4[2] * X[42]; a3 -= mr4[3] * X[43];
              X[44] = (a0 + a1) + (a2 + a3); dst[5808] = X[44]; }
            __builtin_amdgcn_sched_barrier(0);
            rh2 = src[6204] * cf[47];
            { float a0 = rh0, a1 = 0.f, a2 = 0.f, a3 = 0.f;
              mr4 = *(const LAS f32x4*)(Mm + 3084);
              __builtin_amdgcn_sched_barrier(0);
              a0 -= mr5[0] * X[0]; a1 -= mr5[1] * X[1]; a2 -= mr5[2] * X[2]; a3 -= mr5[3] * X[3];
              mr5 = *(const LAS f32x4*)(Mm + 3088);
              __builtin_amdgcn_sched_barrier(0);
              a0 -= mr6[0] * X[4]; a1 -= mr6[1] * X[5]; a2 -= mr6[2] * X[6]; a3 -= mr6[3] * X[7];
              mr6 = *(const LAS f32x4*)(Mm + 3092);
              __builtin_amdgcn_sched_barrier(0);
              a0 -= mr0[0] * X[8]; a1 -= mr0[1] * X[9]; a2 -= mr0[2] * X[10]; a3 -= mr0[3] * X[11];
              mr0 = *(const LAS f32x4*)(Mm + 3096);
              __builtin_amdgcn_sched_barrier(0);
              a0 -= mr1[0] * X[12]; a1 -= mr1[1] * X[13]; a2 -= mr1[2] * X[14]; a3 -= mr1[3] * X[15];
              mr1 = *(const LAS f32x4*)(Mm + 3100);
              __builtin_amdgcn_sched_barrier(0);
              a0 -= mr2[0] * X[16]; a1 -= mr2[1] * X[17]; a2 -= mr2[2] * X[18]; a3 -= mr2[3] * X[19];
              mr2 = *(const LAS f32x4*)(Mm + 3104);
              __builtin_amdgcn_sched_barrier(0);
              a0 -= mr3[0] * X[20]; a1 -= mr3[1] * X[21]; a2 -= mr3[2] * X[22]; a3 -= mr3[3] * X[23];
              mr3 = *(const LAS f32x4*)(Mm + 3128);
              __builtin_amdgcn_sched_barrier(0);
              a0 -= mr4[0] * X[24]; a1 -= mr4[1] * X[25]; a2 -= mr4[2] * X[26]; a3 -= mr4[3] * X[27];
              mr4 = *(const LAS f32x4*)(Mm + 3132);
              __builtin_amdgcn_sched_barrier(0);
              a0 -= mr5[0] * X[28]; a1 -= mr5[1] * X[29]; a2 -= mr5[2] * X[30]; a3 -= mr5[3] * X[31];
              mr5 = *(const LAS f32x4*)(Mm + 3136);
              __builtin_amdgcn_sched_barrier(0);
              a0 -= mr6[0] * X[32]; a1 -= mr6[1] * X[33]; a2 -= mr6[2] * X[34]; a3 -= mr6[3] * X[35];
              mr6 = *(const LAS f32x4*)(Mm + 3140);
              __builtin_amdgcn_sched_barrier(0);
              a0 -= mr0[0] * X[36]; a1 -= mr0[1] * X[37]; a2 -= mr0[2] * X[38]; a3 -= mr0[3] * X[39];
              mr0 = *(const LAS f32x4*)(Mm + 3144);
              __builtin_amdgcn_sched_barrier(0);
              a0 -= mr1[0] * X[40]; a1 -= mr1[1] * X[41]; a2 -= mr1[2] * X[42]; a3 -= mr1[3] * X[43];
              mr1 = *(const LAS f32x4*)(Mm + 3148);
              __builtin_amdgcn_sched_barrier(0);
              a0 -= mr2[0] * X[44];
              X[45] = (a0 + a1) + (a2 + a3); dst[5940] = X[45]; }
            __builtin_amdgcn_sched_barrier(0);
            rh0 = src[6336] * cf[48];
            { float a0 = rh1, a1 = 0.f, a2 = 0.f, a3 = 0.f;
              mr2 = *(const LAS f32x4*)(Mm + 3152);
              __builtin_amdgcn_sched_barrier(0);
              a0 -= mr3[0] * X[0]; a1 -= mr3[1] * X[1]; a2 -= mr3[2] * X[2]; a3 -= mr3[3] * X[3];
              mr3 = *(const LAS f32x4*)(Mm + 3156);
              __builtin_amdgcn_sched_barrier(0);
              a0 -= mr4[0] * X[4]; a1 -= mr4[1] * X[5]; a2 -= mr4[2] * X[6]; a3 -= mr4[3] * X[7];
              mr4 = *(const LAS f32x4*)(Mm + 3160);
              __builtin_amdgcn_sched_barrier(0);
              a0 -= mr5[0] * X[8]; a1 -= mr5[1] * X[9]; a2 -= mr5[2] * X[10]; a3 -= mr5[3] * X[11];
              mr5 = *(const LAS f32x4*)(Mm + 3164);
              __builtin_amdgcn_sched_barrier(0);
              a0 -= mr6[0] * X[12]; a1 -= mr6[1] * X[13]; a2 -= mr6[2] * X[14]; a3 -= mr6[3] * X[15];
              mr6 = *(const LAS f32x4*)(Mm + 3168);
              __builtin_amdgcn_sched_barrier(0);
              a0 -= mr0[0] * X[16]; a1 -= mr0[1] * X[17]; a2 -= mr0[2] * X[18]; a3 -= mr0[3] * X[19];
              mr0 = *(const LAS f32x4*)(Mm + 3172);
              __builtin_amdgcn_sched_barrier(0);
              a0 -= mr1[0] * X[20]; a1 -= mr1[1] * X[21]; a2 -= mr1[2] * X[22]; a3 -= mr1[3] * X[23];
              mr1 = *(const LAS f32x4*)(Mm + 3196);
              __builtin_amdgcn_sched_barrier(0);
              a0 -= mr2[0] * X[24]; a1 -= mr2[1] * X[25]; a2 -= mr2[2] * X[26]; a3 -= mr2[3] * X[27];
              mr2 = *(const LAS f32x4*)(Mm + 3200);
              __builtin_amdgcn_sched_barrier(0);
              a0 -= mr3[0] * X[28]; a1 -= mr3[1] * X[29]; a2 -= mr3[2] * X[30]; a3 -= mr3[3] * X[31];
              mr3 = *(const LAS f32x4*)(Mm + 3204);
              __builtin_amdgcn_sched_barrier(0);
              a0 -= mr4[0] * X[32]; a1 -= mr4[1] * X[33]; a2 -= mr4[2] * X[34]; a3 -= mr4[3] * X[35];
              mr4 = *(const LAS f32x4*)(Mm + 3208);
              __builtin_amdgcn_sched_barrier(0);
              a0 -= mr5[0] * X[36]; a1 -= mr5[1] * X[37]; a2 -= mr5[2] * X[38]; a3 -= mr5[3] * X[39];
              mr5 = *(const LAS f32x4*)(Mm + 3212);
              __builtin_amdgcn_sched_barrier(0);
              a0 -= mr6[0] * X[40]; a1 -= mr6[1] * X[41]; a2 -= mr6[2] * X[42]; a3 -= mr6[3] * X[43];
              mr6 = *(const LAS f32x4*)(Mm + 3216);
              __builtin_amdgcn_sched_barrier(0);
              a0 -= mr0[0] * X[44]; a1 -= mr0[1] * X[45];
              X[46] = (a0 + a1) + (a2 + a3); dst[6072] = X[46]; }
            __builtin_amdgcn_sched_barrier(0);
            rh1 = src[6468] * cf[49];
            { float a0 = rh2, a1 = 0.f, a2 = 0.f, a3 = 0.f;
              mr0 = *(const LAS f32x4*)(Mm + 3220);
              __builtin_amdgcn_sched_barrier(0);
              a0 -= mr1[0] * X[0]; a1 -= mr1[1] * X[1]; a2 -= mr1[2] * X[2]; a3 -= mr1[3] * X[3];
              mr1 = *(const LAS f32x4*)(Mm + 3224);
              __builtin_amdgcn_sched_barrier(0);
              a0 -= mr2[0] * X[4]; a1 -= mr2[1] * X[5]; a2 -= mr2[2] * X[6]; a3 -= mr2[3] * X[7];
              mr2 = *(const LAS f32x4*)(Mm + 3228);
              __builtin_amdgcn_sched_barrier(0);
              a0 -= mr3[0] * X[8]; a1 -= mr3[1] * X[9]; a2 -= mr3[2] * X[10]; a3 -= mr3[3] * X[11];
              mr3 = *(const LAS f32x4*)(Mm + 3232);
              __builtin_amdgcn_sched_barrier(0);
              a0 -= mr4[0] * X[12]; a1 -= mr4[1] * X[13]; a2 -= mr4[2] * X[14]; a3 -= mr4[3] * X[15];
              mr4 = *(const LAS f32x4*)(Mm + 3236);
              __builtin_amdgcn_sched_barrier(0);
              a0 -= mr5[0] * X[16]; a1 -= mr5[1] * X[17]; a2 -= mr5[2] * X[18]; a3 -= mr5[3] * X[19];
              mr5 = *(const LAS f32x4*)(Mm + 3240);
              __builtin_amdgcn_sched_barrier(0);
              a0 -= mr6[0] * X[20]; a1 -= mr6[1] * X[21]; a2 -= mr6[2] * X[22]; a3 -= mr6[3] * X[23];
              mr6 = *(const LAS f32x4*)(Mm + 3264);
              __builtin_amdgcn_sched_barrier(0);
              a0 -= mr0[0] * X[24]; a1 -= mr0[1] * X[25]; a2 -= mr0[2] * X[26]; a3 -= mr0[3] * X[27];
              mr0 = *(const LAS f32x4*)(Mm + 3268);
              __builtin_amdgcn_sched_barrier(0);
              a0 -= mr1[0] * X[28]; a1 -= mr1[1] * X[29]; a2 -= mr1[2] * X[30]; a3 -= mr1[3] * X[31];
              mr1 = *(const LAS f32x4*)(Mm + 3272);
              __builtin_amdgcn_sched_barrier(0);
              a0 -= mr2[0] * X[32]; a1 -= mr2[1] * X[33]; a2 -= mr2[2] * X[34]; a3 -= mr2[3] * X[35];
              mr2 = *(const LAS f32x4*)(Mm + 3276);
              __builtin_amdgcn_sched_barrier(0);
              a0 -= mr3[0] * X[36]; a1 -= mr3[1] * X[37]; a2 -= mr3[2] * X[38]; a3 -= mr3[3] * X[39];
              mr3 = *(const LAS f32x4*)(Mm + 3280);
              __builtin_amdgcn_sched_barrier(0);
              a0 -= mr4[0] * X[40]; a1 -= mr4[1] * X[41]; a2 -= mr4[2] * X[42]; a3 -= mr4[3] * X[43];
              mr4 = *(const LAS f32x4*)(Mm + 3284);
              __builtin_amdgcn_sched_barrier(0);
              a0 -= mr5[0] * X[44]; a1 -= mr5[1] * X[45]; a2 -= mr5[2] * X[46];
              X[47] = (a0 + a1) + (a2 + a3); dst[6204] = X[47]; }
            __builtin_amdgcn_sched_barrier(0);
            rh2 = src[6600] * cf[50];
            { float a0 = rh0, a1 = 0.f, a2 = 0.f, a3 = 0.f;
              mr5 = *(const LAS f32x4*)(Mm + 3288);
              __builtin_amdgcn_sched_barrier(0);
              a0 -= mr6[0] * X[0]; a1 -= mr6[1] * X[1]; a2 -= mr6[2] * X[2]; a3 -= mr6[3] * X[3];
              mr6 = *(const LAS f32x4*)(Mm + 3292);
              __builtin_amdgcn_sched_barrier(0);
              a0 -= mr0[0] * X[4]; a1 -= mr0[1] * X[5]; a2 -= mr0[2] * X[6]; a3 -= mr0[3] * X[7];
              mr0 = *(const LAS f32x4*)(Mm + 3296);
              __builtin_amdgcn_sched_barrier(0);
              a0 -= mr1[0] * X[8]; a1 -= mr1[1] * X[9]; a2 -= mr1[2] * X[10]; a3 -= mr1[3] * X[11];
              mr1 = *(const LAS f32x4*)(Mm + 3300);
              __builtin_amdgcn_sched_barrier(0);
              a0 -= mr2[0] * X[12]; a1 -= mr2[1] * X[13]; a2 -= mr2[2] * X[14]; a3 -= mr2[3] * X[15];
              mr2 = *(const LAS f32x4*)(Mm + 3304);
              __builtin_amdgcn_sched_barrier(0);
              a0 -= mr3[0] * X[16]; a1 -= mr3[1] * X[17]; a2 -= mr3[2] * X[18]; a3 -= mr3[3] * X[19];
              mr3 = *(const LAS f32x4*)(Mm + 3308);
              __builtin_amdgcn_sched_barrier(0);
              a0 -= mr4[0] * X[20]; a1 -= mr4[1] * X[21]; a2 -= mr4[2] * X[22]; a3 -= mr4[3] * X[23];
              mr4 = *(const LAS f32x4*)(Mm + 3332);
              __builtin_amdgcn_sched_barrier(0);
              a0 -= mr5[0] * X[24]; a1 -= mr5[1] * X[25]; a2 -= mr5[2] * X[26]; a3 -= mr5[3] * X[27];
              mr5 = *(const LAS f32x4*)(Mm + 3336);
              __builtin_amdgcn_sched_barrier(0);
              a0 -= mr6[0] * X[28]; a1 -= mr6[1] * X[29]; a2 -= mr6[2] * X[30]; a3 -= mr6[3] * X[31];
              mr6 = *(const LAS f32x4*)(Mm + 3340);
              __builtin_amdgcn_sched_barrier(0);
              a0 -= mr0[0] * X[32]; a1 -= mr0[1] * X[33]; a2 -= mr0[2] * X[34]; a3 -= mr0[3] * X[35];
              mr0 = *(const LAS f32x4*)(Mm + 3344);
              __builtin_amdgcn_sched_barrier(0);
              a0 -= mr1[0] * X[36]; a1 -= mr1[1] * X[37]; a2 -= mr1[2] * X[38]; a3 -= mr1[3] * X[39];
              mr1 = *(const LAS f32x4*)(Mm + 3348);
              __builtin_amdgcn_sched_barrier(0);
              a0 -= mr2[0] * X[40]; a1 -= mr2[1] * X[41]; a2 -= mr2[2] * X[42]; a3 -= mr2[3] * X[43];
              mr2 = *(const LAS f32x4*)(Mm + 3352);
              __builtin_amdgcn_sched_barrier(0);
              a0 -= mr3[0] * X[44]; a1 -= mr3[1] * X[45]; a2 -= mr3[2] * X[46]; a3 -= mr3[3] * X[47];
              X[48] = (a0 + a1) + (a2 + a3); dst[6336] = X[48]; }
            __builtin_amdgcn_sched_barrier(0);
            rh0 = src[6732] * cf[51];
            { float a0 = rh1, a1 = 0.f, a2 = 0.f, a3 = 0.f;
              mr3 = *(const LAS f32x4*)(Mm + 3356);
              __builtin_amdgcn_sched_barrier(0);
              a0 -= mr4[0] * X[0]; a1 -= mr4[1] * X[1]; a2 -= mr4[2] * X[2]; a3 -= mr4[3] * X[3];
              mr4 = *(const LAS f32x4*)(Mm + 3360);
              __builtin_amdgcn_sched_barrier(0);
              a0 -= mr5[0] * X[4]; a1 -= mr5[1] * X[5]; a2 -= mr5[2] * X[6]; a3 -= mr5[3] * X[7];
              mr5 = *(const LAS f32x4*)(Mm + 3364);
              __builtin_amdgcn_sched_barrier(0);
              a0 -= mr6[0] * X[8]; a1 -= mr6[1] * X[9]; a2 -= mr6[2] * X[10]; a3 -= mr6[3] * X[11];
              mr6 = *(const LAS f32x4*)(Mm + 3368);
              __builtin_amdgcn_sched_barrier(0);
              a0 -= mr0[0] * X[12]; a1 -= mr0[1] * X[13]; a2 -= mr0[2] * X[14]; a3 -= mr0[3] * X[15];
              mr0 = *(const LAS f32x4*)(Mm + 3372);
              __builtin_amdgcn_sched_barrier(0);
              a0 -= mr1[0] * X[16]; a1 -= mr1[1] * X[17]; a2 -= mr1[2] * X[18]; a3 -= mr1[3] * X[19];
              mr1 = *(const LAS f32x4*)(Mm + 3376);
              __builtin_amdgcn_sched_barrier(0);
              a0 -= mr2[0] * X[20]; a1 -= mr2[1] * X[21]; a2 -= mr2[2] * X[22]; a3 -= mr2[3] * X[23];
              mr2 = *(const LAS f32x4*)(Mm + 3380);
              __builtin_amdgcn_sched_barrier(0);
              a0 -= mr3[0] * X[24]; a1 -= mr3[1] * X[25]; a2 -= mr3[2] * X[26]; a3 -= mr3[3] * X[27];
              mr3 = *(const LAS f32x4*)(Mm + 3400);
              __builtin_amdgcn_sched_barrier(0);
              a0 -= mr4[0] * X[28]; a1 -= mr4[1] * X[29]; a2 -= mr4[2] * X[30]; a3 -= mr4[3] * X[31];
              mr4 = *(const LAS f32x4*)(Mm + 3404);
              __builtin_amdgcn_sched_barrier(0);
              a0 -= mr5[0] * X[32]; a1 -= mr5[1] * X[33]; a2 -= mr5[2] * X[34]; a3 -= mr5[3] * X[35];
              mr5 = *(const LAS f32x4*)(Mm + 3408);
              __builtin_amdgcn_sched_barrier(0);
              a0 -= mr6[0] * X[36]; a1 -= mr6[1] * X[37]; a2 -= mr6[2] * X[38]; a3 -= mr6[3] * X[39];
              mr6 = *(const LAS f32x4*)(Mm + 3412);
              __builtin_amdgcn_sched_barrier(0);
              a0 -= mr0[0] * X[40]; a1 -= mr0[1] * X[41]; a2 -= mr0[2] * X[42]; a3 -= mr0[3] * X[43];
              mr0 = *(const LAS f32x4*)(Mm + 3416);
              __builtin_amdgcn_sched_barrier(0);
              a0 -= mr1[0] * X[44]; a1 -= mr1[1] * X[45]; a2 -= mr1[2] * X[46]; a3 -= mr1[3] * X[47];
              mr1 = *(const LAS f32x4*)(Mm + 3420);
              __builtin_amdgcn_sched_barrier(0);
              a0 -= mr2[0] * X[48];
              X[49] = (a0 + a1) + (a2 + a3); dst[6468] = X[49]; }
            __builtin_amdgcn_sched_barrier(0);
            rh1 = src[6864] * cf[52];
            { float a0 = rh2, a1 = 0.f, a2 = 0.f, a3 = 0.f;
              mr2 = *(const LAS f32x4*)(Mm + 3424);
              __builtin_amdgcn_sched_barrier(0);
              a0 -= mr3[0] * X[0]; a1 -= mr3[1] * X[1]; a2 -= mr3[2] * X[2]; a3 -= mr3[3] * X[3];
              mr3 = *(const LAS f32x4*)(Mm + 3428);
              __builtin_amdgcn_sched_barrier(0);
              a0 -= mr4[0] * X[4]; a1 -= mr4[1] * X[5]; a2 -= mr4[2] * X[6]; a3 -= mr4[3] * X[7];
              mr4 = *(const LAS f32x4*)(Mm + 3432);
              __builtin_amdgcn_sched_barrier(0);
              a0 -= mr5[0] * X[8]; a1 -= mr5[1] * X[9]; a2 -= mr5[2] * X[10]; a3 -= mr5[3] * X[11];
              mr5 = *(const LAS f32x4*)(Mm + 3436);
              __builtin_amdgcn_sched_barrier(0);
              a0 -= mr6[0] * X[12]; a1 -= mr6[1] * X[13]; a2 -= mr6[2] * X[14]; a3 -= mr6[3] * X[15];
              mr6 = *(const LAS f32x4*)(Mm + 3440);
              __builtin_amdgcn_sched_barrier(0);
              a0 -= mr0[0] * X[16]; a1 -= mr0[1] * X[17]; a2 -= mr0[2] * X[18]; a3 -= mr0[3] * X[19];
              mr0 = *(const LAS f32x4*)(Mm + 3444);
              __builtin_amdgcn_sched_barrier(0);
              a0 -= mr1[0] * X[20]; a1 -= mr1[1] * X[21]; a2 -= mr1[2] * X[22]; a3 -= mr1[3] * X[23];
              mr1 = *(const LAS f32x4*)(Mm + 3448);
              __builtin_amdgcn_sched_barrier(0);
              a0 -= mr2[0] * X[24]; a1 -= mr2[1] * X[25]; a2 -= mr2[2] * X[26]; a3 -= mr2[3] * X[27];
              mr2 = *(const LAS f32x4*)(Mm + 3468);
              __builtin_amdgcn_sched_barrier(0);
              a0 -= mr3[0] * X[28]; a1 -= mr3[1] * X[29]; a2 -= mr3[2] * X[30]; a3 -= mr3[3] * X[31];
              mr3 = *(const LAS f32x4*)(Mm + 3472);
              __builtin_amdgcn_sched_barrier(0);
              a0 -= mr4[0] * X[32]; a1 -= mr4[1] * X[33]; a2 -= mr4[2] * X[34]; a3 -= mr4[3] * X[35];
              mr4 = *(const LAS f32x4*)(Mm + 3476);
              __builtin_amdgcn_sched_barrier(0);
              a0 -= mr5[0] * X[36]; a1 -= mr5[1] * X[37]; a2 -= mr5[2] * X[38]; a3 -= mr5[3] * X[39];
              mr5 = *(const LAS f32x4*)(Mm + 3480);
              __builtin_amdgcn_sched_barrier(0);
              a0 -= mr6[0] * X[40]; a1 -= mr6[1] * X[41]; a2 -= mr6[2] * X[42]; a3 -= mr6[3] * X[43];
              mr6 = *(const LAS f32x4*)(Mm + 3484);
              __builtin_amdgcn_sched_barrier(0);
              a0 -= mr0[0] * X[44]; a1 -= mr0[1] * X[45]; a2 -= mr0[2] * X[46]; a3 -= mr0[3] * X[47];
              mr0 = *(const LAS f32x4*)(Mm + 3488);
              __builtin_amdgcn_sched_barrier(0);
              a0 -= mr1[0] * X[48]; a1 -= mr1[1] * X[49];
              X[50] = (a0 + a1) + (a2 + a3); dst[6600] = X[50]; }
            __builtin_amdgcn_sched_barrier(0);
            rh2 = src[6996] * cf[53];
            { float a0 = rh0, a1 = 0.f, a2 = 0.f, a3 = 0.f;
              mr1 = *(const LAS f32x4*)(Mm + 3492);
              __builtin_amdgcn_sched_barrier(0);
              a0 -= mr2[0] * X[0]; a1 -= mr2[1] * X[1]; a2 -= mr2[2] * X[2]; a3 -= mr2[3] * X[3];
              mr2 = *(const LAS f32x4*)(Mm + 3496);
              __builtin_amdgcn_sched_barrier(0);
              a0 -= mr3[0] * X[4]; a1 -= mr3[1] * X[5]; a2 -= mr3[2] * X[6]; a3 -= mr3[3] * X[7];
              mr3 = *(const LAS f32x4*)(Mm + 3500);
              __builtin_amdgcn_sched_barrier(0);
              a0 -= mr4[0] * X[8]; a1 -= mr4[1] * X[9]; a2 -= mr4[2] * X[10]; a3 -= mr4[3] * X[11];
              mr4 = *(const LAS f32x4*)(Mm + 3504);
              __builtin_amdgcn_sched_barrier(0);
              a0 -= mr5[0] * X[12]; a1 -= mr5[1] * X[13]; a2 -= mr5[2] * X[14]; a3 -= mr5[3] * X[15];
              mr5 = *(const LAS f32x4*)(Mm + 3508);
              __builtin_amdgcn_sched_barrier(0);
              a0 -= mr6[0] * X[16]; a1 -= mr6[1] * X[17]; a2 -= mr6[2] * X[18]; a3 -= mr6[3] * X[19];
              mr6 = *(const LAS f32x4*)(Mm + 3512);
              __builtin_amdgcn_sched_barrier(0);
              a0 -= mr0[0] * X[20]; a1 -= mr0[1] * X[21]; a2 -= mr0[2] * X[22]; a3 -= mr0[3] * X[23];
              mr0 = *(const LAS f32x4*)(Mm + 3516);
              __builtin_amdgcn_sched_barrier(0);
              a0 -= mr1[0] * X[24]; a1 -= mr1[1] * X[25]; a2 -= mr1[2] * X[26]; a3 -= mr1[3] * X[27];
              mr1 = *(const LAS f32x4*)(Mm + 3536);
              __builtin_amdgcn_sched_barrier(0);
              a0 -= mr2[0] * X[28]; a1 -= mr2[1] * X[29]; a2 -= mr2[2] * X[30]; a3 -= mr2[3] * X[31];
              mr2 = *(const LAS f32x4*)(Mm + 3540);
              __builtin_amdgcn_sched_barrier(0);
              a0 -= mr3[0] * X[32]; a1 -= mr3[1] * X[33]; a2 -= mr3[2] * X[34]; a3 -= mr3[3] * X[35];
              mr3 = *(const LAS f32x4*)(Mm + 3544);
              __builtin_amdgcn_sched_barrier(0);
              a0 -= mr4[0] * X[36]; a1 -= mr4[1] * X[37]; a2 -= mr4[2] * X[38]; a3 -= mr4[3] * X[39];
              mr4 = *(const LAS f32x4*)(Mm + 3548);
              __builtin_amdgcn_sched_barrier(0);
              a0 -= mr5[0] * X[40]; a1 -= mr5[1] * X[41]; a2 -= mr5[2] * X[42]; a3 -= mr5[3] * X[43];
              mr5 = *(const LAS f32x4*)(Mm + 3552);
              __builtin_amdgcn_sched_barrier(0);
              a0 -= mr6[0] * X[44]; a1 -= mr6[1] * X[45]; a2 -= mr6[2] * X[46]; a3 -= mr6[3] * X[47];
              mr6 = *(const LAS f32x4*)(Mm + 3556);
              __builtin_amdgcn_sched_barrier(0);
              a0 -= mr0[0] * X[48]; a1 -= mr0[1] * X[49]; a2 -= mr0[2] * X[50];
              X[51] = (a0 + a1) + (a2 + a3); dst[6732] = X[51]; }
            __builtin_amdgcn_sched_barrier(0);
            rh0 = src[7128] * cf[54];
            { float a0 = rh1, a1 = 0.f, a2 = 0.f, a3 = 0.f;
              mr0 = *(const LAS f32x4*)(Mm + 3560);
              __builtin_amdgcn_sched_barrier(0);
              a0 -= mr1[0] * X[0]; a1 -= mr1[1] * X[1]; a2 -= mr1[2] * X[2]; a3 -= mr1[3] * X[3];
              mr1 = *(const LAS f32x4*)(Mm + 3564);
              __builtin_amdgcn_sched_barrier(0);
              a0 -= mr2[0] * X[4]; a1 -= mr2[1] * X[5]; a2 -= mr2[2] * X[6]; a3 -= mr2[3] * X[7];
              mr2 = *(const LAS f32x4*)(Mm + 3568);
              __builtin_amdgcn_sched_barrier(0);
              a0 -= mr3[0] * X[8]; a1 -= mr3[1] * X[9]; a2 -= mr3[2] * X[10]; a3 -= mr3[3] * X[11];
              mr3 = *(const LAS f32x4*)(Mm + 3572);
              __builtin_amdgcn_sched_barrier(0);
              a0 -= mr4[0] * X[12]; a1 -= mr4[1] * X[13]; a2 -= mr4[2] * X[14]; a3 -= mr4[3] * X[15];
              mr4 = *(const LAS f32x4*)(Mm + 3576);
              __builtin_amdgcn_sched_barrier(0);
              a0 -= mr5[0] * X[16]; a1 -= mr5[1] * X[17]; a2 -= mr5[2] * X[18]; a3 -= mr5[3] * X[19];
              mr5 = *(const LAS f32x4*)(Mm + 3580);
              __builtin_amdgcn_sched_barrier(0);
              a0 -= mr6[0] * X[20]; a1 -= mr6[1] * X[21]; a2 -= mr6[2] * X[22]; a3 -= mr6[3] * X[23];
              mr6 = *(const LAS f32x4*)(Mm + 3584);
              __builtin_amdgcn_sched_barrier(0);
              a0 -= mr0[0] * X[24]; a1 -= mr0[1] * X[25]; a2 -= mr0[2] * X[26]; a3 -= mr0[3] * X[27];
              mr0 = *(const LAS f32x4*)(Mm + 3604);
              __builtin_amdgcn_sched_barrier(0);
              a0 -= mr1[0] * X[28]; a1 -= mr1[1] * X[29]; a2 -= mr1[2] * X[30]; a3 -= mr1[3] * X[31];
              mr1 = *(const LAS f32x4*)(Mm + 3608);
              __builtin_amdgcn_sched_barrier(0);
              a0 -= mr2[0] * X[32]; a1 -= mr2[1] * X[33]; a2 -= mr2[2] * X[34]; a3 -= mr2[3] * X[35];
              mr2 = *(const LAS f32x4*)(Mm + 3612);
              __builtin_amdgcn_sched_barrier(0);
              a0 -= mr3[0] * X[36]; a1 -= mr3[1] * X[37]; a2 -= mr3[2] * X[38]; a3 -= mr3[3] * X[39];
              mr3 = *(const LAS f32x4*)(Mm + 3616);
              __builtin_amdgcn_sched_barrier(0);
              a0 -= mr4[0] * X[40]; a1 -= mr4[1] * X[41]; a2 -= mr4[2] * X[42]; a3 -= mr4[3] * X[43];
              mr4 = *(const LAS f32x4*)(Mm + 3620);
              __builtin_amdgcn_sched_barrier(0);
              a0 -= mr5[0] * X[44]; a1 -= mr5[1] * X[45]; a2 -= mr5[2] * X[46]; a3 -= mr5[3] * X[47];
              mr5 = *(const LAS f32x4*)(Mm + 3624);
              __builtin_amdgcn_sched_barrier(0);
              a0 -= mr6[0] * X[48]; a1 -= mr6[1] * X[49]; a2 -= mr6[2] * X[50]; a3 -= mr6[3] * X[51];
              X[52] = (a0 + a1) + (a2 + a3); dst[6864] = X[52]; }
            __builtin_amdgcn_sched_barrier(0);
            rh1 = src[7260] * cf[55];
            { float a0 = rh2, a1 = 0.f, a2 = 0.f, a3 = 0.f;
              mr6 = *(const LAS f32x4*)(Mm + 3628);
              __builtin_amdgcn_sched_barrier(0);
              a0 -= mr0[0] * X[0]; a1 -= mr0[1] * X[1]; a2 -= mr0[2] * X[2]; a3 -= mr0[3] * X[3];
              mr0 = *(const LAS f32x4*)(Mm + 3632);
              __builtin_amdgcn_sched_barrier(0);
              a0 -= mr1[0] * X[4]; a1 -= mr1[1] * X[5]; a2 -= mr1[2] * X[6]; a3 -= mr1[3] * X[7];
              mr1 = *(const LAS f32x4*)(Mm + 3636);
              __builtin_amdgcn_sched_barrier(0);
              a0 -= mr2[0] * X[8]; a1 -= mr2[1] * X[9]; a2 -= mr2[2] * X[10]; a3 -= mr2[3] * X[11];
              mr2 = *(const LAS f32x4*)(Mm + 3640);
              __builtin_amdgcn_sched_barrier(0);
              a0 -= mr3[0] * X[12]; a1 -= mr3[1] * X[13]; a2 -= mr3[2] * X[14]; a3 -= mr3[3] * X[15];
              mr3 = *(const LAS f32x4*)(Mm + 3644);
              __builtin_amdgcn_sched_barrier(0);
              a0 -= mr4[0] * X[16]; a1 -= mr4[1] * X[17]; a2 -= mr4[2] * X[18]; a3 -= mr4[3] * X[19];
              mr4 = *(const LAS f32x4*)(Mm + 3648);
              __builtin_amdgcn_sched_barrier(0);
              a0 -= mr5[0] * X[20]; a1 -= mr5[1] * X[21]; a2 -= mr5[2] * X[22]; a3 -= mr5[3] * X[23];
              mr5 = *(const LAS f32x4*)(Mm + 3652);
              __builtin_amdgcn_sched_barrier(0);
              a0 -= mr6[0] * X[24]; a1 -= mr6[1] * X[25]; a2 -= mr6[2] * X[26]; a3 -= mr6[3] * X[27];
              mr6 = *(const LAS f32x4*)(Mm + 3656);
              __builtin_amdgcn_sched_barrier(0);
              a0 -= mr0[0] * X[28]; a1 -= mr0[1] * X[29]; a2 -= mr0[2] * X[30]; a3 -= mr0[3] * X[31];
              mr0 = *(const LAS f32x4*)(Mm + 3672);
              __builtin_amdgcn_sched_barrier(0);
              a0 -= mr1[0] * X[32]; a1 -= mr1[1] * X[33]; a2 -= mr1[2] * X[34]; a3 -= mr1[3] * X[35];
              mr1 = *(const LAS f32x4*)(Mm + 3676);
              __builtin_amdgcn_sched_barrier(0);
              a0 -= mr2[0] * X[36]; a1 -= mr2[1] * X[37]; a2 -= mr2[2] * X[38]; a3 -= mr2[3] * X[39];
              mr2 = *(const LAS f32x4*)(Mm + 3680);
              __builtin_amdgcn_sched_barrier(0);
              a0 -= mr3[0] * X[40]; a1 -= mr3[1] * X[41]; a2 -= mr3[2] * X[42]; a3 -= mr3[3] * X[43];
              mr3 = *(const LAS f32x4*)(Mm + 3684);
              __builtin_amdgcn_sched_barrier(0);
              a0 -= mr4[0] * X[44]; a1 -= mr4[1] * X[45]; a2 -= mr4[2] * X[46]; a3 -= mr4[3] * X[47];
              mr4 = *(const LAS f32x4*)(Mm + 3688);
              __builtin_amdgcn_sched_barrier(0);
              a0 -= mr5[0] * X[48]; a1 -= mr5[1] * X[49]; a2 -= mr5[2] * X[50]; a3 -= mr5[3] * X[51];
              mr5 = *(const LAS f32x4*)(Mm + 3692);
              __builtin_amdgcn_sched_barrier(0);
              a0 -= mr6[0] * X[52];
              X[53] = (a0 + a1) + (a2 + a3); dst[6996] = X[53]; }
            __builtin_amdgcn_sched_barrier(0);
            rh2 = src[7392] * cf[56];
            { float a0 = rh0, a1 = 0.f, a2 = 0.f, a3 = 0.f;
              mr6 = *(const LAS f32x4*)(Mm + 3696);
              __builtin_amdgcn_sched_barrier(0);
              a0 -= mr0[0] * X[0]; a1 -= mr0[1] * X[1]; a2 -= mr0[2] * X[2]; a3 -= mr0[3] * X[3];
              mr0 = *(const LAS f32x4*)(Mm + 3700);
              __builtin_amdgcn_sched_barrier(0);
              a0 -= mr1[0] * X[4]; a1 -= mr1[1] * X[5]; a2 -= mr1[2] * X[6]; a3 -= mr1[3] * X[7];
              mr1 = *(const LAS f32x4*)(Mm + 3704);
              __builtin_amdgcn_sched_barrier(0);
              a0 -= mr2[0] * X[8]; a1 -= mr2[1] * X[9]; a2 -= mr2[2] * X[10]; a3 -= mr2[3] * X[11];
              mr2 = *(const LAS f32x4*)(Mm + 3708);
              __builtin_amdgcn_sched_barrier(0);
              a0 -= mr3[0] * X[12]; a1 -= mr3[1] * X[13]; a2 -= mr3[2] * X[14]; a3 -= mr3[3] * X[15];
              mr3 = *(const LAS f32x4*)(Mm + 3712);
              __builtin_amdgcn_sched_barrier(0);
              a0 -= mr4[0] * X[16]; a1 -= mr4[1] * X[17]; a2 -= mr4[2] * X[18]; a3 -= mr4[3] * X[19];
              mr4 = *(const LAS f32x4*)(Mm + 3716);
              __builtin_amdgcn_sched_barrier(0);
              a0 -= mr5[0] * X[20]; a1 -= mr5[1] * X[21]; a2 -= mr5[2] * X[22]; a3 -= mr5[3] * X[23];
              mr5 = *(const LAS f32x4*)(Mm + 3720);
              __builtin_amdgcn_sched_barrier(0);
              a0 -= mr6[0] * X[24]; a1 -= mr6[1] * X[25]; a2 -= mr6[2] * X[26]; a3 -= mr6[3] * X[27];
              mr6 = *(const LAS f32x4*)(Mm + 3724);
              __builtin_amdgcn_sched_barrier(0);
              a0 -= mr0[0] * X[28]; a1 -= mr0[1] * X[29]; a2 -= mr0[2] * X[30]; a3 -= mr0[3] * X[31];
              mr0 = *(const LAS f32x4*)(Mm + 3740);
              __builtin_amdgcn_sched_barrier(0);
              a0 -= mr1[0] * X[32]; a1 -= mr1[1] * X[33]; a2 -= mr1[2] * X[34]; a3 -= mr1[3] * X[35];
              mr1 = *(const LAS f32x4*)(Mm + 3744);
              __builtin_amdgcn_sched_barrier(0);
              a0 -= mr2[0] * X[36]; a1 -= mr2[1] * X[37]; a2 -= mr2[2] * X[38]; a3 -= mr2[3] * X[39];
              mr2 = *(const LAS f32x4*)(Mm + 3748);
              __builtin_amdgcn_sched_barrier(0);
              a0 -= mr3[0] * X[40]; a1 -= mr3[1] * X[41]; a2 -= mr3[2] * X[42]; a3 -= mr3[3] * X[43];
              mr3 = *(const LAS f32x4*)(Mm + 3752);
              __builtin_amdgcn_sched_barrier(0);
              a0 -= mr4[0] * X[44]; a1 -= mr4[1] * X[45]; a2 -= mr4[2] * X[46]; a3 -= mr4[3] * X[47];
              mr4 = *(const LAS f32x4*)(Mm + 3756);
              __builtin_amdgcn_sched_barrier(0);
              a0 -= mr5[0] * X[48]; a1 -= mr5[1] * X[49]; a2 -= mr5[2] * X[50]; a3 -= mr5[3] * X[51];
              mr5 = *(const LAS f32x4*)(Mm + 3760);
              __builtin_amdgcn_sched_barrier(0);
              a0 -= mr6[0] * X[52]; a1 -= mr6[1] * X[53];
              X[54] = (a0 + a1) + (a2 + a3); dst[7128] = X[54]; }
            __builtin_amdgcn_sched_barrier(0);
            rh0 = src[7524] * cf[57];
            { float a0 = rh1, a1 = 0.f, a2 = 0.f, a3 = 0.f;
              mr6 = *(const LAS f32x4*)(Mm + 3764);
              __builtin_amdgcn_sched_barrier(0);
              a0 -= mr0[0] * X[0]; a1 -= mr0[1] * X[1]; a2 -= mr0[2] * X[2]; a3 -= mr0[3] * X[3];
              mr0 = *(const LAS f32x4*)(Mm + 3768);
              __builtin_amdgcn_sched_barrier(0);
              a0 -= mr1[0] * X[4]; a1 -= mr1[1] * X[5]; a2 -= mr1[2] * X[6]; a3 -= mr1[3] * X[7];
              mr1 = *(const LAS f32x4*)(Mm + 3772);
              __builtin_amdgcn_sched_barrier(0);
              a0 -= mr2[0] * X[8]; a1 -= mr2[1] * X[9]; a2 -= mr2[2] * X[10]; a3 -= mr2[3] * X[11];
              mr2 = *(const LAS f32x4*)(Mm + 3776);
              __builtin_amdgcn_sched_barrier(0);
              a0 -= mr3[0] * X[12]; a1 -= mr3[1] * X[13]; a2 -= mr3[2] * X[14]; a3 -= mr3[3] * X[15];
              mr3 = *(const LAS f32x4*)(Mm + 3780);
              __builtin_amdgcn_sched_barrier(0);
              a0 -= mr4[0] * X[16]; a1 -= mr4[1] * X[17]; a2 -= mr4[2] * X[18]; a3 -= mr4[3] * X[19];
              mr4 = *(const LAS f32x4*)(Mm + 3784);
              __builtin_amdgcn_sched_barrier(0);
              a0 -= mr5[0] * X[20]; a1 -= mr5[1] * X[21]; a2 -= mr5[2] * X[22]; a3 -= mr5[3] * X[23];
              mr5 = *(const LAS f32x4*)(Mm + 3788);
              __builtin_amdgcn_sched_barrier(0);
              a0 -= mr6[0] * X[24]; a1 -= mr6[1] * X[25]; a2 -= mr6[2] * X[26]; a3 -= mr6[3] * X[27];
              mr6 = *(const LAS f32x4*)(Mm + 3792);
              __builtin_amdgcn_sched_barrier(0);
              a0 -= mr0[0] * X[28]; a1 -= mr0[1] * X[29]; a2 -= mr0[2] * X[30]; a3 -= mr0[3] * X[31];
              mr0 = *(const LAS f32x4*)(Mm + 3808);
              __builtin_amdgcn_sched_barrier(0);
              a0 -= mr1[0] * X[32]; a1 -= mr1[1] * X[33]; a2 -= mr1[2] * X[34]; a3 -= mr1[3] * X[35];
              mr1 = *(const LAS f32x4*)(Mm + 3812);
              __builtin_amdgcn_sched_barrier(0);
              a0 -= mr2[0] * X[36]; a1 -= mr2[1] * X[37]; a2 -= mr2[2] * X[38]; a3 -= mr2[3] * X[39];
              mr2 = *(const LAS f32x4*)(Mm + 3816);
              __builtin_amdgcn_sched_barrier(0);
              a0 -= mr3[0] * X[40]; a1 -= mr3[1] * X[41]; a2 -= mr3[2] * X[42]; a3 -= mr3[3] * X[43];
              mr3 = *(const LAS f32x4*)(Mm + 3820);
              __builtin_amdgcn_sched_barrier(0);
              a0 -= mr4[0] * X[44]; a1 -= mr4[1] * X[45]; a2 -= mr4[2] * X[46]; a3 -= mr4[3] * X[47];
              mr4 = *(const LAS f32x4*)(Mm + 3824);
              __builtin_amdgcn_sched_barrier(0);
              a0 -= mr5[0] * X[48]; a1 -= mr5[1] * X[49]; a2 -= mr5[2] * X[50]; a3 -= mr5[3] * X[51];
              mr5 = *(const LAS f32x4*)(Mm + 3828);
              __builtin_amdgcn_sched_barrier(0);
              a0 -= mr6[0] * X[52]; a1 -= mr6[1] * X[53]; a2 -= mr6[2] * X[54];
              X[55] = (a0 + a1) + (a2 + a3); dst[7260] = X[55]; }
            __builtin_amdgcn_sched_barrier(0);
            rh1 = src[7656] * cf[58];
            { float a0 = rh2, a1 = 0.f, a2 = 0.f, a3 = 0.f;
              mr6 = *(const LAS f32x4*)(Mm + 3832);
              __builtin_amdgcn_sched_barrier(0);
              a0 -= mr0[0] * X[0]; a1 -= mr0[1] * X[1]; a2 -= mr0[2] * X[2]; a3 -= mr0[3] * X[3];
              mr0 = *(const LAS f32x4*)(Mm + 3836);
              __builtin_amdgcn_sched_barrier(0);
              a0 -= mr1[0] * X[4]; a1 -= mr1[1] * X[5]; a2 -= mr1[2] * X[6]; a3 -= mr1[3] * X[7];
              mr1 = *(const LAS f32x4*)(Mm + 3840);
              __builtin_amdgcn_sched_barrier(0);
              a0 -= mr2[0] * X[8]; a1 -= mr2[1] * X[9]; a2 -= mr2[2] * X[10]; a3 -= mr2[3] * X[11];
              mr2 = *(const LAS f32x4*)(Mm + 3844);
              __builtin_amdgcn_sched_barrier(0);
              a0 -= mr3[0] * X[12]; a1 -= mr3[1] * X[13]; a2 -= mr3[2] * X[14]; a3 -= mr3[3] * X[15];
              mr3 = *(const LAS f32x4*)(Mm + 3848);
              __builtin_amdgcn_sched_barrier(0);
              a0 -= mr4[0] * X[16]; a1 -= mr4[1] * X[17]; a2 -= mr4[2] * X[18]; a3 -= mr4[3] * X[19];
              mr4 = *(const LAS f32x4*)(Mm + 3852);
              __builtin_amdgcn_sched_barrier(0);
              a0 -= mr5[0] * X[20]; a1 -= mr5[1] * X[21]; a2 -= mr5[2] * X[22]; a3 -= mr5[3] * X[23];
              mr5 = *(const LAS f32x4*)(Mm + 3856);
              __builtin_amdgcn_sched_barrier(0);
              a0 -= mr6[0] * X[24]; a1 -= mr6[1] * X[25]; a2 -= mr6[2] * X[26]; a3 -= mr6[3] * X[27];
              mr6 = *(const LAS f32x4*)(Mm + 3860);
              __builtin_amdgcn_sched_barrier(0);
              a0 -= mr0[0] * X[28]; a1 -= mr0[1] * X[29]; a2 -= mr0[2] * X[30]; a3 -= mr0[3] * X[31];
              mr0 = *(const LAS f32x4*)(Mm + 3876);
              __builtin_amdgcn_sched_barrier(0);
              a0 -= mr1[0] * X[32]; a1 -= mr1[1] * X[33]; a2 -= mr1[2] * X[34]; a3 -= mr1[3] * X[35];
              mr1 = *(const LAS f32x4*)(Mm + 3880);
              __builtin_amdgcn_sched_barrier(0);
              a0 -= mr2[0] * X[36]; a1 -= mr2[1] * X[37]; a2 -= mr2[2] * X[38]; a3 -= mr2[3] * X[39];
              mr2 = *(const LAS f32x4*)(Mm + 3884);
              __builtin_amdgcn_sched_barrier(0);
              a0 -= mr3[0] * X[40]; a1 -= mr3[1] * X[41]; a2 -= mr3[2] * X[42]; a3 -= mr3[3] * X[43];
              mr3 = *(const LAS f32x4*)(Mm + 3888);
              __builtin_amdgcn_sched_barrier(0);
              a0 -= mr4[0] * X[44]; a1 -= mr4[1] * X[45]; a2 -= mr4[2] * X[46]; a3 -= mr4[3] * X[47];
              mr4 = *(const LAS f32x4*)(Mm + 3892);
              __builtin_amdgcn_sched_barrier(0);
              a0 -= mr5[0] * X[48]; a1 -= mr5[1] * X[49]; a2 -= mr5[2] * X[50]; a3 -= mr5[3] * X[51];
              mr5 = *(const LAS f32x4*)(Mm + 3896);
              __builtin_amdgcn_sched_barrier(0);
              a0 -= mr6[0] * X[52]; a1 -= mr6[1] * X[53]; a2 -= mr6[2] * X[54]; a3 -= mr6[3] * X[55];
              X[56] = (a0 + a1) + (a2 + a3); dst[7392] = X[56]; }
            __builtin_amdgcn_sched_barrier(0);
            rh2 = src[7788] * cf[59];
            { float a0 = rh0, a1 = 0.f, a2 = 0.f, a3 = 0.f;
              mr6 = *(const LAS f32x4*)(Mm + 3900);
              __builtin_amdgcn_sched_barrier(0);
              a0 -= mr0[0] * X[0]; a1 -= mr0[1] * X[1]; a2 -= mr0[2] * X[2]; a3 -= mr0[3] * X[3];
              mr0 = *(const LAS f32x4*)(Mm + 3904);
              __builtin_amdgcn_sched_barrier(0);
              a0 -= mr1[0] * X[4]; a1 -= mr1[1] * X[5]; a2 -= mr1[2] * X[6]; a3 -= mr1[3] * X[7];
              mr1 = *(const LAS f32x4*)(Mm + 3908);
              __builtin_amdgcn_sched_barrier(0);
              a0 -= mr2[0] * X[8]; a1 -= mr2[1] * X[9]; a2 -= mr2[2] * X[10]; a3 -= mr2[3] * X[11];
              mr2 = *(const LAS f32x4*)(Mm + 3912);
              __builtin_amdgcn_sched_barrier(0);
              a0 -= mr3[0] * X[12]; a1 -= mr3[1] * X[13]; a2 -= mr3[2] * X[14]; a3 -= mr3[3] * X[15];
              mr3 = *(const LAS f32x4*)(Mm + 3916);
              __builtin_amdgcn_sched_barrier(0);
              a0 -= mr4[0] * X[16]; a1 -= mr4[1] * X[17]; a2 -= mr4[2] * X[18]; a3 -= mr4[3] * X[19];
              mr4 = *(const LAS f32x4*)(Mm + 3920);
              __builtin_amdgcn_sched_barrier(0);
              a0 -= mr5[0] * X[20]; a1 -= mr5[1] * X[21]; a2 -= mr5[2] * X[22]; a3 -= mr5[3] * X[23];
              mr5 = *(const LAS f32x4*)(Mm + 3924);
              __builtin_amdgcn_sched_barrier(0);
              a0 -= mr6[0] * X[24]; a1 -= mr6[1] * X[25]; a2 -= mr6[2] * X[26]; a3 -= mr6[3] * X[27];
              mr6 = *(const LAS f32x4*)(Mm + 3928);
              __builtin_amdgcn_sched_barrier(0);
              a0 -= mr0[0] * X[28]; a1 -= mr0[1] * X[29]; a2 -= mr0[2] * X[30]; a3 -= mr0[3] * X[31];
              mr0 = *(const LAS f32x4*)(Mm + 3932);
              __builtin_amdgcn_sched_barrier(0);
              a0 -= mr1[0] * X[32]; a1 -= mr1[1] * X[33]; a2 -= mr1[2] * X[34]; a3 -= mr1[3] * X[35];
              mr1 = *(const LAS f32x4*)(Mm + 3944);
              __builtin_amdgcn_sched_barrier(0);
              a0 -= mr2[0] * X[36]; a1 -= mr2[1] * X[37]; a2 -= mr2[2] * X[38]; a3 -= mr2[3] * X[39];
              mr2 = *(const LAS f32x4*)(Mm + 3948);
              __builtin_amdgcn_sched_barrier(0);
              a0 -= mr3[0] * X[40]; a1 -= mr3[1] * X[41]; a2 -= mr3[2] * X[42]; a3 -= mr3[3] * X[43];
              mr3 = *(const LAS f32x4*)(Mm + 3952);
              __builtin_amdgcn_sched_barrier(0);
              a0 -= mr4[0] * X[44]; a1 -= mr4[1] * X[45]; a2 -= mr4[2] * X[46]; a3 -= mr4[3] * X[47];
              mr4 = *(const LAS f32x4*)(Mm + 3956);
              __builtin_amdgcn_sched_barrier(0);
              a0 -= mr5[0] * X[48]; a1 -= mr5[1] * X[49]; a2 -= mr5[2] * X[50]; a3 -= mr5[3] * X[51];
              mr5 = *(const LAS f32x4*)(Mm + 3960);
              __builtin_amdgcn_sched_barrier(0);
              a0 -= mr6[0] * X[52]; a1 -= mr6[1] * X[53]; a2 -= mr6[2] * X[54]; a3 -= mr6[3] * X[55];
              mr6 = *(const LAS f32x4*)(Mm + 3964);
              __builtin_amdgcn_sched_barrier(0);
              a0 -= mr0[0] * X[56];
              X[57] = (a0 + a1) + (a2 + a3); dst[7524] = X[57]; }
            __builtin_amdgcn_sched_barrier(0);
            rh0 = src[7920] * cf[60];
            { float a0 = rh1, a1 = 0.f, a2 = 0.f, a3 = 0.f;
              mr0 = *(const LAS f32x4*)(Mm + 3968);
              __builtin_amdgcn_sched_barrier(0);
              a0 -= mr1[0] * X[0]; a1 -= mr1[1] * X[1]; a2 -= mr1[2] * X[2]; a3 -= mr1[3] * X[3];
              mr1 = *(const LAS f32x4*)(Mm + 3972);
              __builtin_amdgcn_sched_barrier(0);
              a0 -= mr2[0] * X[4]; a1 -= mr2[1] * X[5]; a2 -= mr2[2] * X[6]; a3 -= mr2[3] * X[7];
              mr2 = *(const LAS f32x4*)(Mm + 3976);
              __builtin_amdgcn_sched_barrier(0);
              a0 -= mr3[0] * X[8]; a1 -= mr3[1] * X[9]; a2 -= mr3[2] * X[10]; a3 -= mr3[3] * X[11];
              mr3 = *(const LAS f32x4*)(Mm + 3980);
              __builtin_amdgcn_sched_barrier(0);
              a0 -= mr4[0] * X[12]; a1 -= mr4[1] * X[13]; a2 -= mr4[2] * X[14]; a3 -= mr4[3] * X[15];
              mr4 = *(const LAS f32x4*)(Mm + 3984);
              __builtin_amdgcn_sched_barrier(0);
              a0 -= mr5[0] * X[16]; a1 -= mr5[1] * X[17]; a2 -= mr5[2] * X[18]; a3 -= mr5[3] * X[19];
              mr5 = *(const LAS f32x4*)(Mm + 3988);
              __builtin_amdgcn_sched_barrier(0);
              a0 -= mr6[0] * X[20]; a1 -= mr6[1] * X[21]; a2 -= mr6[2] * X[22]; a3 -= mr6[3] * X[23];
              mr6 = *(const LAS f32x4*)(Mm + 3992);
              __builtin_amdgcn_sched_barrier(0);
              a0 -= mr0[0] * X[24]; a1 -= mr0[1] * X[25]; a2 -= mr0[2] * X[26]; a3 -= mr0[3] * X[27];
              mr0 = *(const LAS f32x4*)(Mm + 3996);
              __builtin_amdgcn_sched_barrier(0);
              a0 -= mr1[0] * X[28]; a1 -= mr1[1] * X[29]; a2 -= mr1[2] * X[30]; a3 -= mr1[3] * X[31];
              mr1 = *(const LAS f32x4*)(Mm + 4000);
              __builtin_amdgcn_sched_barrier(0);
              a0 -= mr2[0] * X[32]; a1 -= mr2[1] * X[33]; a2 -= mr2[2] * X[34]; a3 -= mr2[3] * X[35];
              mr2 = *(const LAS f32x4*)(Mm + 4012);
              __builtin_amdgcn_sched_barrier(0);
              a0 -= mr3[0] * X[36]; a1 -= mr3[1] * X[37]; a2 -= mr3[2] * X[38]; a3 -= mr3[3] * X[39];
              mr3 = *(const LAS f32x4*)(Mm + 4016);
              __builtin_amdgcn_sched_barrier(0);
              a0 -= mr4[0] * X[40]; a1 -= mr4[1] * X[41]; a2 -= mr4[2] * X[42]; a3 -= mr4[3] * X[43];
              mr4 = *(const LAS f32x4*)(Mm + 4020);
              __builtin_amdgcn_sched_barrier(0);
              a0 -= mr5[0] * X[44]; a1 -= mr5[1] * X[45]; a2 -= mr5[2] * X[46]; a3 -= mr5[3] * X[47];
              mr5 = *(const LAS f32x4*)(Mm + 4024);
              __builtin_amdgcn_sched_barrier(0);
              a0 -= mr6[0] * X[48]; a1 -= mr6[1] * X[49]; a2 -= mr6[2] * X[50]; a3 -= mr6[3] * X[51];
              mr6 = *(const LAS f32x4*)(Mm + 4028);
              __builtin_amdgcn_sched_barrier(0);
              a0 -= mr0[0] * X[52]; a1 -= mr0[1] * X[53]; a2 -= mr0[2] * X[54]; a3 -= mr0[3] * X[55];
              mr0 = *(const LAS f32x4*)(Mm + 4032);
              __builtin_amdgcn_sched_barrier(0);
              a0 -= mr1[0] * X[56]; a1 -= mr1[1] * X[57];
              X[58] = (a0 + a1) + (a2 + a3); dst[7656] = X[58]; }
            __builtin_amdgcn_sched_barrier(0);
            rh1 = src[8052] * cf[61];
            { float a0 = rh2, a1 = 0.f, a2 = 0.f, a3 = 0.f;
              mr1 = *(const LAS f32x4*)(Mm + 4036);
              __builtin_amdgcn_sched_barrier(0);
              a0 -= mr2[0] * X[0]; a1 -= mr2[1] * X[1]; a2 -= mr2[2] * X[2]; a3 -= mr2[3] * X[3];
              mr2 = *(const LAS f32x4*)(Mm + 4040);
              __builtin_amdgcn_sched_barrier(0);
              a0 -= mr3[0] * X[4]; a1 -= mr3[1] * X[5]; a2 -= mr3[2] * X[6]; a3 -= mr3[3] * X[7];
              mr3 = *(const LAS f32x4*)(Mm + 4044);
              __builtin_amdgcn_sched_barrier(0);
              a0 -= mr4[0] * X[8]; a1 -= mr4[1] * X[9]; a2 -= mr4[2] * X[10]; a3 -= mr4[3] * X[11];
              mr4 = *(const LAS f32x4*)(Mm + 4048);
              __builtin_amdgcn_sched_barrier(0);
              a0 -= mr5[0] * X[12]; a1 -= mr5[1] * X[13]; a2 -= mr5[2] * X[14]; a3 -= mr5[3] * X[15];
              mr5 = *(const LAS f32x4*)(Mm + 4052);
              __builtin_amdgcn_sched_barrier(0);
              a0 -= mr6[0] * X[16]; a1 -= mr6[1] * X[17]; a2 -= mr6[2] * X[18]; a3 -= mr6[3] * X[19];
              mr6 = *(const LAS f32x4*)(Mm + 4056);
              __builtin_amdgcn_sched_barrier(0);
              a0 -= mr0[0] * X[20]; a1 -= mr0[1] * X[21]; a2 -= mr0[2] * X[22]; a3 -= mr0[3] * X[23];
              mr0 = *(const LAS f32x4*)(Mm + 4060);
              __builtin_amdgcn_sched_barrier(0);
              a0 -= mr1[0] * X[24]; a1 -= mr1[1] * X[25]; a2 -= mr1[2] * X[26]; a3 -= mr1[3] * X[27];
              mr1 = *(const LAS f32x4*)(Mm + 4064);
              __builtin_amdgcn_sched_barrier(0);
              a0 -= mr2[0] * X[28]; a1 -= mr2[1] * X[29]; a2 -= mr2[2] * X[30]; a3 -= mr2[3] * X[31];
              mr2 = *(const LAS f32x4*)(Mm + 4068);
              __builtin_amdgcn_sched_barrier(0);
              a0 -= mr3[0] * X[32]; a1 -= mr3[1] * X[33]; a2 -= mr3[2] * X[34]; a3 -= mr3[3] * X[35];
              mr3 = *(const LAS f32x4*)(Mm + 4080);
              __builtin_amdgcn_sched_barrier(0);
              a0 -= mr4[0] * X[36]; a1 -= mr4[1] * X[37]; a2 -= mr4[2] * X[38]; a3 -= mr4[3] * X[39];
              mr4 = *(const LAS f32x4*)(Mm + 4084);
              __builtin_amdgcn_sched_barrier(0);
              a0 -= mr5[0] * X[40]; a1 -= mr5[1] * X[41]; a2 -= mr5[2] * X[42]; a3 -= mr5[3] * X[43];
              mr5 = *(const LAS f32x4*)(Mm + 4088);
              __builtin_amdgcn_sched_barrier(0);
              a0 -= mr6[0] * X[44]; a1 -= mr6[1] * X[45]; a2 -= mr6[2] * X[46]; a3 -= mr6[3] * X[47];
              mr6 = *(const LAS f32x4*)(Mm + 4092);
              __builtin_amdgcn_sched_barrier(0);
              a0 -= mr0[0] * X[48]; a1 -= mr0[1] * X[49]; a2 -= mr0[2] * X[50]; a3 -= mr0[3] * X[51];
              mr0 = *(const LAS f32x4*)(Mm + 4096);
              __builtin_amdgcn_sched_barrier(0);
              a0 -= mr1[0] * X[52]; a1 -= mr1[1] * X[53]; a2 -= mr1[2] * X[54]; a3 -= mr1[3] * X[55];
              mr1 = *(const LAS f32x4*)(Mm + 4100);
              __builtin_amdgcn_sched_barrier(0);
              a0 -= mr2[0] * X[56]; a1 -= mr2[1] * X[57]; a2 -= mr2[2] * X[58];
              X[59] = (a0 + a1) + (a2 + a3); dst[7788] = X[59]; }
            __builtin_amdgcn_sched_barrier(0);
            rh2 = src[8184] * cf[62];
            { float a0 = rh0, a1 = 0.f, a2 = 0.f, a3 = 0.f;
              mr2 = *(const LAS f32x4*)(Mm + 4104);
              __builtin_amdgcn_sched_barrier(0);
              a0 -= mr3[0] * X[0]; a1 -= mr3[1] * X[1]; a2 -= mr3[2] * X[2]; a3 -= mr3[3] * X[3];
              mr3 = *(const LAS f32x4*)(Mm + 4108);
              __builtin_amdgcn_sched_barrier(0);
              a0 -= mr4[0] * X[4]; a1 -= mr4[1] * X[5]; a2 -= mr4[2] * X[6]; a3 -= mr4[3] * X[7];
              mr4 = *(const LAS f32x4*)(Mm + 4112);
              __builtin_amdgcn_sched_barrier(0);
              a0 -= mr5[0] * X[8]; a1 -= mr5[1] * X[9]; a2 -= mr5[2] * X[10]; a3 -= mr5[3] * X[11];
              mr5 = *(const LAS f32x4*)(Mm + 4116);
              __builtin_amdgcn_sched_barrier(0);
              a0 -= mr6[0] * X[12]; a1 -= mr6[1] * X[13]; a2 -= mr6[2] * X[14]; a3 -= mr6[3] * X[15];
              mr6 = *(const LAS f32x4*)(Mm + 4120);
              __builtin_amdgcn_sched_barrier(0);
              a0 -= mr0[0] * X[16]; a1 -= mr0[1] * X[17]; a2 -= mr0[2] * X[18]; a3 -= mr0[3] * X[19];
              mr0 = *(const LAS f32x4*)(Mm + 4124);
              __builtin_amdgcn_sched_barrier(0);
              a0 -= mr1[0] * X[20]; a1 -= mr1[1] * X[21]; a2 -= mr1[2] * X[22]; a3 -= mr1[3] * X[23];
              mr1 = *(const LAS f32x4*)(Mm + 4128);
              __builtin_amdgcn_sched_barrier(0);
              a0 -= mr2[0] * X[24]; a1 -= mr2[1] * X[25]; a2 -= mr2[2] * X[26]; a3 -= mr2[3] * X[27];
              mr2 = *(const LAS f32x4*)(Mm + 4132);
              __builtin_amdgcn_sched_barrier(0);
              a0 -= mr3[0] * X[28]; a1 -= mr3[1] * X[29]; a2 -= mr3[2] * X[30]; a3 -= mr3[3] * X[31];
              mr3 = *(const LAS f32x4*)(Mm + 4136);
              __builtin_amdgcn_sched_barrier(0);
              a0 -= mr4[0] * X[32]; a1 -= mr4[1] * X[33]; a2 -= mr4[2] * X[34]; a3 -= mr4[3] * X[35];
              mr4 = *(const LAS f32x4*)(Mm + 4148);
              __builtin_amdgcn_sched_barrier(0);
              a0 -= mr5[0] * X[36]; a1 -= mr5[1] * X[37]; a2 -= mr5[2] * X[38]; a3 -= mr5[3] * X[39];
              mr5 = *(const LAS f32x4*)(Mm + 4152);
              __builtin_amdgcn_sched_barrier(0);
              a0 -= mr6[0] * X[40]; a1 -= mr6[1] * X[41]; a2 -= mr6[2] * X[42]; a3 -= mr6[3] * X[43];
              mr6 = *(const LAS f32x4*)(Mm + 4156);
              __builtin_amdgcn_sched_barrier(0);
              a0 -= mr0[0] * X[44]; a1 -= mr0[1] * X[45]; a2 -= mr0[2] * X[46]; a3 -= mr0[3] * X[47];
              mr0 = *(const LAS f32x4*)(Mm + 4160);
              __builtin_amdgcn_sched_barrier(0);
              a0 -= mr1[0] * X[48]; a1 -= mr1[1] * X[49]; a2 -= mr1[2] * X[50]; a3 -= mr1[3] * X[51];
              mr1 = *(const LAS f32x4*)(Mm + 4164);
              __builtin_amdgcn_sched_barrier(0);
              a0 -= mr2[0] * X[52]; a1 -= mr2[1] * X[53]; a2 -= mr2[2] * X[54]; a3 -= mr2[3] * X[55];
              mr2 = *(const LAS f32x4*)(Mm + 4168);
              __builtin_amdgcn_sched_barrier(0);
              a0 -= mr3[0] * X[56]; a1 -= mr3[1] * X[57]; a2 -= mr3[2] * X[58]; a3 -= mr3[3] * X[59];
              X[60] = (a0 + a1) + (a2 + a3); dst[7920] = X[60]; }
            __builtin_amdgcn_sched_barrier(0);
            rh0 = src[8316] * cf[63];
            { float a0 = rh1, a1 = 0.f, a2 = 0.f, a3 = 0.f;
              mr3 = *(const LAS f32x4*)(Mm + 4172);
              __builtin_amdgcn_sched_barrier(0);
              a0 -= mr4[0] * X[0]; a1 -= mr4[1] * X[1]; a2 -= mr4[2] * X[2]; a3 -= mr4[3] * X[3];
              mr4 = *(const LAS f32x4*)(Mm + 4176);
              __builtin_amdgcn_sched_barrier(0);
              a0 -= mr5[0] * X[4]; a1 -= mr5[1] * X[5]; a2 -= mr5[2] * X[6]; a3 -= mr5[3] * X[7];
              mr5 = *(const LAS f32x4*)(Mm + 4180);
              __builtin_amdgcn_sched_barrier(0);
              a0 -= mr6[0] * X[8]; a1 -= mr6[1] * X[9]; a2 -= mr6[2] * X[10]; a3 -= mr6[3] * X[11];
              mr6 = *(const LAS f32x4*)(Mm + 4184);
              __builtin_amdgcn_sched_barrier(0);
              a0 -= mr0[0] * X[12]; a1 -= mr0[1] * X[13]; a2 -= mr0[2] * X[14]; a3 -= mr0[3] * X[15];
              mr0 = *(const LAS f32x4*)(Mm + 4188);
              __builtin_amdgcn_sched_barrier(0);
              a0 -= mr1[0] * X[16]; a1 -= mr1[1] * X[17]; a2 -= mr1[2] * X[18]; a3 -= mr1[3] * X[19];
              mr1 = *(const LAS f32x4*)(Mm + 4192);
              __builtin_amdgcn_sched_barrier(0);
              a0 -= mr2[0] * X[20]; a1 -= mr2[1] * X[21]; a2 -= mr2[2] * X[22]; a3 -= mr2[3] * X[23];
              mr2 = *(const LAS f32x4*)(Mm + 4196);
              __builtin_amdgcn_sched_barrier(0);
              a0 -= mr3[0] * X[24]; a1 -= mr3[1] * X[25]; a2 -= mr3[2] * X[26]; a3 -= mr3[3] * X[27];
              mr3 = *(const LAS f32x4*)(Mm + 4200);
              __builtin_amdgcn_sched_barrier(0);
              a0 -= mr4[0] * X[28]; a1 -= mr4[1] * X[29]; a2 -= mr4[2] * X[30]; a3 -= mr4[3] * X[31];
              mr4 = *(const LAS f32x4*)(Mm + 4204);
              __builtin_amdgcn_sched_barrier(0);
              a0 -= mr5[0] * X[32]; a1 -= mr5[1] * X[33]; a2 -= mr5[2] * X[34]; a3 -= mr5[3] * X[35];
              mr5 = *(const LAS f32x4*)(Mm + 4208);
              __builtin_amdgcn_sched_barrier(0);
              a0 -= mr6[0] * X[36]; a1 -= mr6[1] * X[37]; a2 -= mr6[2] * X[38]; a3 -= mr6[3] * X[39];
              mr6 = *(const LAS f32x4*)(Mm + 4216);
              __builtin_amdgcn_sched_barrier(0);
              a0 -= mr0[0] * X[40]; a1 -= mr0[1] * X[41]; a2 -= mr0[2] * X[42]; a3 -= mr0[3] * X[43];
              mr0 = *(const LAS f32x4*)(Mm + 4220);
              __builtin_amdgcn_sched_barrier(0);
              a0 -= mr1[0] * X[44]; a1 -= mr1[1] * X[45]; a2 -= mr1[2] * X[46]; a3 -= mr1[3] * X[47];
              mr1 = *(const LAS f32x4*)(Mm + 4224);
              __builtin_amdgcn_sched_barrier(0);
              a0 -= mr2[0] * X[48]; a1 -= mr2[1] * X[49]; a2 -= mr2[2] * X[50]; a3 -= mr2[3] * X[51];
              mr2 = *(const LAS f32x4*)(Mm + 4228);
              __builtin_amdgcn_sched_barrier(0);
              a0 -= mr3[0] * X[52]; a1 -= mr3[1] * X[53]; a2 -= mr3[2] * X[54]; a3 -= mr3[3] * X[55];
              mr3 = *(const LAS f32x4*)(Mm + 4232);
              __builtin_amdgcn_sched_barrier(0);
              a0 -= mr4[0] * X[56]; a1 -= mr4[1] * X[57]; a2 -= mr4[2] * X[58]; a3 -= mr4[3] * X[59];
              mr4 = *(const LAS f32x4*)(Mm + 4236);
              __builtin_amdgcn_sched_barrier(0);
              a0 -= mr5[0] * X[60];
              X[61] = (a0 + a1) + (a2 + a3); dst[8052] = X[61]; }
            __builtin_amdgcn_sched_barrier(0);
            { float a0 = rh2, a1 = 0.f, a2 = 0.f, a3 = 0.f;
              mr5 = *(const LAS f32x4*)(Mm + 4240);
              __builtin_amdgcn_sched_barrier(0);
              a0 -= mr6[0] * X[0]; a1 -= mr6[1] * X[1]; a2 -= mr6[2] * X[2]; a3 -= mr6[3] * X[3];
              mr6 = *(const LAS f32x4*)(Mm + 4244);
              __builtin_amdgcn_sched_barrier(0);
              a0 -= mr0[0] * X[4]; a1 -= mr0[1] * X[5]; a2 -= mr0[2] * X[6]; a3 -= mr0[3] * X[7];
              mr0 = *(const LAS f32x4*)(Mm + 4248);
              __builtin_amdgcn_sched_barrier(0);
              a0 -= mr1[0] * X[8]; a1 -= mr1[1] * X[9]; a2 -= mr1[2] * X[10]; a3 -= mr1[3] * X[11];
              mr1 = *(const LAS f32x4*)(Mm + 4252);
              __builtin_amdgcn_sched_barrier(0);
              a0 -= mr2[0] * X[12]; a1 -= mr2[1] * X[13]; a2 -= mr2[2] * X[14]; a3 -= mr2[3] * X[15];
              mr2 = *(const LAS f32x4*)(Mm + 4256);
              __builtin_amdgcn_sched_barrier(0);
              a0 -= mr3[0] * X[16]; a1 -= mr3[1] * X[17]; a2 -= mr3[2] * X[18]; a3 -= mr3[3] * X[19];
              mr3 = *(const LAS f32x4*)(Mm + 4260);
              __builtin_amdgcn_sched_barrier(0);
              a0 -= mr4[0] * X[20]; a1 -= mr4[1] * X[21]; a2 -= mr4[2] * X[22]; a3 -= mr4[3] * X[23];
              mr4 = *(const LAS f32x4*)(Mm + 4264);
              __builtin_amdgcn_sched_barrier(0);
              a0 -= mr5[0] * X[24]; a1 -= mr5[1] * X[25]; a2 -= mr5[2] * X[26]; a3 -= mr5[3] * X[27];
              mr5 = *(const LAS f32x4*)(Mm + 4268);
              __builtin_amdgcn_sched_barrier(0);
              a0 -= mr6[0] * X[28]; a1 -= mr6[1] * X[29]; a2 -= mr6[2] * X[30]; a3 -= mr6[3] * X[31];
              mr6 = *(const LAS f32x4*)(Mm + 4272);
              __builtin_amdgcn_sched_barrier(0);
              a0 -= mr0[0] * X[32]; a1 -= mr0[1] * X[33]; a2 -= mr0[2] * X[34]; a3 -= mr0[3] * X[35];
              mr0 = *(const LAS f32x4*)(Mm + 4276);
              __builtin_amdgcn_sched_barrier(0);
              a0 -= mr1[0] * X[36]; a1 -= mr1[1] * X[37]; a2 -= mr1[2] * X[38]; a3 -= mr1[3] * X[39];
              mr1 = *(const LAS f32x4*)(Mm + 4284);
              __builtin_amdgcn_sched_barrier(0);
              a0 -= mr2[0] * X[40]; a1 -= mr2[1] * X[41]; a2 -= mr2[2] * X[42]; a3 -= mr2[3] * X[43];
              mr2 = *(const LAS f32x4*)(Mm + 4288);
              __builtin_amdgcn_sched_barrier(0);
              a0 -= mr3[0] * X[44]; a1 -= mr3[1] * X[45]; a2 -= mr3[2] * X[46]; a3 -= mr3[3] * X[47];
              mr3 = *(const LAS f32x4*)(Mm + 4292);
              __builtin_amdgcn_sched_barrier(0);
              a0 -= mr4[0] * X[48]; a1 -= mr4[1] * X[49]; a2 -= mr4[2] * X[50]; a3 -= mr4[3] * X[51];
              mr4 = *(const LAS f32x4*)(Mm + 4296);
              __builtin_amdgcn_sched_barrier(0);
              a0 -= mr5[0] * X[52]; a1 -= mr5[1] * X[53]; a2 -= mr5[2] * X[54]; a3 -= mr5[3] * X[55];
              mr5 = *(const LAS f32x4*)(Mm + 4300);
              __builtin_amdgcn_sched_barrier(0);
              a0 -= mr6[0] * X[56]; a1 -= mr6[1] * X[57]; a2 -= mr6[2] * X[58]; a3 -= mr6[3] * X[59];
              mr6 = *(const LAS f32x4*)(Mm + 4304);
              __builtin_amdgcn_sched_barrier(0);
              a0 -= mr0[0] * X[60]; a1 -= mr0[1] * X[61];
              X[62] = (a0 + a1) + (a2 + a3); dst[8184] = X[62]; }
            __builtin_amdgcn_sched_barrier(0);
            { float a0 = rh0, a1 = 0.f, a2 = 0.f, a3 = 0.f;
              mr0 = *(const LAS f32x4*)(Mm + 4308);
              __builtin_amdgcn_sched_barrier(0);
              a0 -= mr1[0] * X[0]; a1 -= mr1[1] * X[1]; a2 -= mr1[2] * X[2]; a3 -= mr1[3] * X[3];
              mr1 = *(const LAS f32x4*)(Mm + 4312);
              __builtin_amdgcn_sched_barrier(0);
              a0 -= mr2[0] * X[4]; a1 -= mr2[1] * X[5]; a2 -= mr2[2] * X[6]; a3 -= mr2[3] * X[7];
              mr2 = *(const LAS f32x4*)(Mm + 4316);
              __builtin_amdgcn_sched_barrier(0);
              a0 -= mr3[0] * X[8]; a1 -= mr3[1] * X[9]; a2 -= mr3[2] * X[10]; a3 -= mr3[3] * X[11];
              mr3 = *(const LAS f32x4*)(Mm + 4320);
              __builtin_amdgcn_sched_barrier(0);
              a0 -= mr4[0] * X[12]; a1 -= mr4[1] * X[13]; a2 -= mr4[2] * X[14]; a3 -= mr4[3] * X[15];
              mr4 = *(const LAS f32x4*)(Mm + 4324);
              __builtin_amdgcn_sched_barrier(0);
              a0 -= mr5[0] * X[16]; a1 -= mr5[1] * X[17]; a2 -= mr5[2] * X[18]; a3 -= mr5[3] * X[19];
              mr5 = *(const LAS f32x4*)(Mm + 4328);
              __builtin_amdgcn_sched_barrier(0);
              a0 -= mr6[0] * X[20]; a1 -= mr6[1] * X[21]; a2 -= mr6[2] * X[22]; a3 -= mr6[3] * X[23];
              mr6 = *(const LAS f32x4*)(Mm + 4332);
              __builtin_amdgcn_sched_barrier(0);
              a0 -= mr0[0] * X[24]; a1 -= mr0[1] * X[25]; a2 -= mr0[2] * X[26]; a3 -= mr0[3] * X[27];
              mr0 = *(const LAS f32x4*)(Mm + 4336);
              __builtin_amdgcn_sched_barrier(0);
              a0 -= mr1[0] * X[28]; a1 -= mr1[1] * X[29]; a2 -= mr1[2] * X[30]; a3 -= mr1[3] * X[31];
              mr1 = *(const LAS f32x4*)(Mm + 4340);
              __builtin_amdgcn_sched_barrier(0);
              a0 -= mr2[0] * X[32]; a1 -= mr2[1] * X[33]; a2 -= mr2[2] * X[34]; a3 -= mr2[3] * X[35];
              mr2 = *(const LAS f32x4*)(Mm + 4344);
              __builtin_amdgcn_sched_barrier(0);
              a0 -= mr3[0] * X[36]; a1 -= mr3[1] * X[37]; a2 -= mr3[2] * X[38]; a3 -= mr3[3] * X[39];
              __builtin_amdgcn_sched_barrier(0);
              a0 -= mr4[0] * X[40]; a1 -= mr4[1] * X[41]; a2 -= mr4[2] * X[42]; a3 -= mr4[3] * X[43];
              __builtin_amdgcn_sched_barrier(0);
              a0 -= mr5[0] * X[44]; a1 -= mr5[1] * X[45]; a2 -= mr5[2] * X[46]; a3 -= mr5[3] * X[47];
              __builtin_amdgcn_sched_barrier(0);
              a0 -= mr6[0] * X[48]; a1 -= mr6[1] * X[49]; a2 -= mr6[2] * X[50]; a3 -= mr6[3] * X[51];
              __builtin_amdgcn_sched_barrier(0);
              a0 -= mr0[0] * X[52]; a1 -= mr0[1] * X[53]; a2 -= mr0[2] * X[54]; a3 -= mr0[3] * X[55];
              __builtin_amdgcn_sched_barrier(0);
              a0 -= mr1[0] * X[56]; a1 -= mr1[1] * X[57]; a2 -= mr1[2] * X[58]; a3 -= mr1[3] * X[59];
              __builtin_amdgcn_sched_barrier(0);
              a0 -= mr2[0] * X[60]; a1 -= mr2[1] * X[61]; a2 -= mr2[2] * X[62];
              X[63] = (a0 + a1) + (a2 + a3); dst[8316] = X[63]; }
            __builtin_amdgcn_sched_barrier(0);
            __builtin_amdgcn_s_setprio(0);
        } else {
            const int t2 = tid - 256; const float glast = gt[64 + 63];
#pragma unroll
            for (int i = 0; i < 4; ++i) { const int task = t2 + 256 * i, d = task & 127, gq = task >> 7, g = gq >> 2, q = gq & 3;
                float v[8];
#pragma unroll
                for (int e = 0; e < 4; ++e) { const int ta = 32 * g + 4 * q + e, tb = ta + 16;
                    v[e] = Kf[ta * 132 + d] * __expf(glast - gt[64 + ta]); v[4 + e] = Kf[tb * 132 + d] * __expf(glast - gt[64 + tb]); }
                v4u o; o.x = pk2(v[0], v[1]); o.y = pk2(v[2], v[3]); o.z = pk2(v[4], v[5]); o.w = pk2(v[6], v[7]);
                *(v4u*)(KDT + ((size_t)unit * 128 + d) * 64 + 32 * g + 8 * q) = o; }
            if (t2 == 0) GL[unit] = expf(glast);
        }
        bar_lds();
#pragma unroll
        for (int i = 0; i < 4; ++i) { const int idx = tid + NT * i, t = idx >> 5, c4 = (idx & 31) * 4;
            *(f32x4*)(U + ((size_t)unit * 64 + t) * 128 + c4) = *(const LAS f32x4*)(Vf + t * 132 + c4); }
#pragma unroll
        for (int i = 0; i < 2; ++i) { const int idx = tid + NT * i, t = idx >> 4, c8 = (idx & 15) * 8;
            const LAS float* wf = (const LAS float*)Qb + t * 132 + (c8 & ~31) + ((c8 & 31) >> 1);
            const f32x4 lo = *(const LAS f32x4*)wf, hi = *(const LAS f32x4*)(wf + 16);
            v4u o; o.x = pk2(lo[0], lo[1]); o.y = pk2(lo[2], lo[3]); o.z = pk2(hi[0], hi[1]); o.w = pk2(hi[2], hi[3]);
            *(v4u*)(WKb + ((size_t)unit * 64 + t) * 128 + c8) = o; }
        bar_lds();
    }
}

DI void phase_mix(const Args& a, int l, LAS unsigned char* lds, int tid, int lane, int wave, int bid, int G) {
    unsigned char* ws = a.ws;
    const bf16* P = (const bf16*)(ws + WS_P);
    bf16* MIX = (bf16*)a.out;
    const int r = lane & 15, q = lane >> 4;
    if (bid < 64) {
        const char* QDc = (const char*)(ws + WS_QD); const char* WKc = (const char*)(ws + WS_WK); const char* KDTc = (const char*)(ws + WS_KDT); const char* ACc = (const char*)(ws + WS_AC);
        const float* U = (const float*)(ws + WS_U); const float* GL = (const float*)(ws + WS_GL);
        const int bh = bid >> 1, h = bh & 3, b = bh >> 2, col = 64 * (bid & 1) + 16 * (wave & 3) + r; const bool act = wave < 4;
        constexpr int SBUF = 73728;
        const float glv = GL[(size_t)bh * 64 + lane];
        const unsigned ldsbase = (unsigned)__builtin_amdgcn_readfirstlane((int)(unsigned)(size_t)lds);
        unsigned o256[2], o128[2], ra[4], rk[2], ou[2];
        const char* Uc = (const char*)U + (bid & 1) * 256;
#pragma unroll
        for (int i = 0; i < 2; ++i) { const int sl = (wave + 8 * i) * 64 + lane;
            { const int row = sl >> 4, kc = (sl & 15) ^ (row & 15); o256[i] = (unsigned)(row * 256 + kc * 16); }
            { const int row = sl >> 3, kc = (sl & 7) ^ ((row >> 1) & 7); o128[i] = (unsigned)(row * 128 + kc * 16); }
            ou[i] = (unsigned)((sl >> 4) * 512 + (sl & 15) * 16); }
#pragma unroll
        for (int ks = 0; ks < 4; ++ks) ra[ks] = (unsigned)(r * 256 + (((4 * ks + q) ^ r) << 4));
#pragma unroll
        for (int ks = 0; ks < 2; ++ks) rk[ks] = (unsigned)(r * 128 + (((4 * ks + q) ^ (r >> 1)) << 4));
#define SC_GLDS(gp, loff) glds16((const void*)(gp), ldsbase + (unsigned)(loff))
#define SC_STAGE(n_, b_) do { const size_t un_ = (size_t)bh * 64 + (n_); const int lb_ = (b_) * SBUF + wave * 1024; \
            SC_GLDS(WKc + un_ * 16384 + o256[0], lb_); SC_GLDS(WKc + un_ * 16384 + o256[1], lb_ + 8192); \
            SC_GLDS(QDc + un_ * 16384 + o256[0], lb_ + 16384); SC_GLDS(QDc + un_ * 16384 + o256[1], lb_ + 16384 + 8192); \
            SC_GLDS(KDTc + un_ * 16384 + o128[0], lb_ + 32768); SC_GLDS(KDTc + un_ * 16384 + o128[1], lb_ + 32768 + 8192); \
            SC_GLDS(ACc + un_ * 8192 + o128[0], lb_ + 49152); \
            SC_GLDS(Uc + un_ * 32768 + ou[0], lb_ + 57344); SC_GLDS(Uc + un_ * 32768 + ou[1], lb_ + 57344 + 8192); } while (0)
        f32x4 S[8];
#pragma unroll
        for (int mt = 0; mt < 8; ++mt) S[mt] = (f32x4){0.f, 0.f, 0.f, 0.f};
        if (act) __builtin_amdgcn_s_setprio(2);
        SC_STAGE(0, 0);
        asm volatile("s_waitcnt vmcnt(0)" ::: "memory"); __syncthreads();
        bf16* Og = (bf16*)(ws + WS_P) + (size_t)b * SEQ * NP + 1024 + h * 128 + col;
        f32x4 ovp[4];
#pragma unroll
        for (int mt = 0; mt < 4; ++mt) ovp[mt] = (f32x4){0.f, 0.f, 0.f, 0.f};
        for (int n = 0; n <= 64; ++n) {
            const int cur = n & 1;
            if (n == 64) break;
            if (n + 1 < 64) SC_STAGE(n + 1, cur ^ 1);
            if (act) {
            const LAS unsigned char* sb = lds + cur * SBUF;
            bf16x8 fa[16], fb[16], fc[8]; float ul[16];
#pragma unroll
            for (int mt = 0; mt < 4; ++mt)
#pragma unroll
                for (int ks = 0; ks < 4; ++ks) fa[mt * 4 + ks] = *(const LAS bf16x8*)(sb + mt * 4096 + ra[ks]);
#pragma unroll
            for (int mt = 0; mt < 4; ++mt)
#pragma unroll
                for (int ks = 0; ks < 4; ++ks) fb[mt * 4 + ks] = *(const LAS bf16x8*)(sb + 16384 + mt * 4096 + ra[ks]);
            bf16x8 Sb[4];
#pragma unroll
            for (int ks = 0; ks < 4; ++ks) Sb[ks] = pack8(S[2 * ks], S[2 * ks + 1]);
            __builtin_amdgcn_sched_barrier(0);
            f32x4 wv[4], ov[4];
#pragma unroll
            for (int mt = 0; mt < 4; ++mt) { f32x4 acc = {0.f, 0.f, 0.f, 0.f};
#pragma unroll
                for (int ks = 0; ks < 4; ++ks) acc = MFMA16(fa[mt * 4 + ks], Sb[ks], acc);
                wv[mt] = acc; }
#pragma unroll
            for (int mt = 0; mt < 4; ++mt) { const LAS float* up = (const LAS float*)(sb + 57344 + (16 * mt + 4 * q) * 256 + (16 * (wave & 3) + r) * 4);
#pragma unroll
                for (int i = 0; i < 4; ++i) ul[mt * 4 + i] = up[i * 64];
#pragma unroll
                for (int ks = 0; ks < 2; ++ks) fc[mt * 2 + ks] = *(const LAS bf16x8*)(sb + 49152 + mt * 2048 + rk[ks]); }
            __builtin_amdgcn_sched_barrier(0);
#pragma unroll
            for (int mt = 0; mt < 4; ++mt) { f32x4 acc = {0.f, 0.f, 0.f, 0.f};
#pragma unroll
                for (int ks = 0; ks < 4; ++ks) acc = MFMA16(fb[mt * 4 + ks], Sb[ks], acc);
                ov[mt] = acc; }
#pragma unroll
            for (int mt = 0; mt < 8; ++mt)
#pragma unroll
                for (int ks = 0; ks < 2; ++ks) fa[mt * 2 + ks] = *(const LAS bf16x8*)(sb + 32768 + mt * 2048 + rk[ks]);
            __builtin_amdgcn_sched_barrier(0);
#pragma unroll
            for (int mt = 0; mt < 4; ++mt)
#pragma unroll
                for (int i = 0; i < 4; ++i) wv[mt][i] = ul[mt * 4 + i] - wv[mt][i];
            bf16x8 Wb[2];
#pragma unroll
            for (int ks = 0; ks < 2; ++ks) Wb[ks] = pack8(wv[2 * ks], wv[2 * ks + 1]);
#pragma unroll
            for (int mt = 0; mt < 4; ++mt)
#pragma unroll
                for (int ks = 0; ks < 2; ++ks) ov[mt] = MFMA16(fc[mt * 2 + ks], Wb[ks], ov[mt]);
            const float gl = __builtin_bit_cast(float, __builtin_amdgcn_readlane(__builtin_bit_cast(int, glv), n));
#pragma unroll
            for (int mt = 0; mt < 8; ++mt) { S[mt] = S[mt] * gl;
#pragma unroll
                for (int ks = 0; ks < 2; ++ks) S[mt] = MFMA16(fa[mt * 2 + ks], Wb[ks], S[mt]); }
            { GAS bf16* og = (GAS bf16*)(Og + (size_t)(n * 64 + 4 * q) * NP);
#pragma unroll
              for (int mt = 0; mt < 4; ++mt)
#pragma unroll
                  for (int i = 0; i < 4; ++i) og[(size_t)(16 * mt + i) * NP] = f2bf(ov[mt][i]); }
            asm volatile("s_waitcnt vmcnt(16) lgkmcnt(0)\n\ts_barrier" ::: "memory");
            } else {
            asm volatile("s_waitcnt vmcnt(0) lgkmcnt(0)\n\ts_barrier" ::: "memory");
            }
        }
__builtin_amdgcn_s_setprio(0);
#undef SC_STAGE
#undef SC_GLDS
    } else {
        const float* lng = a.in[6] + l * 512; const float* lnb = a.in[7] + l * 512;
        const float* sw = a.in[8] + (size_t)l * 4 * 128 * 128; const float* sb = a.in[9] + l * 4 * 128;
        LAS float* stat = (LAS float*)lds;
        LAS bf16* vnT = (LAS bf16*)(lds + 1024);
        for (int unit = bid - 64; unit < 256; unit += G - 64) {
            const int b = unit >> 5, n = unit & 31; const size_t m0 = (size_t)b * SEQ + n * 128;
            { const int row = tid >> 2, part = tid & 3; const bf16* src = P + (m0 + row) * NP + 512 + part * 128;
              float s = 0.f, s2 = 0.f;
#pragma unroll 4
              for (int i = 0; i < 16; ++i) { const v4u x = *(const v4u*)(src + 8 * i);
                  const float g0 = gelu_tanh(bflo(x.x)), g1 = gelu_tanh(bfhi(x.x)), g2 = gelu_tanh(bflo(x.y)), g3 = gelu_tanh(bfhi(x.y)),
                              g4 = gelu_tanh(bflo(x.z)), g5 = gelu_tanh(bfhi(x.z)), g6 = gelu_tanh(bflo(x.w)), g7 = gelu_tanh(bfhi(x.w));
                  s += ((g0 + g1) + (g2 + g3)) + ((g4 + g5) + (g6 + g7));
                  s2 += ((g0 * g0 + g1 * g1) + (g2 * g2 + g3 * g3)) + ((g4 * g4 + g5 * g5) + (g6 * g6 + g7 * g7)); }
              s += __shfl_xor(s, 1); s += __shfl_xor(s, 2); s2 += __shfl_xor(s2, 1); s2 += __shfl_xor(s2, 2);
              const float mean = s * (1.f / 512.f), var = fmaxf(s2 * (1.f / 512.f) - mean * mean, 0.f);
              if (part == 0) { stat[2 * row] = mean; stat[2 * row + 1] = rsqrtf(var + 1e-5f); } }
            bar_lds();
            for (int h = 0; h < 4; ++h) {
                LAS bf16* vt = vnT + (h & 1) * (128 * 136);
                const float* Wm = sw + ((size_t)h * 128 + 16 * wave + r) * 128;
                f32x4 wq[4][2];
#pragma unroll
                for (int ks = 0; ks < 4; ++ks) { wq[ks][0] = *(const f32x4*)(Wm + 32 * ks + 8 * q); wq[ks][1] = *(const f32x4*)(Wm + 32 * ks + 8 * q + 4); }
                bf16 uq[4][8];
#pragma unroll
                for (int i = 0; i < 4; ++i)
#pragma unroll
                    for (int nt = 0; nt < 8; ++nt) uq[i][nt] = P[(m0 + 16 * wave + 4 * q + i) * NP + h * 128 + 16 * nt + r];
#pragma unroll
                for (int i = 0; i < 4; ++i) { const int task = tid + NT * i, s = task & 127, dg = task >> 7;
                    const v4u x = *(const v4u*)(P + (m0 + s) * NP + 512 + h * 128 + dg * 8);
                    const float mean = stat[2 * s], rstd = stat[2 * s + 1];
                    const f32x4 g0 = *(const f32x4*)(lng + h * 128 + dg * 8), g1 = *(const f32x4*)(lng + h * 128 + dg * 8 + 4);
                    const f32x4 b0 = *(const f32x4*)(lnb + h * 128 + dg * 8), b1 = *(const f32x4*)(lnb + h * 128 + dg * 8 + 4);
                    const float xv[8] = {bflo(x.x), bfhi(x.x), bflo(x.y), bfhi(x.y), bflo(x.z), bfhi(x.z), bflo(x.w), bfhi(x.w)};
#pragma unroll
                    for (int e = 0; e < 8; ++e) { const float gg = e < 4 ? g0[e & 3] : g1[e & 3], bb = e < 4 ? b0[e & 3] : b1[e & 3];
                        vt[(dg * 8 + e) * 136 + s] = f2bf((gelu_tanh(xv[e]) - mean) * rstd * gg + bb); } }
                bar_lds();
                f32x4 acc[8];
#pragma unroll
                for (int nt = 0; nt < 8; ++nt) acc[nt] = (f32x4){0.f, 0.f, 0.f, 0.f};
                const int tA = 16 * wave + r;
#pragma unroll
                for (int ks = 0; ks < 4; ++ks) { if (ks > (wave >> 1)) break;
                    const int s0 = 32 * ks + 8 * q;
                    f32x4 w0 = wq[ks][0], w1 = wq[ks][1];
#pragma unroll
                    for (int e = 0; e < 4; ++e) { if (s0 + e > tA) w0[e] = 0.f; if (s0 + 4 + e > tA) w1[e] = 0.f; }
                    const bf16x8 af = pack8(w0, w1);
#pragma unroll
                    for (int nt = 0; nt < 8; ++nt) acc[nt] = MFMA16(af, *(const LAS bf16x8*)(vt + (16 * nt + r) * 136 + s0), acc[nt]);
                }
#pragma unroll
                for (int i = 0; i < 4; ++i) { const int t = 16 * wave + 4 * q + i; const float bs = sb[h * 128 + t];
#pragma unroll
                    for (int nt = 0; nt < 8; ++nt) { const int d = 16 * nt + r;
                        const float uu = bf2f(uq[i][nt]);
                        MIX[(m0 + t) * D + h * 128 + d] = f2bf(gelu_tanh(uu) * (acc[nt][i] + bs)); } }
            }
            bar_lds();
        }
        if (l + 1 < DEPTH && bid >= 128) convert_weights(a, l + 1, lds + 73728, wave, lane, (bid - 128) * NWAVES + wave, (G - 128) * NWAVES);
    }
}

DI void phase_gnorm(const Args& a, int l, int tid, int lane, int wave, int bid, int G) {
    const bf16* P = (const bf16*)(a.ws + WS_P); bf16* MIX = (bf16*)a.out;
    const float* ngp = a.in[13] + l * 128 + (lane & 15) * 8;
    const f32x4 g0 = *(const f32x4*)ngp, g1 = *(const f32x4*)(ngp + 4);
    for (int m = bid * NWAVES + wave; m < M; m += G * NWAVES) {
        const v4u ob = *(const v4u*)(P + (size_t)m * NP + 1024 + lane * 8), zb = *(const v4u*)(P + (size_t)m * NP + 2560 + lane * 8);
        f32x4 o0 = {bflo(ob.x), bfhi(ob.x), bflo(ob.y), bfhi(ob.y)}, o1 = {bflo(ob.z), bfhi(ob.z), bflo(ob.w), bfhi(ob.w)};
        const f32x4 z0 = {bflo(zb.x), bfhi(zb.x), bflo(zb.y), bfhi(zb.y)}, z1 = {bflo(zb.z), bfhi(zb.z), bflo(zb.w), bfhi(zb.w)};
        float ss = ((o0[0] * o0[0] + o0[1] * o0[1]) + (o0[2] * o0[2] + o0[3] * o0[3])) + ((o1[0] * o1[0] + o1[1] * o1[1]) + (o1[2] * o1[2] + o1[3] * o1[3]));
        ss = row16_sum(ss);
        const float rstd = rsqrtf(ss * (1.f / 128.f) + 1e-6f);
        o0 = o0 * rstd * g0; o1 = o1 * rstd * g1;
        v4u w; w.x = pk2(o0[0] * silu_f(z0[0]), o0[1] * silu_f(z0[1])); w.y = pk2(o0[2] * silu_f(z0[2]), o0[3] * silu_f(z0[3]));
        w.z = pk2(o1[0] * silu_f(z1[0]), o1[1] * silu_f(z1[1])); w.w = pk2(o1[2] * silu_f(z1[2]), o1[3] * silu_f(z1[3]));
        *(v4u*)(MIX + (size_t)m * D + 512 + lane * 8) = w;
    }
}

#define XB_TMO      128
#define XB_XCNT(j)  (256  + 64 * (j))
#define XB_XSUB(j)  (1280 + 64 * (j))
#define XB_XGEN(j)  (2304 + 64 * (j))
#define XB_TOP      3328
#define XB_TOPGEN   3392
#define XCD_BAR_WORDS 3456
#define XB_SPIN_CAP (1u << 18)

__device__ __forceinline__ unsigned xb_ld(unsigned* p)              { return __hip_atomic_load(p, __ATOMIC_RELAXED, __HIP_MEMORY_SCOPE_AGENT); }
__device__ __forceinline__ unsigned xb_add(unsigned* p, unsigned v) { return __hip_atomic_fetch_add(p, v, __ATOMIC_RELAXED, __HIP_MEMORY_SCOPE_AGENT); }
__device__ __forceinline__ unsigned xb_xcc_id() { return (unsigned)__builtin_amdgcn_s_getreg((3 << 11) | 20) & 0xFu; }
#define XB_SPIN(cond, bar) do { unsigned _sp = 0; while (cond) { __builtin_amdgcn_s_sleep(1); \
    if ((++_sp & 255u) == 0u) { if (xb_ld(&(bar)[XB_TMO])) break; if (_sp > XB_SPIN_CAP) { atomicAdd(&(bar)[XB_TMO], 1u); break; } } } } while (0)

struct XcdBarrier {
    unsigned* bar; unsigned x;
    volatile LAS unsigned* st;
};

__device__ __forceinline__ XcdBarrier xcd_barrier_post(unsigned* bar, volatile LAS unsigned* st) {
    XcdBarrier b; b.bar = bar; b.x = xb_xcc_id(); b.st = st;
    if (threadIdx.x == 0) (void)xb_add(&bar[XB_XCNT(b.x)], 1u);
    return b;
}
__device__ __forceinline__ void xcd_barrier_complete(unsigned* bar, unsigned x, unsigned& nloc, unsigned& nx) {
    const unsigned G = gridDim.x * gridDim.y * gridDim.z;
    unsigned sum, cnt, mine, sp = 0u;
    for (;;) {
        sum = 0u; cnt = 0u; mine = 0u;
#pragma unroll
        for (unsigned j = 0; j < 16; ++j) { const unsigned c = xb_ld(&bar[XB_XCNT(j)]); sum += c; cnt += (c > 0u) ? 1u : 0u; mine = (j == x) ? c : mine; }
        if (sum == G) break;
        __builtin_amdgcn_s_sleep(1);
        if ((++sp & 255u) == 0u) { if (xb_ld(&bar[XB_TMO])) break; if (sp > XB_SPIN_CAP) { atomicAdd(&bar[XB_TMO], 1u); break; } }
    }
    nloc = mine > 0u ? mine : 1u; nx = cnt > 0u ? cnt : 1u;
}

__device__ __forceinline__ void xcd_barrier(const XcdBarrier& b) {
    asm volatile("s_waitcnt vmcnt(0)" ::: "memory");
    __syncthreads();
    if (threadIdx.x == 0) {
        unsigned* bar = b.bar;
        __builtin_amdgcn_s_waitcnt(0);
        unsigned nloc = b.st[0], nx = b.st[1];
        if (nloc == 0u) { xcd_barrier_complete(bar, b.x, nloc, nx); b.st[0] = nloc; b.st[1] = nx; }
        const unsigned old = xb_add(&bar[XB_XSUB(b.x)], 1u);
        const unsigned gen = old / nloc;
        if (old + 1u == (gen + 1u) * nloc) {
            __builtin_amdgcn_fence(__ATOMIC_RELEASE, "agent");
            asm volatile("s_waitcnt vmcnt(0)" ::: "memory");
            const unsigned og = xb_add(&bar[XB_TOP], 1u);
            const unsigned tg = og / nx;
            if (og + 1u == (tg + 1u) * nx) xb_add(&bar[XB_TOPGEN], 1u);
            else XB_SPIN(xb_ld(&bar[XB_TOPGEN]) == tg, bar);
            __builtin_amdgcn_fence(__ATOMIC_ACQUIRE, "agent");
            xb_add(&bar[XB_XGEN(b.x)], 1u);
            asm volatile("s_waitcnt vmcnt(0)" ::: "memory");
        } else {
            XB_SPIN(xb_ld(&bar[XB_XGEN(b.x)]) == gen, bar);
            __builtin_amdgcn_fence(__ATOMIC_ACQUIRE, "agent");
            asm volatile("s_waitcnt vmcnt(0)" ::: "memory");
        }
    }
    __syncthreads();
}

__global__ void __launch_bounds__(NT, 2) mk_fwd(Args a_in) {
    extern __shared__ __attribute__((aligned(16))) unsigned char lds_raw[];
    LAS unsigned char* lds = (LAS unsigned char*)lds_raw;
    cg::grid_group grid = cg::this_grid();
    volatile LAS unsigned* bst = (volatile LAS unsigned*)(lds + LDS_BYTES - 64);
    if (threadIdx.x < 2) bst[threadIdx.x] = 0u;
    __syncthreads();
    XcdBarrier xbar = xcd_barrier_post((unsigned*)(a_in.ws + WS_CTL), bst);
    int rep = 0;
    for (int ph = a_in.ph_lo; ph < a_in.ph_hi; ) {
        int tid = threadIdx.x; asm volatile("" : "+v"(tid));
        const int lane = tid & 63, wave = __builtin_amdgcn_readfirstlane(tid >> 6);
        int bid = blockIdx.x, G = gridDim.x; asm volatile("" : "+s"(bid)); asm volatile("" : "+s"(G));
        Args a = a_in; asm volatile("" : "+s"(a.ws)); asm volatile("" : "+s"(a.out));
        unsigned char* ws = a.ws;
        const float* mod = (const float*)(ws + WS_MOD);
        if (ph == 0) { if (PH_EN(8)) { phase_mod(a, lds, tid, lane, wave, bid, G); convert_weights(a, 0, lds + 49152, wave, lane, bid * NWAVES + wave, G * NWAVES); } }
        else if (ph == NPHASE - 1) { if (PH_EN(9)) phase_norm<2>(a, 0, lds, tid, lane, wave, bid, G); }
        else {
            const int l = (ph - 1) / 9, s0 = (ph - 1) % 9, s = s0 <= 3 ? s0 : s0 - 1;
            if (s0 == 4) { if (PH_EN(10)) phase_gnorm(a, l, tid, lane, wave, bid, G); }
            else if (s == 0) { if (PH_EN(0)) phase_norm<0>(a, l, lds, tid, lane, wave, bid, G); }
            else if (s == 1) { if (PH_EN(1)) {
                pg8::Gemm g{(const bf16*)(ws + WS_H), (const bf16*)(ws + ws_wset(l)), M, NP, D}; pg8::StaticOrder S; S.init(M, NP, G, bid);
                pg8::EpiBf16<0> E{(bf16*)(ws + WS_P), NP, nullptr, 0, 0, 1.f};
                pg8::gemm_phase<pg8::EpiBf16<0>, pg8::StaticOrder, true, true>(lds, g, S, E, tid);
            } }
            else if (s == 2) { if (PH_EN(2)) phase_prep(a, l, lds, tid, lane, wave, bid, G); }
            else if (s == 3) { if (PH_EN(3) && rep < (bid < 64 ? REP_SCAN : REP_SGU)) phase_mix(a, l, lds, tid, lane, wave, bid, G); }
            else if (s == 4) { if (PH_EN(4)) {
                pg8::Gemm g{(const bf16*)a.out, (const bf16*)(ws + ws_wset(l) + W_OFF_OUT), M, D, D}; pg8::StaticOrder S; S.init(M, D, G, bid);
                if (l == 0) { pg8::EpiGateRes<true> E{(const void*)a.in[0], (bf16*)(ws + WS_X), D, mod + 2048};
                    pg8::gemm_phase<pg8::EpiGateRes<true>, pg8::StaticOrder, true, true>(lds, g, S, E, tid); }
                else { pg8::EpiGateRes<false> E{(const void*)(ws + WS_X), (bf16*)(ws + WS_X), D, mod + (size_t)l * 8 * NMOD + 2048};
                    pg8::gemm_phase<pg8::EpiGateRes<false>, pg8::StaticOrder, true, true>(lds, g, S, E, tid); }
            } }
            else if (s == 5) { if (PH_EN(5)) phase_norm<1>(a, l, lds, tid, lane, wave, bid, G); }
            else if (s == 6) { if (PH_EN(6)) {
                pg8::Gemm g{(const bf16*)(ws + WS_H), (const bf16*)(ws + ws_wset(l) + W_OFF_1), M, FF, D}; pg8::StaticOrder S; S.init(M, FF, G, bid);
                pg8::EpiBf16<2> E{(bf16*)(ws + WS_F), FF, nullptr, 0, 0, 1.f};
                pg8::gemm_phase<pg8::EpiBf16<2>, pg8::StaticOrder, true, true>(lds, g, S, E, tid);
            } }
            else { if (PH_EN(7)) {
                pg8::Gemm g{(const bf16*)(ws + WS_F), (const bf16*)(ws + ws_wset(l) + W_OFF_2), M, D, FF}; pg8::StaticOrder S; S.init(M, D, G, bid);
                pg8::EpiGateRes<false> E{(const void*)(ws + WS_X), (bf16*)(ws + WS_X), D, mod + (size_t)l * 8 * NMOD + 5120};
                pg8::gemm_phase<pg8::EpiGateRes<false>, pg8::StaticOrder, true, true>(lds, g, S, E, tid);
            } }
        }
        { const int s9 = (ph - 1) % 9; const int sx = (ph == 0) ? 8 : (ph == NPHASE - 1) ? 9 : s9 == 4 ? 10 : s9 < 4 ? s9 : s9 - 1;
          const int reps = sx == 8 ? REP_MOD : sx == 0 ? REP_N0 : sx == 1 ? REP_G1 : sx == 2 ? REP_PREP : sx == 3 ? (REP_SCAN > REP_SGU ? REP_SCAN : REP_SGU) : sx == 5 ? REP_N1 : sx == 6 ? REP_FF1 : 1;
          const bool again = rep + 1 < reps;
          if (again || ph + 1 < a_in.ph_hi) { if (a_in.ph_lo < 0) grid.sync();   xcd_barrier(xbar); for (int i = 0; i < REP_SYNC; ++i) xcd_barrier(xbar); }
          if (again) ++rep; else { rep = 0; ++ph; } }
    }
}

extern "C" void kernel_launch(void* const* d_in, const int* in_sizes, int n_in, void* d_out, int out_size, void* d_ws, size_t ws_size, hipStream_t stream) {
    static int grid = 0;
    if (grid == 0) {
        if (n_in != 19 || in_sizes[0] != M * D || out_size != M * D || ws_size < WS_END) {
            fprintf(stderr, "kernel_launch: unexpected problem: n_in %d in0 %d out %d ws %zu (need %zu)\n", n_in, n_in > 0 ? in_sizes[0] : -1, out_size, ws_size, (size_t)WS_END); grid = -1; return; }
        int dev = 0, cus = 0, per_cu = 0;
        if (hipGetDevice(&dev) != hipSuccess || hipDeviceGetAttribute(&cus, hipDeviceAttributeMultiprocessorCount, dev) != hipSuccess) { fprintf(stderr, "kernel_launch: device query failed\n"); grid = -1; return; }
        if (hipFuncSetAttribute((const void*)mk_fwd, hipFuncAttributeMaxDynamicSharedMemorySize, LDS_BYTES) != hipSuccess) { fprintf(stderr, "kernel_launch: hipFuncSetAttribute failed\n"); grid = -1; return; }
        if (hipOccupancyMaxActiveBlocksPerMultiprocessor(&per_cu, (const void*)mk_fwd, NT, LDS_BYTES) != hipSuccess || per_cu < 1) { fprintf(stderr, "kernel_launch: occupancy query gives %d\n", per_cu); per_cu = 1; }
        (void)hipGetLastError();
        grid = cus * per_cu;
        if (grid > 256) grid = 256;
        if (grid < 64) { fprintf(stderr, "kernel_launch: grid %d too small\n", grid); grid = -1; return; }
    }
    if (grid < 0) return;
    if (hipMemsetAsync((char*)d_ws + WS_CTL, 0, 16384, stream) != hipSuccess) { fprintf(stderr, "kernel_launch: memset of the barrier words failed\n"); return; }
    Args a{};
    for (int i = 0; i < 19; ++i) a.in[i] = (const float*)d_in[i];
    a.out = (float*)d_out; a.ws = (unsigned char*)d_ws;
#if MK_LAUNCHES == 1
    a.ph_lo = 0; a.ph_hi = NPHASE;
    { void* args[] = {&a};
      hipError_t e = hipLaunchCooperativeKernel((const void*)mk_fwd, dim3(grid), dim3(NT), args, LDS_BYTES, stream);
      if (e != hipSuccess) fprintf(stderr, "kernel_launch: cooperative launch failed: %s (grid %d)\n", hipGetErrorString(e), grid); }
#else
    for (int ph = 0; ph < NPHASE; ++ph) {
        a.ph_lo = ph; a.ph_hi = ph + 1;
        void* args[] = {&a};
        hipError_t e = hipLaunchCooperativeKernel((const void*)mk_fwd, dim3(grid), dim3(NT), args, LDS_BYTES, stream);
        if (e != hipSuccess) { fprintf(stderr, "kernel_launch: launch of phase %d failed: %s (grid %d)\n", ph, hipGetErrorString(e), grid); break; }
    }
#endif
}
```

```cpp
#include <hip/hip_runtime.h>
#include <hip/hip_cooperative_groups.h>
#include <cstdio>
#include <cstdint>
namespace cg = cooperative_groups;
namespace pg8 {
#define PG8_LAS __attribute__((address_space(3)))
typedef unsigned short bf16_t;
typedef short bf16x8 __attribute__((ext_vector_type(8)));
typedef float f32x4 __attribute__((ext_vector_type(4)));
typedef unsigned u32x4 __attribute__((ext_vector_type(4)));
constexpr int BM = 256, BK = 64, HALF = 128, HTB = HALF * BK * 2  , STAGE_BYTES = 8 * HTB, NXCD = 8, WGM = 8;

__host__ __device__ __forceinline__ int lds_byte(int r, int c) { const int st = (r >> 4) * 2 + (c >> 5), rr = r & 15, cc = c & 31, ob = rr * 64 + cc * 2; return st * 1024 + (ob ^ (((ob >> 9) & 1) << 5)); }
__host__ __device__ __forceinline__ void stage_rc(int b, int& R, int& C) { const int st = b / 1024, sb = b % 1024, swz = sb ^ (((sb >> 9) & 1) << 5); R = (st >> 1) * 16 + swz / 64; C = (st & 1) * 32 + (swz % 64) / 2; }
__host__ __device__ __forceinline__ int perm32(int rho) { const int n = rho >> 4, i = rho & 15; return 8 * (i >> 2) + 4 * n + (i & 3); }

struct Unit { int pm, pn; };
struct Gemm { const bf16_t* A; const bf16_t* Bt; int M, N, K; };

struct StaticOrder {
    int nM, nN, nwg, G, c;
    __host__ __device__ void init(int M, int N, int G_, int c_) { nM = M / BM; nN = N / BM; nwg = nM * nN; G = G_; c = c_; }
    __host__ __device__ bool next(int i, Unit& u) const {
        const long L = (long)i * G + c; if (L >= nwg) return false;
        int wgid = (int)L; { const int q = nwg / NXCD, r = nwg % NXCD, xcd = wgid % NXCD, off = wgid / NXCD; wgid = (xcd < r ? xcd * (q + 1) : r * (q + 1) + (xcd - r) * q) + off; }
        const int nig = WGM * nN, gid = wgid / nig, fm = gid * WGM, gsz = (nM - fm) < WGM ? (nM - fm) : WGM;
        u.pm = fm + ((wgid % nig) % gsz); u.pn = (wgid % nig) / gsz; return true;
    }
    __device__ __forceinline__ void a_ready(const Unit&) const {}
    __device__ __forceinline__ void done(const Unit&) const {}
};

__device__ __forceinline__ unsigned cvt_pk_bf16(float lo, float hi) { unsigned r; asm volatile("v_cvt_pk_bf16_f32 %0, %1, %2" : "=v"(r) : "v"(lo), "v"(hi)); return r; }
typedef float f32x2 __attribute__((ext_vector_type(2)));
__device__ __forceinline__ f32x2 gelu_pk(f32x2 v) {
    const f32x2 av = __builtin_elementwise_abs(v), d = av * 0.2316418882f + 1.0f;
    f32x2 t; t.x = __builtin_amdgcn_rcpf(d.x); t.y = __builtin_amdgcn_rcpf(d.y);
    f32x2 q = t * 0.5307027145f + (-0.7265760135f); q = q * t + 0.7107068705f; q = q * t + (-0.142248368f); q = q * t + 0.127414796f; q = q * t;
    const f32x2 s = (v * v) * (-0.72134752044f);
    f32x2 e; e.x = __builtin_amdgcn_exp2f(s.x); e.y = __builtin_amdgcn_exp2f(s.y);
    const f32x2 m = v * (q * e), r = v - m;
    f32x2 o; o.x = v.x < 0.f ? m.x : r.x; o.y = v.y < 0.f ? m.y : r.y; return o;
}

template <int ACT  > struct EpiBf16 {
    static constexpr bool PERM = true, AFTER_DRAIN = false; static_assert(ACT == 0 || ACT == 1 || ACT == 2, "EpiBf16: ACT is 0 (none), 1 (gelu_pk) or 2 (squared relu)");
    bf16_t* O; int ldc; const float* bias; int split_cols; size_t split_stride; float scale0;
    __device__ __forceinline__ void operator()(const f32x4 (&acc)[2][2][4][2], const Unit& u, int wr, int wc, int fr, int fq) const {
        const int row0 = u.pm * BM + wr * 64 + fr; int colt = u.pn * BM; bf16_t* base = O;
        float sc = 1.f; if (split_cols) { const int t = colt / split_cols; base += (size_t)t * split_stride; colt -= t * split_cols; if (t == 0) sc = scale0; }
        const int col0 = colt + wc * 32 + 8 * fq, bcol0 = u.pn * BM + wc * 32 + 8 * fq;
        f32x4 bv[2][2];
#pragma unroll
        for (int bj = 0; bj < 2; ++bj)
#pragma unroll
            for (int n = 0; n < 2; ++n) bv[bj][n] = bias ? *(const f32x4*)(bias + bcol0 + bj * HALF + 4 * n) : (f32x4){0.f, 0.f, 0.f, 0.f};
#pragma unroll
        for (int ai = 0; ai < 2; ++ai)
#pragma unroll
            for (int m = 0; m < 4; ++m) { bf16_t* rowp = base + (size_t)(row0 + ai * HALF + m * 16) * ldc + col0;
#pragma unroll
                for (int bj = 0; bj < 2; ++bj) { f32x4 v0 = acc[ai][bj][m][0] + bv[bj][0], v1 = acc[ai][bj][m][1] + bv[bj][1];
                    if (ACT == 1) { f32x2 a = gelu_pk((f32x2){v0[0], v0[1]}), b = gelu_pk((f32x2){v0[2], v0[3]}), c = gelu_pk((f32x2){v1[0], v1[1]}), d = gelu_pk((f32x2){v1[2], v1[3]});
                        v0 = (f32x4){a.x, a.y, b.x, b.y}; v1 = (f32x4){c.x, c.y, d.x, d.y}; }
                    if (ACT == 2) { v0 = __builtin_elementwise_max(v0, (f32x4){0.f, 0.f, 0.f, 0.f}); v1 = __builtin_elementwise_max(v1, (f32x4){0.f, 0.f, 0.f, 0.f}); v0 = v0 * v0; v1 = v1 * v1; }
                    v0 = v0 * sc; v1 = v1 * sc; u32x4 w; w.x = cvt_pk_bf16(v0[0], v0[1]); w.y = cvt_pk_bf16(v0[2], v0[3]); w.z = cvt_pk_bf16(v1[0], v1[1]); w.w = cvt_pk_bf16(v1[2], v1[3]);
                    if (ACT == 2) __builtin_nontemporal_store(w, (u32x4*)(rowp + bj * HALF));
                    else *(u32x4*)(rowp + bj * HALF) = w; } }
    }
};
template <bool BASE_F32> struct EpiGateRes {
    static constexpr bool PERM = true, AFTER_DRAIN = false;
    const void* base; bf16_t* out; int ldc; const float* gate;
    __device__ __forceinline__ void operator()(const f32x4 (&acc)[2][2][4][2], const Unit& u, int wr, int wc, int fr, int fq) const {
        const int col0 = u.pn * BM + wc * 32 + 8 * fq;
        const float* gp = gate + (size_t)(u.pm >> 4) * 6144 + col0;
        f32x4 gv[2][2];
#pragma unroll
        for (int bj = 0; bj < 2; ++bj)
#pragma unroll
            for (int n = 0; n < 2; ++n) gv[bj][n] = *(const f32x4*)(gp + bj * HALF + 4 * n);
#pragma unroll
        for (int ai = 0; ai < 2; ++ai)
#pragma unroll
            for (int m = 0; m < 4; ++m) { const size_t off = (size_t)(u.pm * BM + ai * HALF + wr * 64 + m * 16 + fr) * ldc + col0;
#pragma unroll
                for (int bj = 0; bj < 2; ++bj) { f32x4 b0, b1;
                    if (BASE_F32) { const float* bp = (const float*)base + off + bj * HALF; b0 = *(const f32x4*)bp; b1 = *(const f32x4*)(bp + 4); }
                    else { const u32x4 w = *(const u32x4*)((const bf16_t*)base + off + bj * HALF);
                        b0 = (f32x4){__uint_as_float(w.x << 16), __uint_as_float(w.x & 0xffff0000u), __uint_as_float(w.y << 16), __uint_as_float(w.y & 0xffff0000u)};
                        b1 = (f32x4){__uint_as_float(w.z << 16), __uint_as_float(w.z & 0xffff0000u), __uint_as_float(w.w << 16), __uint_as_float(w.w & 0xffff0000u)}; }
                    const f32x4 v0 = b0 + gv[bj][0] * acc[ai][bj][m][0], v1 = b1 + gv[bj][1] * acc[ai][bj][m][1];
                    u32x4 o; o.x = cvt_pk_bf16(v0[0], v0[1]); o.y = cvt_pk_bf16(v0[2], v0[3]); o.z = cvt_pk_bf16(v1[0], v1[1]); o.w = cvt_pk_bf16(v1[2], v1[3]);
                    *(u32x4*)(out + off + bj * HALF) = o; }
                if (m & 1) asm volatile("" ::: "memory"); }
    }
};
template <class Epi, class Sched, bool ALIGN_EPI = false, bool SP2 = false>
__device__ __forceinline__ void gemm_phase(PG8_LAS unsigned char* lds, const Gemm g, const Sched& S, const Epi& E, const int tid) {
    const int wid = __builtin_amdgcn_readfirstlane(tid >> 6), lane = tid & 63, wr = wid >> 2, wc = wid & 3, fr = lane & 15, fq = lane >> 4;
    const int K = g.K, nt = K / BK;
    unsigned voffA[2], voffB[2];
#pragma unroll
    for (int i = 0; i < 2; ++i) { int R, C; stage_rc(tid * 16 + i * 8192, R, C); const int Rb = Epi::PERM ? ((R & ~31) + perm32(R & 31)) : R;
        voffA[i] = (unsigned)(R * K + C) * 2u; voffB[i] = (unsigned)(Rb * K + C) * 2u; }
    const size_t kstep = (size_t)(BK * 2);
    const size_t hstep = (size_t)HALF * K * 2;
    const size_t tstep = 2 * hstep;
    const unsigned ldsw = (unsigned)wid * 1024u;
    const int aoff = lds_byte(wr * 64 + fr, fq * 8), boff = lds_byte(wc * 32 + fr, fq * 8);
#define PG8_SA(b, h) (((b) * 2 + (h)) * HTB)
#define PG8_SB(b, h) ((4 + (b) * 2 + (h)) * HTB)
#define PG8_STAGE(bufoff, gbase, voff) do { _Pragma("unroll") for (int _i = 0; _i < 2; ++_i) \
        __builtin_amdgcn_global_load_lds((const unsigned*)((const char*)(gbase) + (voff)[_i]), (PG8_LAS unsigned*)(lds + (bufoff) + ldsw + _i * 8192), 16, 0, 0); } while (0)
#define PG8_LDA(dst, b, h) do { _Pragma("unroll") for (int m = 0; m < 4; ++m) _Pragma("unroll") for (int k = 0; k < 2; ++k) dst[m][k] = *(const PG8_LAS bf16x8*)(lds + PG8_SA(b, h) + aoff + m * 2048 + k * 1024); } while (0)
#define PG8_LDB(dst, b, h) do { _Pragma("unroll") for (int n = 0; n < 2; ++n) _Pragma("unroll") for (int k = 0; k < 2; ++k) dst[n][k] = *(const PG8_LAS bf16x8*)(lds + PG8_SB(b, h) + boff + n * 2048 + k * 1024); } while (0)
#define PG8_MMA(ai, bj, At, Bt) do { __builtin_amdgcn_s_setprio(1); _Pragma("unroll") for (int m = 0; m < 4; ++m) _Pragma("unroll") for (int n = 0; n < 2; ++n) _Pragma("unroll") for (int k = 0; k < 2; ++k) \
        acc[ai][bj][m][n] = __builtin_amdgcn_mfma_f32_16x16x32_bf16(Bt[n][k], At[m][k], acc[ai][bj][m][n], 0, 0, 0); __builtin_amdgcn_s_setprio(0); } while (0)
#define PG8_WAIT_V(n) asm volatile("s_waitcnt vmcnt(" #n ")" ::: "memory")
#define PG8_WAIT_L(n) asm volatile("s_waitcnt lgkmcnt(" #n ")" ::: "memory")
#define PG8_BAR __builtin_amdgcn_s_barrier()
#define PG8_SCHED __builtin_amdgcn_sched_barrier(0)
    Unit cur, nxt; int ui = 0;
    if (!S.next(0, cur)) return;
    f32x4 acc[2][2][4][2];
#pragma unroll
    for (int a = 0; a < 2; ++a)
#pragma unroll
        for (int b = 0; b < 2; ++b)
#pragma unroll
            for (int m = 0; m < 4; ++m)
#pragma unroll
                for (int n = 0; n < 2; ++n) acc[a][b][m][n] = (f32x4){0.f, 0.f, 0.f, 0.f};
    bf16x8 At[4][2], B0[2][2], B1[2][2];
    const char* cA = (const char*)g.A + (size_t)cur.pm * tstep; const char* cB = (const char*)g.Bt + (size_t)cur.pn * tstep;
    S.a_ready(cur);
    if constexpr (SP2) {
        PG8_STAGE(PG8_SB(0, 0), cB, voffB); PG8_STAGE(PG8_SB(0, 1), cB + hstep, voffB); PG8_STAGE(PG8_SA(0, 0), cA, voffA); PG8_STAGE(PG8_SA(0, 1), cA + hstep, voffA);
        if (wr == 1) PG8_BAR;
        PG8_WAIT_V(2); PG8_BAR;
        PG8_STAGE(PG8_SB(1, 0), cB + kstep, voffB); PG8_STAGE(PG8_SA(1, 0), cA + kstep, voffA); PG8_STAGE(PG8_SB(1, 1), cB + hstep + kstep, voffB);
        PG8_WAIT_V(6); PG8_BAR;
    } else {
        PG8_STAGE(PG8_SB(0, 0), cB, voffB); PG8_STAGE(PG8_SA(0, 0), cA, voffA); PG8_STAGE(PG8_SB(0, 1), cB + hstep, voffB); PG8_STAGE(PG8_SA(0, 1), cA + hstep, voffA);
        if (wr == 1) PG8_BAR;
        PG8_WAIT_V(4); PG8_BAR;
        PG8_STAGE(PG8_SB(1, 0), cB + kstep, voffB); PG8_STAGE(PG8_SA(1, 0), cA + kstep, voffA); PG8_STAGE(PG8_SB(1, 1), cB + hstep + kstep, voffB);
        PG8_WAIT_V(6); PG8_BAR;
    }
    for (;;) {
        const bool has_next = S.next(ui + 1, nxt);
        const char* nA = has_next ? (const char*)g.A + (size_t)nxt.pm * tstep : cA; const char* nB = has_next ? (const char*)g.Bt + (size_t)nxt.pn * tstep : cB;
        for (int t = 0; t < nt; t += 2) {
            const bool last = (t == nt - 2);
            const char* a1 = cA + (size_t)(t + 1) * kstep;
            const char* a2 = last ? nA : cA + (size_t)(t + 2) * kstep; const char* b2 = last ? nB : cB + (size_t)(t + 2) * kstep;
            const char* a3 = a2 + kstep; const char* b3 = b2 + kstep;
            if (last && has_next) S.a_ready(nxt);
            if constexpr (SP2) {
            PG8_LDB(B0, 0, 0); PG8_LDB(B1, 0, 1); PG8_SCHED; PG8_LDA(At, 0, 0); PG8_STAGE(PG8_SA(1, 1), a1 + hstep, voffA);
            PG8_WAIT_V(8); PG8_WAIT_L(0); PG8_BAR; PG8_MMA(0, 0, At, B0); PG8_MMA(0, 1, At, B1); PG8_BAR; PG8_SCHED;
            PG8_LDA(At, 0, 1); PG8_STAGE(PG8_SB(0, 0), b2, voffB); PG8_STAGE(PG8_SB(0, 1), b2 + hstep, voffB); PG8_STAGE(PG8_SA(0, 0), a2, voffA);
            PG8_WAIT_V(8); PG8_WAIT_L(0); PG8_BAR; PG8_MMA(1, 0, At, B0); PG8_MMA(1, 1, At, B1); PG8_BAR; PG8_SCHED;
            PG8_LDB(B0, 1, 0); PG8_LDB(B1, 1, 1); PG8_SCHED; PG8_LDA(At, 1, 0); PG8_STAGE(PG8_SA(0, 1), a2 + hstep, voffA);
            PG8_WAIT_V(8); PG8_WAIT_L(0); PG8_BAR; PG8_MMA(0, 0, At, B0); PG8_MMA(0, 1, At, B1); PG8_BAR; PG8_SCHED;
            PG8_LDA(At, 1, 1); PG8_STAGE(PG8_SB(1, 0), b3, voffB); PG8_STAGE(PG8_SB(1, 1), b3 + hstep, voffB); PG8_STAGE(PG8_SA(1, 0), a3, voffA);
            PG8_WAIT_V(8); PG8_WAIT_L(0); PG8_BAR; PG8_MMA(1, 0, At, B0); PG8_MMA(1, 1, At, B1); PG8_BAR; PG8_SCHED;
            } else {
            PG8_LDB(B0, 0, 0); PG8_SCHED; PG8_LDA(At, 0, 0); PG8_STAGE(PG8_SA(1, 1), a1 + hstep, voffA);
            PG8_WAIT_L(8); PG8_BAR; PG8_WAIT_L(0); PG8_MMA(0, 0, At, B0); PG8_BAR; PG8_SCHED;
            PG8_LDB(B1, 0, 1); PG8_STAGE(PG8_SB(0, 0), b2, voffB);
            PG8_BAR; PG8_WAIT_L(0); PG8_MMA(0, 1, At, B1); PG8_BAR;
            PG8_LDA(At, 0, 1); PG8_STAGE(PG8_SA(0, 0), a2, voffA);
            PG8_BAR; PG8_WAIT_L(0); PG8_MMA(1, 0, At, B0); PG8_BAR; PG8_SCHED;
            PG8_STAGE(PG8_SB(0, 1), b2 + hstep, voffB);
            PG8_WAIT_V(6); PG8_BAR; PG8_MMA(1, 1, At, B1); PG8_BAR;
            PG8_LDB(B0, 1, 0); PG8_SCHED; PG8_LDA(At, 1, 0); PG8_STAGE(PG8_SA(0, 1), a2 + hstep, voffA);
            PG8_WAIT_L(8); PG8_BAR; PG8_WAIT_L(0); PG8_MMA(0, 0, At, B0); PG8_BAR; PG8_SCHED;
            PG8_LDB(B1, 1, 1); PG8_STAGE(PG8_SB(1, 0), b3, voffB);
            PG8_BAR; PG8_WAIT_L(0); PG8_MMA(0, 1, At, B1); PG8_BAR;
            PG8_LDA(At, 1, 1); PG8_STAGE(PG8_SA(1, 0), a3, voffA);
            PG8_BAR; PG8_WAIT_L(0); PG8_MMA(1, 0, At, B0); PG8_BAR; PG8_SCHED;
            PG8_STAGE(PG8_SB(1, 1), b3 + hstep, voffB);
            PG8_WAIT_V(6); PG8_BAR; PG8_MMA(1, 1, At, B1); PG8_BAR;
            }
        }
        if constexpr (ALIGN_EPI) { if (wr == 0) PG8_BAR; }
        if constexpr (!Epi::AFTER_DRAIN) { E(acc, cur, wr, wc, fr, fq); S.done(cur); }
        if (!has_next) break;
#pragma unroll
        for (int a = 0; a < 2; ++a)
#pragma unroll
            for (int b = 0; b < 2; ++b)
#pragma unroll
                for (int m = 0; m < 4; ++m)
#pragma unroll
                    for (int n = 0; n < 2; ++n) acc[a][b][m][n] = (f32x4){0.f, 0.f, 0.f, 0.f};
        cur = nxt; cA = nA; cB = nB; ++ui;
        if constexpr (ALIGN_EPI) { if (wr == 1) PG8_BAR; }
    }
    PG8_WAIT_V(0);
    if constexpr (!ALIGN_EPI) { if (wr == 0) PG8_BAR; }
    PG8_BAR;
    if constexpr (Epi::AFTER_DRAIN) { E.fused(acc, cur, wr, wc, fr, fq, lds, wid, lane); S.done(cur); }
#undef PG8_SA
#undef PG8_SB
#undef PG8_STAGE
#undef PG8_LDA
#undef PG8_LDB
#undef PG8_MMA
#undef PG8_WAIT_V
#undef PG8_WAIT_L
#undef PG8_BAR
#undef PG8_SCHED
}
}
#define LAS __attribute__((address_space(3)))
#define DI __device__ __forceinline__
typedef unsigned short bf16;
typedef unsigned v4u __attribute__((ext_vector_type(4)));
typedef unsigned v2u __attribute__((ext_vector_type(2)));
typedef float f32x4 __attribute__((ext_vector_type(4)));
typedef float f32x2 __attribute__((ext_vector_type(2)));
typedef short bf16x8 __attribute__((ext_vector_type(8)));
typedef __bf16 bf16x2_t __attribute__((ext_vector_type(2)));

#ifndef PHASE_ONLY
#define PHASE_ONLY -1
#endif
#define PH_EN(k) (PHASE_ONLY < 0 || PHASE_ONLY == (k))
#define REP_MOD 1
#define REP_N0 1
#define REP_G1 1
#define REP_PREP 1
#define REP_SCAN 1
#define REP_SGU 1
#define REP_N1 1
#define REP_FF1 1
#define REP_SYNC 0
#ifndef MK_LAUNCHES
#define MK_LAUNCHES 1
#endif

constexpr int NWAVES = 8, NT = 512;
constexpr int BATCH = 8, SEQ = 4096, D = 1024, M = BATCH * SEQ, DEPTH = 4, FF = 4096, INW = 3080, NP = 3072, NMOD = 6144;
constexpr int NPHASE = 2 + 9 * DEPTH;
constexpr size_t MiB = 1u << 20;
constexpr size_t WS_CTL = 0, WS_MOD = 1 * MiB, WS_BA = 2 * MiB, WS_GL = 3 * MiB, WS_WIN = 4 * MiB, WS_WOUT = 10 * MiB, WS_W1 = 12 * MiB, WS_W2 = 20 * MiB,
                 WS_H = 28 * MiB, WS_X = 92 * MiB  , WS_P = 156 * MiB, WS_QD = 348 * MiB, WS_WK = 380 * MiB, WS_KDT = 412 * MiB, WS_AC = 444 * MiB, WS_WSET1 = 460 * MiB, WS_END = 484 * MiB;
DI size_t ws_wset(int l) { return (l & 1) ? WS_WSET1 : WS_WIN; }
constexpr size_t W_OFF_OUT = WS_WOUT - WS_WIN, W_OFF_1 = WS_W1 - WS_WIN, W_OFF_2 = WS_W2 - WS_WIN;
constexpr size_t WS_U = WS_H;
constexpr size_t WS_F = WS_P;
constexpr int LDS_BYTES = 148480;

struct Args { const float* in[19]; float* out; unsigned char* ws; int ph_lo, ph_hi; };

DI float bflo(unsigned u) { return __uint_as_float(u << 16); }
DI float bfhi(unsigned u) { return __uint_as_float(u & 0xffff0000u); }
DI float bf2f(bf16 b) { return __uint_as_float((unsigned)b << 16); }
DI unsigned pk2(float lo, float hi) { f32x2 v = {lo, hi}; bf16x2_t b = __builtin_convertvector(v, bf16x2_t); return __builtin_bit_cast(unsigned, b); }
DI bf16 f2bf(float f) { return (bf16)(pk2(f, 0.f) & 0xffffu); }
template <int CTRL> DI float dpp_f(float v) { return __builtin_bit_cast(float, __builtin_amdgcn_update_dpp(0, __builtin_bit_cast(int, v), CTRL, 0xf, 0xf, false)); }
DI float row16_sum(float v) {
    v += dpp_f<0xB1>(v);
    v += dpp_f<0x4E>(v);
    v += dpp_f<0x141>(v);
    v += dpp_f<0x140>(v);
    return v;
}
template <int CTRL, int RMASK> DI float dpp_rm(float v) { return __builtin_bit_cast(float, __builtin_amdgcn_update_dpp(0, __builtin_bit_cast(int, v), CTRL, RMASK, 0xf, false)); }
DI float wave_sum(float v) {
    v = row16_sum(v);
    v += dpp_rm<0x142, 0xa>(v);
    v += dpp_rm<0x143, 0xc>(v);
    return __builtin_bit_cast(float, __builtin_amdgcn_readlane(__builtin_bit_cast(int, v), 63));
}
DI float silu_f(float v) { return v * __builtin_amdgcn_rcpf(1.f + __expf(-v)); }
DI float gelu_tanh(float v) { const float u = 1.5957691216057308f * (v + 0.044715f * v * v * v); return v * __builtin_amdgcn_rcpf(1.f + __expf(-u)); }
DI void bar_lds() { asm volatile("s_waitcnt lgkmcnt(0)\n\ts_barrier" ::: "memory"); }
#define GAS __attribute__((address_space(1)))
DI void glds16(const void* gsrc, unsigned lds_dst) { unsigned keep;
    asm volatile("s_mov_b32 %0, m0\n\ts_mov_b32 m0, %2\n\ts_nop 0\n\tglobal_load_lds_dwordx4 %1, off\n\ts_mov_b32 m0, %0" : "=&s"(keep) : "v"(gsrc), "s"(lds_dst) : "memory"); }
DI int pos32(int o) { return 8 * ((o >> 2) & 3) + 4 * (o >> 4) + (o & 3); }
DI bf16x8 pack8(const f32x4& a, const f32x4& b) { v4u p; p.x = pk2(a[0], a[1]); p.y = pk2(a[2], a[3]); p.z = pk2(b[0], b[1]); p.w = pk2(b[2], b[3]); return __builtin_bit_cast(bf16x8, p); }
DI bf16x8 ld16g(const bf16* p) { return *(const bf16x8*)p; }
#define MFMA16(a, b, c) __builtin_amdgcn_mfma_f32_16x16x32_bf16((a), (b), (c), 0, 0, 0)

DI void phase_mod(const Args& a, LAS unsigned char* lds, int tid, int lane, int wave, int bid, int G) {
    LAS float* sc = (LAS float*)lds;
    LAS float* red = sc + 8192;
    const float* c = a.in[1]; const float* w_ada = a.in[2]; const float* b_ada = a.in[3];
    float* mod = (float*)(a.ws + WS_MOD);
    for (int i = tid; i < 8192; i += NT) sc[i] = silu_f(c[i]);
    __syncthreads();
    for (int unit = bid; unit < DEPTH * 96; unit += G) {
        const int l = unit / 96, j0 = (unit % 96) * 64;
        const float* w = w_ada + (size_t)l * D * NMOD + j0 + lane;
        float acc[8];
#pragma unroll
        for (int b = 0; b < 8; ++b) acc[b] = 0.f;
#pragma unroll 8
        for (int k = wave * 128; k < wave * 128 + 128; ++k) {
            const float wv = w[(size_t)k * NMOD];
#pragma unroll
            for (int b = 0; b < 8; ++b) acc[b] += sc[b * 1024 + k] * wv;
        }
#pragma unroll
        for (int b = 0; b < 8; ++b) red[(wave * 8 + b) * 64 + lane] = acc[b];
        __syncthreads();
        { const int b = tid >> 6, j = tid & 63; float s = b_ada[l * NMOD + j0 + j];
#pragma unroll
          for (int w8 = 0; w8 < 8; ++w8) s += red[(w8 * 8 + b) * 64 + j];
          mod[(size_t)(l * 8 + b) * NMOD + j0 + j] = s; }
        __syncthreads();
    }
}

DI void transpose_item(const float* W, int ldw, int K, int nblk, bf16* WT, LAS float* scr, int item, int lane) {
    const int kb = item / nblk, nb = item % nblk, k0 = 64 * kb, n0 = 32 * nb;
#pragma unroll 8
    for (int i = 0; i < 32; ++i) { const int kk = 2 * i + (lane >> 5); scr[kk * 33 + (lane & 31)] = W[(size_t)(k0 + kk) * ldw + n0 + (lane & 31)]; }
    asm volatile("s_waitcnt lgkmcnt(0)" ::: "memory");
    const int c = lane & 7;
#pragma unroll
    for (int j = 0; j < 4; ++j) { const int n = (lane >> 3) + 8 * j; const LAS float* s = scr + (8 * c) * 33 + n;
        v4u o; o.x = pk2(s[0 * 33], s[1 * 33]); o.y = pk2(s[2 * 33], s[3 * 33]); o.z = pk2(s[4 * 33], s[5 * 33]); o.w = pk2(s[6 * 33], s[7 * 33]);
        *(v4u*)(WT + (size_t)(n0 + n) * K + k0 + 8 * c) = o; }
    asm volatile("s_waitcnt lgkmcnt(0)" ::: "memory");
}

DI void convert_weights(const Args& a, int l, LAS unsigned char* scr_base, int wave, int lane, int gw, int NGW) {
    LAS float* scr = (LAS float*)(scr_base + wave * 8448);
    unsigned char* wb = a.ws + ws_wset(l);
    const float* w_in = a.in[5] + (size_t)l * D * INW; const float* w_out = a.in[14] + (size_t)l * D * D;
    const float* w1 = a.in[16] + (size_t)l * D * FF;   const float* w2 = a.in[17] + (size_t)l * FF * D;
    constexpr int I_IN = 16 * 96, I_OUT = 16 * 32, I_1 = 16 * 128, I_2 = 64 * 32, NIT = I_IN + I_OUT + I_1 + I_2;
    for (int it = gw; it < NIT; it += NGW) {
        int r = it;
        if (r < I_IN) { transpose_item(w_in, INW, D, 96, (bf16*)wb, scr, r, lane); continue; } r -= I_IN;
        if (r < I_OUT) { transpose_item(w_out, D, D, 32, (bf16*)(wb + W_OFF_OUT), scr, r, lane); continue; } r -= I_OUT;
        if (r < I_1) { transpose_item(w1, FF, D, 128, (bf16*)(wb + W_OFF_1), scr, r, lane); continue; } r -= I_1;
        transpose_item(w2, D, FF, 32, (bf16*)(wb + W_OFF_2), scr, r, lane);
    }
}

template <int MODE> DI void phase_norm(const Args& a, int l, LAS unsigned char* lds, int tid, int lane, int wave, int bid, int G) {
    constexpr int RB = (MODE == 0) ? 2 : 4;
    const int gw = bid * NWAVES + wave, NGW = G * NWAVES;
    unsigned char* ws = a.ws;
    const bool xf32 = (MODE == 0 && l == 0);
    const float* xin = a.in[0]; const bf16* xbf = (const bf16*)(ws + WS_X);
    const float* gam = (MODE == 0) ? a.in[4] + l * D : (MODE == 1) ? a.in[15] + l * D : a.in[18];
    const float* mod = (const float*)(ws + WS_MOD);
    bf16* H = (bf16*)(ws + WS_H);
    float* BA = (float*)(ws + WS_BA);
    LAS f32x4* w8s = (LAS f32x4*)(lds + 67584);
    if (MODE == 0) {
        const float* w_in = a.in[5] + (size_t)l * D * INW + NP;
        for (int idx = tid; idx < 2048; idx += NT) { const int k = idx >> 1, half = idx & 1;
            w8s[(((k >> 8) * 4 + (k & 3)) * 2 + half) * 64 + ((k & 255) >> 2)] = *(const f32x4*)(w_in + (size_t)k * INW + 4 * half); }
        __syncthreads();
    }
    for (int mb = gw * 16; mb < M; mb += NGW * 16) {
        const int b = mb / SEQ;
        f32x4 ca[4], cb[4];
#pragma unroll
        for (int j = 0; j < 4; ++j) {
            const f32x4 gg = *(const f32x4*)(gam + 4 * lane + 256 * j);
            if (MODE == 2) { ca[j] = gg; cb[j] = (f32x4){0.f, 0.f, 0.f, 0.f}; }
            else { const float* mr = mod + (size_t)(l * 8 + b) * NMOD + (MODE == 0 ? 0 : 3072) + 4 * lane + 256 * j;
                   const f32x4 sh = *(const f32x4*)mr, scl = *(const f32x4*)(mr + 1024); ca[j] = gg * (scl + 1.0f); cb[j] = sh; }
        }
        for (int i0 = 0; i0 < 16; i0 += RB) {
            asm volatile("" ::: "memory");
            f32x4 v[RB][4]; float ss[RB];
#pragma unroll
            for (int rr = 0; rr < RB; ++rr) { const f32x4* xr = (const f32x4*)(xin + (size_t)(mb + i0 + rr) * D) + lane; const v2u* xb = (const v2u*)(xbf + (size_t)(mb + i0 + rr) * D) + lane; float sq = 0.f;
#pragma unroll
                for (int j = 0; j < 4; ++j) { if (xf32) v[rr][j] = xr[64 * j]; else { const v2u w = xb[64 * j]; v[rr][j] = (f32x4){bflo(w.x), bfhi(w.x), bflo(w.y), bfhi(w.y)}; } sq += (v[rr][j].x * v[rr][j].x + v[rr][j].y * v[rr][j].y) + (v[rr][j].z * v[rr][j].z + v[rr][j].w * v[rr][j].w); }
                ss[rr] = sq; }
#pragma unroll
            for (int rr = 0; rr < RB; ++rr) ss[rr] = rsqrtf(wave_sum(ss[rr]) * (1.f / D) + 1e-6f);
#pragma unroll
            for (int rr = 0; rr < RB; ++rr) { const size_t m = (size_t)(mb + i0 + rr);
#pragma unroll
                for (int j = 0; j < 4; ++j) v[rr][j] = v[rr][j] * ss[rr] * ca[j] + cb[j];
                if (MODE == 2) { f32x4* o = (f32x4*)(a.out + m * D) + lane;
#pragma unroll
                    for (int j = 0; j < 4; ++j) o[64 * j] = v[rr][j];
                } else { v2u* o = (v2u*)(H + m * D) + lane;
#pragma unroll
                    for (int j = 0; j < 4; ++j) { v2u w; w.x = pk2(v[rr][j].x, v[rr][j].y); w.y = pk2(v[rr][j].z, v[rr][j].w); o[64 * j] = w; } }
            }
            if (MODE == 0) {
                f32x4 d[RB][2];
#pragma unroll
                for (int rr = 0; rr < RB; ++rr) { d[rr][0] = (f32x4){0.f, 0.f, 0.f, 0.f}; d[rr][1] = (f32x4){0.f, 0.f, 0.f, 0.f}; }
#pragma unroll
                for (int j = 0; j < 4; ++j) { asm volatile("" ::: "memory");
#pragma unroll
                    for (int e = 0; e < 4; ++e) { const f32x4 w0 = w8s[((j * 4 + e) * 2 + 0) * 64 + lane], w1 = w8s[((j * 4 + e) * 2 + 1) * 64 + lane];
#pragma unroll
                        for (int rr = 0; rr < RB; ++rr) { d[rr][0] += w0 * v[rr][j][e]; d[rr][1] += w1 * v[rr][j][e]; } } }
#pragma unroll
                for (int rr = 0; rr < RB; ++rr) {
#pragma unroll
                    for (int e = 0; e < 4; ++e) { d[rr][0][e] = wave_sum(d[rr][0][e]); d[rr][1][e] = wave_sum(d[rr][1][e]); }
                    if (lane == 0) { *(f32x4*)(BA + (size_t)(mb + i0 + rr) * 8) = d[rr][0]; *(f32x4*)(BA + (size_t)(mb + i0 + rr) * 8 + 4) = d[rr][1]; } }
            }
        }
    }
}

DI void phase_prep(const Args& a, int l, LAS unsigned char* lds, int tid, int lane, int wave, int bid, int G) {
    unsigned char* ws = a.ws;
    const bf16* P = (const bf16*)(ws + WS_P);
    const float* BA = (const float*)(ws + WS_BA);
    const float* convw = a.in[10] + (size_t)l * 4 * 1536;
    bf16* QD = (bf16*)(ws + WS_QD); bf16* WKb = (bf16*)(ws + WS_WK); bf16* KDT = (bf16*)(ws + WS_KDT); bf16* AC = (bf16*)(ws + WS_AC);
    float* U = (float*)(ws + WS_U); float* GL = (float*)(ws + WS_GL);
    for (int unit = bid; unit < 2048; unit += G) {
        asm volatile("" : "+v"(lds));
        LAS float* Qf = (LAS float*)lds; LAS float* Kf = Qf + 64 * 132; LAS float* Vf = Kf + 64 * 132;
        LAS bf16* Qb = (LAS bf16*)(lds + 101376); LAS bf16* Kb = Qb + 64 * 136;
        LAS float* gt = (LAS float*)(lds + 136192);
        LAS float* Mm = Qf;
        const int n = unit & 63, bh = unit >> 6, b = bh >> 2; int h = bh & 3;
        asm volatile("" : "+s"(h));
        const int t0 = n * 64; const size_t m0 = (size_t)b * SEQ + t0;
        if (tid < 384) {
            const int cgi = tid % 48, rr = tid / 48, sel = cgi >> 4, d0 = (cgi & 15) * 8;
            const int pc = 1024 + sel * 512 + h * 128 + d0, cc = sel * 512 + h * 128 + d0;
            f32x4 cw[4][2];
#pragma unroll
            for (int j = 0; j < 4; ++j) { cw[j][0] = *(const f32x4*)(convw + j * 1536 + cc); cw[j][1] = *(const f32x4*)(convw + j * 1536 + cc + 4); }
            v4u xr[11];
#pragma unroll
            for (int i = 0; i < 11; ++i) { const int t = rr * 8 + i - 3; const bool ok = (t0 + t) >= 0;
                const bf16* p = P + ((long)m0 + t) * NP + pc; xr[i] = ok ? *(const v4u*)p : (v4u){0u, 0u, 0u, 0u}; }
            LAS float* dst = (sel == 0 ? Qf : sel == 1 ? Kf : Vf) + d0;
#pragma unroll
            for (int i = 0; i < 8; ++i) {
                f32x4 o0 = {0.f, 0.f, 0.f, 0.f}, o1 = {0.f, 0.f, 0.f, 0.f};
#pragma unroll
                for (int j = 0; j < 4; ++j) { const v4u x = xr[i + j];
                    const f32x4 x0 = {bflo(x.x), bfhi(x.x), bflo(x.y), bfhi(x.y)}, x1 = {bflo(x.z), bfhi(x.z), bflo(x.w), bfhi(x.w)};
                    o0 += cw[j][0] * x0; o1 += cw[j][1] * x1; }
#pragma unroll
                for (int e = 0; e < 4; ++e) { o0[e] = silu_f(o0[e]); o1[e] = silu_f(o1[e]); }
                *(LAS f32x4*)(dst + (rr * 8 + i) * 132) = o0; *(LAS f32x4*)(dst + (rr * 8 + i) * 132 + 4) = o1;
                const float sq = row16_sum(((o0[0] * o0[0] + o0[1] * o0[1]) + (o0[2] * o0[2] + o0[3] * o0[3])) + ((o1[0] * o1[0] + o1[1] * o1[1]) + (o1[2] * o1[2] + o1[3] * o1[3])));
                if (sel < 2 && (cgi & 15) == 0) gt[192 + sel * 64 + rr * 8 + i] = sq;
            }
        } else if (wave == 7) {
            const float bb = BA[(m0 + lane) * 8 + h], aa = BA[(m0 + lane) * 8 + 4 + h];
            const float beta = 1.f / (1.f + expf(-bb));
            const float xx = aa + a.in[12][l * 4 + h];
            const float sp = fmaxf(xx, 0.f) + log1pf(expf(-fabsf(xx)));
            float g = -expf(a.in[11][l * 4 + h]) * sp;
#pragma unroll
            for (int off = 1; off < 64; off <<= 1) { const float v = __shfl_up(g, off); if (lane >= off) g += v; }
            { const float gm = expf(g); gt[lane] = beta; gt[64 + lane] = g; gt[128 + lane] = gm; gt[320 + lane] = beta * gm; }
        }
        bar_lds();
        for (int i = 0; i < 8; ++i) {
            const int t = wave * 8 + i;
            f32x2 qv = *(LAS f32x2*)(Qf + t * 132 + 2 * lane), kv = *(LAS f32x2*)(Kf + t * 132 + 2 * lane);
            const float rq = rsqrtf(gt[192 + t] + 1e-6f) * 0.08838834764831845f, rk = rsqrtf(gt[256 + t] + 1e-6f);
            qv = qv * rq; kv = kv * rk;
            *(LAS unsigned*)(Qb + t * 136 + 2 * lane) = pk2(qv.x, qv.y);
            *(LAS unsigned*)(Kb + t * 136 + 2 * lane) = pk2(kv.x, kv.y);
            *(LAS f32x2*)(Kf + t * 132 + 2 * lane) = kv;
            const float gm = gt[128 + t];
            const int d = 2 * lane, dp = (d & ~31) + pos32(d & 31);
            *(unsigned*)(QD + ((size_t)unit * 64 + t) * 128 + dp) = pk2(qv.x * gm, qv.y * gm);
        }
        bar_lds();
        {
            const int which = wave >> 2, mt = wave & 3, r = lane & 15, q = lane >> 4;
            const LAS bf16* Ab = which ? Qb : Kb;
            bf16x8 af[4];
#pragma unroll
            for (int ks = 0; ks < 4; ++ks) af[ks] = *(const LAS bf16x8*)(Ab + (16 * mt + r) * 136 + 32 * ks + 8 * q);
            for (int nt = 0; nt < 4; ++nt) {
                f32x4 acc = {0.f, 0.f, 0.f, 0.f};
                if (nt <= mt) {
#pragma unroll
                    for (int ks = 0; ks < 4; ++ks) { const bf16x8 bfr = *(const LAS bf16x8*)(Kb + (16 * nt + r) * 136 + 32 * ks + 8 * q); acc = MFMA16(af[ks], bfr, acc); }
                }
                const int s = 16 * nt + r; const float gs = gt[64 + s];
#pragma unroll
                for (int i = 0; i < 4; ++i) { const int t = 16 * mt + 4 * q + i;
                    const float dec = __expf(fminf(gt[64 + t] - gs, 0.f));
                    if (which == 0) { if (nt <= mt) Mm[t * 68 + s] = (s < t) ? gt[t] * acc[i] * dec : 0.f; }
                    else { const float v = (s <= t) ? acc[i] * dec : 0.f; AC[((size_t)unit * 64 + t) * 64 + (s & ~31) + pos32(s & 31)] = f2bf(v); }
                }
            }
        }
        bar_lds();
        if (wave < 4) {
            const int part = wave >> 1, c = 64 * (wave & 1) + lane;
            const LAS float* src = (part ? Kf : Vf) + c;
            LAS float* dst = (part ? (LAS float*)Qb : Vf) + c;
            const LAS float* cf = gt + (part ? 320 : 0);
            __builtin_amdgcn_s_setprio(2);
            float X[64];
            f32x4 mr0, mr1, mr2, mr3, mr4, mr5, mr6;
            float rh0, rh1, rh2;
            mr0 = *(const LAS f32x4*)(Mm + 68);
            mr1 = *(const LAS f32x4*)(Mm + 136);
            mr2 = *(const LAS f32x4*)(Mm + 204);
            mr3 = *(const LAS f32x4*)(Mm + 272);
            mr4 = *(const LAS f32x4*)(Mm + 340);
            mr5 = *(const LAS f32x4*)(Mm + 344);
            rh0 = src[0] * cf[0]; rh1 = src[132] * cf[1];
            rh2 = src[264] * cf[2];
            X[0] = rh0; dst[0] = X[0];
            rh0 = src[396] * cf[3];
            { float a0 = rh1, a1 = 0.f, a2 = 0.f, a3 = 0.f;
              mr6 = *(const LAS f32x4*)(Mm + 408);
              __builtin_amdgcn_sched_barrier(0);
              a0 -= mr0[0] * X[0];
              X[1] = (a0 + a1) + (a2 + a3); dst[132] = X[1]; }
            __builtin_amdgcn_sched_barrier(0);
            rh1 = src[528] * cf[4];
            { float a0 = rh2, a1 = 0.f, a2 = 0.f, a3 = 0.f;
              mr0 = *(const LAS f32x4*)(Mm + 412);
              __builtin_amdgcn_sched_barrier(0);
              a0 -= mr1[0] * X[0]; a1 -= mr1[1] * X[1];
              X[2] = (a0 + a1) + (a2 + a3); dst[264] = X[2]; }
            __builtin_amdgcn_sched_barrier(0);
            rh2 = src[660] * cf[5];
            { float a0 = rh0, a1 = 0.f, a2 = 0.f, a3 = 0.f;
              mr1 = *(const LAS f32x4*)(Mm + 476);
              __builtin_amdgcn_sched_barrier(0);
              a0 -= mr2[0] * X[0]; a1 -= mr2[1] * X[1]; a2 -= mr2[2] * X[2];
              X[3] = (a0 + a1) + (a2 + a3); dst[396] = X[3]; }
            __builtin_amdgcn_sched_barrier(0);
            rh0 = src[792] * cf[6];
            { float a0 = rh1, a1 = 0.f, a2 = 0.f, a3 = 0.f;
              mr2 = *(const LAS f32x4*)(Mm + 480);
              __builtin_amdgcn_sched_barrier(0);
              a0 -= mr3[0] * X[0]; a1 -= mr3[1] * X[1]; a2 -= mr3[2] * X[2]; a3 -= mr3[3] * X[3];
              X[4] = (a0 + a1) + (a2 + a3); dst[528] = X[4]; }
            __builtin_amdgcn_sched_barrier(0);
            rh1 = src[924] * cf[7];
            { float a0 = rh2, a1 = 0.f, a2 = 0.f, a3 = 0.f;
              mr3 = *(const LAS f32x4*)(Mm + 544);
              __builtin_amdgcn_sched_barrier(0);
              a0 -= mr4[0] * X[0]; a1 -= mr4[1] * X[1]; a2 -= mr4[2] * X[2]; a3 -= mr4[3] * X[3];
              mr4 = *(const LAS f32x4*)(Mm + 548);
              __builtin_amdgcn_sched_barrier(0);
              a0 -= mr5[0] * X[4];
              X[5] = (a0 + a1) + (a2 + a3); dst[660] = X[5]; }
            __builtin_amdgcn_sched_barrier(0);
            rh2 = src[1056] * cf[8];
            { float a0 = rh0, a1 = 0.f, a2 = 0.f, a3 = 0.f;
              mr5 = *(const LAS f32x4*)(Mm + 612);
              __builtin_amdgcn_sched_barrier(0);
              a0 -= mr6[0] * X[0]; a1 -= mr6[1] * X[1]; a2 -= mr6[2] * X[2]; a3 -= mr6[3] * X[3];
              mr6 = *(const LAS f32x4*)(Mm + 616);
              __builtin_amdgcn_sched_barrier(0);
              a0 -= mr0[0] * X[4]; a1 -= mr0[1] * X[5];
              X[6] = (a0 + a1) + (a2 + a3); dst[792] = X[6]; }
            __builtin_amdgcn_sched_barrier(0);
            rh0 = src[1188] * cf[9];
            { float a0 = rh1, a1 = 0.f, a2 = 0.f, a3 = 0.f;
              mr0 = *(const LAS f32x4*)(Mm + 620);
              __builtin_amdgcn_sched_barrier(0);
              a0 -= mr1[0] * X[0]; a1 -= mr1[1] * X[1]; a2 -= mr1[2] * X[2]; a3 -= mr1[3] * X[3];
              mr1 = *(const LAS f32x4*)(Mm + 680);
              __builtin_amdgcn_sched_barrier(0);
              a0 -= mr2[0] * X[4]; a1 -= mr2[1] * X[5]; a2 -= mr2[2] * X[6];
              X[7] = (a0 + a1) + (a2 + a3); dst[924] = X[7]; }
            __builtin_amdgcn_sched_barrier(0);
            rh1 = src[1320] * cf[10];
            { float a0 = rh2, a1 = 0.f, a2 = 0.f, a3 = 0.f;
              mr2 = *(const LAS f32x4*)(Mm + 684);
              __builtin_amdgcn_sched_barrier(0);
              a0 -= mr3[0] * X[0]; a1 -= mr3[1] * X[1]; a2 -= mr3[2] * X[2]; a3 -= mr3[3] * X[3];
              mr3 = *(const LAS f32x4*)(Mm + 688);
              __builtin_amdgcn_sched_barrier(0);
              a0 -= mr4[0] * X[4]; a1 -= mr4[1] * X[5]; a2 -= mr4[2] * X[6]; a3 -= mr4[3] * X[7];
              X[8] = (a0 + a1) + (a2 + a3); dst[1056] = X[8]; }
            __builtin_amdgcn_sched_barrier(0);
            rh2 = src[1452] * cf[11];
            { float a0 = rh0, a1 = 0.f, a2 = 0.f, a3 = 0.f;
              mr4 = *(const LAS f32x4*)(Mm + 748);
              __builtin_amdgcn_sched_barrier(0);
              a0 -= mr5[0] * X[0]; a1 -= mr5[1] * X[1]; a2 -= mr5[2] * X[2]; a3 -= mr5[3] * X[3];
              mr5 = *(const LAS f32x4*)(Mm + 752);
              __builtin_amdgcn_sched_barrier(0);
              a0 -= mr6[0] * X[4]; a1 -= mr6[1] * X[5]; a2 -= mr6[2] * X[6]; a3 -= mr6[3] * X[7];
              mr6 = *(const LAS f32x4*)(Mm + 756);
              __builtin_amdgcn_sched_barrier(0);
              a0 -= mr0[0] * X[8];
              X[9] = (a0 + a1) + (a2 + a3); dst[1188] = X[9]; }
            __builtin_amdgcn_sched_barrier(0);
            rh0 = src[1584] * cf[12];
            { float a0 = rh1, a1 = 0.f, a2 = 0.f, a3 = 0.f;
              mr0 = *(const LAS f32x4*)(Mm + 816);
              __builtin_amdgcn_sched_barrier(0);
              a0 -= mr1[0] * X[0]; a1 -= mr1[1] * X[1]; a2 -= mr1[2] * X[2]; a3 -= mr1[3] * X[3];
              mr1 = *(const LAS f32x4*)(Mm + 820);
              __builtin_amdgcn_sched_barrier(0);
              a0 -= mr2[0] * X[4]; a1 -= mr2[1] * X[5]; a2 -= mr2[2] * X[6]; a3 -= mr2[3] * X[7];
              mr2 = *(const LAS f32x4*)(Mm + 824);
              __builtin_amdgcn_sched_barrier(0);
              a0 -= mr3[0] * X[8]; a1 -= mr3[1] * X[9];
              X[10] = (a0 + a1) + (a2 + a3); dst[1320] = X[10]; }
            __builtin_amdgcn_sched_barrier(0);
            rh1 = src[1716] * cf[13];
            { float a0 = rh2, a1 = 0.f, a2 = 0.f, a3 = 0.f;
              mr3 = *(const LAS f32x4*)(Mm + 884);
              __builtin_amdgcn_sched_barrier(0);
              a0 -= mr4[0] * X[0]; a1 -= mr4[1] * X[1]; a2 -= mr4[2] * X[2]; a3 -= mr4[3] * X[3];
              mr4 = *(const LAS f32x4*)(Mm + 888);
              __builtin_amdgcn_sched_barrier(0);
              a0 -= mr5[0] * X[4]; a1 -= mr5[1] * X[5]; a2 -= mr5[2] * X[6]; a3 -= mr5[3] * X[7];
              mr5 = *(const LAS f32x4*)(Mm + 892);
              __builtin_amdgcn_sched_barrier(0);
              a0 -= mr6[0] * X[8]; a1 -= mr6[1] * X[9]; a2 -= mr6[2] * X[10];
              X[11] = (a0 + a1) + (a2 + a3); dst[1452] = X[11]; }
            __builtin_amdgcn_sched_barrier(0);
            rh2 = src[1848] * cf[14];
            { float a0 = rh0, a1 = 0.f, a2 = 0.f, a3 = 0.f;
              mr6 = *(const LAS f32x4*)(Mm + 896);
              __builtin_amdgcn_sched_barrier(0);
              a0 -= mr0[0] * X[0]; a1 -= mr0[1] * X[1]; a2 -= mr0[2] * X[2]; a3 -= mr0[3] * X[3];
              mr0 = *(const LAS f32x4*)(Mm + 952);
              __builtin_amdgcn_sched_barrier(0);
              a0 -= mr1[0] * X[4]; a1 -= mr1[1] * X[5]; a2 -= mr1[2] * X[6]; a3 -= mr1[3] * X[7];
              mr1 = *(const LAS f32x4*)(Mm + 956);
              __builtin_amdgcn_sched_barrier(0);
              a0 -= mr2[0] * X[8]; a1 -= mr2[1] * X[9]; a2 -= mr2[2] * X[10]; a3 -= mr2[3] * X[11];
              X[12] = (a0 + a1) + (a2 + a3); dst[1584] = X[12]; }
            __builtin_amdgcn_sched_barrier(0);
            rh0 = src[1980] * cf[15];
            { float a0 = rh1, a1 = 0.f, a2 = 0.f, a3 = 0.f;
              mr2 = *(const LAS f32x4*)(Mm + 960);
              __builtin_amdgcn_sched_barrier(0);
              a0 -= mr3[0] * X[0]; a1 -= mr3[1] * X[1]; a2 -= mr3[2] * X[2]; a3 -= mr3[3] * X[3];
              mr3 = *(const LAS f32x4*)(Mm + 964);
              __builtin_amdgcn_sched_barrier(0);
              a0 -= mr4[0] * X[4]; a1 -= mr4[1] * X[5]; a2 -= mr4[2] * X[6]; a3 -= mr4[3] * X[7];
              mr4 = *(const LAS f32x4*)(Mm + 1020);
              __builtin_amdgcn_sched_barrier(0);
              a0 -= mr5[0] * X[8]; a1 -= mr5[1] * X[9]; a2 -= mr5[2] * X[10]; a3 -= mr5[3] * X[11];
              mr5 = *(const LAS f32x4*)(Mm + 1024);
              __builtin_amdgcn_sched_barrier(0);
              a0 -= mr6[0] * X[12];
              X[13] = (a0 + a1) + (a2 + a3); dst[1716] = X[13]; }
            __builtin_amdgcn_sched_barrier(0);
            rh1 = src[2112] * cf[16];
            { float a0 = rh2, a1 = 0.f, a2 = 0.f, a3 = 0.f;
              mr6 = *(const LAS f32x4*)(Mm + 1028);
              __builtin_amdgcn_sched_barrier(0);
              a0 -= mr0[0] * X[0]; a1 -= mr0[1] * X[1]; a2 -= mr0[2] * X[2]; a3 -= mr0[3] * X[3];
              mr0 = *(const LAS f32x4*)(Mm + 1032);
              __builtin_amdgcn_sched_barrier(0);
              a0 -= mr1[0] * X[4]; a1 -= mr1[1] * X[5]; a2 -= mr1[2] * X[6]; a3 -= mr1[3] * X[7];
              mr1 = *(const LAS f32x4*)(Mm + 1088);
              __builtin_amdgcn_sched_barrier(0);
              a0 -= mr2[0] * X[8]; a1 -= mr2[1] * X[9]; a2 -= mr2[2] * X[10]; a3 -= mr2[3] * X[11];
              mr2 = *(const LAS f32x4*)(Mm + 1092);
              __builtin_amdgcn_sched_barrier(0);
              a0 -= mr3[0] * X[12]; a1 -= mr3[1] * X[13];
              X[14] = (a0 + a1) + (a2 + a3); dst[1848] = X[14]; }
            __builtin_amdgcn_sched_barrier(0);
            rh2 = src[2244] * cf[17];
            { float a0 = rh0, a1 = 0.f, a2 = 0.f, a3 = 0.f;
              mr3 = *(const LAS f32x4*)(Mm + 1096);
              __builtin_amdgcn_sched_barrier(0);
              a0 -= mr4[0] * X[0]; a1 -= mr4[1] * X[1]; a2 -= mr4[2] * X[2]; a3 -= mr4[3] * X[3];
              mr4 = *(const LAS f32x4*)(Mm + 1100);
              __builtin_amdgcn_sched_barrier(0);
              a0 -= mr5[0] * X[4]; a1 -= mr5[1] * X[5]; a2 -= mr5[2] * X[6]; a3 -= mr5[3] * X[7];
              mr5 = *(const LAS f32x4*)(Mm + 1156);
              __builtin_amdgcn_sched_barrier(0);
              a0 -= mr6[0] * X[8]; a1 -= mr6[1] * X[9]; a2 -= mr6[2] * X[10]; a3 -= mr6[3] * X[11];
              mr6 = *(const LAS f32x4*)(Mm + 1160);
              __builtin_amdgcn_sched_barrier(0);
              a0 -= mr0[0] * X[12]; a1 -= mr0[1] * X[13]; a2 -= mr0[2] * X[14];
              X[15] = (a0 + a1) + (a2 + a3); dst[1980] = X[15]; }
            __builtin_amdgcn_sched_barrier(0);
            rh0 = src[2376] * cf[18];
            { float a0 = rh1, a1 = 0.f, a2 = 0.f, a3 = 0.f;
              mr0 = *(const LAS f32x4*)(Mm + 1164);
              __builtin_amdgcn_sched_barrier(0);
              a0 -= mr1[0] * X[0]; a1 -= mr1[1] * X[1]; a2 -= mr1[2] * X[2]; a3 -= mr1[3] * X[3];
              mr1 = *(const LAS f32x4*)(Mm + 1168);
              __builtin_amdgcn_sched_barrier(0);
              a0 -= mr2[0] * X[4]; a1 -= mr2[1] * X[5]; a2 -= mr2[2] * X[6]; a3 -= mr2[3] * X[7];
              mr2 = *(const LAS f32x4*)(Mm + 1172);
              __builtin_amdgcn_sched_barrier(0);
              a0 -= mr3[0] * X[8]; a1 -= mr3[1] * X[9]; a2 -= mr3[2] * X[10]; a3 -= mr3[3] * X[11];
              mr3 = *(const LAS f32x4*)(Mm + 1224);
              __builtin_amdgcn_sched_barrier(0);
              a0 -= mr4[0] * X[12]; a1 -= mr4[1] * X[13]; a2 -= mr4[2] * X[14]; a3 -= mr4[3] * X[15];
              X[16] = (a0 + a1) + (a2 + a3); dst[2112] = X[16]; }
            __builtin_amdgcn_sched_barrier(0);
            rh1 = src[2508] * cf[19];
            { float a0 = rh2, a1 = 0.f, a2 = 0.f, a3 = 0.f;
              mr4 = *(const LAS f32x4*)(Mm + 1228);
              __builtin_amdgcn_sched_barrier(0);
              a0 -= mr5[0] * X[0]; a1 -= mr5[1] * X[1]; a2 -= mr5[2] * X[2]; a3 -= mr5[3] * X[3];
              mr5 = *(const LAS f32x4*)(Mm + 1232);
              __builtin_amdgcn_sched_barrier(0);
              a0 -= mr6[0] * X[4]; a1 -= mr6[1] * X[5]; a2 -= mr6[2] * X[6]; a3 -= mr6[3] * X[7];
              mr6 = *(const LAS f32x4*)(Mm + 1236);
              __builtin_amdgcn_sched_barrier(0);
              a0 -= mr0[0] * X[8]; a1 -= mr0[1] * X[9]; a2 -= mr0[2] * X[10]; a3 -= mr0[3] * X[11];
              mr0 = *(const LAS f32x4*)(Mm + 1240);
              __builtin_amdgcn_sched_barrier(0);
              a0 -= mr1[0] * X[12]; a1 -= mr1[1] * X[13]; a2 -= mr1[2] * X[14]; a3 -= mr1[3] * X[15];
              mr1 = *(const LAS f32x4*)(Mm + 1292);
              __builtin_amdgcn_sched_barrier(0);
              a0 -= mr2[0] * X[16];
              X[17] = (a0 + a1) + (a2 + a3); dst[2244] = X[17]; }
            __builtin_amdgcn_sched_barrier(0);
            rh2 = src[2640] * cf[20];
            { float a0 = rh0, a1 = 0.f, a2 = 0.f, a3 = 0.f;
              mr2 = *(const LAS f32x4*)(Mm + 1296);
              __builtin_amdgcn_sched_barrier(0);
              a0 -= mr3[0] * X[0]; a1 -= mr3[1] * X[1]; a2 -= mr3[2] * X[2]; a3 -= mr3[3] * X[3];
              mr3 = *(const LAS f32x4*)(Mm + 1300);
              __builtin_amdgcn_sched_barrier(0);
              a0 -= mr4[0] * X[4]; a1 -= mr4[1] * X[5]; a2 -= mr4[2] * X[6]; a3 -= mr4[3] * X[7];
              mr4 = *(const LAS f32x4*)(Mm + 1304);
              __builtin_amdgcn_sched_barrier(0);
              a0 -= mr5[0] * X[8]; a1 -= mr5[1] * X[9]; a2 -= mr5[2] * X[10]; a3 -= mr5[3] * X[11];
              mr5 = *(const LAS f32x4*)(Mm + 1308);
              __builtin_amdgcn_sched_barrier(0);
              a0 -= mr6[0] * X[12]; a1 -= mr6[1] * X[13]; a2 -= mr6[2] * X[14]; a3 -= mr6[3] * X[15];
              mr6 = *(const LAS f32x4*)(Mm + 1360);
              __builtin_amdgcn_sched_barrier(0);
              a0 -= mr0[0] * X[16]; a1 -= mr0[1] * X[17];
              X[18] = (a0 + a1) + (a2 + a3); dst[2376] = X[18]; }
            __builtin_amdgcn_sched_barrier(0);
            rh0 = src[2772] * cf[21];
            { float a0 = rh1, a1 = 0.f, a2 = 0.f, a3 = 0.f;
              mr0 = *(const LAS f32x4*)(Mm + 1364);
              __builtin_amdgcn_sched_barrier(0);
              a0 -= mr1[0] * X[0]; a1 -= mr1[1] * X[1]; a2 -= mr1[2] * X[2]; a3 -= mr1[3] * X[3];
              mr1 = *(const LAS f32x4*)(Mm + 1368);
              __builtin_amdgcn_sched_barrier(0);
              a0 -= mr2[0] * X[4]; a1 -= mr2[1] * X[5]; a2 -= mr2[2] * X[6]; a3 -= mr2[3] * X[7];
              mr2 = *(const LAS f32x4*)(Mm + 1372);
              __builtin_amdgcn_sched_barrier(0);
              a0 -= mr3[0] * X[8]; a1 -= mr3[1] * X[9]; a2 -= mr3[2] * X[10]; a3 -= mr3[3] * X[11];
              mr3 = *(const LAS f32x4*)(Mm + 1376);
              __builtin_amdgcn_sched_barrier(0);
              a0 -= mr4[0] * X[12]; a1 -= mr4[1] * X[13]; a2 -= mr4[2] * X[14]; a3 -= mr4[3] * X[15];
              mr4 = *(const LAS f32x4*)(Mm + 1428);
              __builtin_amdgcn_sched_barrier(0);
              a0 -= mr5[0] * X[16]; a1 -= mr5[1] * X[17]; a2 -= mr5[2] * X[18];
              X[19] = (a0 + a1) + (a2 + a3); dst[2508] = X[19]; }
            __builtin_amdgcn_sched_barrier(0);
            rh1 = src[2904] * cf[22];
            { float a0 = rh2, a1 = 0.f, a2 = 0.f, a3 = 0.f;
              mr5 = *(const LAS f32x4*)(Mm + 1432);
              __builtin_amdgcn_sched_barrier(0);
              a0 -= mr6[0] * X[0]; a1 -= mr6[1] * X[1]; a2 -= mr6[2] * X[2]; a3 -= mr6[3] * X[3];
              mr6 = *(const LAS f32x4*)(Mm + 1436);
              __builtin_amdgcn_sched_barrier(0);
              a0 -= mr0[0] * X[4]; a1 -= mr0[1] * X[5]; a2 -= mr0[2] * X[6]; a3 -= mr0[3] * X[7];
              mr0 = *(const LAS f32x4*)(Mm + 1440);
              __builtin_amdgcn_sched_barrier(0);
              a0 -= mr1[0] * X[8]; a1 -= mr1[1] * X[9]; a2 -= mr1[2] * X[10]; a3 -= mr1[3] * X[11];
              mr1 = *(const LAS f32x4*)(Mm + 1444);
              __builtin_amdgcn_sched_barrier(0);
              a0 -= mr2[0] * X[12]; a1 -= mr2[1] * X[13]; a2 -= mr2[2] * X[14]; a3 -= mr2[3] * X[15];
              mr2 = *(const LAS f32x4*)(Mm + 1448);
              __builtin_amdgcn_sched_barrier(0);
              a0 -= mr3[0] * X[16]; a1 -= mr3[1] * X[17]; a2 -= mr3[2] * X[18]; a3 -= mr3[3] * X[19];
              X[20] = (a0 + a1) + (a2 + a3); dst[2640] = X[20]; }
            __builtin_amdgcn_sched_barrier(0);
            rh2 = src[3036] * cf[23];
            { float a0 = rh0, a1 = 0.f, a2 = 0.f, a3 = 0.f;
              mr3 = *(const LAS f32x4*)(Mm + 1496);
              __builtin_amdgcn_sched_barrier(0);
              a0 -= mr4[0] * X[0]; a1 -= mr4[1] * X[1]; a2 -= mr4[2] * X[2]; a3 -= mr4[3] * X[3];
              mr4 = *(const LAS f32x4*)(Mm + 1500);
              __builtin_amdgcn_sched_barrier(0);
              a0 -= mr5[0] * X[4]; a1 -= mr5[1] * X[5]; a2 -= mr5[2] * X[6]; a3 -= mr5[3] * X[7];
              mr5 = *(const LAS f32x4*)(Mm + 1504);
              __builtin_amdgcn_sched_barrier(0);
              a0 -= mr6[0] * X[8]; a1 -= mr6[1] * X[9]; a2 -= mr6[2] * X[10]; a3 -= mr6[3] * X[11];
              mr6 = *(const LAS f32x4*)(Mm + 1508);
              __builtin_amdgcn_sched_barrier(0);
              a0 -= mr0[0] * X[12]; a1 -= mr0[1] * X[13]; a2 -= mr0[2] * X[14]; a3 -= mr0[3] * X[15];
              mr0 = *(const LAS f32x4*)(Mm + 1512);
              __builtin_amdgcn_sched_barrier(0);
              a0 -= mr1[0] * X[16]; a1 -= mr1[1] * X[17]; a2 -= mr1[2] * X[18]; a3 -= mr1[3] * X[19];
              mr1 = *(const LAS f32x4*)(Mm + 1516);
              __builtin_amdgcn_sched_barrier(0);
              a0 -= mr2[0] * X[20];
              X[21] = (a0 + a1) + (a2 + a3); dst[2772] = X[21]; }
            __builtin_amdgcn_sched_barrier(0);
            rh0 = src[3168] * cf[24];
            { float a0 = rh1, a1 = 0.f, a2 = 0.f, a3 = 0.f;
              mr2 = *(const LAS f32x4*)(Mm + 1564);
              __builtin_amdgcn_sched_barrier(0);
              a0 -= mr3[0] * X[0]; a1 -= mr3[1] * X[1]; a2 -= mr3[2] * X[2]; a3 -= mr3[3] * X[3];
              mr3 = *(const LAS f32x4*)(Mm + 1568);
              __builtin_amdgcn_sched_barrier(0);
              a0 -= mr4[0] * X[4]; a1 -= mr4[1] * X[5]; a2 -= mr4[2] * X[6]; a3 -= mr4[3] * X[7];
              mr4 = *(const LAS f32x4*)(Mm + 1572);
              __builtin_amdgcn_sched_barrier(0);
              a0 -= mr5[0] * X[8]; a1 -= mr5[1] * X[9]; a2 -= mr5[2] * X[10]; a3 -= mr5[3] * X[11];
              mr5 = *(const LAS f32x4*)(Mm + 1576);
              __builtin_amdgcn_sched_barrier(0);
              a0 -= mr6[0] * X[12]; a1 -= mr6[1] * X[13]; a2 -= mr6[2] * X[14]; a3 -= mr6[3] * X[15];
              mr6 = *(const LAS f32x4*)(Mm + 1580);
              __builtin_amdgcn_sched_barrier(0);
              a0 -= mr0[0] * X[16]; a1 -= mr0[1] * X[17]; a2 -= mr0[2] * X[18]; a3 -= mr0[3] * X[19];
              mr0 = *(const LAS f32x4*)(Mm + 1584);
              __builtin_amdgcn_sched_barrier(0);
              a0 -= mr1[0] * X[20]; a1 -= mr1[1] * X[21];
              X[22] = (a0 + a1) + (a2 + a3); dst[2904] = X[22]; }
            __builtin_amdgcn_sched_barrier(0);
            rh1 = src[3300] * cf[25];
            { float a0 = rh2, a1 = 0.f, a2 = 0.f, a3 = 0.f;
              mr1 = *(const LAS f32x4*)(Mm + 1632);
              __builtin_amdgcn_sched_barrier(0);
              a0 -= mr2[0] * X[0]; a1 -= mr2[1] * X[1]; a2 -= mr2[2] * X[2]; a3 -= mr2[3] * X[3];
              mr2 = *(const LAS f32x4*)(Mm + 1636);
              __builtin_amdgcn_sched_barrier(0);
              a0 -= mr3[0] * X[4]; a1 -= mr3[1] * X[5]; a2 -= mr3[2] * X[6]; a3 -= mr3[3] * X[7];
              mr3 = *(const LAS f32x4*)(Mm + 1640);
              __builtin_amdgcn_sched_barrier(0);
              a0 -= mr4[0] * X[8]; a1 -= mr4[1] * X[9]; a2 -= mr4[2] * X[10]; a3 -= mr4[3] * X[11];
              mr4 = *(const LAS f32x4*)(Mm + 1644);
              __builtin_amdgcn_sched_barrier(0);
              a0 -= mr5[0] * X[12]; a1 -= mr5[1] * X[13]; a2 -= mr5[2] * X[14]; a3 -= mr5[3] * X[15];
              mr5 = *(const LAS f32x4*)(Mm + 1648);
              __builtin_amdgcn_sched_barrier(0);
              a0 -= mr6[0] * X[16]; a1 -= mr6[1] * X[17]; a2 -= mr6[2] * X[18]; a3 -= mr6[3] * X[19];
              mr6 = *(const LAS f32x4*)(Mm + 1652);
              __builtin_amdgcn_sched_barrier(0);
              a0 -= mr0[0] * X[20]; a1 -= mr0[1] * X[21]; a2 -= mr0[2] * X[22];
              X[23] = (a0 + a1) + (a2 + a3); dst[3036] = X[23]; }
            __builtin_amdgcn_sched_barrier(0);
            rh2 = src[3432] * cf[26];
            { float a0 = rh0, a1 = 0.f, a2 = 0.f, a3 = 0.f;
              mr0 = *(const LAS f32x4*)(Mm + 1700);
              __builtin_amdgcn_sched_barrier(0);
              a0 -= mr1[0] * X[0]; a1 -= mr1[1] * X[1]; a2 -= mr1[2] * X[2]; a3 -= mr1[3] * X[3];
              mr1 = *(const LAS f32x4*)(Mm + 1704);
              __builtin_amdgcn_sched_barrier(0);
              a0 -= mr2[0] * X[4]; a1 -= mr2[1] * X[5]; a2 -= mr2[2] * X[6]; a3 -= mr2[3] * X[7];
              mr2 = *(const LAS f32x4*)(Mm + 1708);
              __builtin_amdgcn_sched_barrier(0);
              a0 -= mr3[0] * X[8]; a1 -= mr3[1] * X[9]; a2 -= mr3[2] * X[10]; a3 -= mr3[3] * X[11];
              mr3 = *(const LAS f32x4*)(Mm + 1712);
              __builtin_amdgcn_sched_barrier(0);
              a0 -= mr4[0] * X[12]; a1 -= mr4[1] * X[13]; a2 -= mr4[2] * X[14]; a3 -= mr4[3] * X[15];
              mr4 = *(const LAS f32x4*)(Mm + 1716);
              __builtin_amdgcn_sched_barrier(0);
              a0 -= mr5[0] * X[16]; a1 -= mr5[1] * X[17]; a2 -= mr5[2] * X[18]; a3 -= mr5[3] * X[19];
              mr5 = *(const LAS f32x4*)(Mm + 1720);
              __builtin_amdgcn_sched_barrier(0);
              a0 -= mr6[0] * X[20]; a1 -= mr6[1] * X[21]; a2 -= mr6[2] * X[22]; a3 -= mr6[3] * X[23];
              X[24] = (a0 + a1) + (a2 + a3); dst[3168] = X[24]; }
            __builtin_amdgcn_sched_barrier(0);
            rh0 = src[3564] * cf[27];
            { float a0 = rh1, a1 = 0.f, a2 = 0.f, a3 = 0.f;
              mr6 = *(const LAS f32x4*)(Mm + 1724);
              __builtin_amdgcn_sched_barrier(0);
              a0 -= mr0[0] * X[0]; a1 -= mr0[1] * X[1]; a2 -= mr0[2] * X[2]; a3 -= mr0[3] * X[3];
              mr0 = *(const LAS f32x4*)(Mm + 1768);
              __builtin_amdgcn_sched_barrier(0);
              a0 -= mr1[0] * X[4]; a1 -= mr1[1] * X[5]; a2 -= mr1[2] * X[6]; a3 -= mr1[3] * X[7];
              mr1 = *(const LAS f32x4*)(Mm + 1772);
              __builtin_amdgcn_sched_barrier(0);
              a0 -= mr2[0] * X[8]; a1 -= mr2[1] * X[9]; a2 -= mr2[2] * X[10]; a3 -= mr2[3] * X[11];
              mr2 = *(const LAS f32x4*)(Mm + 1776);
              __builtin_amdgcn_sched_barrier(0);
              a0 -= mr3[0] * X[12]; a1 -= mr3[1] * X[13]; a2 -= mr3[2] * X[14]; a3 -= mr3[3] * X[15];
              mr3 = *(const LAS f32x4*)(Mm + 1780);
              __builtin_amdgcn_sched_barrier(0);
              a0 -= mr4[0] * X[16]; a1 -= mr4[1] * X[17]; a2 -= mr4[2] * X[18]; a3 -= mr4[3] * X[19];
              mr4 = *(const LAS f32x4*)(Mm + 1784);
              __builtin_amdgcn_sched_barrier(0);
              a0 -= mr5[0] * X[20]; a1 -= mr5[1] * X[21]; a2 -= mr5[2] * X[22]; a3 -= mr5[3] * X[23];
              mr5 = *(const LAS f32x4*)(Mm + 1788);
              __builtin_amdgcn_sched_barrier(0);
              a0 -= mr6[0] * X[24];
              X[25] = (a0 + a1) + (a2 + a3); dst[3300] = X[25]; }
            __builtin_amdgcn_sched_barrier(0);
            rh1 = src[3696] * cf[28];
            { float a0 = rh2, a1 = 0.f, a2 = 0.f, a3 = 0.f;
              mr6 = *(const LAS f32x4*)(Mm + 1792);
              __builtin_amdgcn_sched_barrier(0);
              a0 -= mr0[0] * X[0]; a1 -= mr0[1] * X[1]; a2 -= mr0[2] * X[2]; a3 -= mr0[3] * X[3];
              mr0 = *(const LAS f32x4*)(Mm + 1836);
              __builtin_amdgcn_sched_barrier(0);
              a0 -= mr1[0] * X[4]; a1 -= mr1[1] * X[5]; a2 -= mr1[2] * X[6]; a3 -= mr1[3] * X[7];
              mr1 = *(const LAS f32x4*)(Mm + 1840);
              __builtin_amdgcn_sched_barrier(0);
              a0 -= mr2[0] * X[8]; a1 -= mr2[1] * X[9]; a2 -= mr2[2] * X[10]; a3 -= mr2[3] * X[11];
              mr2 = *(const LAS f32x4*)(Mm + 1844);
              __builtin_amdgcn_sched_barrier(0);
              a0 -= mr3[0] * X[12]; a1 -= mr3[1] * X[13]; a2 -= mr3[2] * X[14]; a3 -= mr3[3] * X[15];
              mr3 = *(const LAS f32x4*)(Mm + 1848);
              __builtin_amdgcn_sched_barrier(0);
              a0 -= mr4[0] * X[16]; a1 -= mr4[1] * X[17]; a2 -= mr4[2] * X[18]; a3 -= mr4[3] * X[19];
              mr4 = *(const LAS f32x4*)(Mm + 1852);
              __builtin_amdgcn_sched_barrier(0);
              a0 -= mr5[0] * X[20]; a1 -= mr5[1] * X[21]; a2 -= mr5[2] * X[22]; a3 -= mr5[3] * X[23];
              mr5 = *(const LAS f32x4*)(Mm + 1856);
              __builtin_amdgcn_sched_barrier(0);
              a0 -= mr6[0] * X[24]; a1 -= mr6[1] * X[25];
              X[26] = (a0 + a1) + (a2 + a3); dst[3432] = X[26]; }
            __builtin_amdgcn_sched_barrier(0);
            rh2 = src[3828] * cf[29];
            { float a0 = rh0, a1 = 0.f, a2 = 0.f, a3 = 0.f;
              mr6 = *(const LAS f32x4*)(Mm + 1860);
              __builtin_amdgcn_sched_barrier(0);
              a0 -= mr0[0] * X[0]; a1 -= mr0[1] * X[1]; a2 -= mr0[2] * X[2]; a3 -= mr0[3] * X[3];
              mr0 = *(const LAS f32x4*)(Mm + 1904);
              __builtin_amdgcn_sched_barrier(0);
              a0 -= mr1[0] * X[4]; a1 -= mr1[1] * X[5]; a2 -= mr1[2] * X[6]; a3 -= mr1[3] * X[7];
              mr1 = *(const LAS f32x4*)(Mm + 1908);
              __builtin_amdgcn_sched_barrier(0);
              a0 -= mr2[0] * X[8]; a1 -= mr2[1] * X[9]; a2 -= mr2[2] * X[10]; a3 -= mr2[3] * X[11];
              mr2 = *(const LAS f32x4*)(Mm + 1912);
              __builtin_amdgcn_sched_barrier(0);
              a0 -= mr3[0] * X[12]; a1 -= mr3[1] * X[13]; a2 -= mr3[2] * X[14]; a3 -= mr3[3] * X[15];
              mr3 = *(const LAS f32x4*)(Mm + 1916);
              __builtin_amdgcn_sched_barrier(0);
              a0 -= mr4[0] * X[16]; a1 -= mr4[1] * X[17]; a2 -= mr4[2] * X[18]; a3 -= mr4[3] * X[19];
              mr4 = *(const LAS f32x4*)(Mm + 1920);
              __builtin_amdgcn_sched_barrier(0);
              a0 -= mr5[0] * X[20]; a1 -= mr5[1] * X[21]; a2 -= mr5[2] * X[22]; a3 -= mr5[3] * X[23];
              mr5 = *(const LAS f32x4*)(Mm + 1924);
              __builtin_amdgcn_sched_barrier(0);
              a0 -= mr6[0] * X[24]; a1 -= mr6[1] * X[25]; a2 -= mr6[2] * X[26];
              X[27] = (a0 + a1) + (a2 + a3); dst[3564] = X[27]; }
            __builtin_amdgcn_sched_barrier(0);
            rh0 = src[3960] * cf[30];
            { float a0 = rh1, a1 = 0.f, a2 = 0.f, a3 = 0.f;
              mr6 = *(const LAS f32x4*)(Mm + 1928);
              __builtin_amdgcn_sched_barrier(0);
              a0 -= mr0[0] * X[0]; a1 -= mr0[1] * X[1]; a2 -= mr0[2] * X[2]; a3 -= mr0[3] * X[3];
              mr0 = *(const LAS f32x4*)(Mm + 1972);
              __builtin_amdgcn_sched_barrier(0);
              a0 -= mr1[0] * X[4]; a1 -= mr1[1] * X[5]; a2 -= mr1[2] * X[6]; a3 -= mr1[3] * X[7];
              mr1 = *(const LAS f32x4*)(Mm + 1976);
              __builtin_amdgcn_sched_barrier(0);
              a0 -= mr2[0] * X[8]; a1 -= mr2[1] * X[9]; a2 -= mr2[2] * X[10]; a3 -= mr2[3] * X[11];
              mr2 = *(const LAS f32x4*)(Mm + 1980);
              __builtin_amdgcn_sched_barrier(0);
              a0 -= mr3[0] * X[12]; a1 -= mr3[1] * X[13]; a2 -= mr3[2] * X[14]; a3 -= mr3[3] * X[15];
              mr3 = *(const LAS f32x4*)(Mm + 1984);
              __builtin_amdgcn_sched_barrier(0);
              a0 -= mr4[0] * X[16]; a1 -= mr4[1] * X[17]; a2 -= mr4[2] * X[18]; a3 -= mr4[3] * X[19];
              mr4 = *(const LAS f32x4*)(Mm + 1988);
              __builtin_amdgcn_sched_barrier(0);
              a0 -= mr5[0] * X[20]; a1 -= mr5[1] * X[21]; a2 -= mr5[2] * X[22]; a3 -= mr5[3] * X[23];
              mr5 = *(const LAS f32x4*)(Mm + 1992);
              __builtin_amdgcn_sched_barrier(0);
              a0 -= mr6[0] * X[24]; a1 -= mr6[1] * X[25]; a2 -= mr6[2] * X[26]; a3 -= mr6[3] * X[27];
              X[28] = (a0 + a1) + (a2 + a3); dst[3696] = X[28]; }
            __builtin_amdgcn_sched_barrier(0);
            rh1 = src[4092] * cf[31];
            { float a0 = rh2, a1 = 0.f, a2 = 0.f, a3 = 0.f;
              mr6 = *(const LAS f32x4*)(Mm + 1996);
              __builtin_amdgcn_sched_barrier(0);
              a0 -= mr0[0] * X[0]; a1 -= mr0[1] * X[1]; a2 -= mr0[2] * X[2]; a3 -= mr0[3] * X[3];
              mr0 = *(const LAS f32x4*)(Mm + 2000);
              __builtin_amdgcn_sched_barrier(0);
              a0 -= mr1[0] * X[4]; a1 -= mr1[1] * X[5]; a2 -= mr1[2] * X[6]; a3 -= mr1[3] * X[7];
              mr1 = *(const LAS f32x4*)(Mm + 2040);
              __builtin_amdgcn_sched_barrier(0);
              a0 -= mr2[0] * X[8]; a1 -= mr2[1] * X[9]; a2 -= mr2[2] * X[10]; a3 -= mr2[3] * X[11];
              mr2 = *(const LAS f32x4*)(Mm + 2044);
              __builtin_amdgcn_sched_barrier(0);
              a0 -= mr3[0] * X[12]; a1 -= mr3[1] * X[13]; a2 -= mr3[2] * X[14]; a3 -= mr3[3] * X[15];
              mr3 = *(const LAS f32x4*)(Mm + 2048);
              __builtin_amdgcn_sched_barrier(0);
              a0 -= mr4[0] * X[16]; a1 -= mr4[1] * X[17]; a2 -= mr4[2] * X[18]; a3 -= mr4[3] * X[19];
              mr4 = *(const LAS f32x4*)(Mm + 2052);
              __builtin_amdgcn_sched_barrier(0);
              a0 -= mr5[0] * X[20]; a1 -= mr5[1] * X[21]; a2 -= mr5[2] * X[22]; a3 -= mr5[3] * X[23];
              mr5 = *(const LAS f32x4*)(Mm + 2056);
              __builtin_amdgcn_sched_barrier(0);
              a0 -= mr6[0] * X[24]; a1 -= mr6[1] * X[25]; a2 -= mr6[2] * X[26]; a3 -= mr6[3] * X[27];
              mr6 = *(const LAS f32x4*)(Mm + 2060);
              __builtin_amdgcn_sched_barrier(0);
              a0 -= mr0[0] * X[28];
              X[29] = (a0 + a1) + (a2 + a3); dst[3828] = X[29]; }
            __builtin_amdgcn_sched_barrier(0);
            rh2 = src[4224] * cf[32];
            { float a0 = rh0, a1 = 0.f, a2 = 0.f, a3 = 0.f;
              mr0 = *(const LAS f32x4*)(Mm + 2064);
              __builtin_amdgcn_sched_barrier(0);
              a0 -= mr1[0] * X[0]; a1 -= mr1[1] * X[1]; a2 -= mr1[2] * X[2]; a3 -= mr1[3] * X[3];
              mr1 = *(const LAS f32x4*)(Mm + 2068);
              __builtin_amdgcn_sched_barrier(0);
              a0 -= mr2[0] * X[4]; a1 -= mr2[1] * X[5]; a2 -= mr2[2] * X[6]; a3 -= mr2[3] * X[7];
              mr2 = *(const LAS f32x4*)(Mm + 2108);
              __builtin_amdgcn_sched_barrier(0);
              a0 -= mr3[0] * X[8]; a1 -= mr3[1] * X[9]; a2 -= mr3[2] * X[10]; a3 -= mr3[3] * X[11];
              mr3 = *(const LAS f32x4*)(Mm + 2112);
              __builtin_amdgcn_sched_barrier(0);
              a0 -= mr4[0] * X[12]; a1 -= mr4[1] * X[13]; a2 -= mr4[2] * X[14]; a3 -= mr4[3] * X[15];
              mr4 = *(const LAS f32x4*)(Mm + 2116);
              __builtin_amdgcn_sched_barrier(0);
              a0 -= mr5[0] * X[16]; a1 -= mr5[1] * X[17]; a2 -= mr5[2] * X[18]; a3 -= mr5[3] * X[19];
              mr5 = *(const LAS f32x4*)(Mm + 2120);
              __builtin_amdgcn_sched_barrier(0);
              a0 -= mr6[0] * X[20]; a1 -= mr6[1] * X[21]; a2 -= mr6[2] * X[22]; a3 -= mr6[3] * X[23];
              mr6 = *(const LAS f32x4*)(Mm + 2124);
              __builtin_amdgcn_sched_barrier(0);
              a0 -= mr0[0] * X[24]; a1 -= mr0[1] * X[25]; a2 -= mr0[2] * X[26]; a3 -= mr0[3] * X[27];
              mr0 = *(const LAS f32x4*)(Mm + 2128);
              __builtin_amdgcn_sched_barrier(0);
              a0 -= mr1[0] * X[28]; a1 -= mr1[1] * X[29];
              X[30] = (a0 + a1) + (a2 + a3); dst[3960] = X[30]; }
            __builtin_amdgcn_sched_barrier(0);
            rh0 = src[4356] * cf[33];
            { float a0 = rh1, a1 = 0.f, a2 = 0.f, a3 = 0.f;
              mr1 = *(const LAS f32x4*)(Mm + 2132);
              __builtin_amdgcn_sched_barrier(0);
              a0 -= mr2[0] * X[0]; a1 -= mr2[1] * X[1]; a2 -= mr2[2] * X[2]; a3 -= mr2[3] * X[3];
              mr2 = *(const LAS f32x4*)(Mm + 2136);
              __builtin_amdgcn_sched_barrier(0);
              a0 -= mr3[0] * X[4]; a1 -= mr3[1] * X[5]; a2 -= mr3[2] * X[6]; a3 -= mr3[3] * X[7];
              mr3 = *(const LAS f32x4*)(Mm + 2176);
              __builtin_amdgcn_sched_barrier(0);
              a0 -= mr4[0] * X[8]; a1 -= mr4[1] * X[9]; a2 -= mr4[2] * X[10]; a3 -= mr4[3] * X[11];
              mr4 = *(const LAS f32x4*)(Mm + 2180);
              __builtin_amdgcn_sched_barrier(0);
              a0 -= mr5[0] * X[12]; a1 -= mr5[1] * X[13]; a2 -= mr5[2] * X[14]; a3 -= mr5[3] * X[15];
              mr5 = *(const LAS f32x4*)(Mm + 2184);
              __builtin_amdgcn_sched_barrier(0);
              a0 -= mr6[0] * X[16]; a1 -= mr6[1] * X[17]; a2 -= mr6[2] * X[18]; a3 -= mr6[3] * X[19];
              mr6 = *(const LAS f32x4*)(Mm + 2188);
              __builtin_amdgcn_sched_barrier(0);
              a0 -= mr0[0] * X[20]; a1 -= mr0[1] * X[21]; a2 -= mr0[2] * X[22]; a3 -= mr0[3] * X[23];
              mr0 = *(const LAS f32x4*)(Mm + 2192);
              __builtin_amdgcn_sched_barrier(0);
              a0 -= mr1[0] * X[24]; a1 -= mr1[1] * X[25]; a2 -= mr1[2] * X[26]; a3 -= mr1[3] * X[27];
              mr1 = *(const LAS f32x4*)(Mm + 2196);
              __builtin_amdgcn_sched_barrier(0);
              a0 -= mr2[0] * X[28]; a1 -= mr2[1] * X[29]; a2 -= mr2[2] * X[30];
              X[31] = (a0 + a1) + (a2 + a3); dst[4092] = X[31]; }
            __builtin_amdgcn_sched_barrier(0);
            rh1 = src[4488] * cf[34];
            { float a0 = rh2, a1 = 0.f, a2 = 0.f, a3 = 0.f;
              mr2 = *(const LAS f32x4*)(Mm + 2200);
              __builtin_amdgcn_sched_barrier(0);
              a0 -= mr3[0] * X[0]; a1 -= mr3[1] * X[1]; a2 -= mr3[2] * X[2]; a3 -= mr3[3] * X[3];
              mr3 = *(const LAS f32x4*)(Mm + 2204);
              __builtin_amdgcn_sched_barrier(0);
              a0 -= mr4[0] * X[4]; a1 -= mr4[1] * X[5]; a2 -= mr4[2] * X[6]; a3 -= mr4[3] * X[7];
              mr4 = *(const LAS f32x4*)(Mm + 2244);
              __builtin_amdgcn_sched_barrier(0);
              a0 -= mr5[0] * X[8]; a1 -= mr5[1] * X[9]; a2 -= mr5[2] * X[10]; a3 -= mr5[3] * X[11];
              mr5 = *(const LAS f32x4*)(Mm + 2248);
              __builtin_amdgcn_sched_barrier(0);
              a0 -= mr6[0] * X[12]; a1 -= mr6[1] * X[13]; a2 -= mr6[2] * X[14]; a3 -= mr6[3] * X[15];
              mr6 = *(const LAS f32x4*)(Mm + 2252);
              __builtin_amdgcn_sched_barrier(0);
              a0 -= mr0[0] * X[16]; a1 -= mr0[1] * X[17]; a2 -= mr0[2] * X[18]; a3 -= mr0[3] * X[19];
              mr0 = *(const LAS f32x4*)(Mm + 2256);
              __builtin_amdgcn_sched_barrier(0);
              a0 -= mr1[0] * X[20]; a1 -= mr1[1] * X[21]; a2 -= mr1[2] * X[22]; a3 -= mr1[3] * X[23];
              mr1 = *(const LAS f32x4*)(Mm + 2260);
              __builtin_amdgcn_sched_barrier(0);
              a0 -= mr2[0] * X[24]; a1 -= mr2[1] * X[25]; a2 -= mr2[2] * X[26]; a3 -= mr2[3] * X[27];
              mr2 = *(const LAS f32x4*)(Mm + 2264);
              __builtin_amdgcn_sched_barrier(0);
              a0 -= mr3[0] * X[28]; a1 -= mr3[1] * X[29]; a2 -= mr3[2] * X[30]; a3 -= mr3[3] * X[31];
              X[32] = (a0 + a1) + (a2 + a3); dst[4224] = X[32]; }
            __builtin_amdgcn_sched_barrier(0);
            rh2 = src[4620] * cf[35];
            { float a0 = rh0, a1 = 0.f, a2 = 0.f, a3 = 0.f;
              mr3 = *(const LAS f32x4*)(Mm + 2268);
              __builtin_amdgcn_sched_barrier(0);
              a0 -= mr4[0] * X[0]; a1 -= mr4[1] * X[1]; a2 -= mr4[2] * X[2]; a3 -= mr4[3] * X[3];
              mr4 = *(const LAS f32x4*)(Mm + 2272);
              __builtin_amdgcn_sched_barrier(0);
              a0 -= mr5[0] * X[4]; a1 -= mr5[1] * X[5]; a2 -= mr5[2] * X[6]; a3 -= mr5[3] * X[7];
              mr5 = *(const LAS f32x4*)(Mm + 2276);
              __builtin_amdgcn_sched_barrier(0);
              a0 -= mr6[0] * X[8]; a1 -= mr6[1] * X[9]; a2 -= mr6[2] * X[10]; a3 -= mr6[3] * X[11];
              mr6 = *(const LAS f32x4*)(Mm + 2312);
              __builtin_amdgcn_sched_barrier(0);
              a0 -= mr0[0] * X[12]; a1 -= mr0[1] * X[13]; a2 -= mr0[2] * X[14]; a3 -= mr0[3] * X[15];
              mr0 = *(const LAS f32x4*)(Mm + 2316);
              __builtin_amdgcn_sched_barrier(0);
              a0 -= mr1[0] * X[16]; a1 -= mr1[1] * X[17]; a2 -= mr1[2] * X[18]; a3 -= mr1[3] * X[19];
              mr1 = *(const LAS f32x4*)(Mm + 2320);
              __builtin_amdgcn_sched_barrier(0);
              a0 -= mr2[0] * X[20]; a1 -= mr2[1] * X[21]; a2 -= mr2[2] * X[22]; a3 -= mr2[3] * X[23];
              mr2 = *(const LAS f32x4*)(Mm + 2324);
              __builtin_amdgcn_sched_barrier(0);
              a0 -= mr3[0] * X[24]; a1 -= mr3[1] * X[25]; a2 -= mr3[2] * X[26]; a3 -= mr3[3] * X[27];
              mr3 = *(const LAS f32x4*)(Mm + 2328);
              __builtin_amdgcn_sched_barrier(0);
              a0 -= mr4[0] * X[28]; a1 -= mr4[1] * X[29]; a2 -= mr4[2] * X[30]; a3 -= mr4[3] * X[31];
              mr4 = *(const LAS f32x4*)(Mm + 2332);
              __builtin_amdgcn_sched_barrier(0);
              a0 -= mr5[0] * X[32];
              X[33] = (a0 + a1) + (a2 + a3); dst[4356] = X[33]; }
            __builtin_amdgcn_sched_barrier(0);
            rh0 = src[4752] * cf[36];
            { float a0 = rh1, a1 = 0.f, a2 = 0.f, a3 = 0.f;
              mr5 = *(const LAS f32x4*)(Mm + 2336);
              __builtin_amdgcn_sched_barrier(0);
              a0 -= mr6[0] * X[0]; a1 -= mr6[1] * X[1]; a2 -= mr6[2] * X[2]; a3 -= mr6[3] * X[3];
              mr6 = *(const LAS f32x4*)(Mm + 2340);
              __builtin_amdgcn_sched_barrier(0);
              a0 -= mr0[0] * X[4]; a1 -= mr0[1] * X[5]; a2 -= mr0[2] * X[6]; a3 -= mr0[3] * X[7];
              mr0 = *(const LAS f32x4*)(Mm + 2344);
              __builtin_amdgcn_sched_barrier(0);
              a0 -= mr1[0] * X[8]; a1 -= mr1[1] * X[9]; a2 -= mr1[2] * X[10]; a3 -= mr1[3] * X[11];
              mr1 = *(const LAS f32x4*)(Mm + 2380);
              __builtin_amdgcn_sched_barrier(0);
              a0 -= mr2[0] * X[12]; a1 -= mr2[1] * X[13]; a2 -= mr2[2] * X[14]; a3 -= mr2[3] * X[15];
              mr2 = *(const LAS f32x4*)(Mm + 2384);
              __builtin_amdgcn_sched_barrier(0);
              a0 -= mr3[0] * X[16]; a1 -= mr3[1] * X[17]; a2 -= mr3[2] * X[18]; a3 -= mr3[3] * X[19];
              mr3 = *(const LAS f32x4*)(Mm + 2388);
              __builtin_amdgcn_sched_barrier(0);
              a0 -= mr4[0] * X[20]; a1 -= mr4[1] * X[21]; a2 -= mr4[2] * X[22]; a3 -= mr4[3] * X[23];
              mr4 = *(const LAS f32x4*)(Mm + 2392);
              __builtin_amdgcn_sched_barrier(0);
              a0 -= mr5[0] * X[24]; a1 -= mr5[1] * X[25]; a2 -= mr5[2] * X[26]; a3 -= mr5[3] * X[27];
              mr5 = *(const LAS f32x4*)(Mm + 2396);
              __builtin_amdgcn_sched_barrier(0);
              a0 -= mr6[0] * X[28]; a1 -= mr6[1] * X[29]; a2 -= mr6[2] * X[30]; a3 -= mr6[3] * X[31];
              mr6 = *(const LAS f32x4*)(Mm + 2400);
              __builtin_amdgcn_sched_barrier(0);
              a0 -= mr0[0] * X[32]; a1 -= mr0[1] * X[33];
              X[34] = (a0 + a1) + (a2 + a3); dst[4488] = X[34]; }
            __builtin_amdgcn_sched_barrier(0);
            rh1 = src[4884] * cf[37];
            { float a0 = rh2, a1 = 0.f, a2 = 0.f, a3 = 0.f;
              mr0 = *(const LAS f32x4*)(Mm + 2404);
              __builtin_amdgcn_sched_barrier(0);
              a0 -= mr1[0] * X[0]; a1 -= mr1[1] * X[1]; a2 -= mr1[2] * X[2]; a3 -= mr1[3] * X[3];
              mr1 = *(const LAS f32x4*)(Mm + 2408);
              __builtin_amdgcn_sched_barrier(0);
              a0 -= mr2[0] * X[4]; a1 -= mr2[1] * X[5]; a2 -= mr2[2] * X[6]; a3 -= mr2[3] * X[7];
              mr2 = *(const LAS f32x4*)(Mm + 2412);
              __builtin_amdgcn_sched_barrier(0);
              a0 -= mr3[0] * X[8]; a1 -= mr3[1] * X[9]; a2 -= mr3[2] * X[10]; a3 -= mr3[3] * X[11];
              mr3 = *(const LAS f32x4*)(Mm + 2448);
              __builtin_amdgcn_sched_barrier(0);
              a0 -= mr4[0] * X[12]; a1 -= mr4[1] * X[13]; a2 -= mr4[2] * X[14]; a3 -= mr4[3] * X[15];
              mr4 = *(const LAS f32x4*)(Mm + 2452);
              __builtin_amdgcn_sched_barrier(0);
              a0 -= mr5[0] * X[16]; a1 -= mr5[1] * X[17]; a2 -= mr5[2] * X[18]; a3 -= mr5[3] * X[19];
              mr5 = *(const LAS f32x4*)(Mm + 2456);
              __builtin_amdgcn_sched_barrier(0);
              a0 -= mr6[0] * X[20]; a1 -= mr6[1] * X[21]; a2 -= mr6[2] * X[22]; a3 -= mr6[3] * X[23];
              mr6 = *(const LAS f32x4*)(Mm + 2460);
              __builtin_amdgcn_sched_barrier(0);
              a0 -= mr0[0] * X[24]; a1 -= mr0[1] * X[25]; a2 -= mr0[2] * X[26]; a3 -= mr0[3] * X[27];
              mr0 = *(const LAS f32x4*)(Mm + 2464);
              __builtin_amdgcn_sched_barrier(0);
              a0 -= mr1[0] * X[28]; a1 -= mr1[1] * X[29]; a2 -= mr1[2] * X[30]; a3 -= mr1[3] * X[31];
              mr1 = *(const LAS f32x4*)(Mm + 2468);
              __builtin_amdgcn_sched_barrier(0);
              a0 -= mr2[0] * X[32]; a1 -= mr2[1] * X[33]; a2 -= mr2[2] * X[34];
              X[35] = (a0 + a1) + (a2 + a3); dst[4620] = X[35]; }
            __builtin_amdgcn_sched_barrier(0);
            rh2 = src[5016] * cf[38];
            { float a0 = rh0, a1 = 0.f, a2 = 0.f, a3 = 0.f;
              mr2 = *(const LAS f32x4*)(Mm + 2472);
              __builtin_amdgcn_sched_barrier(0);
              a0 -= mr3[0] * X[0]; a1 -= mr3[1] * X[1]; a2 -= mr3[2] * X[2]; a3 -= mr3[3] * X[3];
              mr3 = *(const LAS f32x4*)(Mm + 2476);
              __builtin_amdgcn_sched_barrier(0);
              a0 -= mr4[0] * X[4]; a1 -= mr4[1] * X[5]; a2 -= mr4[2] * X[6]; a3 -= mr4[3] * X[7];
              mr4 = *(const LAS f32x4*)(Mm + 2480);
              __builtin_amdgcn_sched_barrier(0);
              a0 -= mr5[0] * X[8]; a1 -= mr5[1] * X[9]; a2 -= mr5[2] * X[10]; a3 -= mr5[3] * X[11];
              mr5 = *(const LAS f32x4*)(Mm + 2516);
              __builtin_amdgcn_sched_barrier(0);
              a0 -= mr6[0] * X[12]; a1 -= mr6[1] * X[13]; a2 -= mr6[2] * X[14]; a3 -= mr6[3] * X[15];
              mr6 = *(const LAS f32x4*)(Mm + 2520);
              __builtin_amdgcn_sched_barrier(0);
              a0 -= mr0[0] * X[16]; a1 -= mr0[1] * X[17]; a2 -= mr0[2] * X[18]; a3 -= mr0[3] * X[19];
              mr0 = *(const LAS f32x4*)(Mm + 2524);
              __builtin_amdgcn_sched_barrier(0);
              a0 -= mr1[0] * X[20]; a1 -= mr1[1] * X[21]; a2 -= mr1[2] * X[22]; a3 -= mr1[3] * X[23];
              mr1 = *(const LAS f32x4*)(Mm + 2528);
              __builtin_amdgcn_sched_barrier(0);
              a0 -= mr2[0] * X[24]; a1 -= mr2[1] * X[25]; a2 -= mr2[2] * X[26]; a3 -= mr2[3] * X[27];
              mr2 = *(const LAS f32x4*)(Mm + 2532);
              __builtin_amdgcn_sched_barrier(0);
              a0 -= mr3[0] * X[28]; a1 -= mr3[1] * X[29]; a2 -= mr3[2] * X[30]; a3 -= mr3[3] * X[31];
              mr3 = *(const LAS f32x4*)(Mm + 2536);
              __builtin_amdgcn_sched_barrier(0);
              a0 -= mr4[0] * X[32]; a1 -= mr4[1] * X[33]; a2 -= mr4[2] * X[34]; a3 -= mr4[3] * X[35];
              X[36] = (a0 + a1) + (a2 + a3); dst[4752] = X[36]; }
            __builtin_amdgcn_sched_barrier(0);
            rh0 = src[5148] * cf[39];
            { float a0 = rh1, a1 = 0.f, a2 = 0.f, a3 = 0.f;
              mr4 = *(const LAS f32x4*)(Mm + 2540);
              __builtin_amdgcn_sched_barrier(0);
              a0 -= mr5[0] * X[0]; a1 -= mr5[1] * X[1]; a2 -= mr5[2] * X[2]; a3 -= mr5[3] * X[3];
              mr5 = *(const LAS f32x4*)(Mm + 2544);
              __builtin_amdgcn_sched_barrier(0);
              a0 -= mr6[0] * X[4]; a1 -= mr6[1] * X[5]; a2 -= mr6[2] * X[6]; a3 -= mr6[3] * X[7];
              mr6 = *(const LAS f32x4*)(Mm + 2548);
              __builtin_amdgcn_sched_barrier(0);
              a0 -= mr0[0] * X[8]; a1 -= mr0[1] * X[9]; a2 -= mr0[2] * X[10]; a3 -= mr0[3] * X[11];
              mr0 = *(const LAS f32x4*)(Mm + 2552);
              __builtin_amdgcn_sched_barrier(0);
              a0 -= mr1[0] * X[12]; a1 -= mr1[1] * X[13]; a2 -= mr1[2] * X[14]; a3 -= mr1[3] * X[15];
              mr1 = *(const LAS f32x4*)(Mm + 2584);
              __builtin_amdgcn_sched_barrier(0);
              a0 -= mr2[0] * X[16]; a1 -= mr2[1] * X[17]; a2 -= mr2[2] * X[18]; a3 -= mr2[3] * X[19];
              mr2 = *(const LAS f32x4*)(Mm + 2588);
              __builtin_amdgcn_sched_barrier(0);
              a0 -= mr3[0] * X[20]; a1 -= mr3[1] * X[21]; a2 -= mr3[2] * X[22]; a3 -= mr3[3] * X[23];
              mr3 = *(const LAS f32x4*)(Mm + 2592);
              __builtin_amdgcn_sched_barrier(0);
              a0 -= mr4[0] * X[24]; a1 -= mr4[1] * X[25]; a2 -= mr4[2] * X[26]; a3 -= mr4[3] * X[27];
              mr4 = *(const LAS f32x4*)(Mm + 2596);
              __builtin_amdgcn_sched_barrier(0);
              a0 -= mr5[0] * X[28]; a1 -= mr5[1] * X[29]; a2 -= mr5[2] * X[30]; a3 -= mr5[3] * X[31];
              mr5 = *(const LAS f32x4*)(Mm + 2600);
              __builtin_amdgcn_sched_barrier(0);
              a0 -= mr6[0] * X[32]; a1 -= mr6[1] * X[33]; a2 -= mr6[2] * X[34]; a3 -= mr6[3] * X[35];
              mr6 = *(const LAS f32x4*)(Mm + 2604);
              __builtin_amdgcn_sched_barrier(0);
              a0 -= mr0[0] * X[36];
              X[37] = (a0 + a1) + (a2 + a3); dst[4884] = X[37]; }
            __builtin_amdgcn_sched_barrier(0);
            rh1 = src[5280] * cf[40];
            { float a0 = rh2, a1 = 0.f, a2 = 0.f, a3 = 0.f;
              mr0 = *(const LAS f32x4*)(Mm + 2608);
              __builtin_amdgcn_sched_barrier(0);
              a0 -= mr1[0] * X[0]; a1 -= mr1[1] * X[1]; a2 -= mr1[2] * X[2]; a3 -= mr1[3] * X[3];
              mr1 = *(const LAS f32x4*)(Mm + 2612);
              __builtin_amdgcn_sched_barrier(0);
              a0 -= mr2[0] * X[4]; a1 -= mr2[1] * X[5]; a2 -= mr2[2] * X[6]; a3 -= mr2[3] * X[7];
              mr2 = *(const LAS f32x4*)(Mm + 2616);
              __builtin_amdgcn_sched_barrier(0);
              a0 -= mr3[0] * X[8]; a1 -= mr3[1] * X[9]; a2 -= mr3[2] * X[10]; a3 -= mr3[3] * X[11];
              mr3 = *(const LAS f32x4*)(Mm + 2620);
              __builtin_amdgcn_sched_barrier(0);
              a0 -= mr4[0] * X[12]; a1 -= mr4[1] * X[13]; a2 -= mr4[2] * X[14]; a3 -= mr4[3] * X[15];
              mr4 = *(const LAS f32x4*)(Mm + 2652);
              __builtin_amdgcn_sched_barrier(0);
              a0 -= mr5[0] * X[16]; a1 -= mr5[1] * X[17]; a2 -= mr5[2] * X[18]; a3 -= mr5[3] * X[19];
              mr5 = *(const LAS f32x4*)(Mm + 2656);
              __builtin_amdgcn_sched_barrier(0);
              a0 -= mr6[0] * X[20]; a1 -= mr6[1] * X[21]; a2 -= mr6[2] * X[22]; a3 -= mr6[3] * X[23];
              mr6 = *(const LAS f32x4*)(Mm + 2660);
              __builtin_amdgcn_sched_barrier(0);
              a0 -= mr0[0] * X[24]; a1 -= mr0[1] * X[25]; a2 -= mr0[2] * X[26]; a3 -= mr0[3] * X[27];
              mr0 = *(const LAS f32x4*)(Mm + 2664);
              __builtin_amdgcn_sched_barrier(0);
              a0 -= mr1[0] * X[28]; a1 -= mr1[1] * X[29]; a2 -= mr1[2] * X[30]; a3 -= mr1[3] * X[31];
              mr1 = *(const LAS f32x4*)(Mm + 2668);
              __builtin_amdgcn_sched_barrier(0);
              a0 -= mr2[0] * X[32]; a1 -= mr2[1] * X[33]; a2 -= mr2[2] * X[34]; a3 -= mr2[3] * X[35];
              mr2 = *(const LAS f32x4*)(Mm + 2672);
              __builtin_amdgcn_sched_barrier(0);
              a0 -= mr3[0] * X[36]; a1 -= mr3[1] * X[37];
              X[38] = (a0 + a1) + (a2 + a3); dst[5016] = X[38]; }
            __builtin_amdgcn_sched_barrier(0);
            rh2 = src[5412] * cf[41];
            { float a0 = rh0, a1 = 0.f, a2 = 0.f, a3 = 0.f;
              mr3 = *(const LAS f32x4*)(Mm + 2676);
              __builtin_amdgcn_sched_barrier(0);
              a0 -= mr4[0] * X[0]; a1 -= mr4[1] * X[1]; a2 -= mr4[2] * X[2]; a3 -= mr4[3] * X[3];
              mr4 = *(const LAS f32x4*)(Mm + 2680);
              __builtin_amdgcn_sched_barrier(0);
              a0 -= mr5[0] * X[4]; a1 -= mr5[1] * X[5]; a2 -= mr5[2] * X[6]; a3 -= mr5[3] * X[7];
              mr5 = *(const LAS f32x4*)(Mm + 2684);
              __builtin_amdgcn_sched_barrier(0);
              a0 -= mr6[0] * X[8]; a1 -= mr6[1] * X[9]; a2 -= mr6[2] * X[10]; a3 -= mr6[3] * X[11];
              mr6 = *(const LAS f32x4*)(Mm + 2688);
              __builtin_amdgcn_sched_barrier(0);
              a0 -= mr0[0] * X[12]; a1 -= mr0[1] * X[13]; a2 -= mr0[2] * X[14]; a3 -= mr0[3] * X[15];
              mr0 = *(const LAS f32x4*)(Mm + 2720);
              __builtin_amdgcn_sched_barrier(0);
              a0 -= mr1[0] * X[16]; a1 -= mr1[1] * X[17]; a2 -= mr1[2] * X[18]; a3 -= mr1[3] * X[19];
              mr1 = *(const LAS f32x4*)(Mm + 2724);
              __builtin_amdgcn_sched_barrier(0);
              a0 -= mr2[0] * X[20]; a1 -= mr2[1] * X[21]; a2 -= mr2[2] * X[22]; a3 -= mr2[3] * X[23];
              mr2 = *(const LAS f32x4*)(Mm + 2728);
              __builtin_amdgcn_sched_barrier(0);
              a0 -= mr3[0] * X[24]; a1 -= mr3[1] * X[25]; a2 -= mr3[2] * X[26]; a3 -= mr3[3] * X[27];
              mr3 = *(const LAS f32x4*)(Mm + 2732);
              __builtin_amdgcn_sched_barrier(0);
              a0 -= mr4[0] * X[28]; a1 -= mr4[1] * X[29]; a2 -= mr4[2] * X[30]; a3 -= mr4[3] * X[31];
              mr4 = *(const LAS f32x4*)(Mm + 2736);
              __builtin_amdgcn_sched_barrier(0);
              a0 -= mr5[0] * X[32]; a1 -= mr5[1] * X[33]; a2 -= mr5[2] * X[34]; a3 -= mr5[3] * X[35];
              mr5 = *(const LAS f32x4*)(Mm + 2740);
              __builtin_amdgcn_sched_barrier(0);
              a0 -= mr6[0] * X[36]; a1 -= mr6[1] * X[37]; a2 -= mr6[2] * X[38];
              X[39] = (a0 + a1) + (a2 + a3); dst[5148] = X[39]; }
            __builtin_amdgcn_sched_barrier(0);
            rh0 = src[5544] * cf[42];
            { float a0 = rh1, a1 = 0.f, a2 = 0.f, a3 = 0.f;
              mr6 = *(const LAS f32x4*)(Mm + 2744);
              __builtin_amdgcn_sched_barrier(0);
              a0 -= mr0[0] * X[0]; a1 -= mr0[1] * X[1]; a2 -= mr0[2] * X[2]; a3 -= mr0[3] * X[3];
              mr0 = *(const LAS f32x4*)(Mm + 2748);
              __builtin_amdgcn_sched_barrier(0);
              a0 -= mr1[0] * X[4]; a1 -= mr1[1] * X[5]; a2 -= mr1[2] * X[6]; a3 -= mr1[3] * X[7];
              mr1 = *(const LAS f32x4*)(Mm + 2752);
              __builtin_amdgcn_sched_barrier(0);
              a0 -= mr2[0] * X[8]; a1 -= mr2[1] * X[9]; a2 -= mr2[2] * X[10]; a3 -= mr2[3] * X[11];
              mr2 = *(const LAS f32x4*)(Mm + 2756);
              __builtin_amdgcn_sched_barrier(0);
              a0 -= mr3[0] * X[12]; a1 -= mr3[1] * X[13]; a2 -= mr3[2] * X[14]; a3 -= mr3[3] * X[15];
              mr3 = *(const LAS f32x4*)(Mm + 2788);
              __builtin_amdgcn_sched_barrier(0);
              a0 -= mr4[0] * X[16]; a1 -= mr4[1] * X[17]; a2 -= mr4[2] * X[18]; a3 -= mr4[3] * X[19];
              mr4 = *(const LAS f32x4*)(Mm + 2792);
              __builtin_amdgcn_sched_barrier(0);
              a0 -= mr5[0] * X[20]; a1 -= mr5[1] * X[21]; a2 -= mr5[2] * X[22]; a3 -= mr5[3] * X[23];
              mr5 = *(const LAS f32x4*)(Mm + 2796);
              __builtin_amdgcn_sched_barrier(0);
              a0 -= mr6[0] * X[24]; a1 -= mr6[1] * X[25]; a2 -= mr6[2] * X[26]; a3 -= mr6[3] * X[27];
              mr6 = *(const LAS f32x4*)(Mm + 2800);
              __builtin_amdgcn_sched_barrier(0);
              a0 -= mr0[0] * X[28]; a1 -= mr0[1] * X[29]; a2 -= mr0[2] * X[30]; a3 -= mr0[3] * X[31];
              mr0 = *(const LAS f32x4*)(Mm + 2804);
              __builtin_amdgcn_sched_barrier(0);
              a0 -= mr1[0] * X[32]; a1 -= mr1[1] * X[33]; a2 -= mr1[2] * X[34]; a3 -= mr1[3] * X[35];
              mr1 = *(const LAS f32x4*)(Mm + 2808);
              __builtin_amdgcn_sched_barrier(0);
              a0 -= mr2[0] * X[36]; a1 -= mr2[1] * X[37]; a2 -= mr2[2] * X[38]; a3 -= mr2[3] * X[39];
              X[40] = (a0 + a1) + (a2 + a3); dst[5280] = X[40]; }
            __builtin_amdgcn_sched_barrier(0);
            rh1 = src[5676] * cf[43];
            { float a0 = rh2, a1 = 0.f, a2 = 0.f, a3 = 0.f;
              mr2 = *(const LAS f32x4*)(Mm + 2812);
              __builtin_amdgcn_sched_barrier(0);
              a0 -= mr3[0] * X[0]; a1 -= mr3[1] * X[1]; a2 -= mr3[2] * X[2]; a3 -= mr3[3] * X[3];
              mr3 = *(const LAS f32x4*)(Mm + 2816);
              __builtin_amdgcn_sched_barrier(0);
              a0 -= mr4[0] * X[4]; a1 -= mr4[1] * X[5]; a2 -= mr4[2] * X[6]; a3 -= mr4[3] * X[7];
              mr4 = *(const LAS f32x4*)(Mm + 2820);
              __builtin_amdgcn_sched_barrier(0);
              a0 -= mr5[0] * X[8]; a1 -= mr5[1] * X[9]; a2 -= mr5[2] * X[10]; a3 -= mr5[3] * X[11];
              mr5 = *(const LAS f32x4*)(Mm + 2824);
              __builtin_amdgcn_sched_barrier(0);
              a0 -= mr6[0] * X[12]; a1 -= mr6[1] * X[13]; a2 -= mr6[2] * X[14]; a3 -= mr6[3] * X[15];
              mr6 = *(const LAS f32x4*)(Mm + 2828);
              __builtin_amdgcn_sched_barrier(0);
              a0 -= mr0[0] * X[16]; a1 -= mr0[1] * X[17]; a2 -= mr0[2] * X[18]; a3 -= mr0[3] * X[19];
              mr0 = *(const LAS f32x4*)(Mm + 2856);
              __builtin_amdgcn_sched_barrier(0);
              a0 -= mr1[0] * X[20]; a1 -= mr1[1] * X[21]; a2 -= mr1[2] * X[22]; a3 -= mr1[3] * X[23];
              mr1 = *(const LAS f32x4*)(Mm + 2860);
              __builtin_amdgcn_sched_barrier(0);
              a0 -= mr2[0] * X[24]; a1 -= mr2[1] * X[25]; a2 -= mr2[2] * X[26]; a3 -= mr2[3] * X[27];
              mr2 = *(const LAS f32x4*)(Mm + 2864);
              __builtin_amdgcn_sched_barrier(0);
              a0 -= mr3[0] * X[28]; a1 -= mr3[1] * X[29]; a2 -= mr3[2] * X[30]; a3 -= mr3[3] * X[31];
              mr3 = *(const LAS f32x4*)(Mm + 2868);
              __builtin_amdgcn_sched_barrier(0);
              a0 -= mr4[0] * X[32]; a1 -= mr4[1] * X[33]; a2 -= mr4[2] * X[34]; a3 -= mr4[3] * X[35];
              mr4 = *(const LAS f32x4*)(Mm + 2872);
              __builtin_amdgcn_sched_barrier(0);
              a0 -= mr5[0] * X[36]; a1 -= mr5[1] * X[37]; a2 -= mr5[2] * X[38]; a3 -= mr5[3] * X[39];
              mr5 = *(const LAS f32x4*)(Mm + 2876);
              __builtin_amdgcn_sched_barrier(0);
              a0 -= mr6[0] * X[40];
              X[41] = (a0 + a1) + (a2 + a3); dst[5412] = X[41]; }
            __builtin_amdgcn_sched_barrier(0);
            rh2 = src[5808] * cf[44];
            { float a0 = rh0, a1 = 0.f, a2 = 0.f, a3 = 0.f;
              mr6 = *(const LAS f32x4*)(Mm + 2880);
              __builtin_amdgcn_sched_barrier(0);
              a0 -= mr0[0] * X[0]; a1 -= mr0[1] * X[1]; a2 -= mr0[2] * X[2]; a3 -= mr0[3] * X[3];
              mr0 = *(const LAS f32x4*)(Mm + 2884);
              __builtin_amdgcn_sched_barrier(0);
              a0 -= mr1[0] * X[4]; a1 -= mr1[1] * X[5]; a2 -= mr1[2] * X[6]; a3 -= mr1[3] * X[7];
              mr1 = *(const LAS f32x4*)(Mm + 2888);
              __builtin_amdgcn_sched_barrier(0);
              a0 -= mr2[0] * X[8]; a1 -= mr2[1] * X[9]; a2 -= mr2[2] * X[10]; a3 -= mr2[3] * X[11];
              mr2 = *(const LAS f32x4*)(Mm + 2892);
              __builtin_amdgcn_sched_barrier(0);
              a0 -= mr3[0] * X[12]; a1 -= mr3[1] * X[13]; a2 -= mr3[2] * X[14]; a3 -= mr3[3] * X[15];
              mr3 = *(const LAS f32x4*)(Mm + 2896);
              __builtin_amdgcn_sched_barrier(0);
              a0 -= mr4[0] * X[16]; a1 -= mr4[1] * X[17]; a2 -= mr4[2] * X[18]; a3 -= mr4[3] * X[19];
              mr4 = *(const LAS f32x4*)(Mm + 2924);
              __builtin_amdgcn_sched_barrier(0);
              a0 -= mr5[0] * X[20]; a1 -= mr5[1] * X[21]; a2 -= mr5[2] * X[22]; a3 -= mr5[3] * X[23];
              mr5 = *(const LAS f32x4*)(Mm + 2928);
              __builtin_amdgcn_sched_barrier(0);
              a0 -= mr6[0] * X[24]; a1 -= mr6[1] * X[25]; a2 -= mr6[2] * X[26]; a3 -= mr6[3] * X[27];
              mr6 = *(const LAS f32x4*)(Mm + 2932);
              __builtin_amdgcn_sched_barrier(0);
              a0 -= mr0[0] * X[28]; a1 -= mr0[1] * X[29]; a2 -= mr0[2] * X[30]; a3 -= mr0[3] * X[31];
              mr0 = *(const LAS f32x4*)(Mm + 2936);
              __builtin_amdgcn_sched_barrier(0);
              a0 -= mr1[0] * X[32]; a1 -= mr1[1] * X[33]; a2 -= mr1[2] * X[34]; a3 -= mr1[3] * X[35];
              mr1 = *(const LAS f32x4*)(Mm + 2940);
              __builtin_amdgcn_sched_barrier(0);
              a0 -= mr2[0] * X[36]; a1 -= mr2[1] * X[37]; a2 -= mr2[2] * X[38]; a3 -= mr2[3] * X[39];
              mr2 = *(const LAS f32x4*)(Mm + 2944);
              __builtin_amdgcn_sched_barrier(0);
              a0 -= mr3[0] * X[40]; a1 -= mr3[1] * X[41];
              X[42] = (a0 + a1) + (a2 + a3); dst[5544] = X[42]; }
            __builtin_amdgcn_sched_barrier(0);
            rh0 = src[5940] * cf[45];
            { float a0 = rh1, a1 = 0.f, a2 = 0.f, a3 = 0.f;
              mr3 = *(const LAS f32x4*)(Mm + 2948);
              __builtin_amdgcn_sched_barrier(0);
              a0 -= mr4[0] * X[0]; a1 -= mr4[1] * X[1]; a2 -= mr4[2] * X[2]; a3 -= mr4[3] * X[3];
              mr4 = *(const LAS f32x4*)(Mm + 2952);
              __builtin_amdgcn_sched_barrier(0);
              a0 -= mr5[0] * X[4]; a1 -= mr5[1] * X[5]; a2 -= mr5[2] * X[6]; a3 -= mr5[3] * X[7];
              mr5 = *(const LAS f32x4*)(Mm + 2956);
              __builtin_amdgcn_sched_barrier(0);
              a0 -= mr6[0] * X[8]; a1 -= mr6[1] * X[9]; a2 -= mr6[2] * X[10]; a3 -= mr6[3] * X[11];
              mr6 = *(const LAS f32x4*)(Mm + 2960);
              __builtin_amdgcn_sched_barrier(0);
              a0 -= mr0[0] * X[12]; a1 -= mr0[1] * X[13]; a2 -= mr0[2] * X[14]; a3 -= mr0[3] * X[15];
              mr0 = *(const LAS f32x4*)(Mm + 2964);
              __builtin_amdgcn_sched_barrier(0);
              a0 -= mr1[0] * X[16]; a1 -= mr1[1] * X[17]; a2 -= mr1[2] * X[18]; a3 -= mr1[3] * X[19];
              mr1 = *(const LAS f32x4*)(Mm + 2992);
              __builtin_amdgcn_sched_barrier(0);
              a0 -= mr2[0] * X[20]; a1 -= mr2[1] * X[21]; a2 -= mr2[2] * X[22]; a3 -= mr2[3] * X[23];
              mr2 = *(const LAS f32x4*)(Mm + 2996);
              __builtin_amdgcn_sched_barrier(0);
              a0 -= mr3[0] * X[24]; a1 -= mr3[1] * X[25]; a2 -= mr3[2] * X[26]; a3 -= mr3[3] * X[27];
              mr3 = *(const LAS f32x4*)(Mm + 3000);
              __builtin_amdgcn_sched_barrier(0);
              a0 -= mr4[0] * X[28]; a1 -= mr4[1] * X[29]; a2 -= mr4[2] * X[30]; a3 -= mr4[3] * X[31];
              mr4 = *(const LAS f32x4*)(Mm + 3004);
              __builtin_amdgcn_sched_barrier(0);
              a0 -= mr5[0] * X[32]; a1 -= mr5[1] * X[33]; a2 -= mr5[2] * X[34]; a3 -= mr5[3] * X[35];
              mr5 = *(const LAS f32x4*)(Mm + 3008);
              __builtin_amdgcn_sched_barrier(0);
              a0 -= mr6[0] * X[36]; a1 -= mr6[1] * X[37]; a2 -= mr6[2] * X[38]; a3 -= mr6[3] * X[39];
              mr6 = *(const LAS f32x4*)(Mm + 3012);
              __builtin_amdgcn_sched_barrier(0);
              a0 -= mr0[0] * X[40]; a1 -= mr0[1] * X[41]; a2 -= mr0[2] * X[42];
              X[43] = (a0 + a1) + (a2 + a3); dst[5676] = X[43]; }
            __builtin_amdgcn_sched_barrier(0);
            rh1 = src[6072] * cf[46];
            { float a0 = rh2, a1 = 0.f, a2 = 0.f, a3 = 0.f;
              mr0 = *(const LAS f32x4*)(Mm + 3016);
              __builtin_amdgcn_sched_barrier(0);
              a0 -= mr1[0] * X[0]; a1 -= mr1[1] * X[1]; a2 -= mr1[2] * X[2]; a3 -= mr1[3] * X[3];
              mr1 = *(const LAS f32x4*)(Mm + 3020);
              __builtin_amdgcn_sched_barrier(0);
              a0 -= mr2[0] * X[4]; a1 -= mr2[1] * X[5]; a2 -= mr2[2] * X[6]; a3 -= mr2[3] * X[7];
              mr2 = *(const LAS f32x4*)(Mm + 3024);
              __builtin_amdgcn_sched_barrier(0);
              a0 -= mr3[0] * X[8]; a1 -= mr3[1] * X[9]; a2 -= mr3[2] * X[10]; a3 -= mr3[3] * X[11];
              mr3 = *(const LAS f32x4*)(Mm + 3028);
              __builtin_amdgcn_sched_barrier(0);
              a0 -= mr4[0] * X[12]; a1 -= mr4[1] * X[13]; a2 -= mr4[2] * X[14]; a3 -= mr4[3] * X[15];
              mr4 = *(const LAS f32x4*)(Mm + 3032);
              __builtin_amdgcn_sched_barrier(0);
              a0 -= mr5[0] * X[16]; a1 -= mr5[1] * X[17]; a2 -= mr5[2] * X[18]; a3 -= mr5[3] * X[19];
              mr5 = *(const LAS f32x4*)(Mm + 3060);
              __builtin_amdgcn_sched_barrier(0);
              a0 -= mr6[0] * X[20]; a1 -= mr6[1] * X[21]; a2 -= mr6[2] * X[22]; a3 -= mr6[3] * X[23];
              mr6 = *(const LAS f32x4*)(Mm + 3064);
              __builtin_amdgcn_sched_barrier(0);
              a0 -= mr0[0] * X[24]; a1 -= mr0[1] * X[25]; a2 -= mr0[2] * X[26]; a3 -= mr0[3] * X[27];
              mr0 = *(const LAS f32x4*)(Mm + 3068);
              __builtin_amdgcn_sched_barrier(0);
              a0 -= mr1[0] * X[28]; a1 -= mr1[1] * X[29]; a2 -= mr1[2] * X[30]; a3 -= mr1[3] * X[31];
              mr1 = *(const LAS f32x4*)(Mm + 3072);
              __builtin_amdgcn_sched_barrier(0);
              a0 -= mr2[0] * X[32]; a1 -= mr2[1] * X[33]; a2 -= mr2[2] * X[34]; a3 -= mr2[3] * X[35];
              mr2 = *(const LAS f32x4*)(Mm + 3076);
              __builtin_amdgcn_sched_barrier(0);
              a0 -= mr3[0] * X[36]; a1 -= mr3[1] * X[37]; a2 -= mr3[2] * X[38]; a3 -= mr3[3] * X[39];
              mr3 = *(const LAS f32x4*)(Mm + 3080);
              __builtin_amdgcn_sched_barrier(0);
              a0 -= mr4[0] * X[40]; a1 -= mr4[1] * X[41]; a2 -= mr4[2] * X[42]; a3 -= mr4[3] * X[43];
              X[44] = (a0 + a1) + (a2 + a3); dst[5808] = X[44]; }
            __builtin_amdgcn_sched_barrier(0);
            rh2 = src[6204] * cf[47];
            { float a0 = rh0, a1 = 0.f, a2 = 0.f, a3 = 0.f;
              mr4 = *(const LAS f32x4*)(Mm + 3084);
              __builtin_amdgcn_sched_barrier(0);
              a0 -= mr5[0] * X[0]; a1 -= mr5[1] * X[1]; a2 -= mr5[2] * X[2]; a3 -= mr5[3] * X[3];
              mr5 = *(const LAS f32x4*)(Mm + 3088);
              __builtin_amdgcn_sched_barrier(0);
              a0 -= mr6[0] * X[4]; a1 -= mr6[1] * X[5]; a2 -= mr6[2] * X[6]; a3 -= mr6[3] * X[7];
              mr6 = *(const LAS f32x4*)(Mm + 3092);
              __builtin_amdgcn_sched_barrier(0);
              a0 -= mr0[0] * X[8]; a1 -= mr0[1] * X[9]; a2 -= mr0[2] * X[10]; a3 -= mr0[3] * X[11];
              mr0 = *(const LAS f32x4*)(Mm + 3096);
              __builtin_amdgcn_sched_barrier(0);
              a0 -= mr1[0] * X[12]; a1 -= mr1[1] * X[13]; a2 -= mr1[2] * X[14]; a3 -= mr1[3] * X[15];
              mr1 = *(const LAS f32x4*)(Mm + 3100);
              __builtin_amdgcn_sched_barrier(0);
              a0 -= mr2[0] * X[16]; a1 -= mr2[1] * X[17]; a2 -= mr2[2] * X[18]; a3 -= mr2[3] * X[19];
              mr2 = *(const LAS f32x4*)(Mm + 3104);
              __builtin_amdgcn_sched_barrier(0);
              a0 -= mr3[0] * X[20]; a1 -= mr3[1] * X[21]; a2 -= mr3[2] * X[22]; a3 -= mr3[3] * X[23];
              mr3 = *(const LAS f32x4*)(Mm + 3128);
              __builtin_amdgcn_sched_barrier(0);
              a0 -= mr4[0] * X[24]; a1 -= mr4[1] * X[25]; a2 -= mr4[2] * X[26]; a3 -= mr4[3] * X[27];
              mr4 = *(const LAS f32x4*)(Mm + 3132);
              __builtin_amdgcn_sched_barrier(0);
              a0 -= mr5[0] * X[28]; a1 -= mr5[1] * X[29]; a2 -= mr5[2] * X[30]; a3 -= mr5[3] * X[31];
              mr5 = *(const LAS f32x4*)(Mm + 3136);
              __builtin_amdgcn_sched_barrier(0);
              a0 -= mr6[0] * X[32]; a1 -= mr6[1] * X[33]; a2 -= mr6[2] * X[34]; a3 -= mr6[3] * X[35];
              mr6 = *(const LAS f32x4*)(Mm + 3140);
              __builtin_amdgcn_sched_barrier(0);
              a0 -= mr0[0] * X[36]; a1 -= mr0[1] * X[37]; a2 -= mr0[2] * X[38]; a3 -= mr0[3] * X[39];
              mr0 = *(const LAS f32x4*)(Mm + 3144);
              __builtin_amdgcn_sched_barrier(0);
              a0 -= mr1[0] * X[40]; a1 -= mr1[1] * X[41]; a2 -= mr1[2] * X[42]; a3 -= mr1[3] * X[43];
              mr1 = *(const LAS f32x4*)(Mm + 3148);
              __builtin_amdgcn_sched_barrier(0);
              a0 -= mr2[0] * X[44];
              X[45] = (a0 + a1) + (a2 + a3); dst[5940] = X[45]; }
            __builtin_amdgcn_sched_barrier(0);
            rh0 = src[6336] * cf[48];
            { float a0 = rh1, a1 = 0.f, a2 = 0.f, a3 = 0.f;
              mr2 = *(const LAS f32x4*)(Mm + 3152);
              __builtin_amdgcn_sched_barrier(0);
              a0 -= mr3[0] * X[0]; a1 -= mr3[1] * X[1]; a2 -= mr3[2] * X[2]; a3 -= mr3[3] * X[3];
              mr3 = *(const LAS f32x4*)(Mm + 3156);
              __builtin_amdgcn_sched_barrier(0);
              a0 -= mr4[0] * X[4]; a1 -= mr4[1] * X[5]; a2 -= mr4[2] * X[6]; a3 -= mr4[3] * X[7];
              mr4 = *(const LAS f32x4*)(Mm + 3160);
              __builtin_amdgcn_sched_barrier(0);
              a0 -= mr5[0] * X[8]; a1 -= mr5[1] * X[9]; a2 -= mr5[2] * X[10]; a3 -= mr5[3] * X[11];
              mr5 = *(const LAS f32x4*)(Mm + 3164);
              __builtin_amdgcn_sched_barrier(0);
              a0 -= mr6[0] * X[12]; a1 -= mr6[1] * X[13]; a2 -= mr6[2] * X[14]; a3 -= mr6[3] * X[15];
              mr6 = *(const LAS f32x4*)(Mm + 3168);
              __builtin_amdgcn_sched_barrier(0);
              a0 -= mr0[0] * X[16]; a1 -= mr0[1] * X[17]; a2 -= mr0[2] * X[18]; a3 -= mr0[3] * X[19];
              mr0 = *(const LAS f32x4*)(Mm + 3172);
              __builtin_amdgcn_sched_barrier(0);
              a0 -= mr1[0] * X[20]; a1 -= mr1[1] * X[21]; a2 -= mr1[2] * X[22]; a3 -= mr1[3] * X[23];
              mr1 = *(const LAS f32x4*)(Mm + 3196);
              __builtin_amdgcn_sched_barrier(0);
              a0 -= mr2[0] * X[24]; a1 -= mr2[1] * X[25]; a2 -= mr2[2] * X[26]; a3 -= mr2[3] * X[27];
              mr2 = *(const LAS f32x4*)(Mm + 3200);
              __builtin_amdgcn_sched_barrier(0);
              a0 -= mr3[0] * X[28]; a1 -= mr3[1] * X[29]; a2 -= mr3[2] * X[30]; a3 -= mr3[3] * X[31];
              mr3 = *(const LAS f32x4*)(Mm + 3204);
              __builtin_amdgcn_sched_barrier(0);
              a0 -= mr4[0] * X[32]; a1 -= mr4[1] * X[33]; a2 -= mr4[2] * X[34]; a3 -= mr4[3] * X[35];
              mr4 = *(const LAS f32x4*)(Mm + 3208);
              __builtin_amdgcn_sched_barrier(0);
              a0 -= mr5[0] * X[36]; a1 -= mr5[1] * X[37]; a2 -= mr5[2] * X[38]; a3 -= mr5[3] * X[39];
              mr5 = *(const LAS f32x4*)(Mm + 3212);
              __builtin_amdgcn_sched_barrier(0);
              a0 -= mr6[0] * X[40]; a1 -= mr6[1] * X[41]; a2 -= mr6[2] * X[42]; a3 -= mr6[3] * X[43];
              mr6 = *(const LAS f32x4*)(Mm + 3216);
              __builtin_amdgcn_sched_barrier(0);
              a0 -= mr0[0] * X[44]; a1 -= mr0[1] * X[45];
              X[46] = (a0 + a1) + (a2 + a3); dst[6072] = X[46]; }
            __builtin_amdgcn_sched_barrier(0);
            rh1 = src[6468] * cf[49];
            { float a0 = rh2, a1 = 0.f, a2 = 0.f, a3 = 0.f;
              mr0 = *(const LAS f32x4*)(Mm + 3220);
              __builtin_amdgcn_sched_barrier(0);
              a0 -= mr1[0] * X[0]; a1 -= mr1[1] * X[1]; a2 -= mr1[2] * X[2]; a3 -= mr1[3] * X[3];
              mr1 = *(const LAS f32x4*)(Mm + 3224);
              __builtin_amdgcn_sched_barrier(0);
              a0 -= mr2[0] * X[4]; a1 -= mr2[1] * X[5]; a2 -= mr2[2] * X[6]; a3 -= mr2[3] * X[7];
              mr2 = *(const LAS f32x4*)(Mm + 3228);
              __builtin_amdgcn_sched_barrier(0);
              a0 -= mr3[0] * X[8]; a1 -= mr3[1] * X[9]; a2 -= mr3[2] * X[10]; a3 -= mr3[3] * X[11];
              mr3 = *(const LAS f32x4*)(Mm + 3232);
              __builtin_amdgcn_sched_barrier(0);
              a0 -= mr4[0] * X[12]; a1 -= mr4[1] * X[13]; a2 -= mr4[2] * X[14]; a3 -= mr4[3] * X[15];
              mr4 = *(const LAS f32x4*)(Mm + 3236);
              __builtin_amdgcn_sched_barrier(0);
              a0 -= mr5[0] * X[16]; a1 -= mr5[1] * X[17]; a2 -= mr5[2] * X[18]; a3 -= mr5[3] * X[19];
              mr5 = *(const LAS f32x4*)(Mm + 3240);
              __builtin_amdgcn_sched_barrier(0);
              a0 -= mr6[0] * X[20]; a1 -= mr6[1] * X[21]; a2 -= mr6[2] * X[22]; a3 -= mr6[3] * X[23];
              mr6 = *(const LAS f32x4*)(Mm + 3264);
              __builtin_amdgcn_sched_barrier(0);
              a0 -= mr0[0] * X[24]; a1 -= mr0[1] * X[25]; a2 -= mr0[2] * X[26]; a3 -= mr0[3] * X[27];
              mr0 = *(const LAS f32x4*)(Mm + 3268);
              __builtin_amdgcn_sched_barrier(0);
              a0 -= mr1[0] * X[28]; a1 -= mr1[1] * X[29]; a2 -= mr1[2] * X[30]; a3 -= mr1[3] * X[31];
              mr1 = *(const LAS f32x4*)(Mm + 3272);
              __builtin_amdgcn_sched_barrier(0);
              a0 -= mr2[0] * X[32]; a1 -= mr2[1] * X[33]; a2 -= mr2[2] * X[34]; a3 -= mr2[3] * X[35];
              mr2 = *(const LAS f32x4*)(Mm + 3276);
              __builtin_amdgcn_sched_barrier(0);
              a0 -= mr3[0] * X[36]; a1 -= mr3[1] * X[37]; a2 -= mr3[2] * X[38]; a3 -= mr3[3] * X[39];
              mr3 = *(const LAS f32x4*)(Mm + 3280);
              __builtin_amdgcn_sched_barrier(0);
              a0 -= mr4[0] * X[40]; a1 -= mr4[1] * X[41]; a2 -= mr4[2] * X[42]; a3 -= mr4[3] * X[43];
              mr4 = *(const LAS f32x4*)(Mm + 3284);
              __builtin_amdgcn_sched_barrier(0);
              a0 -= mr5[0] * X[44]; a1 -= mr5[1] * X[45]; a2 -= mr5[2] * X[46];
              X[47] = (a0 + a1) + (a2 + a3); dst[6204] = X[47]; }
            __builtin_amdgcn_sched_barrier(0);
            rh2 = src[6600] * cf[50];
            { float a0 = rh0, a1 = 0.f, a2 = 0.f, a3 = 0.f;
              mr5 = *(const LAS f32x4*)(Mm + 3288);
              __builtin_amdgcn_sched_barrier(0);
              a0 -= mr6[0] * X[0]; a1 -= mr6[1] * X[1]; a2 -= mr6[2] * X[2]; a3 -= mr6[3] * X[3];
              mr6 = *(const LAS f32x4*)(Mm + 3292);
              __builtin_amdgcn_sched_barrier(0);
              a0 -= mr0[0] * X[4]; a1 -= mr0[1] * X[5]; a2 -= mr0[2] * X[6]; a3 -= mr0[3] * X[7];
              mr0 = *(const LAS f32x4*)(Mm + 3296);
              __builtin_amdgcn_sched_barrier(0);
              a0 -= mr1[0] * X[8]; a1 -= mr1[1] * X[9]; a2 -= mr1[2] * X[10]; a3 -= mr1[3] * X[11];
              mr1 = *(const LAS f32x4*)(Mm + 3300);
              __builtin_amdgcn_sched_barrier(0);
              a0 -= mr2[0] * X[12]; a1 -= mr2[1] * X[13]; a2 -= mr2[2] * X[14]; a3 -= mr2[3] * X[15];
              mr2 = *(const LAS f32x4*)(Mm + 3304);
              __builtin_amdgcn_sched_barrier(0);
              a0 -= mr3[0] * X[16]; a1 -= mr3[1] * X[17]; a2 -= mr3[2] * X[18]; a3 -= mr3[3] * X[19];
              mr3 = *(const LAS f32x4*)(Mm + 3308);
              __builtin_amdgcn_sched_barrier(0);
              a0 -= mr4[0] * X[20]; a1 -= mr4[1] * X[21]; a2 -= mr4[2] * X[22]; a3 -= mr4[3] * X[23];
              mr4 = *(const LAS f32x4*)(Mm + 3332);
              __builtin_amdgcn_sched_barrier(0);
              a0 -= mr5[0] * X[24]; a1 -= mr5[1] * X[25]; a2 -= mr5[2] * X[26]; a3 -= mr5[3] * X[27];
              mr5 = *(const LAS f32x4*)(Mm + 3336);
              __builtin_amdgcn_sched_barrier(0);
              a0 -= mr6[0] * X[28]; a1 -= mr6[1] * X[29]; a2 -= mr6[2] * X[30]; a3 -= mr6[3] * X[31];
              mr6 = *(const LAS f32x4*)(Mm + 3340);
              __builtin_amdgcn_sched_barrier(0);
              a0 -= mr0[0] * X[32]; a1 -= mr0[1] * X[33]; a2 -= mr0[2] * X[34]; a3 -= mr0[3] * X[35];
              mr0 = *(const LAS f32x4*)(Mm + 3344);
              __builtin_amdgcn_sched_barrier(0);
              a0 -= mr1[0] * X[36]; a1 -= mr1[1] * X[37]; a2 -= mr1[2] * X[38]; a3 -= mr1[3] * X[39];
              mr1 = *(const LAS f32x4*)(Mm + 3348);
              __builtin_amdgcn_sched_barrier(0);
              a0 -= mr2[0] * X[40]; a1 -= mr2[1] * X[41]; a2 -= mr2[2] * X[42]; a3 -= mr2[3] * X[43];
              mr2 = *(const LAS f32x4*)(Mm + 3352);
              __builtin_amdgcn_sched_barrier(0);
              a0 -= mr3[0] * X[44]; a1 -= mr3[1] * X[45]; a2 -= mr3[2] * X[46]; a3 -= mr3[3] * X[47];
              X[48] = (a0 + a1) + (a2 + a3); dst[6336] = X[48]; }
            __builtin_amdgcn_sched_barrier(0);
            rh0 = src[6732] * cf[51];
            { float a0 = rh1, a1 = 0.f, a2 = 0.f, a3 = 0.f;
              mr3 = *(const LAS f32x4*)(Mm + 3356);
              __builtin_amdgcn_sched_barrier(0);
              a0 -= mr4[0] * X[0]; a1 -= mr4[1] * X[1]; a2 -= mr4[2] * X[2]; a3 -= mr4[3] * X[3];
              mr4 = *(const LAS f32x4*)(Mm + 3360);
              __builtin_amdgcn_sched_barrier(0);
              a0 -= mr5[0] * X[4]; a1 -= mr5[1] * X[5]; a2 -= mr5[2] * X[6]; a3 -= mr5[3] * X[7];
              mr5 = *(const LAS f32x4*)(Mm + 3364);
              __builtin_amdgcn_sched_barrier(0);
              a0 -= mr6[0] * X[8]; a1 -= mr6[1] * X[9]; a2 -= mr6[2] * X[10]; a3 -= mr6[3] * X[11];
              mr6 = *(const LAS f32x4*)(Mm + 3368);
              __builtin_amdgcn_sched_barrier(0);
              a0 -= mr0[0] * X[12]; a1 -= mr0[1] * X[13]; a2 -= mr0[2] * X[14]; a3 -= mr0[3] * X[15];
              mr0 = *(const LAS f32x4*)(Mm + 3372);
              __builtin_amdgcn_sched_barrier(0);
              a0 -= mr1[0] * X[16]; a1 -= mr1[1] * X[17]; a2 -= mr1[2] * X[18]; a3 -= mr1[3] * X[19];
              mr1 = *(const LAS f32x4*)(Mm + 3376);
              __builtin_amdgcn_sched_barrier(0);
              a0 -= mr2[0] * X[20]; a1 -= mr2[1] * X[21]; a2 -= mr2[2] * X[22]; a3 -= mr2[3] * X[23];
              mr2 = *(const LAS f32x4*)(Mm + 3380);
              __builtin_amdgcn_sched_barrier(0);
              a0 -= mr3[0] * X[24]; a1 -= mr3[1] * X[25]; a2 -= mr3[2] * X[26]; a3 -= mr3[3] * X[27];
              mr3 = *(const LAS f32x4*)(Mm + 3400);
              __builtin_amdgcn_sched_barrier(0);
              a0 -= mr4[0] * X[28]; a1 -= mr4[1] * X[29]; a2 -= mr4[2] * X[30]; a3 -= mr4[3] * X[31];
              mr4 = *(const LAS f32x4*)(Mm + 3404);
              __builtin_amdgcn_sched_barrier(0);
              a0 -= mr5[0] * X[32]; a1 -= mr5[1] * X[33]; a2 -= mr5[2] * X[34]; a3 -= mr5[3] * X[35];
              mr5 = *(const LAS f32x4*)(Mm + 3408);
              __builtin_amdgcn_sched_barrier(0);
              a0 -= mr6[0] * X[36]; a1 -= mr6[1] * X[37]; a2 -= mr6[2] * X[38]; a3 -= mr6[3] * X[39];
              mr6 = *(const LAS f32x4*)(Mm + 3412);
              __builtin_amdgcn_sched_barrier(0);
              a0 -= mr0[0] * X[40]; a1 -= mr0[1] * X[41]; a2 -= mr0[2] * X[42]; a3 -= mr0[3] * X[43];
              mr0 = *(const LAS f32x4*)(Mm + 3416);
              __builtin_amdgcn_sched_barrier(0);
              a0 -= mr1[0] * X[44]; a1 -= mr1[1] * X[45]; a2 -= mr1[2] * X[46]; a3 -= mr1[3] * X[47];
              mr1 = *(const LAS f32x4*)(Mm + 3420);
              __builtin_amdgcn_sched_barrier(0);
              a0 -= mr2[0] * X[48];
              X[49] = (a0 + a1) + (a2 + a3); dst[6468] = X[49]; }
            __builtin_amdgcn_sched_barrier(0);
            rh1 = src[6864] * cf[52];
            { float a0 = rh2, a1 = 0.f, a2 = 0.f, a3 = 0.f;
              mr2 = *(const LAS f32x4*)(Mm + 3424);
              __builtin_amdgcn_sched_barrier(0);
              a0 -= mr3[0] * X[0]; a1 -= mr3[1] * X[1]; a2 -= mr3[2] * X[2]; a3 -= mr3[3] * X[3];
              mr3 = *(const LAS f32x4*)(Mm + 3428);
              __builtin_amdgcn_sched_barrier(0);
              a0 -= mr4[0] * X[4]; a1 -= mr4[1] * X[5]; a2 -= mr4[2] * X[6]; a3 -= mr4[3] * X[7];
              mr4 = *(const LAS f32x4*)(Mm + 3432);
              __builtin_amdgcn_sched_barrier(0);
              a0 -= mr5[0] * X[8]; a1 -= mr5[1] * X[9]; a2 -= mr5[2] * X[10]; a3 -= mr5[3] * X[11];
              mr5 = *(const LAS f32x4*)(Mm + 3436);
              __builtin_amdgcn_sched_barrier(0);
              a0 -= mr6[0] * X[12]; a1 -= mr6[1] * X[13]; a2 -= mr6[2] * X[14]; a3 -= mr6[3] * X[15];
              mr6 = *(const LAS f32x4*)(Mm + 3440);
              __builtin_amdgcn_sched_barrier(0);
              a0 -= mr0[0] * X[16]; a1 -= mr0[1] * X[17]; a2 -= mr0[2] * X[18]; a3 -= mr0[3] * X[19];
              mr0 = *(const LAS f32x4*)(Mm + 3444);
              __builtin_amdgcn_sched_barrier(0);
              a0 -= mr1[0] * X[20]; a1 -= mr1[1] * X[21]; a2 -= mr1[2] * X[22]; a3 -= mr1[3] * X[23];
              mr1 = *(const LAS f32x4*)(Mm + 3448);
              __builtin_amdgcn_sched_barrier(0);
              a0 -= mr2[0] * X[24]; a1 -= mr2[1] * X[25]; a2 -= mr2[2] * X[26]; a3 -= mr2[3] * X[27];
              mr2 = *(const LAS f32x4*)(Mm + 3468);
              __builtin_amdgcn_sched_barrier(0);
              a0 -= mr3[0] * X[28]; a1 -= mr3[1] * X[29]; a2 -= mr3[2] * X[30]; a3 -= mr3[3] * X[31];
              mr3 = *(const LAS f32x4*)(Mm + 3472);
              __builtin_amdgcn_sched_barrier(0);
              a0 -= mr4[0] * X[32]; a1 -= mr4[1] * X[33]; a2 -= mr4[2] * X[34]; a3 -= mr4[3] * X[35];
              mr4 = *(const LAS f32x4*)(Mm + 3476);
              __builtin_amdgcn_sched_barrier(0);
              a0 -= mr5[0] * X[36]; a1 -= mr5[1] * X[37]; a2 -= mr5[2] * X[38]; a3 -= mr5[3] * X[39];
              mr5 = *(const LAS f32x4*)(Mm + 3480);
              __builtin_amdgcn_sched_barrier(0);
              a0 -= mr6[0] * X[40]; a1 -= mr6[1] * X[41]; a2 -= mr6[2] * X[42]; a3 -= mr6[3] * X[43];
              mr6 = *(const LAS f32x4*)(Mm + 3484);
              __builtin_amdgcn_sched_barrier(0);
              a0 -= mr0[0] * X[44]; a1 -= mr0[1] * X[45]; a2 -= mr0[2] * X[46]; a3 -= mr0[3] * X[47];
              mr0 = *(const LAS f32x4*)(Mm + 3488);
              __builtin_amdgcn_sched_barrier(0);
              a0 -= mr1[0] * X[48]; a1 -= mr1[1] * X[49];
              X[50] = (a0 + a1) + (a2 + a3); dst[6600] = X[50]; }
            __builtin_amdgcn_sched_barrier(0);
            rh2 = src[6996] * cf[53];
            { float a0 = rh0, a1 = 0.f, a2 = 0.f, a3 = 0.f;
              mr1 = *(const LAS f32x4*)(Mm + 3492);
              __builtin_amdgcn_sched_barrier(0);
              a0 -= mr2[0] * X[0]; a1 -= mr2[1] * X[1]; a2 -= mr2[2] * X[2]; a3 -= mr2[3] * X[3];
              mr2 = *(const LAS f32x4*)(Mm + 3496);
              __builtin_amdgcn_sched_barrier(0);
              a0 -= mr3[0] * X[4]; a1 -= mr3[1] * X[5]; a2 -= mr3[2] * X[6]; a3 -= mr3[3] * X[7];
              mr3 = *(const LAS f32x4*)(Mm + 3500);
              __builtin_amdgcn_sched_barrier(0);
              a0 -= mr4[0] * X[8]; a1 -= mr4[1] * X[9]; a2 -= mr4[2] * X[10]; a3 -= mr4[3] * X[11];
              mr4 = *(const LAS f32x4*)(Mm + 3504);
              __builtin_amdgcn_sched_barrier(0);
              a0 -= mr5[0] * X[12]; a1 -= mr5[1] * X[13]; a2 -= mr5[2] * X[14]; a3 -= mr5[3] * X[15];
              mr5 = *(const LAS f32x4*)(Mm + 3508);
              __builtin_amdgcn_sched_barrier(0);
              a0 -= mr6[0] * X[16]; a1 -= mr6[1] * X[17]; a2 -= mr6[2] * X[18]; a3 -= mr6[3] * X[19];
              mr6 = *(const LAS f32x4*)(Mm + 3512);
              __builtin_amdgcn_sched_barrier(0);
              a0 -= mr0[0] * X[20]; a1 -= mr0[1] * X[21]; a2 -= mr0[2] * X[22]; a3 -= mr0[3] * X[23];
              mr0 = *(const LAS f32x4*)(Mm + 3516);
              __builtin_amdgcn_sched_barrier(0);
              a0 -= mr1[0] * X[24]; a1 -= mr1[1] * X[25]; a2 -= mr1[2] * X[26]; a3 -= mr1[3] * X[27];
              mr1 = *(const LAS f32x4*)(Mm + 3536);
              __builtin_amdgcn_sched_barrier(0);
              a0 -= mr2[0] * X[28]; a1 -= mr2[1] * X[29]; a2 -= mr2[2] * X[30]; a3 -= mr2[3] * X[31];
              mr2 = *(const LAS f32x4*)(Mm + 3540);
              __builtin_amdgcn_sched_barrier(0);
              a0 -= mr3[0] * X[32]; a1 -= mr3[1] * X[33]; a2 -= mr3[2] * X[34]; a3 -= mr3[3] * X[35];
              mr3 = *(const LAS f32x4*)(Mm + 3544);
              __builtin_amdgcn_sched_barrier(0);
              a0 -= mr4[0] * X[36]; a1 -= mr4[1] * X[37]; a2 -= mr4[2] * X[38]; a3 -= mr4[3] * X[39];
              mr4 = *(const LAS f32x4*)(Mm + 3548);
              __builtin_amdgcn_sched_barrier(0);
              a0 -= mr5[0] * X[40]; a1 -= mr5[1] * X[41]; a2 -= mr5[2] * X[42]; a3 -= mr5[3] * X[43];
              mr5 = *(const LAS f32x4*)(Mm + 3552);
              __builtin_amdgcn_sched_barrier(0);
              a0 -= mr6[0] * X[44]; a1 -= mr6[1] * X[45]; a2 -= mr6[2] * X[46]; a3 -= mr6[3] * X[47];
              mr6 = *(const LAS f32x4*)(Mm + 3556);
              __builtin_amdgcn_sched_barrier(0);
              a0 -= mr0[0] * X[48]; a1 -= mr0[1] * X[49]; a2 -= mr0[2] * X[50];
              X[51] = (a0 + a1) + (a2 + a3); dst[6732] = X[51]; }
            __builtin_amdgcn_sched_barrier(0);
            rh0 = src[7128] * cf[54];
            { float a0 = rh1, a1 = 0.f, a2 = 0.f, a3 = 0.f;
              mr0 = *(const LAS f32x4*)(Mm + 3560);
              __builtin_amdgcn_sched_barrier(0);
              a0 -= mr1[0] * X[0]; a1 -= mr1[1] * X[1]; a2 -= mr1[2] * X[2]; a3 -= mr1[3] * X[3];
              mr1 = *(const LAS f32x4*)(Mm + 3564);
              __builtin_amdgcn_sched_barrier(0);
              a0 -= mr2[0] * X[4]; a1 -= mr2[1] * X[5]; a2 -= mr2[2] * X[6]; a3 -= mr2[3] * X[7];
              mr2 = *(const LAS f32x4*)(Mm + 3568);
              __builtin_amdgcn_sched_barrier(0);
              a0 -= mr3[0] * X[8]; a1 -= mr3[1] * X[9]; a2 -= mr3[2] * X[10]; a3 -= mr3[3] * X[11];
              mr3 = *(const LAS f32x4*)(Mm + 3572);
              __builtin_amdgcn_sched_barrier(0);
              a0 -= mr4[0] * X[12]; a1 -= mr4[1] * X[13]; a2 -= mr4[2] * X[14]; a3 -= mr4[3] * X[15];
              mr4 = *(const LAS f32x4*)(Mm + 3576);
              __builtin_amdgcn_sched_barrier(0);
              a0 -= mr5[0] * X[16]; a1 -= mr5[1] * X[17]; a2 -= mr5[2] * X[18]; a3 -= mr5[3] * X[19];
              mr5 = *(const LAS f32x4*)(Mm + 3580);
              __builtin_amdgcn_sched_barrier(0);
              a0 -= mr6[0] * X[20]; a1 -= mr6[1] * X[21]; a2 -= mr6[2] * X[22]; a3 -= mr6[3] * X[23];
              mr6 = *(const LAS f32x4*)(Mm + 3584);
              __builtin_amdgcn_sched_barrier(0);
              a0 -= mr0[0] * X[24]; a1 -= mr0[1] * X[25]; a2 -= mr0[2] * X[26]; a3 -= mr0[3] * X[27];
              mr0 = *(const LAS f32x4*)(Mm + 3604);
              __builtin_amdgcn_sched_barrier(0);
              a0 -= mr1[0] * X[28]; a1 -= mr1[1] * X[29]; a2 -= mr1[2] * X[30]; a3 -= mr1[3] * X[31];
              mr1 = *(const LAS f32x4*)(Mm + 3608);
              __builtin_amdgcn_sched_barrier(0);
              a0 -= mr2[0] * X[32]; a1 -= mr2[1] * X[33]; a2 -= mr2[2] * X[34]; a3 -= mr2[3] * X[35];
              mr2 = *(const LAS f32x4*)(Mm + 3612);
              __builtin_amdgcn_sched_barrier(0);
              a0 -= mr3[0] * X[36]; a1 -= mr3[1] * X[37]; a2 -= mr3[2] * X[38]; a3 -= mr3[3] * X[39];
              mr3 = *(const LAS f32x4*)(Mm + 3616);
              __builtin_amdgcn_sched_barrier(0);
              a0 -= mr4[0] * X[40]; a1 -= mr4[1] * X[41]; a2 -= mr4[2] * X[42]; a3 -= mr4[3] * X[43];
              mr4 = *(const LAS f32x4*)(Mm + 3620);
              __builtin_amdgcn_sched_barrier(0);
              a0 -= mr5[0] * X[44]; a1 -= mr5[1] * X[45]; a2 -= mr5[2] * X[46]; a3 -= mr5[3] * X[47];
              mr5 = *(const LAS f32x4*)(Mm + 3624);
              __builtin_amdgcn_sched_barrier(0);
              a0 -= mr6[0] * X[48]; a1 -= mr6[1] * X[49]; a2 -= mr6[2] * X[50]; a3 -= mr6[3] * X[51];
              X[52] = (a0 + a1) + (a2 + a3); dst[6864] = X[52]; }
            __builtin_amdgcn_sched_barrier(0);
            rh1 = src[7260] * cf[55];
            { float a0 = rh2, a1 = 0.f, a2 = 0.f, a3 = 0.f;
              mr6 = *(const LAS f32x4*)(Mm + 3628);
              __builtin_amdgcn_sched_barrier(0);
              a0 -= mr0[0] * X[0]; a1 -= mr0[1] * X[1]; a2 -= mr0[2] * X[2]; a3 -= mr0[3] * X[3];
              mr0 = *(const LAS f32x4*)(Mm + 3632);
              __builtin_amdgcn_sched_barrier(0);
              a0 -= mr1[0] * X[4]; a1 -= mr1[1] * X[5]; a2 -= mr1[2] * X[6]; a3 -= mr1[3] * X[7];
              mr1 = *(const LAS f32x4*)(Mm + 3636);
              __builtin_amdgcn_sched_barrier(0);
              a0 -= mr2[0] * X[8]; a1 -= mr2[1] * X[9]; a2 -= mr2[2] * X[10]; a3 -= mr2[3] * X[11];
              mr2 = *(const LAS f32x4*)(Mm + 3640);
              __builtin_amdgcn_sched_barrier(0);
              a0 -= mr3[0] * X[12]; a1 -= mr3[1] * X[13]; a2 -= mr3[2] * X[14]; a3 -= mr3[3] * X[15];
              mr3 = *(const LAS f32x4*)(Mm + 3644);
              __builtin_amdgcn_sched_barrier(0);
              a0 -= mr4[0] * X[16]; a1 -= mr4[1] * X[17]; a2 -= mr4[2] * X[18]; a3 -= mr4[3] * X[19];
              mr4 = *(const LAS f32x4*)(Mm + 3648);
              __builtin_amdgcn_sched_barrier(0);
              a0 -= mr5[0] * X[20]; a1 -= mr5[1] * X[21]; a2 -= mr5[2] * X[22]; a3 -= mr5[3] * X[23];
              mr5 = *(const LAS f32x4*)(Mm + 3652);
              __builtin_amdgcn_sched_barrier(0);
              a0 -= mr6[0] * X[24]; a1 -= mr6[1] * X[25]; a2 -= mr6[2] * X[26]; a3 -= mr6[3] * X[27];
              mr6 = *(const LAS f32x4*)(Mm + 3656);
              __builtin_amdgcn_sched_barrier(0);
              a0 -= mr0[0] * X[28]; a1 -= mr0[1] * X[29]; a2 -= mr0[2] * X[30]; a3 -= mr0[3] * X[31];
              mr0 = *(const LAS f32x4*)(Mm + 3672);
              __builtin_amdgcn_sched_barrier(0);
              a0 -= mr1[0] * X[32]; a1 -= mr1[1] * X[33]; a2 -= mr1[2] * X[34]; a3 -= mr1[3] * X[35];
              mr1 = *(const LAS f32x4*)(Mm + 3676);
              __builtin_amdgcn_sched_barrier(0);
              a0 -= mr2[0] * X[36]; a1 -= mr2[1] * X[37]; a2 -= mr2[2] * X[38]; a3 -= mr2[3] * X[39];
              mr2 = *(const LAS f32x4*)(Mm + 3680);
              __builtin_amdgcn_sched_barrier(0);
              a0 -= mr3[0] * X[40]; a1 -= mr3[1] * X[41]; a2 -= mr3[2] * X[42]; a3 -= mr3[3] * X[43];
              mr3 = *(const LAS f32x4*)(Mm + 3684);
              __builtin_amdgcn_sched_barrier(0);
              a0 -= mr4[0] * X[44]; a1 -= mr4[1] * X[45]; a2 -= mr4[2] * X[46]; a3 -= mr4[3] * X[47];
              mr4 = *(const LAS f32x4*)(Mm + 3688);
              __builtin_amdgcn_sched_barrier(0);
              a0 -= mr5[0] * X[48]; a1 -= mr5[1] * X[49]; a2 -= mr5[2] * X[50]; a3 -= mr5[3] * X[51];
              mr5 = *(const LAS f32x4*)(Mm + 3692);
              __builtin_amdgcn_sched_barrier(0);
              a0 -= mr6[0] * X[52];
              X[53] = (a0 + a1) + (a2 + a3); dst[6996] = X[53]; }
            __builtin_amdgcn_sched_barrier(0);
            rh2 = src[7392] * cf[56];
            { float a0 = rh0, a1 = 0.f, a2 = 0.f, a3 = 0.f;
              mr6 = *(const LAS f32x4*)(Mm + 3696);
              __builtin_amdgcn_sched_barrier(0);
              a0 -= mr0[0] * X[0]; a1 -= mr0[1] * X[1]; a2 -= mr0[2] * X[2]; a3 -= mr0[3] * X[3];
              mr0 = *(const LAS f32x4*)(Mm + 3700);
              __builtin_amdgcn_sched_barrier(0);
              a0 -= mr1[0] * X[4]; a1 -= mr1[1] * X[5]; a2 -= mr1[2] * X[6]; a3 -= mr1[3] * X[7];
              mr1 = *(const LAS f32x4*)(Mm + 3704);
              __builtin_amdgcn_sched_barrier(0);
              a0 -= mr2[0] * X[8]; a1 -= mr2[1] * X[9]; a2 -= mr2[2] * X[10]; a3 -= mr2[3] * X[11];
              mr2 = *(const LAS f32x4*)(Mm + 3708);
              __builtin_amdgcn_sched_barrier(0);
              a0 -= mr3[0] * X[12]; a1 -= mr3[1] * X[13]; a2 -= mr3[2] * X[14]; a3 -= mr3[3] * X[15];
              mr3 = *(const LAS f32x4*)(Mm + 3712);
              __builtin_amdgcn_sched_barrier(0);
              a0 -= mr4[0] * X[16]; a1 -= mr4[1] * X[17]; a2 -= mr4[2] * X[18]; a3 -= mr4[3] * X[19];
              mr4 = *(const LAS f32x4*)(Mm + 3716);
              __builtin_amdgcn_sched_barrier(0);
              a0 -= mr5[0] * X[20]; a1 -= mr5[1] * X[21]; a2 -= mr5[2] * X[22]; a3 -= mr5[3] * X[23];
              mr5 = *(const LAS f32x4*)(Mm + 3720);
              __builtin_amdgcn_sched_barrier(0);
              a0 -= mr6[0] * X[24]; a1 -= mr6[1] * X[25]; a2 -= mr6[2] * X[26]; a3 -= mr6[3] * X[27];
              mr6 = *(const LAS f32x4*)(Mm + 3724);
              __builtin_amdgcn_sched_barrier(0);
              a0 -= mr0[0] * X[28]; a1 -= mr0[1] * X[29]; a2 -= mr0[2] * X[30]; a3 -= mr0[3] * X[31];
              mr0 = *(const LAS f32x4*)(Mm + 3740);
              __builtin_amdgcn_sched_barrier(0);
              a0 -= mr1[0] * X[32]; a1 -= mr1[1] * X[33]; a2 -= mr1[2] * X[34]; a3 -= mr1[3] * X[35];
              mr1 = *(const LAS f32x4*)(Mm + 3744);
              __builtin_amdgcn_sched_barrier(0);
              a0 -= mr2[0] * X[36]; a1 -= mr2[1] * X[37]; a2 -= mr2[2] * X[38]; a3 -= mr2[3] * X[39];
              mr2 = *(const LAS f32x4*)(Mm + 3748);
              __builtin_amdgcn_sched_barrier(0);
              a0 -= mr3[0] * X[40]; a1 -= mr3[1] * X[41]; a2 -= mr3[2] * X[42]; a3 -= mr3[3] * X[43];
              mr3 = *(const LAS f32x4*)(Mm + 3752);
              __builtin_amdgcn_sched_barrier(0);
              a0 -= mr4[0] * X[44]; a1 -= mr4[1] * X[45]; a2 -= mr4[2] * X[46]; a3 -= mr4[3] * X[47];
              mr4 = *(const LAS f32x4*)(Mm + 3756);
              __builtin_amdgcn_sched_barrier(0);
              a0 -= mr5[0] * X[48]; a1 -= mr5[1] * X[49]; a2 -= mr5[2] * X[50]; a3 -= mr5[3] * X[51];
              mr5 = *(const LAS f32x4*)(Mm + 3760);
              __builtin_amdgcn_sched_barrier(0);
              a0 -= mr6[0] * X[52]; a1 -= mr6[1] * X[53];
              X[54] = (a0 + a1) + (a2 + a3); dst[7128] = X[54]; }
            __builtin_amdgcn_sched_barrier(0);
            rh0 = src[7524] * cf[57];
            { float a0 = rh1, a1 = 0.f, a2 = 0.f, a3 = 0.f;
              mr6 = *(const LAS f32x4*)(Mm + 3764);
              __builtin_amdgcn_sched_barrier(0);
              a0 -= mr0[0] * X[0]; a1 -= mr0[1] * X[1]; a2 -= mr0[2] * X[2]; a3 -= mr0[3] * X[3];
              mr0 = *(const LAS f32x4*)(Mm + 3768);
              __builtin_amdgcn_sched_barrier(0);
              a0 -= mr1[0] * X[4]; a1 -= mr1[1] * X[5]; a2 -= mr1[2] * X[6]; a3 -= mr1[3] * X[7];
              mr1 = *(const LAS f32x4*)(Mm + 3772);
              __builtin_amdgcn_sched_barrier(0);
              a0 -= mr2[0] * X[8]; a1 -= mr2[1] * X[9]; a2 -= mr2[2] * X[10]; a3 -= mr2[3] * X[11];
              mr2 = *(const LAS f32x4*)(Mm + 3776);
              __builtin_amdgcn_sched_barrier(0);
              a0 -= mr3[0] * X[12]; a1 -= mr3[1] * X[13]; a2 -= mr3[2] * X[14]; a3 -= mr3[3] * X[15];
              mr3 = *(const LAS f32x4*)(Mm + 3780);
              __builtin_amdgcn_sched_barrier(0);
              a0 -= mr4[0] * X[16]; a1 -= mr4[1] * X[17]; a2 -= mr4[2] * X[18]; a3 -= mr4[3] * X[19];
              mr4 = *(const LAS f32x4*)(Mm + 3784);
              __builtin_amdgcn_sched_barrier(0);
              a0 -= mr5[0] * X[20]; a1 -= mr5[1] * X[21]; a2 -= mr5[2] * X[22]; a3 -= mr5[3] * X[23];
              mr5 = *(const LAS f32x4*)(Mm + 3788);
              __builtin_amdgcn_sched_barrier(0);
              a0 -= mr6[0] * X[24]; a1 -= mr6[1] * X[25]; a2 -= mr6[2] * X[26]; a3 -= mr6[3] * X[27];
              mr6 = *(const LAS f32x4*)(Mm + 3792);
              __builtin_amdgcn_sched_barrier(0);
              a0 -= mr0[0] * X[28]; a1 -= mr0[1] * X[29]; a2 -= mr0[2] * X[30]; a3 -= mr0[3] * X[31];
              mr0 = *(const LAS f32x4*)(Mm + 3808);
              __builtin_amdgcn_sched_barrier(0);
              a0 -= mr1[0] * X[32]; a1 -= mr1[1] * X[33]; a2 -= mr1[2] * X[34]; a3 -= mr1[3] * X[35];
              mr1 = *(const LAS f32x4*)(Mm + 3812);
              __builtin_amdgcn_sched_barrier(0);
              a0 -= mr2[0] * X[36]; a1 -= mr2[1] * X[37]; a2 -= mr2[2] * X[38]; a3 -= mr2[3] * X[39];
              mr2 = *(const LAS f32x4*)(Mm + 3816);
              __builtin_amdgcn_sched_barrier(0);
              a0 -= mr3[0] * X[40]; a1 -= mr3[1] * X[41]; a2 -= mr3[2] * X[42]; a3 -= mr3[3] * X[43];
              mr3 = *(const LAS f32x4*)(Mm + 3820);
              __builtin_amdgcn_sched_barrier(0);
              a0 -= mr4[0] * X[44]; a1 -= mr4[1] * X[45]; a2 -= mr4[2] * X[46]; a3 -= mr4[3] * X[47];
              mr4 = *(const LAS f32x4*)(Mm + 3824);
              __builtin_amdgcn_sched_barrier(0);
              a0 -= mr5[0] * X[48]; a1 -= mr5[1] * X[49]; a2 -= mr5[2] * X[50]; a3 -= mr5[3] * X[51];
              mr5 = *(const LAS f32x4*)(Mm + 3828);
              __builtin_amdgcn_sched_barrier(0);
              a0 -= mr6[0] * X[52]; a1 -= mr6[1] * X[53]; a2 -= mr6[2] * X[54];
              X[55] = (a0 + a1) + (a2 + a3); dst[7260] = X[55]; }
            __builtin_amdgcn_sched_barrier(0);
            rh1 = src[7656] * cf[58];
            { float a0 = rh2, a1 = 0.f, a2 = 0.f, a3 = 0.f;
              mr6 = *(const LAS f32x4*)(Mm + 3832);
              __builtin_amdgcn_sched_barrier(0);
              a0 -= mr0[0] * X[0]; a1 -= mr0[1] * X[1]; a2 -= mr0[2] * X[2]; a3 -= mr0[3] * X[3];
              mr0 = *(const LAS f32x4*)(Mm + 3836);
              __builtin_amdgcn_sched_barrier(0);
              a0 -= mr1[0] * X[4]; a1 -= mr1[1] * X[5]; a2 -= mr1[2] * X[6]; a3 -= mr1[3] * X[7];
              mr1 = *(const LAS f32x4*)(Mm + 3840);
              __builtin_amdgcn_sched_barrier(0);
              a0 -= mr2[0] * X[8]; a1 -= mr2[1] * X[9]; a2 -= mr2[2] * X[10]; a3 -= mr2[3] * X[11];
              mr2 = *(const LAS f32x4*)(Mm + 3844);
              __builtin_amdgcn_sched_barrier(0);
              a0 -= mr3[0] * X[12]; a1 -= mr3[1] * X[13]; a2 -= mr3[2] * X[14]; a3 -= mr3[3] * X[15];
              mr3 = *(const LAS f32x4*)(Mm + 3848);
              __builtin_amdgcn_sched_barrier(0);
              a0 -= mr4[0] * X[16]; a1 -= mr4[1] * X[17]; a2 -= mr4[2] * X[18]; a3 -= mr4[3] * X[19];
              mr4 = *(const LAS f32x4*)(Mm + 3852);
              __builtin_amdgcn_sched_barrier(0);
              a0 -= mr5[0] * X[20]; a1 -= mr5[1] * X[21]; a2 -= mr5[2] * X[22]; a3 -= mr5[3] * X[23];
              mr5 = *(const LAS f32x4*)(Mm + 3856);
              __builtin_amdgcn_sched_barrier(0);
              a0 -= mr6[0] * X[24]; a1 -= mr6[1] * X[25]; a2 -= mr6[2] * X[26]; a3 -= mr6[3] * X[27];
              mr6 = *(const LAS f32x4*)(Mm + 3860);
              __builtin_amdgcn_sched_barrier(0);
              a0 -= mr0[0] * X[28]; a1 -= mr0[1] * X[29]; a2 -= mr0[2] * X[30]; a3 -= mr0[3] * X[31];
              mr0 = *(const LAS f32x4*)(Mm + 3876);
              __builtin_amdgcn_sched_barrier(0);
              a0 -= mr1[0] * X[32]; a1 -= mr1[1] * X[33]; a2 -= mr1[2] * X[34]; a3 -= mr1[3] * X[35];
              mr1 = *(const LAS f32x4*)(Mm + 3880);
              __builtin_amdgcn_sched_barrier(0);
              a0 -= mr2[0] * X[36]; a1 -= mr2[1] * X[37]; a2 -= mr2[2] * X[38]; a3 -= mr2[3] * X[39];
              mr2 = *(const LAS f32x4*)(Mm + 3884);
              __builtin_amdgcn_sched_barrier(0);
              a0 -= mr3[0] * X[40]; a1 -= mr3[1] * X[41]; a2 -= mr3[2] * X[42]; a3 -= mr3[3] * X[43];
              mr3 = *(const LAS f32x4*)(Mm + 3888);
              __builtin_amdgcn_sched_barrier(0);
              a0 -= mr4[0] * X[44]; a1 -= mr4[1] * X[45]; a2 -= mr4[2] * X[46]; a3 -= mr4[3] * X[47];
              mr4 = *(const LAS f32x4*)(Mm + 3892);
              __builtin_amdgcn_sched_barrier(0);
              a0 -= mr5[0] * X[48]; a1 -= mr5[1] * X[49]; a2 -= mr5[2] * X[50]; a3 -= mr5[3] * X[51];
              mr5 = *(const LAS f32x4*)(Mm + 3896);
              __builtin_amdgcn_sched_barrier(0);
              a0 -= mr6[0] * X[52]; a1 -= mr6[1] * X[53]; a2 -= mr6[2] * X[54]; a3 -= mr6[3] * X[55];
              X[56] = (a0 + a1) + (a2 + a3); dst[7392] = X[56]; }
            __builtin_amdgcn_sched_barrier(0);
            rh2 = src[7788] * cf[59];
            { float a0 = rh0, a1 = 0.f, a2 = 0.f, a3 = 0.f;
              mr6 = *(const LAS f32x4*)(Mm + 3900);
              __builtin_amdgcn_sched_barrier(0);
              a0 -= mr0[0] * X[0]; a1 -= mr0[1] * X[1]; a2 -= mr0[2] * X[2]; a3 -= mr0[3] * X[3];
              mr0 = *(const LAS f32x4*)(Mm + 3904);
              __builtin_amdgcn_sched_barrier(0);
              a0 -= mr1[0] * X[4]; a1 -= mr1[1] * X[5]; a2 -= mr1[2] * X[6]; a3 -= mr1[3] * X[7];
              mr1 = *(const LAS f32x4*)(Mm + 3908);
              __builtin_amdgcn_sched_barrier(0);
              a0 -= mr2[0] * X[8]; a1 -= mr2[1] * X[9]; a2 -= mr2[2] * X[10]; a3 -= mr2[3] * X[11];
              mr2 = *(const LAS f32x4*)(Mm + 3912);
              __builtin_amdgcn_sched_barrier(0);
              a0 -= mr3[0] * X[12]; a1 -= mr3[1] * X[13]; a2 -= mr3[2] * X[14]; a3 -= mr3[3] * X[15];
              mr3 = *(const LAS f32x4*)(Mm + 3916);
              __builtin_amdgcn_sched_barrier(0);
              a0 -= mr4[0] * X[16]; a1 -= mr4[1] * X[17]; a2 -= mr4[2] * X[18]; a3 -= mr4[3] * X[19];
              mr4 = *(const LAS f32x4*)(Mm + 3920);
              __builtin_amdgcn_sched_barrier(0);
              a0 -= mr5[0] * X[20]; a1 -= mr5[1] * X[21]; a2 -= mr5[2] * X[22]; a3 -= mr5[3] * X[23];
              mr5 = *(const LAS f32x4*)(Mm + 3924);
              __builtin_amdgcn_sched_barrier(0);
              a0 -= mr6[0] * X[24]; a1 -= mr6[1] * X[25]; a2 -= mr6[2] * X[26]; a3 -= mr6[3] * X[27];
              mr6 = *(const LAS f32x4*)(Mm + 3928);
              __builtin_amdgcn_sched_barrier(0);
              a0 -= mr0[0] * X[28]; a1 -= mr0[1] * X[29]; a2 -= mr0[2] * X[30]; a3 -= mr0[3] * X[31];
              mr0 = *(const LAS f32x4*)(Mm + 3932);
              __builtin_amdgcn_sched_barrier(0);
              a0 -= mr1[0] * X[32]; a1 -= mr1[1] * X[33]; a2 -= mr1[2] * X[34]; a3 -= mr1[3] * X[35];
              mr1 = *(const LAS f32x4*)(Mm + 3944);
              __builtin_amdgcn_sched_barrier(0);
              a0 -= mr2[0] * X[36]; a1 -= mr2[1] * X[37]; a2 -= mr2[2] * X[38]; a3 -= mr2[3] * X[39];
              mr2 = *(const LAS f32x4*)(Mm + 3948);
              __builtin_amdgcn_sched_barrier(0);
              a0 -= mr3[0] * X[40]; a1 -= mr3[1] * X[41]; a2 -= mr3[2] * X[42]; a3 -= mr3[3] * X[43];
              mr3 = *(const LAS f32x4*)(Mm + 3952);
              __builtin_amdgcn_sched_barrier(0);
              a0 -= mr4[0] * X[44]; a1 -= mr4[1] * X[45]; a2 -= mr4[2] * X[46]; a3 -= mr4[3] * X[47];
              mr4 = *(const LAS f32x4*)(Mm + 3956);
              __builtin_amdgcn_sched_barrier(0);
              a0 -= mr5[0] * X[48]; a1 -= mr5[1] * X[49]; a2 -= mr5[2] * X[50]; a3 -= mr5[3] * X[51];
              mr5 = *(const LAS f32x4*)(Mm + 3960);
              __builtin_amdgcn_sched_barrier(0);
              a0 -= mr6[0] * X[52]; a1 -= mr6[1] * X[53]; a2 -= mr6[2] * X[54]; a3 -= mr6[3] * X[55];
              mr6 = *(const LAS f32x4*)(Mm + 3964);
              __builtin_amdgcn_sched_barrier(0);
              a0 -= mr0[0] * X[56];
              X[57] = (a0 + a1) + (a2 + a3); dst[7524] = X[57]; }
            __builtin_amdgcn_sched_barrier(0);
            rh0 = src[7920] * cf[60];
            { float a0 = rh1, a1 = 0.f, a2 = 0.f, a3 = 0.f;
              mr0 = *(const LAS f32x4*)(Mm + 3968);
              __builtin_amdgcn_sched_barrier(0);
              a0 -= mr1[0] * X[0]; a1 -= mr1[1] * X[1]; a2 -= mr1[2] * X[2]; a3 -= mr1[3] * X[3];
              mr1 = *(const LAS f32x4*)(Mm + 3972);
              __builtin_amdgcn_sched_barrier(0);
              a0 -= mr2[0] * X[4]; a1 -= mr2[1] * X[5]; a2 -= mr2[2] * X[6]; a3 -= mr2[3] * X[7];
              mr2 = *(const LAS f32x4*)(Mm + 3976);
              __builtin_amdgcn_sched_barrier(0);
              a0 -= mr3[0] * X[8]; a1 -= mr3[1] * X[9]; a2 -= mr3[2] * X[10]; a3 -= mr3[3] * X[11];
              mr3 = *(const LAS f32x4*)(Mm + 3980);
              __builtin_amdgcn_sched_barrier(0);
              a0 -= mr4[0] * X[12]; a1 -= mr4[1] * X[13]; a2 -= mr4[2] * X[14]; a3 -= mr4[3] * X[15];
              mr4 = *(const LAS f32x4*)(Mm + 3984);
              __builtin_amdgcn_sched_barrier(0);
              a0 -= mr5[0] * X[16]; a1 -= mr5[1] * X[17]; a2 -= mr5[2] * X[18]; a3 -= mr5[3] * X[19];
              mr5 = *(const LAS f32x4*)(Mm + 3988);
              __builtin_amdgcn_sched_barrier(0);
              a0 -= mr6[0] * X[20]; a1 -= mr6[1] * X[21]; a2 -= mr6[2] * X[22]; a3 -= mr6[3] * X[23];
              mr6 = *(const LAS f32x4*)(Mm + 3992);
              __builtin_amdgcn_sched_barrier(0);
              a0 -= mr0[0] * X[24]; a1 -= mr0[1] * X[25]; a2 -= mr0[2] * X[26]; a3 -= mr0[3] * X[27];
              mr0 = *(const LAS f32x4*)(Mm + 3996);
              __builtin_amdgcn_sched_barrier(0);
              a0 -= mr1[0] * X[28]; a1 -= mr1[1] * X[29]; a2 -= mr1[2] * X[30]; a3 -= mr1[3] * X[31];
              mr1 = *(const LAS f32x4*)(Mm + 4000);
              __builtin_amdgcn_sched_barrier(0);
              a0 -= mr2[0] * X[32]; a1 -= mr2[1] * X[33]; a2 -= mr2[2] * X[34]; a3 -= mr2[3] * X[35];
              mr2 = *(const LAS f32x4*)(Mm + 4012);
              __builtin_amdgcn_sched_barrier(0);
              a0 -= mr3[0] * X[36]; a1 -= mr3[1] * X[37]; a2 -= mr3[2] * X[38]; a3 -= mr3[3] * X[39];
              mr3 = *(const LAS f32x4*)(Mm + 4016);
              __builtin_amdgcn_sched_barrier(0);
              a0 -= mr4[0] * X[40]; a1 -= mr4[1] * X[41]; a2 -= mr4[2] * X[42]; a3 -= mr4[3] * X[43];
              mr4 = *(const LAS f32x4*)(Mm + 4020);
              __builtin_amdgcn_sched_barrier(0);
              a0 -= mr5[0] * X[44]; a1 -= mr5[1] * X[45]; a2 -= mr5[2] * X[46]; a3 -= mr5[3] * X[47];
              mr5 = *(const LAS f32x4*)(Mm + 4024);
              __builtin_amdgcn_sched_barrier(0);
              a0 -= mr6[0] * X[48]; a1 -= mr6[1] * X[49]; a2 -= mr6[2] * X[50]; a3 -= mr6[3] * X[51];
              mr6 = *(const LAS f32x4*)(Mm + 4028);
              __builtin_amdgcn_sched_barrier(0);
              a0 -= mr0[0] * X[52]; a1 -= mr0[1] * X[53]; a2 -= mr0[2] * X[54]; a3 -= mr0[3] * X[55];
              mr0 = *(const LAS f32x4*)(Mm + 4032);
              __builtin_amdgcn_sched_barrier(0);
              a0 -= mr1[0] * X[56]; a1 -= mr1[1] * X[57];
              X[58] = (a0 + a1) + (a2 + a3); dst[7656] = X[58]; }
            __builtin_amdgcn_sched_barrier(0);
            rh1 = src[8052] * cf[61];
            { float a0 = rh2, a1 = 0.f, a2 = 0.f, a3 = 0.f;
              mr1 = *(const LAS f32x4*)(Mm + 4036);
              __builtin_amdgcn_sched_barrier(0);
              a0 -= mr2[0] * X[0]; a1 -= mr2[1] * X[1]; a2 -= mr2[2] * X[2]; a3 -= mr2[3] * X[3];
              mr2 = *(const LAS f32x4*)(Mm + 4040);
              __builtin_amdgcn_sched_barrier(0);
              a0 -= mr3[0] * X[4]; a1 -= mr3[1] * X[5]; a2 -= mr3[2] * X[6]; a3 -= mr3[3] * X[7];
              mr3 = *(const LAS f32x4*)(Mm + 4044);
              __builtin_amdgcn_sched_barrier(0);
              a0 -= mr4[0] * X[8]; a1 -= mr4[1] * X[9]; a2 -= mr4[2] * X[10]; a3 -= mr4[3] * X[11];
              mr4 = *(const LAS f32x4*)(Mm + 4048);
              __builtin_amdgcn_sched_barrier(0);
              a0 -= mr5[0] * X[12]; a1 -= mr5[1] * X[13]; a2 -= mr5[2] * X[14]; a3 -= mr5[3] * X[15];
              mr5 = *(const LAS f32x4*)(Mm + 4052);
              __builtin_amdgcn_sched_barrier(0);
              a0 -= mr6[0] * X[16]; a1 -= mr6[1] * X[17]; a2 -= mr6[2] * X[18]; a3 -= mr6[3] * X[19];
              mr6 = *(const LAS f32x4*)(Mm + 4056);
              __builtin_amdgcn_sched_barrier(0);
              a0 -= mr0[0] * X[20]; a1 -= mr0[1] * X[21]; a2 -= mr0[2] * X[22]; a3 -= mr0[3] * X[23];
              mr0 = *(const LAS f32x4*)(Mm + 4060);
              __builtin_amdgcn_sched_barrier(0);
              a0 -= mr1[0] * X[24]; a1 -= mr1[1] * X[25]; a2 -= mr1[2] * X[26]; a3 -= mr1[3] * X[27];
              mr1 = *(const LAS f32x4*)(Mm + 4064);
              __builtin_amdgcn_sched_barrier(0);
              a0 -= mr2[0] * X[28]; a1 -= mr2[1] * X[29]; a2 -= mr2[2] * X[30]; a3 -= mr2[3] * X[31];
              mr2 = *(const LAS f32x4*)(Mm + 4068);
              __builtin_amdgcn_sched_barrier(0);
              a0 -= mr3[0] * X[32]; a1 -= mr3[1] * X[33]; a2 -= mr3[2] * X[34]; a3 -= mr3[3] * X[35];
              mr3 = *(const LAS f32x4*)(Mm + 4080);
              __builtin_amdgcn_sched_barrier(0);
              a0 -= mr4[0] * X[36]; a1 -= mr4[1] * X[37]; a2 -= mr4[2] * X[38]; a3 -= mr4[3] * X[39];
              mr4 = *(const LAS f32x4*)(Mm + 4084);
              __builtin_amdgcn_sched_barrier(0);
              a0 -= mr5[0] * X[40]; a1 -= mr5[1] * X[41]; a2 -= mr5[2] * X[42]; a3 -= mr5[3] * X[43];
              mr5 = *(const LAS f32x4*)(Mm + 4088);
              __builtin_amdgcn_sched_barrier(0);
              a0 -= mr6[0] * X[44]; a1 -= mr6[1] * X[45]; a2 -= mr6[2] * X[46]; a3 -= mr6[3] * X[47];
              mr6 = *(const LAS f32x4*)(Mm + 4092);
              __builtin_amdgcn_sched_barrier(0);
              a0 -= mr0[0] * X[48]; a1 -= mr0[1] * X[49]; a2 -= mr0[2] * X[50]; a3 -= mr0[3] * X[51];
              mr0 = *(const LAS f32x4*)(Mm + 4096);
              __builtin_amdgcn_sched_barrier(0);
              a0 -= mr1[0] * X[52]; a1 -= mr1[1] * X[53]; a2 -= mr1[2] * X[54]; a3 -= mr1[3] * X[55];
              mr1 = *(const LAS f32x4*)(Mm + 4100);
              __builtin_amdgcn_sched_barrier(0);
              a0 -= mr2[0] * X[56]; a1 -= mr2[1] * X[57]; a2 -= mr2[2] * X[58];
              X[59] = (a0 + a1) + (a2 + a3); dst[7788] = X[59]; }
            __builtin_amdgcn_sched_barrier(0);
            rh2 = src[8184] * cf[62];
            { float a0 = rh0, a1 = 0.f, a2 = 0.f, a3 = 0.f;
              mr2 = *(const LAS f32x4*)(Mm + 4104);
              __builtin_amdgcn_sched_barrier(0);
              a0 -= mr3[0] * X[0]; a1 -= mr3[1] * X[1]; a2 -= mr3[2] * X[2]; a3 -= mr3[3] * X[3];
              mr3 = *(const LAS f32x4*)(Mm + 4108);
              __builtin_amdgcn_sched_barrier(0);
              a0 -= mr4[0] * X[4]; a1 -= mr4[1] * X[5]; a2 -= mr4[2] * X[6]; a3 -= mr4[3] * X[7];
              mr4 = *(const LAS f32x4*)(Mm + 4112);
              __builtin_amdgcn_sched_barrier(0);
              a0 -= mr5[0] * X[8]; a1 -= mr5[1] * X[9]; a2 -= mr5[2] * X[10]; a3 -= mr5[3] * X[11];
              mr5 = *(const LAS f32x4*)(Mm + 4116);
              __builtin_amdgcn_sched_barrier(0);
              a0 -= mr6[0] * X[12]; a1 -= mr6[1] * X[13]; a2 -= mr6[2] * X[14]; a3 -= mr6[3] * X[15];
              mr6 = *(const LAS f32x4*)(Mm + 4120);
              __builtin_amdgcn_sched_barrier(0);
              a0 -= mr0[0] * X[16]; a1 -= mr0[1] * X[17]; a2 -= mr0[2] * X[18]; a3 -= mr0[3] * X[19];
              mr0 = *(const LAS f32x4*)(Mm + 4124);
              __builtin_amdgcn_sched_barrier(0);
              a0 -= mr1[0] * X[20]; a1 -= mr1[1] * X[21]; a2 -= mr1[2] * X[22]; a3 -= mr1[3] * X[23];
              mr1 = *(const LAS f32x4*)(Mm + 4128);
              __builtin_amdgcn_sched_barrier(0);
              a0 -= mr2[0] * X[24]; a1 -= mr2[1] * X[25]; a2 -= mr2[2] * X[26]; a3 -= mr2[3] * X[27];
              mr2 = *(const LAS f32x4*)(Mm + 4132);
              __builtin_amdgcn_sched_barrier(0);
              a0 -= mr3[0] * X[28]; a1 -= mr3[1] * X[29]; a2 -= mr3[2] * X[30]; a3 -= mr3[3] * X[31];
              mr3 = *(const LAS f32x4*)(Mm + 4136);
              __builtin_amdgcn_sched_barrier(0);
              a0 -= mr4[0] * X[32]; a1 -= mr4[1] * X[33]; a2 -= mr4[2] * X[34]; a3 -= mr4[3] * X[35];
              mr4 = *(const LAS f32x4*)(Mm + 4148);
              __builtin_amdgcn_sched_barrier(0);
              a0 -= mr5[0] * X[36]; a1 -= mr5[1] * X[37]; a2 -= mr5[2] * X[38]; a3 -= mr5[3] * X[39];
              mr5 = *(const LAS f32x4*)(Mm + 4152);
              __builtin_amdgcn_sched_barrier(0);
              a0 -= mr6[0] * X[40]; a1 -= mr6[1] * X[41]; a2 -= mr6[2] * X[42]; a3 -= mr6[3] * X[43];
              mr6 = *(const LAS f32x4*)(Mm + 4156);
              __builtin_amdgcn_sched_barrier(0);
              a0 -= mr0[0] * X[44]; a1 -= mr0[1] * X[45]; a2 -= mr0[2] * X[46]; a3 -= mr0[3] * X[47];
              mr0 = *(const LAS f32x4*)(Mm + 4160);
              __builtin_amdgcn_sched_barrier(0);
              a0 -= mr1[0] * X[48]; a1 -= mr1[1] * X[49]; a2 -= mr1[2] * X[50]; a3 -= mr1[3] * X[51];
              mr1 = *(const LAS f32x4*)(Mm + 4164);
              __builtin_amdgcn_sched_barrier(0);
              a0 -= mr2[0] * X[52]; a1 -= mr2[1] * X[53]; a2 -= mr2[2] * X[54]; a3 -= mr2[3] * X[55];
              mr2 = *(const LAS f32x4*)(Mm + 4168);
              __builtin_amdgcn_sched_barrier(0);
              a0 -= mr3[0] * X[56]; a1 -= mr3[1] * X[57]; a2 -= mr3[2] * X[58]; a3 -= mr3[3] * X[59];
              X[60] = (a0 + a1) + (a2 + a3); dst[7920] = X[60]; }
            __builtin_amdgcn_sched_barrier(0);
            rh0 = src[8316] * cf[63];
            { float a0 = rh1, a1 = 0.f, a2 = 0.f, a3 = 0.f;
              mr3 = *(const LAS f32x4*)(Mm + 4172);
              __builtin_amdgcn_sched_barrier(0);
              a0 -= mr4[0] * X[0]; a1 -= mr4[1] * X[1]; a2 -= mr4[2] * X[2]; a3 -= mr4[3] * X[3];
              mr4 = *(const LAS f32x4*)(Mm + 4176);
              __builtin_amdgcn_sched_barrier(0);
              a0 -= mr5[0] * X[4]; a1 -= mr5[1] * X[5]; a2 -= mr5[2] * X[6]; a3 -= mr5[3] * X[7];
              mr5 = *(const LAS f32x4*)(Mm + 4180);
              __builtin_amdgcn_sched_barrier(0);
              a0 -= mr6[0] * X[8]; a1 -= mr6[1] * X[9]; a2 -= mr6[2] * X[10]; a3 -= mr6[3] * X[11];
              mr6 = *(const LAS f32x4*)(Mm + 4184);
              __builtin_amdgcn_sched_barrier(0);
              a0 -= mr0[0] * X[12]; a1 -= mr0[1] * X[13]; a2 -= mr0[2] * X[14]; a3 -= mr0[3] * X[15];
              mr0 = *(const LAS f32x4*)(Mm + 4188);
              __builtin_amdgcn_sched_barrier(0);
              a0 -= mr1[0] * X[16]; a1 -= mr1[1] * X[17]; a2 -= mr1[2] * X[18]; a3 -= mr1[3] * X[19];
              mr1 = *(const LAS f32x4*)(Mm + 4192);
              __builtin_amdgcn_sched_barrier(0);
              a0 -= mr2[0] * X[20]; a1 -= mr2[1] * X[21]; a2 -= mr2[2] * X[22]; a3 -= mr2[3] * X[23];
              mr2 = *(const LAS f32x4*)(Mm + 4196);
              __builtin_amdgcn_sched_barrier(0);
              a0 -= mr3[0] * X[24]; a1 -= mr3[1] * X[25]; a2 -= mr3[2] * X[26]; a3 -= mr3[3] * X[27];
              mr3 = *(const LAS f32x4*)(Mm + 4200);
              __builtin_amdgcn_sched_barrier(0);
              a0 -= mr4[0] * X[28]; a1 -= mr4[1] * X[29]; a2 -= mr4[2] * X[30]; a3 -= mr4[3] * X[31];
              mr4 = *(const LAS f32x4*)(Mm + 4204);
              __builtin_amdgcn_sched_barrier(0);
              a0 -= mr5[0] * X[32]; a1 -= mr5[1] * X[33]; a2 -= mr5[2] * X[34]; a3 -= mr5[3] * X[35];
              mr5 = *(const LAS f32x4*)(Mm + 4208);
              __builtin_amdgcn_sched_barrier(0);
              a0 -= mr6[0] * X[36]; a1 -= mr6[1] * X[37]; a2 -= mr6[2] * X[38]; a3 -= mr6[3] * X[39];
              mr6 = *(const LAS f32x4*)(Mm + 4216);
              __builtin_amdgcn_sched_barrier(0);
              a0 -= mr0[0] * X[40]; a1 -= mr0[1] * X[41]; a2 -= mr0[2] * X[42]; a3 -= mr0[3] * X[43];
              mr0 = *(const LAS f32x4*)(Mm + 4220);
              __builtin_amdgcn_sched_barrier(0);
              a0 -= mr1[0] * X[44]; a1 -= mr1[1] * X[45]; a2 -= mr1[2] * X[46]; a3 -= mr1[3] * X[47];
              mr1 = *(const LAS f32x4*)(Mm + 4224);
              __builtin_amdgcn_sched_barrier(0);
              a0 -= mr2[0] * X[48]; a1 -= mr2[1] * X[49]; a2 -= mr2[2] * X[50]; a3 -= mr2[3] * X[51];
              mr2 = *(const LAS f32x4*)(Mm + 4228);
              __builtin_amdgcn_sched_barrier(0);
              a0 -= mr3[0] * X[52]; a1 -= mr3[1] * X[53]; a2 -= mr3[2] * X[54]; a3 -= mr3[3] * X[55];
              mr3 = *(const LAS f32x4*)(Mm + 4232);
              __builtin_amdgcn_sched_barrier(0);
              a0 -= mr4[0] * X[56]; a1 -= mr4[1] * X[57]; a2 -= mr4[2] * X[58]; a3 -= mr4[3] * X[59];
              mr4 = *(const LAS f32x4*)(Mm + 4236);
              __builtin_amdgcn_sched_barrier(0);
              a0 -= mr5[0] * X[60];
              X[61] = (a0 + a1) + (a2 + a3); dst[8052] = X[61]; }
            __builtin_amdgcn_sched_barrier(0);
            { float a0 = rh2, a1 = 0.f, a2 = 0.f, a3 = 0.f;
              mr5 = *(const LAS f32x4*)(Mm + 4240);
              __builtin_amdgcn_sched_barrier(0);
              a0 -= mr6[0] * X[0]; a1 -= mr6[1] * X[1]; a2 -= mr6[2] * X[2]; a3 -= mr6[3] * X[3];
              mr6 = *(const LAS f32x4*)(Mm + 4244);
              __builtin_amdgcn_sched_barrier(0);
              a0 -= mr0[0] * X[4]; a1 -= mr0[1] * X[5]; a2 -= mr0[2] * X[6]; a3 -= mr0[3] * X[7];
              mr0 = *(const LAS f32x4*)(Mm + 4248);
              __builtin_amdgcn_sched_barrier(0);
              a0 -= mr1[0] * X[8]; a1 -= mr1[1] * X[9]; a2 -= mr1[2] * X[10]; a3 -= mr1[3] * X[11];
              mr1 = *(const LAS f32x4*)(Mm + 4252);
              __builtin_amdgcn_sched_barrier(0);
              a0 -= mr2[0] * X[12]; a1 -= mr2[1] * X[13]; a2 -= mr2[2] * X[14]; a3 -= mr2[3] * X[15];
              mr2 = *(const LAS f32x4*)(Mm + 4256);
              __builtin_amdgcn_sched_barrier(0);
              a0 -= mr3[0] * X[16]; a1 -= mr3[1] * X[17]; a2 -= mr3[2] * X[18]; a3 -= mr3[3] * X[19];
              mr3 = *(const LAS f32x4*)(Mm + 4260);
              __builtin_amdgcn_sched_barrier(0);
              a0 -= mr4[0] * X[20]; a1 -= mr4[1] * X[21]; a2 -= mr4[2] * X[22]; a3 -= mr4[3] * X[23];
              mr4 = *(const LAS f32x4*)(Mm + 4264);
              __builtin_amdgcn_sched_barrier(0);
              a0 -= mr5[0] * X[24]; a1 -= mr5[1] * X[25]; a2 -= mr5[2] * X[26]; a3 -= mr5[3] * X[27];
              mr5 = *(const LAS f32x4*)(Mm + 4268);
              __builtin_amdgcn_sched_barrier(0);
              a0 -= mr6[0] * X[28]; a1 -= mr6[1] * X[29]; a2 -= mr6[2] * X[30]; a3 -= mr6[3] * X[31];
              mr6 = *(const LAS f32x4*)(Mm + 4272);
              __builtin_amdgcn_sched_barrier(0);
              a0 -= mr0[0] * X[32]; a1 -= mr0[1] * X[33]; a2 -= mr0[2] * X[34]; a3 -= mr0[3] * X[35];
              mr0 = *(const LAS f32x4*)(Mm + 4276);
              __builtin_amdgcn_sched_barrier(0);
              a0 -= mr1[0] * X[36]; a1 -= mr1[1] * X[37]; a2 -= mr1[2] * X[38]; a3 -= mr1[3] * X[39];
              mr1 = *(const LAS f32x4*)(Mm + 4284);
              __builtin_amdgcn_sched_barrier(0);
              a0 -= mr2[0] * X[40]; a1 -= mr2[1] * X[41]; a2 -= mr2[2] * X[42]; a3 -= mr2[3] * X[43];
              mr2 = *(const LAS f32x4*)(Mm + 4288);
              __builtin_amdgcn_sched_barrier(0);
              a0 -= mr3[0] * X[44]; a1 -= mr3[1] * X[45]; a2 -= mr3[2] * X[46]; a3 -= mr3[3] * X[47];
              mr3 = *(const LAS f32x4*)(Mm + 4292);
              __builtin_amdgcn_sched_barrier(0);
              a0 -= mr4[0] * X[48]; a1 -= mr4[1] * X[49]; a2 -= mr4[2] * X[50]; a3 -= mr4[3] * X[51];
              mr4 = *(const LAS f32x4*)(Mm + 4296);
              __builtin_amdgcn_sched_barrier(0);
              a0 -= mr5[0] * X[52]; a1 -= mr5[1] * X[53]; a2 -= mr5[2] * X[54]; a3 -= mr5[3] * X[55];
              mr5 = *(const LAS f32x4*)(Mm + 4300);
              __builtin_amdgcn_sched_barrier(0);
              a0 -= mr6[0] * X[56]; a1 -= mr6[1] * X[57]; a2 -= mr6[2] * X[58]; a3 -= mr6[3] * X[59];
              mr6 = *(const LAS f32x4*)(Mm + 4304);
              __builtin_amdgcn_sched_barrier(0);
              a0 -= mr0[0] * X[60]; a1 -= mr0[1] * X[61];
              X[62] = (a0 + a1) + (a2 + a3); dst[8184] = X[62]; }
            __builtin_amdgcn_sched_barrier(0);
            { float a0 = rh0, a1 = 0.f, a2 = 0.f, a3 = 0.f;
              mr0 = *(const LAS f32x4*)(Mm + 4308);
              __builtin_amdgcn_sched_barrier(0);
              a0 -= mr1[0] * X[0]; a1 -= mr1[1] * X[1]; a2 -= mr1[2] * X[2]; a3 -= mr1[3] * X[3];
              mr1 = *(const LAS f32x4*)(Mm + 4312);
              __builtin_amdgcn_sched_barrier(0);
              a0 -= mr2[0] * X[4]; a1 -= mr2[1] * X[5]; a2 -= mr2[2] * X[6]; a3 -= mr2[3] * X[7];
              mr2 = *(const LAS f32x4*)(Mm + 4316);
              __builtin_amdgcn_sched_barrier(0);
              a0 -= mr3[0] * X[8]; a1 -= mr3[1] * X[9]; a2 -= mr3[2] * X[10]; a3 -= mr3[3] * X[11];
              mr3 = *(const LAS f32x4*)(Mm + 4320);
              __builtin_amdgcn_sched_barrier(0);
              a0 -= mr4[0] * X[12]; a1 -= mr4[1] * X[13]; a2 -= mr4[2] * X[14]; a3 -= mr4[3] * X[15];
              mr4 = *(const LAS f32x4*)(Mm + 4324);
              __builtin_amdgcn_sched_barrier(0);
              a0 -= mr5[0] * X[16]; a1 -= mr5[1] * X[17]; a2 -= mr5[2] * X[18]; a3 -= mr5[3] * X[19];
              mr5 = *(const LAS f32x4*)(Mm + 4328);
              __builtin_amdgcn_sched_barrier(0);
              a0 -= mr6[0] * X[20]; a1 -= mr6[1] * X[21]; a2 -= mr6[2] * X[22]; a3 -= mr6[3] * X[23];
              mr6 = *(const LAS f32x4*)(Mm + 4332);
              __builtin_amdgcn_sched_barrier(0);
              a0 -= mr0[0] * X[24]; a1 -= mr0[1] * X[25]; a2 -= mr0[2] * X[26]; a3 -= mr0[3] * X[27];
              mr0 = *(const LAS f32x4*)(Mm + 4336);
              __builtin_amdgcn_sched_barrier(0);
              a0 -= mr1[0] * X[28]; a1 -= mr1[1] * X[29]; a2 -= mr1[2] * X[30]; a3 -= mr1[3] * X[31];
              mr1 = *(const LAS f32x4*)(Mm + 4340);
              __builtin_amdgcn_sched_barrier(0);
              a0 -= mr2[0] * X[32]; a1 -= mr2[1] * X[33]; a2 -= mr2[2] * X[34]; a3 -= mr2[3] * X[35];
              mr2 = *(const LAS f32x4*)(Mm + 4344);
              __builtin_amdgcn_sched_barrier(0);
              a0 -= mr3[0] * X[36]; a1 -= mr3[1] * X[37]; a2 -= mr3[2] * X[38]; a3 -= mr3[3] * X[39];
              __builtin_amdgcn_sched_barrier(0);
              a0 -= mr4[0] * X[40]; a1 -= mr4[1] * X[41]; a2 -= mr4[2] * X[42]; a3 -= mr4[3] * X[43];
              __builtin_amdgcn_sched_barrier(0);
              a0 -= mr5[0] * X[44]; a1 -= mr5[1] * X[45]; a2 -= mr5[2] * X[46]; a3 -= mr5[3] * X[47];
              __builtin_amdgcn_sched_barrier(0);
              a0 -= mr6[0] * X[48]; a1 -= mr6[1] * X[49]; a2 -= mr6[2] * X[50]; a3 -= mr6[3] * X[51];
              __builtin_amdgcn_sched_barrier(0);
              a0 -= mr0[0] * X[52]; a1 -= mr0[1] * X[53]; a2 -= mr0[2] * X[54]; a3 -= mr0[3] * X[55];
              __builtin_amdgcn_sched_barrier(0);
              a0 -= mr1[0] * X[56]; a1 -= mr1[1] * X[57]; a2 -= mr1[2] * X[58]; a3 -= mr1[3] * X[59];
              __builtin_amdgcn_sched_barrier(0);
              a0 -= mr2[0] * X[60]; a1 -= mr2[1] * X[61]; a2 -= mr2[2] * X[62];
              X[63] = (a0 + a1) + (a2 + a3); dst[8316] = X[63]; }
            __builtin_amdgcn_sched_barrier(0);
            __builtin_amdgcn_s_setprio(0);
        } else {
            const int t2 = tid - 256; const float glast = gt[64 + 63];
#pragma unroll
            for (int i = 0; i < 4; ++i) { const int task = t2 + 256 * i, d = task & 127, gq = task >> 7, g = gq >> 2, q = gq & 3;
                float v[8];
#pragma unroll
                for (int e = 0; e < 4; ++e) { const int ta = 32 * g + 4 * q + e, tb = ta + 16;
                    v[e] = Kf[ta * 132 + d] * __expf(glast - gt[64 + ta]); v[4 + e] = Kf[tb * 132 + d] * __expf(glast - gt[64 + tb]); }
                v4u o; o.x = pk2(v[0], v[1]); o.y = pk2(v[2], v[3]); o.z = pk2(v[4], v[5]); o.w = pk2(v[6], v[7]);
                *(v4u*)(KDT + ((size_t)unit * 128 + d) * 64 + 32 * g + 8 * q) = o; }
            if (t2 == 0) GL[unit] = expf(glast);
        }
        bar_lds();
#pragma unroll
        for (int i = 0; i < 4; ++i) { const int idx = tid + NT * i, t = idx >> 5, c4 = (idx & 31) * 4;
            *(f32x4*)(U + ((size_t)unit * 64 + t) * 128 + c4) = *(const LAS f32x4*)(Vf + t * 132 + c4); }
#pragma unroll
        for (int i = 0; i < 2; ++i) { const int idx = tid + NT * i, t = idx >> 4, c8 = (idx & 15) * 8;
            const LAS float* wf = (const LAS float*)Qb + t * 132 + (c8 & ~31) + ((c8 & 31) >> 1);
            const f32x4 lo = *(const LAS f32x4*)wf, hi = *(const LAS f32x4*)(wf + 16);
            v4u o; o.x = pk2(lo[0], lo[1]); o.y = pk2(lo[2], lo[3]); o.z = pk2(hi[0], hi[1]); o.w = pk2(hi[2], hi[3]);
            *(v4u*)(WKb + ((size_t)unit * 64 + t) * 128 + c8) = o; }
        bar_lds();
    }
}

DI void phase_mix(const Args& a, int l, LAS unsigned char* lds, int tid, int lane, int wave, int bid, int G) {
    unsigned char* ws = a.ws;
    const bf16* P = (const bf16*)(ws + WS_P);
    bf16* MIX = (bf16*)a.out;
    const int r = lane & 15, q = lane >> 4;
    if (bid < 64) {
        const char* QDc = (const char*)(ws + WS_QD); const char* WKc = (const char*)(ws + WS_WK); const char* KDTc = (const char*)(ws + WS_KDT); const char* ACc = (const char*)(ws + WS_AC);
        const float* U = (const float*)(ws + WS_U); const float* GL = (const float*)(ws + WS_GL);
        const int bh = bid >> 1, h = bh & 3, b = bh >> 2, col = 64 * (bid & 1) + 16 * (wave & 3) + r; const bool act = wave < 4;
        constexpr int SBUF = 73728;
        const float glv = GL[(size_t)bh * 64 + lane];
        const unsigned ldsbase = (unsigned)__builtin_amdgcn_readfirstlane((int)(unsigned)(size_t)lds);
        unsigned o256[2], o128[2], ra[4], rk[2], ou[2];
        const char* Uc = (const char*)U + (bid & 1) * 256;
#pragma unroll
        for (int i = 0; i < 2; ++i) { const int sl = (wave + 8 * i) * 64 + lane;
            { const int row = sl >> 4, kc = (sl & 15) ^ (row & 15); o256[i] = (unsigned)(row * 256 + kc * 16); }
            { const int row = sl >> 3, kc = (sl & 7) ^ ((row >> 1) & 7); o128[i] = (unsigned)(row * 128 + kc * 16); }
            ou[i] = (unsigned)((sl >> 4) * 512 + (sl & 15) * 16); }
#pragma unroll
        for (int ks = 0; ks < 4; ++ks) ra[ks] = (unsigned)(r * 256 + (((4 * ks + q) ^ r) << 4));
#pragma unroll
        for (int ks = 0; ks < 2; ++ks) rk[ks] = (unsigned)(r * 128 + (((4 * ks + q) ^ (r >> 1)) << 4));
#define SC_GLDS(gp, loff) glds16((const void*)(gp), ldsbase + (unsigned)(loff))
#define SC_STAGE(n_, b_) do { const size_t un_ = (size_t)bh * 64 + (n_); const int lb_ = (b_) * SBUF + wave * 1024; \
            SC_GLDS(WKc + un_ * 16384 + o256[0], lb_); SC_GLDS(WKc + un_ * 16384 + o256[1], lb_ + 8192); \
            SC_GLDS(QDc + un_ * 16384 + o256[0], lb_ + 16384); SC_GLDS(QDc + un_ * 16384 + o256[1], lb_ + 16384 + 8192); \
            SC_GLDS(KDTc + un_ * 16384 + o128[0], lb_ + 32768); SC_GLDS(KDTc + un_ * 16384 + o128[1], lb_ + 32768 + 8192); \
            SC_GLDS(ACc + un_ * 8192 + o128[0], lb_ + 49152); \
            SC_GLDS(Uc + un_ * 32768 + ou[0], lb_ + 57344); SC_GLDS(Uc + un_ * 32768 + ou[1], lb_ + 57344 + 8192); } while (0)
        f32x4 S[8];
#pragma unroll
        for (int mt = 0; mt < 8; ++mt) S[mt] = (f32x4){0.f, 0.f, 0.f, 0.f};
        if (act) __builtin_amdgcn_s_setprio(2);
        SC_STAGE(0, 0);
        asm volatile("s_waitcnt vmcnt(0)" ::: "memory"); __syncthreads();
        bf16* Og = (bf16*)(ws + WS_P) + (size_t)b * SEQ * NP + 1024 + h * 128 + col;
        f32x4 ovp[4];
#pragma unroll
        for (int mt = 0; mt < 4; ++mt) ovp[mt] = (f32x4){0.f, 0.f, 0.f, 0.f};
        for (int n = 0; n <= 64; ++n) {
            const int cur = n & 1;
            if (n == 64) break;
            if (n + 1 < 64) SC_STAGE(n + 1, cur ^ 1);
            if (act) {
            const LAS unsigned char* sb = lds + cur * SBUF;
            bf16x8 fa[16], fb[16], fc[8]; float ul[16];
#pragma unroll
            for (int mt = 0; mt < 4; ++mt)
#pragma unroll
                for (int ks = 0; ks < 4; ++ks) fa[mt * 4 + ks] = *(const LAS bf16x8*)(sb + mt * 4096 + ra[ks]);
#pragma unroll
            for (int mt = 0; mt < 4; ++mt)
#pragma unroll
                for (int ks = 0; ks < 4; ++ks) fb[mt * 4 + ks] = *(const LAS bf16x8*)(sb + 16384 + mt * 4096 + ra[ks]);
            bf16x8 Sb[4];
#pragma unroll
            for (int ks = 0; ks < 4; ++ks) Sb[ks] = pack8(S[2 * ks], S[2 * ks + 1]);
            __builtin_amdgcn_sched_barrier(0);
            f32x4 wv[4], ov[4];
#pragma unroll
            for (int mt = 0; mt < 4; ++mt) { f32x4 acc = {0.f, 0.f, 0.f, 0.f};
#pragma unroll
                for (int ks = 0; ks < 4; ++ks) acc = MFMA16(fa[mt * 4 + ks], Sb[ks], acc);
                wv[mt] = acc; }
#pragma unroll
            for (int mt = 0; mt < 4; ++mt) { const LAS float* up = (const LAS float*)(sb + 57344 + (16 * mt + 4 * q) * 256 + (16 * (wave & 3) + r) * 4);
#pragma unroll
                for (int i = 0; i < 4; ++i) ul[mt * 4 + i] = up[i * 64];
#pragma unroll
                for (int ks = 0; ks < 2; ++ks) fc[mt * 2 + ks] = *(const LAS bf16x8*)(sb + 49152 + mt * 2048 + rk[ks]); }
            __builtin_amdgcn_sched_barrier(0);
#pragma unroll
            for (int mt = 0; mt < 4; ++mt) { f32x4 acc = {0.f, 0.f, 0.f, 0.f};
#pragma unroll
                for (int ks = 0; ks < 4; ++ks) acc = MFMA16(fb[mt * 4 + ks], Sb[ks], acc);
                ov[mt] = acc; }
#pragma unroll
            for (int mt = 0; mt < 8; ++mt)
#pragma unroll
                for (int ks = 0; ks < 2; ++ks) fa[mt * 2 + ks] = *(const LAS bf16x8*)(sb + 32768 + mt * 2048 + rk[ks]);
            __builtin_amdgcn_sched_barrier(0);
#pragma unroll
            for (int mt = 0; mt < 4; ++mt)
#pragma unroll
                for (int i = 0; i < 4; ++i) wv[mt][i] = ul[mt * 4 + i] - wv[mt][i];
            bf16x8 Wb[2];
#pragma unroll
            for (int ks = 0; ks < 2; ++ks) Wb[ks] = pack8(wv[2 * ks], wv[2 * ks + 1]);
#pragma unroll
            for (int mt = 0; mt < 4; ++mt)
#pragma unroll
                for (int ks = 0; ks < 2; ++ks) ov[mt] = MFMA16(fc[mt * 2 + ks], Wb[ks], ov[mt]);
            const float gl = __builtin_bit_cast(float, __builtin_amdgcn_readlane(__builtin_bit_cast(int, glv), n));
#pragma unroll
            for (int mt = 0; mt < 8; ++mt) { S[mt] = S[mt] * gl;
#pragma unroll
                for (int ks = 0; ks < 2; ++ks) S[mt] = MFMA16(fa[mt * 2 + ks], Wb[ks], S[mt]); }
            { GAS bf16* og = (GAS bf16*)(Og + (size_t)(n * 64 + 4 * q) * NP);
#pragma unroll
              for (int mt = 0; mt < 4; ++mt)
#pragma unroll
                  for (int i = 0; i < 4; ++i) og[(size_t)(16 * mt + i) * NP] = f2bf(ov[mt][i]); }
            asm volatile("s_waitcnt vmcnt(16) lgkmcnt(0)\n\ts_barrier" ::: "memory");
            } else {
            asm volatile("s_waitcnt vmcnt(0) lgkmcnt(0)\n\ts_barrier" ::: "memory");
            }
        }
__builtin_amdgcn_s_setprio(0);
#undef SC_STAGE
#undef SC_GLDS
    } else {
        const float* lng = a.in[6] + l * 512; const float* lnb = a.in[7] + l * 512;
        const float* sw = a.in[8] + (size_t)l * 4 * 128 * 128; const float* sb = a.in[9] + l * 4 * 128;
        LAS float* stat = (LAS float*)lds;
        LAS bf16* vnT = (LAS bf16*)(lds + 1024);
        for (int unit = bid - 64; unit < 256; unit += G - 64) {
            const int b = unit >> 5, n = unit & 31; const size_t m0 = (size_t)b * SEQ + n * 128;
            { const int row = tid >> 2, part = tid & 3; const bf16* src = P + (m0 + row) * NP + 512 + part * 128;
              float s = 0.f, s2 = 0.f;
#pragma unroll 4
              for (int i = 0; i < 16; ++i) { const v4u x = *(const v4u*)(src + 8 * i);
                  const float g0 = gelu_tanh(bflo(x.x)), g1 = gelu_tanh(bfhi(x.x)), g2 = gelu_tanh(bflo(x.y)), g3 = gelu_tanh(bfhi(x.y)),
                              g4 = gelu_tanh(bflo(x.z)), g5 = gelu_tanh(bfhi(x.z)), g6 = gelu_tanh(bflo(x.w)), g7 = gelu_tanh(bfhi(x.w));
                  s += ((g0 + g1) + (g2 + g3)) + ((g4 + g5) + (g6 + g7));
                  s2 += ((g0 * g0 + g1 * g1) + (g2 * g2 + g3 * g3)) + ((g4 * g4 + g5 * g5) + (g6 * g6 + g7 * g7)); }
              s += __shfl_xor(s, 1); s += __shfl_xor(s, 2); s2 += __shfl_xor(s2, 1); s2 += __shfl_xor(s2, 2);
              const float mean = s * (1.f / 512.f), var = fmaxf(s2 * (1.f / 512.f) - mean * mean, 0.f);
              if (part == 0) { stat[2 * row] = mean; stat[2 * row + 1] = rsqrtf(var + 1e-5f); } }
            bar_lds();
            for (int h = 0; h < 4; ++h) {
                LAS bf16* vt = vnT + (h & 1) * (128 * 136);
                const float* Wm = sw + ((size_t)h * 128 + 16 * wave + r) * 128;
                f32x4 wq[4][2];
#pragma unroll
                for (int ks = 0; ks < 4; ++ks) { wq[ks][0] = *(const f32x4*)(Wm + 32 * ks + 8 * q); wq[ks][1] = *(const f32x4*)(Wm + 32 * ks + 8 * q + 4); }
                bf16 uq[4][8];
#pragma unroll
                for (int i = 0; i < 4; ++i)
#pragma unroll
                    for (int nt = 0; nt < 8; ++nt) uq[i][nt] = P[(m0 + 16 * wave + 4 * q + i) * NP + h * 128 + 16 * nt + r];
#pragma unroll
                for (int i = 0; i < 4; ++i) { const int task = tid + NT * i, s = task & 127, dg = task >> 7;
                    const v4u x = *(const v4u*)(P + (m0 + s) * NP + 512 + h * 128 + dg * 8);
                    const float mean = stat[2 * s], rstd = stat[2 * s + 1];
                    const f32x4 g0 = *(const f32x4*)(lng + h * 128 + dg * 8), g1 = *(const f32x4*)(lng + h * 128 + dg * 8 + 4);
                    const f32x4 b0 = *(const f32x4*)(lnb + h * 128 + dg * 8), b1 = *(const f32x4*)(lnb + h * 128 + dg * 8 + 4);
                    const float xv[8] = {bflo(x.x), bfhi(x.x), bflo(x.y), bfhi(x.y), bflo(x.z), bfhi(x.z), bflo(x.w), bfhi(x.w)};
#pragma unroll
                    for (int e = 0; e < 8; ++e) { const float gg = e < 4 ? g0[e & 3] : g1[e & 3], bb = e < 4 ? b0[e & 3] : b1[e & 3];
                        vt[(dg * 8 + e) * 136 + s] = f2bf((gelu_tanh(xv[e]) - mean) * rstd * gg + bb); } }
                bar_lds();
                f32x4 acc[8];
#pragma unroll
                for (int nt = 0; nt < 8; ++nt) acc[nt] = (f32x4){0.f, 0.f, 0.f, 0.f};
                const int tA = 16 * wave + r;
#pragma unroll
                for (int ks = 0; ks < 4; ++ks) { if (ks > (wave >> 1)) break;
                    const int s0 = 32 * ks + 8 * q;
                    f32x4 w0 = wq[ks][0], w1 = wq[ks][1];
#pragma unroll
                    for (int e = 0; e < 4; ++e) { if (s0 + e > tA) w0[e] = 0.f; if (s0 + 4 + e > tA) w1[e] = 0.f; }
                    const bf16x8 af = pack8(w0, w1);
#pragma unroll
                    for (int nt = 0; nt < 8; ++nt) acc[nt] = MFMA16(af, *(const LAS bf16x8*)(vt + (16 * nt + r) * 136 + s0), acc[nt]);
                }
#pragma unroll
                for (int i = 0; i < 4; ++i) { const int t = 16 * wave + 4 * q + i; const float bs = sb[h * 128 + t];
#pragma unroll
                    for (int nt = 0; nt < 8; ++nt) { const int d = 16 * nt + r;
                        const float uu = bf2f(uq[i][nt]);
                        MIX[(m0 + t) * D + h * 128 + d] = f2bf(gelu_tanh(uu) * (acc[nt][i] + bs)); } }
            }
            bar_lds();
        }
        if (l + 1 < DEPTH && bid >= 128) convert_weights(a, l + 1, lds + 73728, wave, lane, (bid - 128) * NWAVES + wave, (G - 128) * NWAVES);
    }
}

DI void phase_gnorm(const Args& a, int l, int tid, int lane, int wave, int bid, int G) {
    const bf16* P = (const bf16*)(a.ws + WS_P); bf16* MIX = (bf16*)a.out;
    const float* ngp = a.in[13] + l * 128 + (lane & 15) * 8;
    const f32x4 g0 = *(const f32x4*)ngp, g1 = *(const f32x4*)(ngp + 4);
    for (int m = bid * NWAVES + wave; m < M; m += G * NWAVES) {
        const v4u ob = *(const v4u*)(P + (size_t)m * NP + 1024 + lane * 8), zb = *(const v4u*)(P + (size_t)m * NP + 2560 + lane * 8);
        f32x4 o0 = {bflo(ob.x), bfhi(ob.x), bflo(ob.y), bfhi(ob.y)}, o1 = {bflo(ob.z), bfhi(ob.z), bflo(ob.w), bfhi(ob.w)};
        const f32x4 z0 = {bflo(zb.x), bfhi(zb.x), bflo(zb.y), bfhi(zb.y)}, z1 = {bflo(zb.z), bfhi(zb.z), bflo(zb.w), bfhi(zb.w)};
        float ss = ((o0[0] * o0[0] + o0[1] * o0[1]) + (o0[2] * o0[2] + o0[3] * o0[3])) + ((o1[0] * o1[0] + o1[1] * o1[1]) + (o1[2] * o1[2] + o1[3] * o1[3]));
        ss = row16_sum(ss);
        const float rstd = rsqrtf(ss * (1.f / 128.f) + 1e-6f);
        o0 = o0 * rstd * g0; o1 = o1 * rstd * g1;
        v4u w; w.x = pk2(o0[0] * silu_f(z0[0]), o0[1] * silu_f(z0[1])); w.y = pk2(o0[2] * silu_f(z0[2]), o0[3] * silu_f(z0[3]));
        w.z = pk2(o1[0] * silu_f(z1[0]), o1[1] * silu_f(z1[1])); w.w = pk2(o1[2] * silu_f(z1[2]), o1[3] * silu_f(z1[3]));
        *(v4u*)(MIX + (size_t)m * D + 512 + lane * 8) = w;
    }
}

#define XB_TMO      128
#define XB_XCNT(j)  (256  + 64 * (j))
#define XB_XSUB(j)  (1280 + 64 * (j))
#define XB_XGEN(j)  (2304 + 64 * (j))
#define XB_TOP      3328
#define XB_TOPGEN   3392
#define XCD_BAR_WORDS 3456
#define XB_SPIN_CAP (1u << 18)

__device__ __forceinline__ unsigned xb_ld(unsigned* p)              { return __hip_atomic_load(p, __ATOMIC_RELAXED, __HIP_MEMORY_SCOPE_AGENT); }
__device__ __forceinline__ unsigned xb_add(unsigned* p, unsigned v) { return __hip_atomic_fetch_add(p, v, __ATOMIC_RELAXED, __HIP_MEMORY_SCOPE_AGENT); }
__device__ __forceinline__ unsigned xb_xcc_id() { return (unsigned)__builtin_amdgcn_s_getreg((3 << 11) | 20) & 0xFu; }
#define XB_SPIN(cond, bar) do { unsigned _sp = 0; while (cond) { __builtin_amdgcn_s_sleep(1); \
    if ((++_sp & 255u) == 0u) { if (xb_ld(&(bar)[XB_TMO])) break; if (_sp > XB_SPIN_CAP) { atomicAdd(&(bar)[XB_TMO], 1u); break; } } } } while (0)

struct XcdBarrier {
    unsigned* bar; unsigned x;
    volatile LAS unsigned* st;
};

__device__ __forceinline__ XcdBarrier xcd_barrier_post(unsigned* bar, volatile LAS unsigned* st) {
    XcdBarrier b; b.bar = bar; b.x = xb_xcc_id(); b.st = st;
    if (threadIdx.x == 0) (void)xb_add(&bar[XB_XCNT(b.x)], 1u);
    return b;
}
__device__ __forceinline__ void xcd_barrier_complete(unsigned* bar, unsigned x, unsigned& nloc, unsigned& nx) {
    const unsigned G = gridDim.x * gridDim.y * gridDim.z;
    unsigned sum, cnt, mine, sp = 0u;
    for (;;) {
        sum = 0u; cnt = 0u; mine = 0u;
#pragma unroll
        for (unsigned j = 0; j < 16; ++j) { const unsigned c = xb_ld(&bar[XB_XCNT(j)]); sum += c; cnt += (c > 0u) ? 1u : 0u; mine = (j == x) ? c : mine; }
        if (sum == G) break;
        __builtin_amdgcn_s_sleep(1);
        if ((++sp & 255u) == 0u) { if (xb_ld(&bar[XB_TMO])) break; if (sp > XB_SPIN_CAP) { atomicAdd(&bar[XB_TMO], 1u); break; } }
    }
    nloc = mine > 0u ? mine : 1u; nx = cnt > 0u ? cnt : 1u;
}

__device__ __forceinline__ void xcd_barrier(const XcdBarrier& b) {
    asm volatile("s_waitcnt vmcnt(0)" ::: "memory");
    __syncthreads();
    if (threadIdx.x == 0) {
        unsigned* bar = b.bar;
        __builtin_amdgcn_s_waitcnt(0);
        unsigned nloc = b.st[0], nx = b.st[1];
        if (nloc == 0u) { xcd_barrier_complete(bar, b.x, nloc, nx); b.st[0] = nloc; b.st[1] = nx; }
        const unsigned old = xb_add(&bar[XB_XSUB(b.x)], 1u);
        const unsigned gen = old / nloc;
        if (old + 1u == (gen + 1u) * nloc) {
            __builtin_amdgcn_fence(__ATOMIC_RELEASE, "agent");
            asm volatile("s_waitcnt vmcnt(0)" ::: "memory");
            const unsigned og = xb_add(&bar[XB_TOP], 1u);
            const unsigned tg = og / nx;
            if (og + 1u == (tg + 1u) * nx) xb_add(&bar[XB_TOPGEN], 1u);
            else XB_SPIN(xb_ld(&bar[XB_TOPGEN]) == tg, bar);
            __builtin_amdgcn_fence(__ATOMIC_ACQUIRE, "agent");
            xb_add(&bar[XB_XGEN(b.x)], 1u);
            asm volatile("s_waitcnt vmcnt(0)" ::: "memory");
        } else {
            XB_SPIN(xb_ld(&bar[XB_XGEN(b.x)]) == gen, bar);
            __builtin_amdgcn_fence(__ATOMIC_ACQUIRE, "agent");
            asm volatile("s_waitcnt vmcnt(0)" ::: "memory");
        }
    }
    __syncthreads();
}

__global__ void __launch_bounds__(NT, 2) mk_fwd(Args a_in) {
    extern __shared__ __attribute__((aligned(16))) unsigned char lds_raw[];
    LAS unsigned char* lds = (LAS unsigned char*)lds_raw;
    cg::grid_group grid = cg::this_grid();
    volatile LAS unsigned* bst = (volatile LAS unsigned*)(lds + LDS_BYTES - 64);
    if (threadIdx.x < 2) bst[threadIdx.x] = 0u;
    __syncthreads();
    XcdBarrier xbar = xcd_barrier_post((unsigned*)(a_in.ws + WS_CTL), bst);
    int rep = 0;
    for (int ph = a_in.ph_lo; ph < a_in.ph_hi; ) {
        int tid = threadIdx.x; asm volatile("" : "+v"(tid));
        const int lane = tid & 63, wave = __builtin_amdgcn_readfirstlane(tid >> 6);
        int bid = blockIdx.x, G = gridDim.x; asm volatile("" : "+s"(bid)); asm volatile("" : "+s"(G));
        Args a = a_in; asm volatile("" : "+s"(a.ws)); asm volatile("" : "+s"(a.out));
        unsigned char* ws = a.ws;
        const float* mod = (const float*)(ws + WS_MOD);
        if (ph == 0) { if (PH_EN(8)) { phase_mod(a, lds, tid, lane, wave, bid, G); convert_weights(a, 0, lds + 49152, wave, lane, bid * NWAVES + wave, G * NWAVES); } }
        else if (ph == NPHASE - 1) { if (PH_EN(9)) phase_norm<2>(a, 0, lds, tid, lane, wave, bid, G); }
        else {
            const int l = (ph - 1) / 9, s0 = (ph - 1) % 9, s = s0 <= 3 ? s0 : s0 - 1;
            if (s0 == 4) { if (PH_EN(10)) phase_gnorm(a, l, tid, lane, wave, bid, G); }
            else if (s == 0) { if (PH_EN(0)) phase_norm<0>(a, l, lds, tid, lane, wave, bid, G); }
            else if (s == 1) { if (PH_EN(1)) {
                pg8::Gemm g{(const bf16*)(ws + WS_H), (const bf16*)(ws + ws_wset(l)), M, NP, D}; pg8::StaticOrder S; S.init(M, NP, G, bid);
                pg8::EpiBf16<0> E{(bf16*)(ws + WS_P), NP, nullptr, 0, 0, 1.f};
                pg8::gemm_phase<pg8::EpiBf16<0>, pg8::StaticOrder, true, true>(lds, g, S, E, tid);
            } }
            else if (s == 2) { if (PH_EN(2)) phase_prep(a, l, lds, tid, lane, wave, bid, G); }
            else if (s == 3) { if (PH_EN(3) && rep < (bid < 64 ? REP_SCAN : REP_SGU)) phase_mix(a, l, lds, tid, lane, wave, bid, G); }
            else if (s == 4) { if (PH_EN(4)) {
                pg8::Gemm g{(const bf16*)a.out, (const bf16*)(ws + ws_wset(l) + W_OFF_OUT), M, D, D}; pg8::StaticOrder S; S.init(M, D, G, bid);
                if (l == 0) { pg8::EpiGateRes<true> E{(const void*)a.in[0], (bf16*)(ws + WS_X), D, mod + 2048};
                    pg8::gemm_phase<pg8::EpiGateRes<true>, pg8::StaticOrder, true, true>(lds, g, S, E, tid); }
                else { pg8::EpiGateRes<false> E{(const void*)(ws + WS_X), (bf16*)(ws + WS_X), D, mod + (size_t)l * 8 * NMOD + 2048};
                    pg8::gemm_phase<pg8::EpiGateRes<false>, pg8::StaticOrder, true, true>(lds, g, S, E, tid); }
            } }
            else if (s == 5) { if (PH_EN(5)) phase_norm<1>(a, l, lds, tid, lane, wave, bid, G); }
            else if (s == 6) { if (PH_EN(6)) {
                pg8::Gemm g{(const bf16*)(ws + WS_H), (const bf16*)(ws + ws_wset(l) + W_OFF_1), M, FF, D}; pg8::StaticOrder S; S.init(M, FF, G, bid);
                pg8::EpiBf16<2> E{(bf16*)(ws + WS_F), FF, nullptr, 0, 0, 1.f};
                pg8::gemm_phase<pg8::EpiBf16<2>, pg8::StaticOrder, true, true>(lds, g, S, E, tid);
            } }
            else { if (PH_EN(7)) {
                pg8::Gemm g{(const bf16*)(ws + WS_F), (const bf16*)(ws + ws_wset(l) + W_OFF_2), M, D, FF}; pg8::StaticOrder S; S.init(M, D, G, bid);
                pg8::EpiGateRes<false> E{(const void*)(ws + WS_X), (bf16*)(ws + WS_X), D, mod + (size_t)l * 8 * NMOD + 5120};
                pg8::gemm_phase<pg8::EpiGateRes<false>, pg8::StaticOrder, true, true>(lds, g, S, E, tid);
            } }
        }
        { const int s9 = (ph - 1) % 9; const int sx = (ph == 0) ? 8 : (ph == NPHASE - 1) ? 9 : s9 == 4 ? 10 : s9 < 4 ? s9 : s9 - 1;
          const int reps = sx == 8 ? REP_MOD : sx == 0 ? REP_N0 : sx == 1 ? REP_G1 : sx == 2 ? REP_PREP : sx == 3 ? (REP_SCAN > REP_SGU ? REP_SCAN : REP_SGU) : sx == 5 ? REP_N1 : sx == 6 ? REP_FF1 : 1;
          const bool again = rep + 1 < reps;
          if (again || ph + 1 < a_in.ph_hi) { if (a_in.ph_lo < 0) grid.sync();   xcd_barrier(xbar); for (int i = 0; i < REP_SYNC; ++i) xcd_barrier(xbar); }
          if (again) ++rep; else { rep = 0; ++ph; } }
    }
}

extern "C" void kernel_launch(void* const* d_in, const int* in_sizes, int n_in, void* d_out, int out_size, void* d_ws, size_t ws_size, hipStream_t stream) {
    static int grid = 0;
    if (grid == 0) {
        if (n_in != 19 || in_sizes[0] != M * D || out_size != M * D || ws_size < WS_END) {
            fprintf(stderr, "kernel_launch: unexpected problem: n_in %d in0 %d out %d ws %zu (need %zu)\n", n_in, n_in > 0 ? in_sizes[0] : -1, out_size, ws_size, (size_t)WS_END); grid = -1; return; }
        int dev = 0, cus = 0, per_cu = 0;
        if (hipGetDevice(&dev) != hipSuccess || hipDeviceGetAttribute(&cus, hipDeviceAttributeMultiprocessorCount, dev) != hipSuccess) { fprintf(stderr, "kernel_launch: device query failed\n"); grid = -1; return; }
        if (hipFuncSetAttribute((const void*)mk_fwd, hipFuncAttributeMaxDynamicSharedMemorySize, LDS_BYTES) != hipSuccess) { fprintf(stderr, "kernel_launch: hipFuncSetAttribute failed\n"); grid = -1; return; }
        if (hipOccupancyMaxActiveBlocksPerMultiprocessor(&per_cu, (const void*)mk_fwd, NT, LDS_BYTES) != hipSuccess || per_cu < 1) { fprintf(stderr, "kernel_launch: occupancy query gives %d\n", per_cu); per_cu = 1; }
        (void)hipGetLastError();
        grid = cus * per_cu;
        if (grid > 256) grid = 256;
        if (grid < 64) { fprintf(stderr, "kernel_launch: grid %d too small\n", grid); grid = -1; return; }
    }
    if (grid < 0) return;
    if (hipMemsetAsync((char*)d_ws + WS_CTL, 0, 16384, stream) != hipSuccess) { fprintf(stderr, "kernel_launch: memset of the barrier words failed\n"); return; }
    Args a{};
    for (int i = 0; i < 19; ++i) a.in[i] = (const float*)d_in[i];
    a.out = (float*)d_out; a.ws = (unsigned char*)d_ws;
#if MK_LAUNCHES == 1
    a.ph_lo = 0; a.ph_hi = NPHASE;
    { void* args[] = {&a};
      hipError_t e = hipLaunchCooperativeKernel((const void*)mk_fwd, dim3(grid), dim3(NT), args, LDS_BYTES, stream);
      if (e != hipSuccess) fprintf(stderr, "kernel_launch: cooperative launch failed: %s (grid %d)\n", hipGetErrorString(e), grid); }
#else
    for (int ph = 0; ph < NPHASE; ++ph) {
        a.ph_lo = ph; a.ph_hi = ph + 1;
        void* args[] = {&a};
        hipError_t e = hipLaunchCooperativeKernel((const void*)mk_fwd, dim3(grid), dim3(NT), args, LDS_BYTES, stream);
        if (e != hipSuccess) { fprintf(stderr, "kernel_launch: launch of phase %d failed: %s (grid %d)\n", ph, hipGetErrorString(e), grid); break; }
    }
#endif
}
```

```cpp
#include <hip/hip_runtime.h>
#include <hip/hip_cooperative_groups.h>
#include <cstdio>
#include <cstdint>
namespace cg = cooperative_groups;
namespace pg8 {
#define PG8_LAS __attribute__((address_space(3)))
typedef unsigned short bf16_t;
typedef short bf16x8 __attribute__((ext_vector_type(8)));
typedef float f32x4 __attribute__((ext_vector_type(4)));
typedef unsigned u32x4 __attribute__((ext_vector_type(4)));
constexpr int BM = 256, BK = 64, HALF = 128, HTB = HALF * BK * 2  , STAGE_BYTES = 8 * HTB, NXCD = 8, WGM = 8;

__host__ __device__ __forceinline__ int lds_byte(int r, int c) { const int st = (r >> 4) * 2 + (c >> 5), rr = r & 15, cc = c & 31, ob = rr * 64 + cc * 2; return st * 1024 + (ob ^ (((ob >> 9) & 1) << 5)); }
__host__ __device__ __forceinline__ void stage_rc(int b, int& R, int& C) { const int st = b / 1024, sb = b % 1024, swz = sb ^ (((sb >> 9) & 1) << 5); R = (st >> 1) * 16 + swz / 64; C = (st & 1) * 32 + (swz % 64) / 2; }
__host__ __device__ __forceinline__ int perm32(int rho) { const int n = rho >> 4, i = rho & 15; return 8 * (i >> 2) + 4 * n + (i & 3); }

struct Unit { int pm, pn; };
struct Gemm { const bf16_t* A; const bf16_t* Bt; int M, N, K; };

struct StaticOrder {
    int nM, nN, nwg, G, c;
    __host__ __device__ void init(int M, int N, int G_, int c_) { nM = M / BM; nN = N / BM; nwg = nM * nN; G = G_; c = c_; }
    __host__ __device__ bool next(int i, Unit& u) const {
        const long L = (long)i * G + c; if (L >= nwg) return false;
        int wgid = (int)L; { const int q = nwg / NXCD, r = nwg % NXCD, xcd = wgid % NXCD, off = wgid / NXCD; wgid = (xcd < r ? xcd * (q + 1) : r * (q + 1) + (xcd - r) * q) + off; }
        const int nig = WGM * nN, gid = wgid / nig, fm = gid * WGM, gsz = (nM - fm) < WGM ? (nM - fm) : WGM;
        u.pm = fm + ((wgid % nig) % gsz); u.pn = (wgid % nig) / gsz; return true;
    }
    __device__ __forceinline__ void a_ready(const Unit&) const {}
    __device__ __forceinline__ void done(const Unit&) const {}
};

__device__ __forceinline__ unsigned cvt_pk_bf16(float lo, float hi) { unsigned r; asm volatile("v_cvt_pk_bf16_f32 %0, %1, %2" : "=v"(r) : "v"(lo), "v"(hi)); return r; }
typedef float f32x2 __attribute__((ext_vector_type(2)));
__device__ __forceinline__ f32x2 gelu_pk(f32x2 v) {
    const f32x2 av = __builtin_elementwise_abs(v), d = av * 0.2316418882f + 1.0f;
    f32x2 t; t.x = __builtin_amdgcn_rcpf(d.x); t.y = __builtin_amdgcn_rcpf(d.y);
    f32x2 q = t * 0.5307027145f + (-0.7265760135f); q = q * t + 0.7107068705f; q = q * t + (-0.142248368f); q = q * t + 0.127414796f; q = q * t;
    const f32x2 s = (v * v) * (-0.72134752044f);
    f32x2 e; e.x = __builtin_amdgcn_exp2f(s.x); e.y = __builtin_amdgcn_exp2f(s.y);
    const f32x2 m = v * (q * e), r = v - m;
    f32x2 o; o.x = v.x < 0.f ? m.x : r.x; o.y = v.y < 0.f ? m.y : r.y; return o;
}

template <int ACT  > struct EpiBf16 {
    static constexpr bool PERM = true, AFTER_DRAIN = false; static_assert(ACT == 0 || ACT == 1 || ACT == 2, "EpiBf16: ACT is 0 (none), 1 (gelu_pk) or 2 (squared relu)");
    bf16_t* O; int ldc; const float* bias; int split_cols; size_t split_stride; float scale0;
    __device__ __forceinline__ void operator()(const f32x4 (&acc)[2][2][4][2], const Unit& u, int wr, int wc, int fr, int fq) const {
        const int row0 = u.pm * BM + wr * 64 + fr; int colt = u.pn * BM; bf16_t* base = O;
        float sc = 1.f; if (split_cols) { const int t = colt / split_cols; base += (size_t)t * split_stride; colt -= t * split_cols; if (t == 0) sc = scale0; }
        const int col0 = colt + wc * 32 + 8 * fq, bcol0 = u.pn * BM + wc * 32 + 8 * fq;
        f32x4 bv[2][2];
#pragma unroll
        for (int bj = 0; bj < 2; ++bj)
#pragma unroll
            for (int n = 0; n < 2; ++n) bv[bj][n] = bias ? *(const f32x4*)(bias + bcol0 + bj * HALF + 4 * n) : (f32x4){0.f, 0.f, 0.f, 0.f};
#pragma unroll
        for (int ai = 0; ai < 2; ++ai)
#pragma unroll
            for (int m = 0; m < 4; ++m) { bf16_t* rowp = base + (size_t)(row0 + ai * HALF + m * 16) * ldc + col0;
#pragma unroll
                for (int bj = 0; bj < 2; ++bj) { f32x4 v0 = acc[ai][bj][m][0] + bv[bj][0], v1 = acc[ai][bj][m][1] + bv[bj][1];
                    if (ACT == 1) { f32x2 a = gelu_pk((f32x2){v0[0], v0[1]}), b = gelu_pk((f32x2){v0[2], v0[3]}), c = gelu_pk((f32x2){v1[0], v1[1]}), d = gelu_pk((f32x2){v1[2], v1[3]});
                        v0 = (f32x4){a.x, a.y, b.x, b.y}; v1 = (f32x4){c.x, c.y, d.x, d.y}; }
                    if (ACT == 2) { v0 = __builtin_elementwise_max(v0, (f32x4){0.f, 0.f, 0.f, 0.f}); v1 = __builtin_elementwise_max(v1, (f32x4){0.f, 0.f, 0.f, 0.f}); v0 = v0 * v0; v1 = v1 * v1; }
                    v0 = v0 * sc; v1 = v1 * sc; u32x4 w; w.x = cvt_pk_bf16(v0[0], v0[1]); w.y = cvt_pk_bf16(v0[2], v0[3]); w.z = cvt_pk_bf16(v1[0], v1[1]); w.w = cvt_pk_bf16(v1[2], v1[3]);
                    if (ACT == 2) __builtin_nontemporal_store(w, (u32x4*)(rowp + bj * HALF));
                    else *(u32x4*)(rowp + bj * HALF) = w; } }
    }
};
template <bool BASE_F32> struct EpiGateRes {
    static constexpr bool PERM = true, AFTER_DRAIN = false;
    const void* base; bf16_t* out; int ldc; const float* gate;
    __device__ __forceinline__ void operator()(const f32x4 (&acc)[2][2][4][2], const Unit& u, int wr, int wc, int fr, int fq) const {
        const int col0 = u.pn * BM + wc * 32 + 8 * fq;
        const float* gp = gate + (size_t)(u.pm >> 4) * 6144 + col0;
        f32x4 gv[2][2];
#pragma unroll
        for (int bj = 0; bj < 2; ++bj)
#pragma unroll
            for (int n = 0; n < 2; ++n) gv[bj][n] = *(const f32x4*)(gp + bj * HALF + 4 * n);
#pragma unroll
        for (int ai = 0; ai < 2; ++ai)
#pragma unroll
            for (int m = 0; m < 4; ++m) { const size_t off = (size_t)(u.pm * BM + ai * HALF + wr * 64 + m * 16 + fr) * ldc + col0;
#pragma unroll
                for (int bj = 0; bj < 2; ++bj) { f32x4 b0, b1;
                    if (BASE_F32) { const float* bp = (const float*)base + off + bj * HALF; b0 = *(const f32x4*)bp; b1 = *(const f32x4*)(bp + 4); }
                    else { const u32x4 w = *(const u32x4*)((const bf16_t*)base + off + bj * HALF);
                        b0 = (f32x4){__uint_as_float(w.x << 16), __uint_as_float(w.x & 0xffff0000u), __uint_as_float(w.y << 16), __uint_as_float(w.y & 0xffff0000u)};
                        b1 = (f32x4){__uint_as_float(w.z << 16), __uint_as_float(w.z & 0xffff0000u), __uint_as_float(w.w << 16), __uint_as_float(w.w & 0xffff0000u)}; }
                    const f32x4 v0 = b0 + gv[bj][0] * acc[ai][bj][m][0], v1 = b1 + gv[bj][1] * acc[ai][bj][m][1];
                    u32x4 o; o.x = cvt_pk_bf16(v0[0], v0[1]); o.y = cvt_pk_bf16(v0[2], v0[3]); o.z = cvt_pk_bf16(v1[0], v1[1]); o.w = cvt_pk_bf16(v1[2], v1[3]);
                    *(u32x4*)(out + off + bj * HALF) = o; }
                if (m & 1) asm volatile("" ::: "memory"); }
    }
};
template <class Epi, class Sched, bool ALIGN_EPI = false, bool SP2 = false>
__device__ __forceinline__ void gemm_phase(PG8_LAS unsigned char* lds, const Gemm g, const Sched& S, const Epi& E, const int tid) {
    const int wid = __builtin_amdgcn_readfirstlane(tid >> 6), lane = tid & 63, wr = wid >> 2, wc = wid & 3, fr = lane & 15, fq = lane >> 4;
    const int K = g.K, nt = K / BK;
    unsigned voffA[2], voffB[2];
#pragma unroll
    for (int i = 0; i < 2; ++i) { int R, C; stage_rc(tid * 16 + i * 8192, R, C); const int Rb = Epi::PERM ? ((R & ~31) + perm32(R & 31)) : R;
        voffA[i] = (unsigned)(R * K + C) * 2u; voffB[i] = (unsigned)(Rb * K + C) * 2u; }
    const size_t kstep = (size_t)(BK * 2);
    const size_t hstep = (size_t)HALF * K * 2;
    const size_t tstep = 2 * hstep;
    const unsigned ldsw = (unsigned)wid * 1024u;
    const int aoff = lds_byte(wr * 64 + fr, fq * 8), boff = lds_byte(wc * 32 + fr, fq * 8);
#define PG8_SA(b, h) (((b) * 2 + (h)) * HTB)
#define PG8_SB(b, h) ((4 + (b) * 2 + (h)) * HTB)
#define PG8_STAGE(bufoff, gbase, voff) do { _Pragma("unroll") for (int _i = 0; _i < 2; ++_i) \
        __builtin_amdgcn_global_load_lds((const unsigned*)((const char*)(gbase) + (voff)[_i]), (PG8_LAS unsigned*)(lds + (bufoff) + ldsw + _i * 8192), 16, 0, 0); } while (0)
#define PG8_LDA(dst, b, h) do { _Pragma("unroll") for (int m = 0; m < 4; ++m) _Pragma("unroll") for (int k = 0; k < 2; ++k) dst[m][k] = *(const PG8_LAS bf16x8*)(lds + PG8_SA(b, h) + aoff + m * 2048 + k * 1024); } while (0)
#define PG8_LDB(dst, b, h) do { _Pragma("unroll") for (int n = 0; n < 2; ++n) _Pragma("unroll") for (int k = 0; k < 2; ++k) dst[n][k] = *(const PG8_LAS bf16x8*)(lds + PG8_SB(b, h) + boff + n * 2048 + k * 1024); } while (0)
#define PG8_MMA(ai, bj, At, Bt) do { __builtin_amdgcn_s_setprio(1); _Pragma("unroll") for (int m = 0; m < 4; ++m) _Pragma("unroll") for (int n = 0; n < 2; ++n) _Pragma("unroll") for (int k = 0; k < 2; ++k) \
        acc[ai][bj][m][n] = __builtin_amdgcn_mfma_f32_16x16x32_bf16(Bt[n][k], At[m][k], acc[ai][bj][m][n], 0, 0, 0); __builtin_amdgcn_s_setprio(0); } while (0)
#define PG8_WAIT_V(n) asm volatile("s_waitcnt vmcnt(" #n ")" ::: "memory")
#define PG8_WAIT_L(n) asm volatile("s_waitcnt lgkmcnt(" #n ")" ::: "memory")
#define PG8_BAR __builtin_amdgcn_s_barrier()
#define PG8_SCHED __builtin_amdgcn_sched_barrier(0)
    Unit cur, nxt; int ui = 0;
    if (!S.next(0, cur)) return;
    f32x4 acc[2][2][4][2];
#pragma unroll
    for (int a = 0; a < 2; ++a)
#pragma unroll
        for (int b = 0; b < 2; ++b)
#pragma unroll
            for (int m = 0; m < 4; ++m)
#pragma unroll
                for (int n = 0; n < 2; ++n) acc[a][b][m][n] = (f32x4){0.f, 0.f, 0.f, 0.f};
    bf16x8 At[4][2], B0[2][2], B1[2][2];
    const char* cA = (const char*)g.A + (size_t)cur.pm * tstep; const char* cB = (const char*)g.Bt + (size_t)cur.pn * tstep;
    S.a_ready(cur);
    if constexpr (SP2) {
        PG8_STAGE(PG8_SB(0, 0), cB, voffB); PG8_STAGE(PG8_SB(0, 1), cB + hstep, voffB); PG8_STAGE(PG8_SA(0, 0), cA, voffA); PG8_STAGE(PG8_SA(0, 1), cA + hstep, voffA);
        if (wr == 1) PG8_BAR;
        PG8_WAIT_V(2); PG8_BAR;
        PG8_STAGE(PG8_SB(1, 0), cB + kstep, voffB); PG8_STAGE(PG8_SA(1, 0), cA + kstep, voffA); PG8_STAGE(PG8_SB(1, 1), cB + hstep + kstep, voffB);
        PG8_WAIT_V(6); PG8_BAR;
    } else {
        PG8_STAGE(PG8_SB(0, 0), cB, voffB); PG8_STAGE(PG8_SA(0, 0), cA, voffA); PG8_STAGE(PG8_SB(0, 1), cB + hstep, voffB); PG8_STAGE(PG8_SA(0, 1), cA + hstep, voffA);
        if (wr == 1) PG8_BAR;
        PG8_WAIT_V(4); PG8_BAR;
        PG8_STAGE(PG8_SB(1, 0), cB + kstep, voffB); PG8_STAGE(PG8_SA(1, 0), cA + kstep, voffA); PG8_STAGE(PG8_SB(1, 1), cB + hstep + kstep, voffB);
        PG8_WAIT_V(6); PG8_BAR;
    }
    for (;;) {
        const bool has_next = S.next(ui + 1, nxt);
        const char* nA = has_next ? (const char*)g.A + (size_t)nxt.pm * tstep : cA; const char* nB = has_next ? (const char*)g.Bt + (size_t)nxt.pn * tstep : cB;
        for (int t = 0; t < nt; t += 2) {
            const bool last = (t == nt - 2);
            const char* a1 = cA + (size_t)(t + 1) * kstep;
            const char* a2 = last ? nA : cA + (size_t)(t + 2) * kstep; const char* b2 = last ? nB : cB + (size_t)(t + 2) * kstep;
            const char* a3 = a2 + kstep; const char* b3 = b2 + kstep;
            if (last && has_next) S.a_ready(nxt);
            if constexpr (SP2) {
            PG8_LDB(B0, 0, 0); PG8_LDB(B1, 0, 1); PG8_SCHED; PG8_LDA(At, 0, 0); PG8_STAGE(PG8_SA(1, 1), a1 + hstep, voffA);
            PG8_WAIT_V(8); PG8_WAIT_L(0); PG8_BAR; PG8_MMA(0, 0, At, B0); PG8_MMA(0, 1, At, B1); PG8_BAR; PG8_SCHED;
            PG8_LDA(At, 0, 1); PG8_STAGE(PG8_SB(0, 0), b2, voffB); PG8_STAGE(PG8_SB(0, 1), b2 + hstep, voffB); PG8_STAGE(PG8_SA(0, 0), a2, voffA);
            PG8_WAIT_V(8); PG8_WAIT_L(0); PG8_BAR; PG8_MMA(1, 0, At, B0); PG8_MMA(1, 1, At, B1); PG8_BAR; PG8_SCHED;
            PG8_LDB(B0, 1, 0); PG8_LDB(B1, 1, 1); PG8_SCHED; PG8_LDA(At, 1, 0); PG8_STAGE(PG8_SA(0, 1), a2 + hstep, voffA);
            PG8_WAIT_V(8); PG8_WAIT_L(0); PG8_BAR; PG8_MMA(0, 0, At, B0); PG8_MMA(0, 1, At, B1); PG8_BAR; PG8_SCHED;
            PG8_LDA(At, 1, 1); PG8_STAGE(PG8_SB(1, 0), b3, voffB); PG8_STAGE(PG8_SB(1, 1), b3 + hstep, voffB); PG8_STAGE(PG8_SA(1, 0), a3, voffA);
            PG8_WAIT_V(8); PG8_WAIT_L(0); PG8_BAR; PG8_MMA(1, 0, At, B0); PG8_MMA(1, 1, At, B1); PG8_BAR; PG8_SCHED;
            } else {
            PG8_LDB(B0, 0, 0); PG8_SCHED; PG8_LDA(At, 0, 0); PG8_STAGE(PG8_SA(1, 1), a1 + hstep, voffA);
            PG8_WAIT_L(8); PG8_BAR; PG8_WAIT_L(0); PG8_MMA(0, 0, At, B0); PG8_BAR; PG8_SCHED;
            PG8_LDB(B1, 0, 1); PG8_STAGE(PG8_SB(0, 0), b2, voffB);
            PG8_BAR; PG8_WAIT_L(0); PG8_MMA(0, 1, At, B1); PG8_BAR;
            PG8_LDA(At, 0, 1); PG8_STAGE(PG8_SA(0, 0), a2, voffA);
            PG8_BAR; PG8_WAIT_L(0); PG8_MMA(1, 0, At, B0); PG8_BAR; PG8_SCHED;
            PG8_STAGE(PG8_SB(0, 1), b2 + hstep, voffB);
            PG8_WAIT_V(6); PG8_BAR; PG8_MMA(1, 1, At, B1); PG8_BAR;
            PG8_LDB(B0, 1, 0); PG8_SCHED; PG8_LDA(At, 1, 0); PG8_STAGE(PG8_SA(0, 1), a2 + hstep, voffA);
            PG8_WAIT_L(8); PG8_BAR; PG8_WAIT_L(0); PG8_MMA(0, 0, At, B0); PG8_BAR; PG8_SCHED;
            PG8_LDB(B1, 1, 1); PG8_STAGE(PG8_SB(1, 0), b3, voffB);
            PG8_BAR; PG8_WAIT_L(0); PG8_MMA(0, 1, At, B1); PG8_BAR;
            PG8_LDA(At, 1, 1); PG8_STAGE(PG8_SA(1, 0), a3, voffA);
            PG8_BAR; PG8_WAIT_L(0); PG8_MMA(1, 0, At, B0); PG8_BAR; PG8_SCHED;
            PG8_STAGE(PG8_SB(1, 1), b3 + hstep, voffB);
            PG8_WAIT_V(6); PG8_BAR; PG8_MMA(1, 1, At, B1); PG8_BAR;
            }
        }
        if constexpr (ALIGN_EPI) { if (wr == 0) PG8_BAR; }
        if constexpr (!Epi::AFTER_DRAIN) { E(acc, cur, wr, wc, fr, fq); S.done(cur); }
        if (!has_next) break;
#pragma unroll
        for (int a = 0; a < 2; ++a)
#pragma unroll
            for (int b = 0; b < 2; ++b)
#pragma unroll
                for (int m = 0; m < 4; ++m)
#pragma unroll
                    for (int n = 0; n < 2; ++n) acc[a][b][m][n] = (f32x4){0.f, 0.f, 0.f, 0.f};
        cur = nxt; cA = nA; cB = nB; ++ui;
        if constexpr (ALIGN_EPI) { if (wr == 1) PG8_BAR; }
    }
    PG8_WAIT_V(0);
    if constexpr (!ALIGN_EPI) { if (wr == 0) PG8_BAR; }
    PG8_BAR;
    if constexpr (Epi::AFTER_DRAIN) { E.fused(acc, cur, wr, wc, fr, fq, lds, wid, lane); S.done(cur); }
#undef PG8_SA
#undef PG8_SB
#undef PG8_STAGE
#undef PG8_LDA
#undef PG8_LDB
#undef PG8_MMA
#undef PG8_WAIT_V
#undef PG8_WAIT_L
#undef PG8_BAR
#undef PG8_SCHED
}
}
#define LAS __attribute__((address_space(3)))
#define DI __device__ __forceinline__
typedef unsigned short bf16;
typedef unsigned v4u __attribute__((ext_vector_type(4)));
typedef unsigned v2u __attribute__((ext_vector_type(2)));
typedef float f32x4 __attribute__((ext_vector_type(4)));
typedef float f32x2 __attribute__((ext_vector_type(2)));
typedef short bf16x8 __attribute__((ext_vector_type(8)));
typedef __bf16 bf16x2_t __attribute__((ext_vector_type(2)));

#ifndef PHASE_ONLY
#define PHASE_ONLY -1
#endif
#define PH_EN(k) (PHASE_ONLY < 0 || PHASE_ONLY == (k))
#define REP_MOD 1
#define REP_N0 1
#define REP_G1 1
#define REP_PREP 1
#define REP_SCAN 1
#define REP_SGU 1
#define REP_N1 1
#define REP_FF1 1
#define REP_SYNC 0
#ifndef MK_LAUNCHES
#define MK_LAUNCHES 1
#endif

constexpr int NWAVES = 8, NT = 512;
constexpr int BATCH = 8, SEQ = 4096, D = 1024, M = BATCH * SEQ, DEPTH = 4, FF = 4096, INW = 3080, NP = 3072, NMOD = 6144;
constexpr int NPHASE = 2 + 9 * DEPTH;
constexpr size_t MiB = 1u << 20;
constexpr size_t WS_CTL = 0, WS_MOD = 1 * MiB, WS_BA = 2 * MiB, WS_GL = 3 * MiB, WS_WIN = 4 * MiB, WS_WOUT = 10 * MiB, WS_W1 = 12 * MiB, WS_W2 = 20 * MiB,
                 WS_H = 28 * MiB, WS_X = 92 * MiB  , WS_P = 156 * MiB, WS_QD = 348 * MiB, WS_WK = 380 * MiB, WS_KDT = 412 * MiB, WS_AC = 444 * MiB, WS_WSET1 = 460 * MiB, WS_END = 484 * MiB;
DI size_t ws_wset(int l) { return (l & 1) ? WS_WSET1 : WS_WIN; }
constexpr size_t W_OFF_OUT = WS_WOUT - WS_WIN, W_OFF_1 = WS_W1 - WS_WIN, W_OFF_2 = WS_W2 - WS_WIN;
constexpr size_t WS_U = WS_H;
constexpr size_t WS_F = WS_P;
constexpr int LDS_BYTES = 148480;

struct Args { const float* in[19]; float* out; unsigned char* ws; int ph_lo, ph_hi; };

DI float bflo(unsigned u) { return __uint_as_float(u << 16); }
DI float bfhi(unsigned u) { return __uint_as_float(u & 0xffff0000u); }
DI float bf2f(bf16 b) { return __uint_as_float((unsigned)b << 16); }
DI unsigned pk2(float lo, float hi) { f32x2 v = {lo, hi}; bf16x2_t b = __builtin_convertvector(v, bf16x2_t); return __builtin_bit_cast(unsigned, b); }
DI bf16 f2bf(float f) { return (bf16)(pk2(f, 0.f) & 0xffffu); }
template <int CTRL> DI float dpp_f(float v) { return __builtin_bit_cast(float, __builtin_amdgcn_update_dpp(0, __builtin_bit_cast(int, v), CTRL, 0xf, 0xf, false)); }
DI float row16_sum(float v) {
    v += dpp_f<0xB1>(v);
    v += dpp_f<0x4E>(v);
    v += dpp_f<0x141>(v);
    v += dpp_f<0x140>(v);
    return v;
}
template <int CTRL, int RMASK> DI float dpp_rm(float v) { return __builtin_bit_cast(float, __builtin_amdgcn_update_dpp(0, __builtin_bit_cast(int, v), CTRL, RMASK, 0xf, false)); }
DI float wave_sum(float v) {
    v = row16_sum(v);
    v += dpp_rm<0x142, 0xa>(v);
    v += dpp_rm<0x143, 0xc>(v);
    return __builtin_bit_cast(float, __builtin_amdgcn_readlane(__builtin_bit_cast(int, v), 63));
}
DI float silu_f(float v) { return v * __builtin_amdgcn_rcpf(1.f + __expf(-v)); }
DI float gelu_tanh(float v) { const float u = 1.5957691216057308f * (v + 0.044715f * v * v * v); return v * __builtin_amdgcn_rcpf(1.f + __expf(-u)); }
DI void bar_lds() { asm volatile("s_waitcnt lgkmcnt(0)\n\ts_barrier" ::: "memory"); }
#define GAS __attribute__((address_space(1)))
DI void glds16(const void* gsrc, unsigned lds_dst) { unsigned keep;
    asm volatile("s_mov_b32 %0, m0\n\ts_mov_b32 m0, %2\n\ts_nop 0\n\tglobal_load_lds_dwordx4 %1, off\n\ts_mov_b32 m0, %0" : "=&s"(keep) : "v"(gsrc), "s"(lds_dst) : "memory"); }
DI int pos32(int o) { return 8 * ((o >> 2) & 3) + 4 * (o >> 4) + (o & 3); }
DI bf16x8 pack8(const f32x4& a, const f32x4& b) { v4u p; p.x = pk2(a[0], a[1]); p.y = pk2(a[2], a[3]); p.z = pk2(b[0], b[1]); p.w = pk2(b[2], b[3]); return __builtin_bit_cast(bf16x8, p); }
DI bf16x8 ld16g(const bf16* p) { return *(const bf16x8*)p; }
#define MFMA16(a, b, c) __builtin_amdgcn_mfma_f32_16x16x32_bf16((a), (b), (c), 0, 0, 0)

DI void phase_mod(const Args& a, LAS unsigned char* lds, int tid, int lane, int wave, int bid, int G) {
    LAS float* sc = (LAS float*)lds;
    LAS float* red = sc + 8192;
    const float* c = a.in[1]; const float* w_ada = a.in[2]; const float* b_ada = a.in[3];
    float* mod = (float*)(a.ws + WS_MOD);
    for (int i = tid; i < 8192; i += NT) sc[i] = silu_f(c[i]);
    __syncthreads();
    for (int unit = bid; unit < DEPTH * 96; unit += G) {
        const int l = unit / 96, j0 = (unit % 96) * 64;
        const float* w = w_ada + (size_t)l * D * NMOD + j0 + lane;
        float acc[8];
#pragma unroll
        for (int b = 0; b < 8; ++b) acc[b] = 0.f;
#pragma unroll 8
        for (int k = wave * 128; k < wave * 128 + 128; ++k) {
            const float wv = __builtin_nontemporal_load(w + (size_t)k * NMOD);
#pragma unroll
            for (int b = 0; b < 8; ++b) acc[b] += sc[b * 1024 + k] * wv;
        }
#pragma unroll
        for (int b = 0; b < 8; ++b) red[(wave * 8 + b) * 64 + lane] = acc[b];
        __syncthreads();
        { const int b = tid >> 6, j = tid & 63; float s = b_ada[l * NMOD + j0 + j];
#pragma unroll
          for (int w8 = 0; w8 < 8; ++w8) s += red[(w8 * 8 + b) * 64 + j];
          mod[(size_t)(l * 8 + b) * NMOD + j0 + j] = s; }
        __syncthreads();
    }
}

DI void transpose_item(const float* W, int ldw, int K, int nblk, bf16* WT, LAS float* scr, int item, int lane) {
    const int kb = item / nblk, nb = item % nblk, k0 = 64 * kb, n0 = 32 * nb;
#pragma unroll 8
    for (int i = 0; i < 32; ++i) { const int kk = 2 * i + (lane >> 5); scr[kk * 33 + (lane & 31)] = __builtin_nontemporal_load(W + (size_t)(k0 + kk) * ldw + n0 + (lane & 31)); }
    asm volatile("s_waitcnt lgkmcnt(0)" ::: "memory");
    const int c = lane & 7;
#pragma unroll
    for (int j = 0; j < 4; ++j) { const int n = (lane >> 3) + 8 * j; const LAS float* s = scr + (8 * c) * 33 + n;
        v4u o; o.x = pk2(s[0 * 33], s[1 * 33]); o.y = pk2(s[2 * 33], s[3 * 33]); o.z = pk2(s[4 * 33], s[5 * 33]); o.w = pk2(s[6 * 33], s[7 * 33]);
        *(v4u*)(WT + (size_t)(n0 + n) * K + k0 + 8 * c) = o; }
    asm volatile("s_waitcnt lgkmcnt(0)" ::: "memory");
}

DI void convert_weights(const Args& a, int l, LAS unsigned char* scr_base, int wave, int lane, int gw, int NGW) {
    LAS float* scr = (LAS float*)(scr_base + wave * 8448);
    unsigned char* wb = a.ws + ws_wset(l);
    const float* w_in = a.in[5] + (size_t)l * D * INW; const float* w_out = a.in[14] + (size_t)l * D * D;
    const float* w1 = a.in[16] + (size_t)l * D * FF;   const float* w2 = a.in[17] + (size_t)l * FF * D;
    constexpr int I_IN = 16 * 96, I_OUT = 16 * 32, I_1 = 16 * 128, I_2 = 64 * 32, NIT = I_IN + I_OUT + I_1 + I_2;
    for (int it = gw; it < NIT; it += NGW) {
        int r = it;
        if (r < I_IN) { transpose_item(w_in, INW, D, 96, (bf16*)wb, scr, r, lane); continue; } r -= I_IN;
        if (r < I_OUT) { transpose_item(w_out, D, D, 32, (bf16*)(wb + W_OFF_OUT), scr, r, lane); continue; } r -= I_OUT;
        if (r < I_1) { transpose_item(w1, FF, D, 128, (bf16*)(wb + W_OFF_1), scr, r, lane); continue; } r -= I_1;
        transpose_item(w2, D, FF, 32, (bf16*)(wb + W_OFF_2), scr, r, lane);
    }
}

template <int MODE> DI void phase_norm(const Args& a, int l, LAS unsigned char* lds, int tid, int lane, int wave, int bid, int G) {
    constexpr int RB = (MODE == 0) ? 2 : 4;
    const int gw = bid * NWAVES + wave, NGW = G * NWAVES;
    unsigned char* ws = a.ws;
    const bool xf32 = (MODE == 0 && l == 0);
    const float* xin = a.in[0]; const bf16* xbf = (const bf16*)(ws + WS_X);
    const float* gam = (MODE == 0) ? a.in[4] + l * D : (MODE == 1) ? a.in[15] + l * D : a.in[18];
    const float* mod = (const float*)(ws + WS_MOD);
    bf16* H = (bf16*)(ws + WS_H);
    float* BA = (float*)(ws + WS_BA);
    LAS f32x4* w8s = (LAS f32x4*)(lds + 67584);
    if (MODE == 0) {
        const float* w_in = a.in[5] + (size_t)l * D * INW + NP;
        for (int idx = tid; idx < 2048; idx += NT) { const int k = idx >> 1, half = idx & 1;
            w8s[(((k >> 8) * 4 + (k & 3)) * 2 + half) * 64 + ((k & 255) >> 2)] = *(const f32x4*)(w_in + (size_t)k * INW + 4 * half); }
        __syncthreads();
    }
    for (int mb = gw * 16; mb < M; mb += NGW * 16) {
        const int b = mb / SEQ;
        f32x4 ca[4], cb[4];
#pragma unroll
        for (int j = 0; j < 4; ++j) {
            const f32x4 gg = *(const f32x4*)(gam + 4 * lane + 256 * j);
            if (MODE == 2) { ca[j] = gg; cb[j] = (f32x4){0.f, 0.f, 0.f, 0.f}; }
            else { const float* mr = mod + (size_t)(l * 8 + b) * NMOD + (MODE == 0 ? 0 : 3072) + 4 * lane + 256 * j;
                   const f32x4 sh = *(const f32x4*)mr, scl = *(const f32x4*)(mr + 1024); ca[j] = gg * (scl + 1.0f); cb[j] = sh; }
        }
        for (int i0 = 0; i0 < 16; i0 += RB) {
            asm volatile("" ::: "memory");
            f32x4 v[RB][4]; float ss[RB];
#pragma unroll
            for (int rr = 0; rr < RB; ++rr) { const f32x4* xr = (const f32x4*)(xin + (size_t)(mb + i0 + rr) * D) + lane; const v2u* xb = (const v2u*)(xbf + (size_t)(mb + i0 + rr) * D) + lane; float sq = 0.f;
#pragma unroll
                for (int j = 0; j < 4; ++j) { if (xf32) v[rr][j] = xr[64 * j]; else { const v2u w = xb[64 * j]; v[rr][j] = (f32x4){bflo(w.x), bfhi(w.x), bflo(w.y), bfhi(w.y)}; } sq += (v[rr][j].x * v[rr][j].x + v[rr][j].y * v[rr][j].y) + (v[rr][j].z * v[rr][j].z + v[rr][j].w * v[rr][j].w); }
                ss[rr] = sq; }
#pragma unroll
            for (int rr = 0; rr < RB; ++rr) ss[rr] = rsqrtf(wave_sum(ss[rr]) * (1.f / D) + 1e-6f);
#pragma unroll
            for (int rr = 0; rr < RB; ++rr) { const size_t m = (size_t)(mb + i0 + rr);
#pragma unroll
                for (int j = 0; j < 4; ++j) v[rr][j] = v[rr][j] * ss[rr] * ca[j] + cb[j];
                if (MODE == 2) { f32x4* o = (f32x4*)(a.out + m * D) + lane;
#pragma unroll
                    for (int j = 0; j < 4; ++j) __builtin_nontemporal_store(v[rr][j], o + 64 * j);
                } else { v2u* o = (v2u*)(H + m * D) + lane;
#pragma unroll
                    for (int j = 0; j < 4; ++j) { v2u w; w.x = pk2(v[rr][j].x, v[rr][j].y); w.y = pk2(v[rr][j].z, v[rr][j].w); o[64 * j] = w; } }
            }
            if (MODE == 0) {
                f32x4 d[RB][2];
#pragma unroll
                for (int rr = 0; rr < RB; ++rr) { d[rr][0] = (f32x4){0.f, 0.f, 0.f, 0.f}; d[rr][1] = (f32x4){0.f, 0.f, 0.f, 0.f}; }
#pragma unroll
                for (int j = 0; j < 4; ++j) { asm volatile("" ::: "memory");
#pragma unroll
                    for (int e = 0; e < 4; ++e) { const f32x4 w0 = w8s[((j * 4 + e) * 2 + 0) * 64 + lane], w1 = w8s[((j * 4 + e) * 2 + 1) * 64 + lane];
#pragma unroll
                        for (int rr = 0; rr < RB; ++rr) { d[rr][0] += w0 * v[rr][j][e]; d[rr][1] += w1 * v[rr][j][e]; } } }
#pragma unroll
                for (int rr = 0; rr < RB; ++rr) {
#pragma unroll
                    for (int e = 0; e < 4; ++e) { d[rr][0][e] = wave_sum(d[rr][0][e]); d[rr][1][e] = wave_sum(d[rr][1][e]); }
                    if (lane == 0) { *(f32x4*)(BA + (size_t)(mb + i0 + rr) * 8) = d[rr][0]; *(f32x4*)(BA + (size_t)(mb + i0 + rr) * 8 + 4) = d[rr][1]; } }
            }
        }
    }
}

DI void phase_prep(const Args& a, int l, LAS unsigned char* lds, int tid, int lane, int wave, int bid, int G) {
    unsigned char* ws = a.ws;
    const bf16* P = (const bf16*)(ws + WS_P);
    const float* BA = (const float*)(ws + WS_BA);
    const float* convw = a.in[10] + (size_t)l * 4 * 1536;
    bf16* QD = (bf16*)(ws + WS_QD); bf16* WKb = (bf16*)(ws + WS_WK); bf16* KDT = (bf16*)(ws + WS_KDT); bf16* AC = (bf16*)(ws + WS_AC);
    float* U = (float*)(ws + WS_U); float* GL = (float*)(ws + WS_GL);
    for (int unit = bid; unit < 2048; unit += G) {
        asm volatile("" : "+v"(lds));
        LAS float* Qf = (LAS float*)lds; LAS float* Kf = Qf + 64 * 132; LAS float* Vf = Kf + 64 * 132;
        LAS bf16* Qb = (LAS bf16*)(lds + 101376); LAS bf16* Kb = Qb + 64 * 136;
        LAS float* gt = (LAS float*)(lds + 136192);
        LAS float* Mm = Qf;
        const int n = unit & 63, bh = unit >> 6, b = bh >> 2; int h = bh & 3;
        asm volatile("" : "+s"(h));
        const int t0 = n * 64; const size_t m0 = (size_t)b * SEQ + t0;
        if (tid < 384) {
            const int cgi = tid % 48, rr = tid / 48, sel = cgi >> 4, d0 = (cgi & 15) * 8;
            const int pc = 1024 + sel * 512 + h * 128 + d0, cc = sel * 512 + h * 128 + d0;
            f32x4 cw[4][2];
#pragma unroll
            for (int j = 0; j < 4; ++j) { cw[j][0] = *(const f32x4*)(convw + j * 1536 + cc); cw[j][1] = *(const f32x4*)(convw + j * 1536 + cc + 4); }
            v4u xr[11];
#pragma unroll
            for (int i = 0; i < 11; ++i) { const int t = rr * 8 + i - 3; const bool ok = (t0 + t) >= 0;
                const bf16* p = P + ((long)m0 + t) * NP + pc; xr[i] = ok ? *(const v4u*)p : (v4u){0u, 0u, 0u, 0u}; }
            LAS float* dst = (sel == 0 ? Qf : sel == 1 ? Kf : Vf) + d0;
#pragma unroll
            for (int i = 0; i < 8; ++i) {
                f32x4 o0 = {0.f, 0.f, 0.f, 0.f}, o1 = {0.f, 0.f, 0.f, 0.f};
#pragma unroll
                for (int j = 0; j < 4; ++j) { const v4u x = xr[i + j];
                    const f32x4 x0 = {bflo(x.x), bfhi(x.x), bflo(x.y), bfhi(x.y)}, x1 = {bflo(x.z), bfhi(x.z), bflo(x.w), bfhi(x.w)};
                    o0 += cw[j][0] * x0; o1 += cw[j][1] * x1; }
#pragma unroll
                for (int e = 0; e < 4; ++e) { o0[e] = silu_f(o0[e]); o1[e] = silu_f(o1[e]); }
                *(LAS f32x4*)(dst + (rr * 8 + i) * 132) = o0; *(LAS f32x4*)(dst + (rr * 8 + i) * 132 + 4) = o1;
                const float sq = row16_sum(((o0[0] * o0[0] + o0[1] * o0[1]) + (o0[2] * o0[2] + o0[3] * o0[3])) + ((o1[0] * o1[0] + o1[1] * o1[1]) + (o1[2] * o1[2] + o1[3] * o1[3])));
                if (sel < 2 && (cgi & 15) == 0) gt[192 + sel * 64 + rr * 8 + i] = sq;
            }
        } else if (wave == 7) {
            const float bb = BA[(m0 + lane) * 8 + h], aa = BA[(m0 + lane) * 8 + 4 + h];
            const float beta = 1.f / (1.f + expf(-bb));
            const float xx = aa + a.in[12][l * 4 + h];
            const float sp = fmaxf(xx, 0.f) + log1pf(expf(-fabsf(xx)));
            float g = -expf(a.in[11][l * 4 + h]) * sp;
#pragma unroll
            for (int off = 1; off < 64; off <<= 1) { const float v = __shfl_up(g, off); if (lane >= off) g += v; }
            { const float gm = expf(g); gt[lane] = beta; gt[64 + lane] = g; gt[128 + lane] = gm; gt[320 + lane] = beta * gm; }
        }
        bar_lds();
        for (int i = 0; i < 8; ++i) {
            const int t = wave * 8 + i;
            f32x2 qv = *(LAS f32x2*)(Qf + t * 132 + 2 * lane), kv = *(LAS f32x2*)(Kf + t * 132 + 2 * lane);
            const float rq = rsqrtf(gt[192 + t] + 1e-6f) * 0.08838834764831845f, rk = rsqrtf(gt[256 + t] + 1e-6f);
            qv = qv * rq; kv = kv * rk;
            *(LAS unsigned*)(Qb + t * 136 + 2 * lane) = pk2(qv.x, qv.y);
            *(LAS unsigned*)(Kb + t * 136 + 2 * lane) = pk2(kv.x, kv.y);
            *(LAS f32x2*)(Kf + t * 132 + 2 * lane) = kv;
            const float gm = gt[128 + t];
            const int d = 2 * lane, dp = (d & ~31) + pos32(d & 31);
            *(unsigned*)(QD + ((size_t)unit * 64 + t) * 128 + dp) = pk2(qv.x * gm, qv.y * gm);
        }
        bar_lds();
        {
            const int which = wave >> 2, mt = wave & 3, r = lane & 15, q = lane >> 4;
            const LAS bf16* Ab = which ? Qb : Kb;
            bf16x8 af[4];
#pragma unroll
            for (int ks = 0; ks < 4; ++ks) af[ks] = *(const LAS bf16x8*)(Ab + (16 * mt + r) * 136 + 32 * ks + 8 * q);
            for (int nt = 0; nt < 4; ++nt) {
                f32x4 acc = {0.f, 0.f, 0.f, 0.f};
                if (nt <= mt) {
#pragma unroll
                    for (int ks = 0; ks < 4; ++ks) { const bf16x8 bfr = *(const LAS bf16x8*)(Kb + (16 * nt + r) * 136 + 32 * ks + 8 * q); acc = MFMA16(af[ks], bfr, acc); }
                }
                const int s = 16 * nt + r; const float gs = gt[64 + s];
#pragma unroll
                for (int i = 0; i < 4; ++i) { const int t = 16 * mt + 4 * q + i;
                    const float dec = __expf(fminf(gt[64 + t] - gs, 0.f));
                    if (which == 0) { if (nt <= mt) Mm[t * 68 + s] = (s < t) ? gt[t] * acc[i] * dec : 0.f; }
                    else { const float v = (s <= t) ? acc[i] * dec : 0.f; AC[((size_t)unit * 64 + t) * 64 + (s & ~31) + pos32(s & 31)] = f2bf(v); }
                }
            }
        }
        bar_lds();
        if (wave < 4) {
            const int part = wave >> 1, c = 64 * (wave & 1) + lane;
            const LAS float* src = (part ? Kf : Vf) + c;
            LAS float* dst = (part ? (LAS float*)Qb : Vf) + c;
            const LAS float* cf = gt + (part ? 320 : 0);
            __builtin_amdgcn_s_setprio(2);
            float X[64];
            f32x4 mr0, mr1, mr2, mr3, mr4, mr5, mr6;
            float rh0, rh1, rh2;
            mr0 = *(const LAS f32x4*)(Mm + 68);
            mr1 = *(const LAS f32x4*)(Mm + 136);
            mr2 = *(const LAS f32x4*)(Mm + 204);
            mr3 = *(const LAS f32x4*)(Mm + 272);
            mr4 = *(const LAS f32x4*)(Mm + 340);
            mr5 = *(const LAS f32x4*)(Mm + 344);
            rh0 = src[0] * cf[0]; rh1 = src[132] * cf[1];
            rh2 = src[264] * cf[2];
            X[0] = rh0; dst[0] = X[0];
            rh0 = src[396] * cf[3];
            { float a0 = rh1, a1 = 0.f, a2 = 0.f, a3 = 0.f;
              mr6 = *(const LAS f32x4*)(Mm + 408);
              __builtin_amdgcn_sched_barrier(0);
              a0 -= mr0[0] * X[0];
              X[1] = (a0 + a1) + (a2 + a3); dst[132] = X[1]; }
            __builtin_amdgcn_sched_barrier(0);
            rh1 = src[528] * cf[4];
            { float a0 = rh2, a1 = 0.f, a2 = 0.f, a3 = 0.f;
              mr0 = *(const LAS f32x4*)(Mm + 412);
              __builtin_amdgcn_sched_barrier(0);
              a0 -= mr1[0] * X[0]; a1 -= mr1[1] * X[1];
              X[2] = (a0 + a1) + (a2 + a3); dst[264] = X[2]; }
            __builtin_amdgcn_sched_barrier(0);
            rh2 = src[660] * cf[5];
            { float a0 = rh0, a1 = 0.f, a2 = 0.f, a3 = 0.f;
              mr1 = *(const LAS f32x4*)(Mm + 476);
              __builtin_amdgcn_sched_barrier(0);
              a0 -= mr2[0] * X[0]; a1 -= mr2[1] * X[1]; a2 -= mr2[2] * X[2];
              X[3] = (a0 + a1) + (a2 + a3); dst[396] = X[3]; }
            __builtin_amdgcn_sched_barrier(0);
            rh0 = src[792] * cf[6];
            { float a0 = rh1, a1 = 0.f, a2 = 0.f, a3 = 0.f;
              mr2 = *(const LAS f32x4*)(Mm + 480);
              __builtin_amdgcn_sched_barrier(0);
              a0 -= mr3[0] * X[0]; a1 -= mr3[1] * X[1]; a2 -= mr3[2] * X[2]; a3 -= mr3[3] * X[3];
              X[4] = (a0 + a1) + (a2 + a3); dst[528] = X[4]; }
            __builtin_amdgcn_sched_barrier(0);
            rh1 = src[924] * cf[7];
            { float a0 = rh2, a1 = 0.f, a2 = 0.f, a3 = 0.f;
              mr3 = *(const LAS f32x4*)(Mm + 544);
              __builtin_amdgcn_sched_barrier(0);
              a0 -= mr4[0] * X[0]; a1 -= mr4[1] * X[1]; a2 -= mr4[2] * X[2]; a3 -= mr4[3] * X[3];
              mr4 = *(const LAS f32x4*)(Mm + 548);
              __builtin_amdgcn_sched_barrier(0);
              a0 -= mr5[0] * X[4];
              X[5] = (a0 + a1) + (a2 + a3); dst[660] = X[5]; }
            __builtin_amdgcn_sched_barrier(0);
            rh2 = src[1056] * cf[8];
            { float a0 = rh0, a1 = 0.f, a2 = 0.f, a3 = 0.f;
              mr5 = *(const LAS f32x4*)(Mm + 612);
              __builtin_amdgcn_sched_barrier(0);
              a0 -= mr6[0] * X[0]; a1 -= mr6[1] * X[1]; a2 -= mr6[2] * X[2]; a3 -= mr6[3] * X[3];
              mr6 = *(const LAS f32x4*)(Mm + 616);
              __builtin_amdgcn_sched_barrier(0);
              a0 -= mr0[0] * X[4]; a1 -= mr0[1] * X[5];
              X[6] = (a0 + a1) + (a2 + a3); dst[792] = X[6]; }
            __builtin_amdgcn_sched_barrier(0);
            rh0 = src[1188] * cf[9];
            { float a0 = rh1, a1 = 0.f, a2 = 0.f, a3 = 0.f;
              mr0 = *(const LAS f32x4*)(Mm + 620);
              __builtin_amdgcn_sched_barrier(0);
              a0 -= mr1[0] * X[0]; a1 -= mr1[1] * X[1]; a2 -= mr1[2] * X[2]; a3 -= mr1[3] * X[3];
              mr1 = *(const LAS f32x4*)(Mm + 680);
              __builtin_amdgcn_sched_barrier(0);
              a0 -= mr2[0] * X[4]; a1 -= mr2[1] * X[5]; a2 -= mr2[2] * X[6];
              X[7] = (a0 + a1) + (a2 + a3); dst[924] = X[7]; }
            __builtin_amdgcn_sched_barrier(0);
            rh1 = src[1320] * cf[10];
            { float a0 = rh2, a1 = 0.f, a2 = 0.f, a3 = 0.f;
              mr2 = *(const LAS f32x4*)(Mm + 684);
              __builtin_amdgcn_sched_barrier(0);
              a0 -= mr3[0] * X[0]; a1 -= mr3[1] * X[1]; a2 -= mr3[2] * X[2]; a3 -= mr3[3] * X[3];
              mr3 = *(const LAS f32x4*)(Mm + 688);
              __builtin_amdgcn_sched_barrier(0);
              a0 -= mr4[0] * X[4]; a1 -= mr4[1] * X[5]; a2 -= mr4[2] * X[6]; a3 -= mr4[3] * X[7];
              X[8] = (a0 + a1) + (a2 + a3); dst[1056] = X[8]; }
            __builtin_amdgcn_sched_barrier(0);
            rh2 = src[1452] * cf[11];
            { float a0 = rh0, a1 = 0.f, a2 = 0.f, a3 = 0.f;
              mr4 = *(const LAS f32x4*)(Mm + 748);
              __builtin_amdgcn_sched_barrier(0);
              a0 -= mr5[0] * X[0]; a1 -= mr5[1] * X[1]; a2 -= mr5[2] * X[2]; a3 -= mr5[3] * X[3];
              mr5 = *(const LAS f32x4*)(Mm + 752);
              __builtin_amdgcn_sched_barrier(0);
              a0 -= mr6[0] * X[4]; a1 -= mr6[1] * X[5]; a2 -= mr6[2] * X[6]; a3 -= mr6[3] * X[7];
              mr6 = *(const LAS f32x4*)(Mm + 756);
              __builtin_amdgcn_sched_barrier(0);
              a0 -= mr0[0] * X[8];
              X[9] = (a0 + a1) + (a2 + a3); dst[1188] = X[9]; }
            __builtin_amdgcn_sched_barrier(0);
            rh0 = src[1584] * cf[12];
            { float a0 = rh1, a1 = 0.f, a2 = 0.f, a3 = 0.f;
              mr0 = *(const LAS f32x4*)(Mm + 816);
              __builtin_amdgcn_sched_barrier(0);
              a0 -= mr1[0] * X[0]; a1 -= mr1[1] * X[1]; a2 -= mr1[2] * X[2]; a3 -= mr1[3] * X[3];
              mr1 = *(const LAS f32x4*)(Mm + 820);
              __builtin_amdgcn_sched_barrier(0);
              a0 -= mr2[0] * X[4]; a1 -= mr2[1] * X[5]; a2 -= mr2[2] * X[6]; a3 -= mr2[3] * X[7];
              mr2 = *(const LAS f32x4*)(Mm + 824);
              __builtin_amdgcn_sched_barrier(0);
              a0 -= mr3[0] * X[8]; a1 -= mr3[1] * X[9];
              X[10] = (a0 + a1) + (a2 + a3); dst[1320] = X[10]; }
            __builtin_amdgcn_sched_barrier(0);
            rh1 = src[1716] * cf[13];
            { float a0 = rh2, a1 = 0.f, a2 = 0.f, a3 = 0.f;
              mr3 = *(const LAS f32x4*)(Mm + 884);
              __builtin_amdgcn_sched_barrier(0);
              a0 -= mr4[0] * X[0]; a1 -= mr4[1] * X[1]; a2 -= mr4[2] * X[2]; a3 -= mr4[3] * X[3];
              mr4 = *(const LAS f32x4*)(Mm + 888);
              __builtin_amdgcn_sched_barrier(0);
              a0 -= mr5[0] * X[4]; a1 -= mr5[1] * X[5]; a2 -= mr5[2] * X[6]; a3 -= mr5[3] * X[7];
              mr5 = *(const LAS f32x4*)(Mm + 892);
              __builtin_amdgcn_sched_barrier(0);
              a0 -= mr6[0] * X[8]; a1 -= mr6[1] * X[9]; a2 -= mr6[2] * X[10];
              X[11] = (a0 + a1) + (a2 + a3); dst[1452] = X[11]; }
            __builtin_amdgcn_sched_barrier(0);
            rh2 = src[1848] * cf[14];
            { float a0 = rh0, a1 = 0.f, a2 = 0.f, a3 = 0.f;
              mr6 = *(const LAS f32x4*)(Mm + 896);
              __builtin_amdgcn_sched_barrier(0);
              a0 -= mr0[0] * X[0]; a1 -= mr0[1] * X[1]; a2 -= mr0[2] * X[2]; a3 -= mr0[3] * X[3];
              mr0 = *(const LAS f32x4*)(Mm + 952);
              __builtin_amdgcn_sched_barrier(0);
              a0 -= mr1[0] * X[4]; a1 -= mr1[1] * X[5]; a2 -= mr1[2] * X[6]; a3 -= mr1[3] * X[7];
              mr1 = *(const LAS f32x4*)(Mm + 956);
              __builtin_amdgcn_sched_barrier(0);
              a0 -= mr2[0] * X[8]; a1 -= mr2[1] * X[9]; a2 -= mr2[2] * X[10]; a3 -= mr2[3] * X[11];
              X[12] = (a0 + a1) + (a2 + a3); dst[1584] = X[12]; }
            __builtin_amdgcn_sched_barrier(0);
            rh0 = src[1980] * cf[15];
            { float a0 = rh1, a1 = 0.f, a2 = 0.f, a3 = 0.f;
              mr2 = *(const LAS f32x4*)(Mm + 960);
              __builtin_amdgcn_sched_barrier(0);
              a0 -= mr3[0] * X[0]; a1 -= mr3[1] * X[1]; a2 -= mr3[2] * X[2]; a3 -= mr3[3] * X[3];
              mr3 = *(const LAS f32x4*)(Mm + 964);
              __builtin_amdgcn_sched_barrier(0);
              a0 -= mr4[0] * X[4]; a1 -= mr4[1] * X[5]; a2 -= mr4[2] * X[6]; a3 -= mr4[3] * X[7];
              mr4 = *(const LAS f32x4*)(Mm + 1020);
              __builtin_amdgcn_sched_barrier(0);
              a0 -= mr5[0] * X[8]; a1 -= mr5[1] * X[9]; a2 -= mr5[2] * X[10]; a3 -= mr5[3] * X[11];
              mr5 = *(const LAS f32x4*)(Mm + 1024);
              __builtin_amdgcn_sched_barrier(0);
              a0 -= mr6[0] * X[12];
              X[13] = (a0 + a1) + (a2 + a3); dst[1716] = X[13]; }
            __builtin_amdgcn_sched_barrier(0);
            rh1 = src[2112] * cf[16];
            { float a0 = rh2, a1 = 0.f, a2 = 0.f, a3 = 0.f;
              mr6 = *(const LAS f32x4*)(Mm + 1028);
              __builtin_amdgcn_sched_barrier(0);
              a0 -= mr0[0] * X[0]; a1 -= mr0[1] * X[1]; a2 -= mr0[2] * X[2]; a3 -= mr0[3] * X[3];
              mr0 = *(const LAS f32x4*)(Mm + 1032);
              __builtin_amdgcn_sched_barrier(0);
              a0 -= mr1[0] * X[4]; a1 -= mr1[1] * X[5]; a2 -= mr1[2] * X[6]; a3 -= mr1[3] * X[7];
              mr1 = *(const LAS f32x4*)(Mm + 1088);
              __builtin_amdgcn_sched_barrier(0);
              a0 -= mr2[0] * X[8]; a1 -= mr2[1] * X[9]; a2 -= mr2[2] * X[10]; a3 -= mr2[3] * X[11];
              mr2 = *(const LAS f32x4*)(Mm + 1092);
              __builtin_amdgcn_sched_barrier(0);
              a0 -= mr3[0] * X[12]; a1 -= mr3[1] * X[13];
              X[14] = (a0 + a1) + (a2 + a3); dst[1848] = X[14]; }
            __builtin_amdgcn_sched_barrier(0);
            rh2 = src[2244] * cf[17];
            { float a0 = rh0, a1 = 0.f, a2 = 0.f, a3 = 0.f;
              mr3 = *(const LAS f32x4*)(Mm + 1096);
              __builtin_amdgcn_sched_barrier(0);
              a0 -= mr4[0] * X[0]; a1 -= mr4[1] * X[1]; a2 -= mr4[2] * X[2]; a3 -= mr4[3] * X[3];
              mr4 = *(const LAS f32x4*)(Mm + 1100);
              __builtin_amdgcn_sched_barrier(0);
              a0 -= mr5[0] * X[4]; a1 -= mr5[1] * X[5]; a2 -= mr5[2] * X[6]; a3 -= mr5[3] * X[7];
              mr5 = *(const LAS f32x4*)(Mm + 1156);
              __builtin_amdgcn_sched_barrier(0);
              a0 -= mr6[0] * X[8]; a1 -= mr6[1] * X[9]; a2 -= mr6[2] * X[10]; a3 -= mr6[3] * X[11];
              mr6 = *(const LAS f32x4*)(Mm + 1160);
              __builtin_amdgcn_sched_barrier(0);
              a0 -= mr0[0] * X[12]; a1 -= mr0[1] * X[13]; a2 -= mr0[2] * X[14];
              X[15] = (a0 + a1) + (a2 + a3); dst[1980] = X[15]; }
            __builtin_amdgcn_sched_barrier(0);
            rh0 = src[2376] * cf[18];
            { float a0 = rh1, a1 = 0.f, a2 = 0.f, a3 = 0.f;
              mr0 = *(const LAS f32x4*)(Mm + 1164);
              __builtin_amdgcn_sched_barrier(0);
              a0 -= mr1[0] * X[0]; a1 -= mr1[1] * X[1]; a2 -= mr1[2] * X[2]; a3 -= mr1[3] * X[3];
              mr1 = *(const LAS f32x4*)(Mm + 1168);
              __builtin_amdgcn_sched_barrier(0);
              a0 -= mr2[0] * X[4]; a1 -= mr2[1] * X[5]; a2 -= mr2[2] * X[6]; a3 -= mr2[3] * X[7];
              mr2 = *(const LAS f32x4*)(Mm + 1172);
              __builtin_amdgcn_sched_barrier(0);
              a0 -= mr3[0] * X[8]; a1 -= mr3[1] * X[9]; a2 -= mr3[2] * X[10]; a3 -= mr3[3] * X[11];
              mr3 = *(const LAS f32x4*)(Mm + 1224);
              __builtin_amdgcn_sched_barrier(0);
              a0 -= mr4[0] * X[12]; a1 -= mr4[1] * X[13]; a2 -= mr4[2] * X[14]; a3 -= mr4[3] * X[15];
              X[16] = (a0 + a1) + (a2 + a3); dst[2112] = X[16]; }
            __builtin_amdgcn_sched_barrier(0);
            rh1 = src[2508] * cf[19];
            { float a0 = rh2, a1 = 0.f, a2 = 0.f, a3 = 0.f;
              mr4 = *(const LAS f32x4*)(Mm + 1228);
              __builtin_amdgcn_sched_barrier(0);
              a0 -= mr5[0] * X[0]; a1 -= mr5[1] * X[1]; a2 -= mr5[2] * X[2]; a3 -= mr5[3] * X[3];
              mr5 = *(const LAS f32x4*)(Mm + 1232);
              __builtin_amdgcn_sched_barrier(0);
              a0 -= mr6[0] * X[4]; a1 -= mr6[1] * X[5]; a2 -= mr6[2] * X[6]; a3 -= mr6[3] * X[7];
              mr6 = *(const LAS f32x4*)(Mm + 1236);
              __builtin_amdgcn_sched_barrier(0);
              a0 -= mr0[0] * X[8]; a1 -= mr0[1] * X[9]; a2 -= mr0[2] * X[10]; a3 -= mr0[3] * X[11];
              mr0 = *(const LAS f32x4*)(Mm + 1240);
              __builtin_amdgcn_sched_barrier(0);
              a0 -= mr1[0] * X[12]; a1 -= mr1[1] * X[13]; a2 -= mr1[2] * X[14]; a3 -= mr1[3] * X[15];
              mr1 = *(const LAS f32x4*)(Mm + 1292);
              __builtin_amdgcn_sched_barrier(0);
              a0 -= mr2[0] * X[16];
              X[17] = (a0 + a1) + (a2 + a3); dst[2244] = X[17]; }
            __builtin_amdgcn_sched_barrier(0);
            rh2 = src[2640] * cf[20];
            { float a0 = rh0, a1 = 0.f, a2 = 0.f, a3 = 0.f;
              mr2 = *(const LAS f32x4*)(Mm + 1296);
              __builtin_amdgcn_sched_barrier(0);
              a0 -= mr3[0] * X[0]; a1 -= mr3[1] * X[1]; a2 -= mr3[2] * X[2]; a3 -= mr3[3] * X[3];
              mr3 = *(const LAS f32x4*)(Mm + 1300);
              __builtin_amdgcn_sched_barrier(0);
              a0 -= mr4[0] * X[4]; a1 -= mr4[1] * X[5]; a2 -= mr4[2] * X[6]; a3 -= mr4[3] * X[7];
              mr4 = *(const LAS f32x4*)(Mm + 1304);
              __builtin_amdgcn_sched_barrier(0);
              a0 -= mr5[0] * X[8]; a1 -= mr5[1] * X[9]; a2 -= mr5[2] * X[10]; a3 -= mr5[3] * X[11];
              mr5 = *(const LAS f32x4*)(Mm + 1308);
              __builtin_amdgcn_sched_barrier(0);
              a0 -= mr6[0] * X[12]; a1 -= mr6[1] * X[13]; a2 -= mr6[2] * X[14]; a3 -= mr6[3] * X[15];
              mr6 = *(const LAS f32x4*)(Mm + 1360);
              __builtin_amdgcn_sched_barrier(0);
              a0 -= mr0[0] * X[16]; a1 -= mr0[1] * X[17];
              X[18] = (a0 + a1) + (a2 + a3); dst[2376] = X[18]; }
            __builtin_amdgcn_sched_barrier(0);
            rh0 = src[2772] * cf[21];
            { float a0 = rh1, a1 = 0.f, a2 = 0.f, a3 = 0.f;
              mr0 = *(const LAS f32x4*)(Mm + 1364);
              __builtin_amdgcn_sched_barrier(0);
              a0 -= mr1[0] * X[0]; a1 -= mr1[1] * X[1]; a2 -= mr1[2] * X[2]; a3 -= mr1[3] * X[3];
              mr1 = *(const LAS f32x4*)(Mm + 1368);
              __builtin_amdgcn_sched_barrier(0);
              a0 -= mr2[0] * X[4]; a1 -= mr2[1] * X[5]; a2 -= mr2[2] * X[6]; a3 -= mr2[3] * X[7];
              mr2 = *(const LAS f32x4*)(Mm + 1372);
              __builtin_amdgcn_sched_barrier(0);
              a0 -= mr3[0] * X[8]; a1 -= mr3[1] * X[9]; a2 -= mr3[2] * X[10]; a3 -= mr3[3] * X[11];
              mr3 = *(const LAS f32x4*)(Mm + 1376);
              __builtin_amdgcn_sched_barrier(0);
              a0 -= mr4[0] * X[12]; a1 -= mr4[1] * X[13]; a2 -= mr4[2] * X[14]; a3 -= mr4[3] * X[15];
              mr4 = *(const LAS f32x4*)(Mm + 1428);
              __builtin_amdgcn_sched_barrier(0);
              a0 -= mr5[0] * X[16]; a1 -= mr5[1] * X[17]; a2 -= mr5[2] * X[18];
              X[19] = (a0 + a1) + (a2 + a3); dst[2508] = X[19]; }
            __builtin_amdgcn_sched_barrier(0);
            rh1 = src[2904] * cf[22];
            { float a0 = rh2, a1 = 0.f, a2 = 0.f, a3 = 0.f;
              mr5 = *(const LAS f32x4*)(Mm + 1432);
              __builtin_amdgcn_sched_barrier(0);
              a0 -= mr6[0] * X[0]; a1 -= mr6[1] * X[1]; a2 -= mr6[2] * X[2]; a3 -= mr6[3] * X[3];
              mr6 = *(const LAS f32x4*)(Mm + 1436);
              __builtin_amdgcn_sched_barrier(0);
              a0 -= mr0[0] * X[4]; a1 -= mr0[1] * X[5]; a2 -= mr0[2] * X[6]; a3 -= mr0[3] * X[7];
              mr0 = *(const LAS f32x4*)(Mm + 1440);
              __builtin_amdgcn_sched_barrier(0);
              a0 -= mr1[0] * X[8]; a1 -= mr1[1] * X[9]; a2 -= mr1[2] * X[10]; a3 -= mr1[3] * X[11];
              mr1 = *(const LAS f32x4*)(Mm + 1444);
              __builtin_amdgcn_sched_barrier(0);
              a0 -= mr2[0] * X[12]; a1 -= mr2[1] * X[13]; a2 -= mr2[2] * X[14]; a3 -= mr2[3] * X[15];
              mr2 = *(const LAS f32x4*)(Mm + 1448);
              __builtin_amdgcn_sched_barrier(0);
              a0 -= mr3[0] * X[16]; a1 -= mr3[1] * X[17]; a2 -= mr3[2] * X[18]; a3 -= mr3[3] * X[19];
              X[20] = (a0 + a1) + (a2 + a3); dst[2640] = X[20]; }
            __builtin_amdgcn_sched_barrier(0);
            rh2 = src[3036] * cf[23];
            { float a0 = rh0, a1 = 0.f, a2 = 0.f, a3 = 0.f;
              mr3 = *(const LAS f32x4*)(Mm + 1496);
              __builtin_amdgcn_sched_barrier(0);
              a0 -= mr4[0] * X[0]; a1 -= mr4[1] * X[1]; a2 -= mr4[2] * X[2]; a3 -= mr4[3] * X[3];
              mr4 = *(const LAS f32x4*)(Mm + 1500);
              __builtin_amdgcn_sched_barrier(0);
              a0 -= mr5[0] * X[4]; a1 -= mr5[1] * X[5]; a2 -= mr5[2] * X[6]; a3 -= mr5[3] * X[7];
              mr5 = *(const LAS f32x4*)(Mm + 1504);
              __builtin_amdgcn_sched_barrier(0);
              a0 -= mr6[0] * X[8]; a1 -= mr6[1] * X[9]; a2 -= mr6[2] * X[10]; a3 -= mr6[3] * X[11];
              mr6 = *(const LAS f32x4*)(Mm + 1508);
              __builtin_amdgcn_sched_barrier(0);
              a0 -= mr0[0] * X[12]; a1 -= mr0[1] * X[13]; a2 -= mr0[2] * X[14]; a3 -= mr0[3] * X[15];
              mr0 = *(const LAS f32x4*)(Mm + 1512);
              __builtin_amdgcn_sched_barrier(0);
              a0 -= mr1[0] * X[16]; a1 -= mr1[1] * X[17]; a2 -= mr1[2] * X[18]; a3 -= mr1[3] * X[19];
              mr1 = *(const LAS f32x4*)(Mm + 1516);
              __builtin_amdgcn_sched_barrier(0);
              a0 -= mr2[0] * X[20];
              X[21] = (a0 + a1) + (a2 + a3); dst[2772] = X[21]; }
            __builtin_amdgcn_sched_barrier(0);
            rh0 = src[3168] * cf[24];
            { float a0 = rh1, a1 = 0.f, a2 = 0.f, a3 = 0.f;
              mr2 = *(const LAS f32x4*)(Mm + 1564);
              __builtin_amdgcn_sched_barrier(0);
              a0 -= mr3[0] * X[0]; a1 -= mr3[1] * X[1]; a2 -= mr3[2] * X[2]; a3 -= mr3[3] * X[3];
              mr3 = *(const LAS f32x4*)(Mm + 1568);
              __builtin_amdgcn_sched_barrier(0);
              a0 -= mr4[0] * X[4]; a1 -= mr4[1] * X[5]; a2 -= mr4[2] * X[6]; a3 -= mr4[3] * X[7];
              mr4 = *(const LAS f32x4*)(Mm + 1572);
              __builtin_amdgcn_sched_barrier(0);
              a0 -= mr5[0] * X[8]; a1 -= mr5[1] * X[9]; a2 -= mr5[2] * X[10]; a3 -= mr5[3] * X[11];
              mr5 = *(const LAS f32x4*)(Mm + 1576);
              __builtin_amdgcn_sched_barrier(0);
              a0 -= mr6[0] * X[12]; a1 -= mr6[1] * X[13]; a2 -= mr6[2] * X[14]; a3 -= mr6[3] * X[15];
              mr6 = *(const LAS f32x4*)(Mm + 1580);
              __builtin_amdgcn_sched_barrier(0);
              a0 -= mr0[0] * X[16]; a1 -= mr0[1] * X[17]; a2 -= mr0[2] * X[18]; a3 -= mr0[3] * X[19];
              mr0 = *(const LAS f32x4*)(Mm + 1584);
              __builtin_amdgcn_sched_barrier(0);
              a0 -= mr1[0] * X[20]; a1 -= mr1[1] * X[21];
              X[22] = (a0 + a1) + (a2 + a3); dst[2904] = X[22]; }
            __builtin_amdgcn_sched_barrier(0);
            rh1 = src[3300] * cf[25];
            { float a0 = rh2, a1 = 0.f, a2 = 0.f, a3 = 0.f;
              mr1 = *(const LAS f32x4*)(Mm + 1632);
              __builtin_amdgcn_sched_barrier(0);
              a0 -= mr2[0] * X[0]; a1 -= mr2[1] * X[1]; a2 -= mr2[2] * X[2]; a3 -= mr2[3] * X[3];
              mr2 = *(const LAS f32x4*)(Mm + 1636);
              __builtin_amdgcn_sched_barrier(0);
              a0 -= mr3[0] * X[4]; a1 -= mr3[1] * X[5]; a2 -= mr3[2] * X[6]; a3 -= mr3[3] * X[7];
              mr3 = *(const LAS f32x4*)(Mm + 1640);
              __builtin_amdgcn_sched_barrier(0);
              a0 -= mr4[0] * X[8]; a1 -= mr4[1] * X[9]; a2 -= mr4[2] * X[10]; a3 -= mr4[3] * X[11];
              mr4 = *(const LAS f32x4*)(Mm + 1644);
              __builtin_amdgcn_sched_barrier(0);
              a0 -= mr5[0] * X[12]; a1 -= mr5[1] * X[13]; a2 -= mr5[2] * X[14]; a3 -= mr5[3] * X[15];
              mr5 = *(const LAS f32x4*)(Mm + 1648);
              __builtin_amdgcn_sched_barrier(0);
              a0 -= mr6[0] * X[16]; a1 -= mr6[1] * X[17]; a2 -= mr6[2] * X[18]; a3 -= mr6[3] * X[19];
              mr6 = *(const LAS f32x4*)(Mm + 1652);
              __builtin_amdgcn_sched_barrier(0);
              a0 -= mr0[0] * X[20]; a1 -= mr0[1] * X[21]; a2 -= mr0[2] * X[22];
              X[23] = (a0 + a1) + (a2 + a3); dst[3036] = X[23]; }
            __builtin_amdgcn_sched_barrier(0);
            rh2 = src[3432] * cf[26];
            { float a0 = rh0, a1 = 0.f, a2 = 0.f, a3 = 0.f;
              mr0 = *(const LAS f32x4*)(Mm + 1700);
              __builtin_amdgcn_sched_barrier(0);
              a0 -= mr1[0] * X[0]; a1 -= mr1[1] * X[1]; a2 -= mr1[2] * X[2]; a3 -= mr1[3] * X[3];
              mr1 = *(const LAS f32x4*)(Mm + 1704);
              __builtin_amdgcn_sched_barrier(0);
              a0 -= mr2[0] * X[4]; a1 -= mr2[1] * X[5]; a2 -= mr2[2] * X[6]; a3 -= mr2[3] * X[7];
              mr2 = *(const LAS f32x4*)(Mm + 1708);
              __builtin_amdgcn_sched_barrier(0);
              a0 -= mr3[0] * X[8]; a1 -= mr3[1] * X[9]; a2 -= mr3[2] * X[10]; a3 -= mr3[3] * X[11];
              mr3 = *(const LAS f32x4*)(Mm + 1712);
              __builtin_amdgcn_sched_barrier(0);
              a0 -= mr4[0] * X[12]; a1 -= mr4[1] * X[13]; a2 -= mr4[2] * X[14]; a3 -= mr4[3] * X[15];
              mr4 = *(const LAS f32x4*)(Mm + 1716);
              __builtin_amdgcn_sched_barrier(0);
              a0 -= mr5[0] * X[16]; a1 -= mr5[1] * X[17]; a2 -= mr5[2] * X[18]; a3 -= mr5[3] * X[19];
              mr5 = *(const LAS f32x4*)(Mm + 1720);
              __builtin_amdgcn_sched_barrier(0);
              a0 -= mr6[0] * X[20]; a1 -= mr6[1] * X[21]; a2 -= mr6[2] * X[22]; a3 -= mr6[3] * X[23];
              X[24] = (a0 + a1) + (a2 + a3); dst[3168] = X[24]; }
            __builtin_amdgcn_sched_barrier(0);
            rh0 = src[3564] * cf[27];
            { float a0 = rh1, a1 = 0.f, a2 = 0.f, a3 = 0.f;
              mr6 = *(const LAS f32x4*)(Mm + 1724);
              __builtin_amdgcn_sched_barrier(0);
              a0 -= mr0[0] * X[0]; a1 -= mr0[1] * X[1]; a2 -= mr0[2] * X[2]; a3 -= mr0[3] * X[3];
              mr0 = *(const LAS f32x4*)(Mm + 1768);
              __builtin_amdgcn_sched_barrier(0);
              a0 -= mr1[0] * X[4]; a1 -= mr1[1] * X[5]; a2 -= mr1[2] * X[6]; a3 -= mr1[3] * X[7];
              mr1 = *(const LAS f32x4*)(Mm + 1772);
              __builtin_amdgcn_sched_barrier(0);
              a0 -= mr2[0] * X[8]; a1 -= mr2[1] * X[9]; a2 -= mr2[2] * X[10]; a3 -= mr2[3] * X[11];
              mr2 = *(const LAS f32x4*)(Mm + 1776);
              __builtin_amdgcn_sched_barrier(0);
              a0 -= mr3[0] * X[12]; a1 -= mr3[1] * X[13]; a2 -= mr3[2] * X[14]; a3 -= mr3[3] * X[15];
              mr3 = *(const LAS f32x4*)(Mm + 1780);
              __builtin_amdgcn_sched_barrier(0);
              a0 -= mr4[0] * X[16]; a1 -= mr4[1] * X[17]; a2 -= mr4[2] * X[18]; a3 -= mr4[3] * X[19];
              mr4 = *(const LAS f32x4*)(Mm + 1784);
              __builtin_amdgcn_sched_barrier(0);
              a0 -= mr5[0] * X[20]; a1 -= mr5[1] * X[21]; a2 -= mr5[2] * X[22]; a3 -= mr5[3] * X[23];
              mr5 = *(const LAS f32x4*)(Mm + 1788);
              __builtin_amdgcn_sched_barrier(0);
              a0 -= mr6[0] * X[24];
              X[25] = (a0 + a1) + (a2 + a3); dst[3300] = X[25]; }
            __builtin_amdgcn_sched_barrier(0);
            rh1 = src[3696] * cf[28];
            { float a0 = rh2, a1 = 0.f, a2 = 0.f, a3 = 0.f;
              mr6 = *(const LAS f32x4*)(Mm + 1792);
              __builtin_amdgcn_sched_barrier(0);
              a0 -= mr0[0] * X[0]; a1 -= mr0[1] * X[1]; a2 -= mr0[2] * X[2]; a3 -= mr0[3] * X[3];
              mr0 = *(const LAS f32x4*)(Mm + 1836);
              __builtin_amdgcn_sched_barrier(0);
              a0 -= mr1[0] * X[4]; a1 -= mr1[1] * X[5]; a2 -= mr1[2] * X[6]; a3 -= mr1[3] * X[7];
              mr1 = *(const LAS f32x4*)(Mm + 1840);
              __builtin_amdgcn_sched_barrier(0);
              a0 -= mr2[0] * X[8]; a1 -= mr2[1] * X[9]; a2 -= mr2[2] * X[10]; a3 -= mr2[3] * X[11];
              mr2 = *(const LAS f32x4*)(Mm + 1844);
              __builtin_amdgcn_sched_barrier(0);
              a0 -= mr3[0] * X[12]; a1 -= mr3[1] * X[13]; a2 -= mr3[2] * X[14]; a3 -= mr3[3] * X[15];
              mr3 = *(const LAS f32x4*)(Mm + 1848);
              __builtin_amdgcn_sched_barrier(0);
              a0 -= mr4[0] * X[16]; a1 -= mr4[1] * X[17]; a2 -= mr4[2] * X[18]; a3 -= mr4[3] * X[19];
              mr4 = *(const LAS f32x4*)(Mm + 1852);
              __builtin_amdgcn_sched_barrier(0);
              a0 -= mr5[0] * X[20]; a1 -= mr5[1] * X[21]; a2 -= mr5[2] * X[22]; a3 -= mr5[3] * X[23];
              mr5 = *(const LAS f32x4*)(Mm + 1856);
              __builtin_amdgcn_sched_barrier(0);
              a0 -= mr6[0] * X[24]; a1 -= mr6[1] * X[25];
              X[26] = (a0 + a1) + (a2 + a3); dst[3432] = X[26]; }
            __builtin_amdgcn_sched_barrier(0);
            rh2 = src[3828] * cf[29];
            { float a0 = rh0, a1 = 0.f, a2 = 0.f, a3 = 0.f;
              mr6 = *(const LAS f32x4*)(Mm + 1860);
              __builtin_amdgcn_sched_barrier(0);
              a0 -= mr0[0] * X[0]; a1 -= mr0[1] * X[1]; a2 -= mr0[2] * X[2]; a3 -= mr0[3] * X[3];
              mr0 = *(const LAS f32x4*)(Mm + 1904);
              __builtin_amdgcn_sched_barrier(0);
              a0 -= mr1[0] * X[4]; a1 -= mr1[1] * X[5]; a2 -= mr1[2] * X[6]; a3 -= mr1[3] * X[7];
              mr1 = *(const LAS f32x4*)(Mm + 1908);
              __builtin_amdgcn_sched_barrier(0);
              a0 -= mr2[0] * X[8]; a1 -= mr2[1] * X[9]; a2 -= mr2[2] * X[10]; a3 -= mr2[3] * X[11];
              mr2 = *(const LAS f32x4*)(Mm + 1912);
              __builtin_amdgcn_sched_barrier(0);
              a0 -= mr3[0] * X[12]; a1 -= mr3[1] * X[13]; a2 -= mr3[2] * X[14]; a3 -= mr3[3] * X[15];
              mr3 = *(const LAS f32x4*)(Mm + 1916);
              __builtin_amdgcn_sched_barrier(0);
              a0 -= mr4[0] * X[16]; a1 -= mr4[1] * X[17]; a2 -= mr4[2] * X[18]; a3 -= mr4[3] * X[19];
              mr4 = *(const LAS f32x4*)(Mm + 1920);
              __builtin_amdgcn_sched_barrier(0);
              a0 -= mr5[0] * X[20]; a1 -= mr5[1] * X[21]; a2 -= mr5[2] * X[22]; a3 -= mr5[3] * X[23];
              mr5 = *(const LAS f32x4*)(Mm + 1924);
              __builtin_amdgcn_sched_barrier(0);
              a0 -= mr6[0] * X[24]; a1 -= mr6[1] * X[25]; a2 -= mr6[2] * X[26];
              X[27] = (a0 + a1) + (a2 + a3); dst[3564] = X[27]; }
            __builtin_amdgcn_sched_barrier(0);
            rh0 = src[3960] * cf[30];
            { float a0 = rh1, a1 = 0.f, a2 = 0.f, a3 = 0.f;
              mr6 = *(const LAS f32x4*)(Mm + 1928);
              __builtin_amdgcn_sched_barrier(0);
              a0 -= mr0[0] * X[0]; a1 -= mr0[1] * X[1]; a2 -= mr0[2] * X[2]; a3 -= mr0[3] * X[3];
              mr0 = *(const LAS f32x4*)(Mm + 1972);
              __builtin_amdgcn_sched_barrier(0);
              a0 -= mr1[0] * X[4]; a1 -= mr1[1] * X[5]; a2 -= mr1[2] * X[6]; a3 -= mr1[3] * X[7];
              mr1 = *(const LAS f32x4*)(Mm + 1976);
              __builtin_amdgcn_sched_barrier(0);
              a0 -= mr2[0] * X[8]; a1 -= mr2[1] * X[9]; a2 -= mr2[2] * X[10]; a3 -= mr2[3] * X[11];
              mr2 = *(const LAS f32x4*)(Mm + 1980);
              __builtin_amdgcn_sched_barrier(0);
              a0 -= mr3[0] * X[12]; a1 -= mr3[1] * X[13]; a2 -= mr3[2] * X[14]; a3 -= mr3[3] * X[15];
              mr3 = *(const LAS f32x4*)(Mm + 1984);
              __builtin_amdgcn_sched_barrier(0);
              a0 -= mr4[0] * X[16]; a1 -= mr4[1] * X[17]; a2 -= mr4[2] * X[18]; a3 -= mr4[3] * X[19];
              mr4 = *(const LAS f32x4*)(Mm + 1988);
              __builtin_amdgcn_sched_barrier(0);
              a0 -= mr5[0] * X[20]; a1 -= mr5[1] * X[21]; a2 -= mr5[2] * X[22]; a3 -= mr5[3] * X[23];
              mr5 = *(const LAS f32x4*)(Mm + 1992);
              __builtin_amdgcn_sched_barrier(0);
              a0 -= mr6[0] * X[24]; a1 -= mr6[1] * X[25]; a2 -= mr6[2] * X[26]; a3 -= mr6[3] * X[27];
              X[28] = (a0 + a1) + (a2 + a3); dst[3696] = X[28]; }
            __builtin_amdgcn_sched_barrier(0);
            rh1 = src[4092] * cf[31];
            { float a0 = rh2, a1 = 0.f, a2 = 0.f, a3 = 0.f;
              mr6 = *(const LAS f32x4*)(Mm + 1996);
              __builtin_amdgcn_sched_barrier(0);
              a0 -= mr0[0] * X[0]; a1 -= mr0[1] * X[1]; a2 -= mr0[2] * X[2]; a3 -= mr0[3] * X[3];
              mr0 = *(const LAS f32x4*)(Mm + 2000);
              __builtin_amdgcn_sched_barrier(0);
              a0 -= mr1[0] * X[4]; a1 -= mr1[1] * X[5]; a2 -= mr1[2] * X[6]; a3 -= mr1[3] * X[7];
              mr1 = *(const LAS f32x4*)(Mm + 2040);
              __builtin_amdgcn_sched_barrier(0);
              a0 -= mr2[0] * X[8]; a1 -= mr2[1] * X[9]; a2 -= mr2[2] * X[10]; a3 -= mr2[3] * X[11];
              mr2 = *(const LAS f32x4*)(Mm + 2044);
              __builtin_amdgcn_sched_barrier(0);
              a0 -= mr3[0] * X[12]; a1 -= mr3[1] * X[13]; a2 -= mr3[2] * X[14]; a3 -= mr3[3] * X[15];
              mr3 = *(const LAS f32x4*)(Mm + 2048);
              __builtin_amdgcn_sched_barrier(0);
              a0 -= mr4[0] * X[16]; a1 -= mr4[1] * X[17]; a2 -= mr4[2] * X[18]; a3 -= mr4[3] * X[19];
              mr4 = *(const LAS f32x4*)(Mm + 2052);
              __builtin_amdgcn_sched_barrier(0);
              a0 -= mr5[0] * X[20]; a1 -= mr5[1] * X[21]; a2 -= mr5[2] * X[22]; a3 -= mr5[3] * X[23];
              mr5 = *(const LAS f32x4*)(Mm + 2056);
              __builtin_amdgcn_sched_barrier(0);
              a0 -= mr6[0] * X[24]; a1 -= mr6[1] * X[25]; a2 -= mr6[2] * X[26]; a3 -= mr6[3] * X[27];
              mr6 = *(const LAS f32x4*)(Mm + 2060);
              __builtin_amdgcn_sched_barrier(0);
              a0 -= mr0[0] * X[28];
              X[29] = (a0 + a1) + (a2 + a3); dst[3828] = X[29]; }
            __builtin_amdgcn_sched_barrier(0);
            rh2 = src[4224] * cf[32];
            { float a0 = rh0, a1 = 0.f, a2 = 0.f, a3 = 0.f;
              mr0 = *(const LAS f32x4*)(Mm + 2064);
              __builtin_amdgcn_sched_barrier(0);
              a0 -= mr1[0] * X[0]; a1 -= mr1[1] * X[1]; a2 -= mr1[2] * X[2]; a3 -= mr1[3] * X[3];
              mr1 = *(const LAS f32x4*)(Mm + 2068);
              __builtin_amdgcn_sched_barrier(0);
              a0 -= mr2[0] * X[4]; a1 -= mr2[1] * X[5]; a2 -= mr2[2] * X[6]; a3 -= mr2[3] * X[7];
              mr2 = *(const LAS f32x4*)(Mm + 2108);
              __builtin_amdgcn_sched_barrier(0);
              a0 -= mr3[0] * X[8]; a1 -= mr3[1] * X[9]; a2 -= mr3[2] * X[10]; a3 -= mr3[3] * X[11];
              mr3 = *(const LAS f32x4*)(Mm + 2112);
              __builtin_amdgcn_sched_barrier(0);
              a0 -= mr4[0] * X[12]; a1 -= mr4[1] * X[13]; a2 -= mr4[2] * X[14]; a3 -= mr4[3] * X[15];
              mr4 = *(const LAS f32x4*)(Mm + 2116);
              __builtin_amdgcn_sched_barrier(0);
              a0 -= mr5[0] * X[16]; a1 -= mr5[1] * X[17]; a2 -= mr5[2] * X[18]; a3 -= mr5[3] * X[19];
              mr5 = *(const LAS f32x4*)(Mm + 2120);
              __builtin_amdgcn_sched_barrier(0);
              a0 -= mr6[0] * X[20]; a1 -= mr6[1] * X[21]; a2 -= mr6[2] * X[22]; a3 -= mr6[3] * X[23];
              mr6 = *(const LAS f32x4*)(Mm + 2124);
              __builtin_amdgcn_sched_barrier(0);
              a0 -= mr0[0] * X[24]; a1 -= mr0[1] * X[25]; a2 -= mr0[2] * X[26]; a3 -= mr0[3] * X[27];
              mr0 = *(const LAS f32x4*)(Mm + 2128);
              __builtin_amdgcn_sched_barrier(0);
              a0 -= mr1[0] * X[28]; a1 -= mr1[1] * X[29];
              X[30] = (a0 + a1) + (a2 + a3); dst[3960] = X[30]; }
            __builtin_amdgcn_sched_barrier(0);
            rh0 = src[4356] * cf[33];
            { float a0 = rh1, a1 = 0.f, a2 = 0.f, a3 = 0.f;
              mr1 = *(const LAS f32x4*)(Mm + 2132);
              __builtin_amdgcn_sched_barrier(0);
              a0 -= mr2[0] * X[0]; a1 -= mr2[1] * X[1]; a2 -= mr2[2] * X[2]; a3 -= mr2[3] * X[3];
              mr2 = *(const LAS f32x4*)(Mm + 2136);
              __builtin_amdgcn_sched_barrier(0);
              a0 -= mr3[0] * X[4]; a1 -= mr3[1] * X[5]; a2 -= mr3[2] * X[6]; a3 -= mr3[3] * X[7];
              mr3 = *(const LAS f32x4*)(Mm + 2176);
              __builtin_amdgcn_sched_barrier(0);
              a0 -= mr4[0] * X[8]; a1 -= mr4[1] * X[9]; a2 -= mr4[2] * X[10]; a3 -= mr4[3] * X[11];
              mr4 = *(const LAS f32x4*)(Mm + 2180);
              __builtin_amdgcn_sched_barrier(0);
              a0 -= mr5[0] * X[12]; a1 -= mr5[1] * X[13]; a2 -= mr5[2] * X[14]; a3 -= mr5[3] * X[15];
              mr5 = *(const LAS f32x4*)(Mm + 2184);
              __builtin_amdgcn_sched_barrier(0);
              a0 -= mr6[0] * X[16]; a1 -= mr6[1] * X[17]; a2 -= mr6[2] * X[18]; a3 -= mr6[3] * X[19];
              mr6 = *(const LAS f32x4*)(Mm + 2188);
              __builtin_amdgcn_sched_barrier(0);
              a0 -= mr0[0] * X[20]; a1 -= mr0[1] * X[21]; a2 -= mr0[2] * X[22]; a3 -= mr0[3] * X[23];
              mr0 = *(const LAS f32x4*)(Mm + 2192);
              __builtin_amdgcn_sched_barrier(0);
              a0 -= mr1[0] * X[24]; a1 -= mr1[1] * X[25]; a2 -= mr1[2] * X[26]; a3 -= mr1[3] * X[27];
              mr1 = *(const LAS f32x4*)(Mm + 2196);
              __builtin_amdgcn_sched_barrier(0);
              a0 -= mr2[0] * X[28]; a1 -= mr2[1] * X[29]; a2 -= mr2[2] * X[30];
              X[31] = (a0 + a1) + (a2 + a3); dst[4092] = X[31]; }
            __builtin_amdgcn_sched_barrier(0);
            rh1 = src[4488] * cf[34];
            { float a0 = rh2, a1 = 0.f, a2 = 0.f, a3 = 0.f;
              mr2 = *(const LAS f32x4*)(Mm + 2200);
              __builtin_amdgcn_sched_barrier(0);
              a0 -= mr3[0] * X[0]; a1 -= mr3[1] * X[1]; a2 -= mr3[2] * X[2]; a3 -= mr3[3] * X[3];
              mr3 = *(const LAS f32x4*)(Mm + 2204);
              __builtin_amdgcn_sched_barrier(0);
              a0 -= mr4[0] * X[4]; a1 -= mr4[1] * X[5]; a2 -= mr4[2] * X[6]; a3 -= mr4[3] * X[7];
              mr4 = *(const LAS f32x4*)(Mm + 2244);
              __builtin_amdgcn_sched_barrier(0);
              a0 -= mr5[0] * X[8]; a1 -= mr5[1] * X[9]; a2 -= mr5[2] * X[10]; a3 -= mr5[3] * X[11];
              mr5 = *(const LAS f32x4*)(Mm + 2248);
              __builtin_amdgcn_sched_barrier(0);
              a0 -= mr6[0] * X[12]; a1 -= mr6[1] * X[13]; a2 -= mr6[2] * X[14]; a3 -= mr6[3] * X[15];
              mr6 = *(const LAS f32x4*)(Mm + 2252);
              __builtin_amdgcn_sched_barrier(0);
              a0 -= mr0[0] * X[16]; a1 -= mr0[1] * X[17]; a2 -= mr0[2] * X[18]; a3 -= mr0[3] * X[19];
              mr0 = *(const LAS f32x4*)(Mm + 2256);
              __builtin_amdgcn_sched_barrier(0);
              a0 -= mr1[0] * X[20]; a1 -= mr1[1] * X[21]; a2 -= mr1[2] * X[22]; a3 -= mr1[3] * X[23];
              mr1 = *(const LAS f32x4*)(Mm + 2260);
              __builtin_amdgcn_sched_barrier(0);
              a0 -= mr2[0] * X[24]; a1 -= mr2[1] * X[25]; a2 -= mr2[2] * X[26]; a3 -= mr2[3] * X[27];
              mr2 = *(const LAS f32x4*)(Mm + 2264);
              __builtin_amdgcn_sched_barrier(0);
              a0 -= mr3[0] * X[28]; a1 -= mr3[1] * X[29]; a2 -= mr3[2] * X[30]; a3 -= mr3[3] * X[31];
              X[32] = (a0 + a1) + (a2 + a3); dst[4224] = X[32]; }
            __builtin_amdgcn_sched_barrier(0);
            rh2 = src[4620] * cf[35];
            { float a0 = rh0, a1 = 0.f, a2 = 0.f, a3 = 0.f;
              mr3 = *(const LAS f32x4*)(Mm + 2268);
              __builtin_amdgcn_sched_barrier(0);
              a0 -= mr4[0] * X[0]; a1 -= mr4[1] * X[1]; a2 -= mr4[2] * X[2]; a3 -= mr4[3] * X[3];
              mr4 = *(const LAS f32x4*)(Mm + 2272);
              __builtin_amdgcn_sched_barrier(0);
              a0 -= mr5[0] * X[4]; a1 -= mr5[1] * X[5]; a2 -= mr5[2] * X[6]; a3 -= mr5[3] * X[7];
              mr5 = *(const LAS f32x4*)(Mm + 2276);
              __builtin_amdgcn_sched_barrier(0);
              a0 -= mr6[0] * X[8]; a1 -= mr6[1] * X[9]; a2 -= mr6[2] * X[10]; a3 -= mr6[3] * X[11];
              mr6 = *(const LAS f32x4*)(Mm + 2312);
              __builtin_amdgcn_sched_barrier(0);
              a0 -= mr0[0] * X[12]; a1 -= mr0[1] * X[13]; a2 -= mr0[2] * X[14]; a3 -= mr0[3] * X[15];
              mr0 = *(const LAS f32x4*)(Mm + 2316);
              __builtin_amdgcn_sched_barrier(0);
              a0 -= mr1[0] * X[16]; a1 -= mr1[1] * X[17]; a2 -= mr1[2] * X[18]; a3 -= mr1[3] * X[19];
              mr1 = *(const LAS f32x4*)(Mm + 2320);
              __builtin_amdgcn_sched_barrier(0);
              a0 -= mr2[0] * X[20]; a1 -= mr2[1] * X[21]; a2 -= mr2[2] * X[22]; a3 -= mr2[3] * X[23];
              mr2 = *(const LAS f32x4*)(Mm + 2324);
              __builtin_amdgcn_sched_barrier(0);
              a0 -= mr3[0] * X[24]; a1 -= mr3[1] * X[25]; a2 -= mr3[2] * X[26]; a3 -= mr3[3] * X[27];
              mr3 = *(const LAS f32x4*)(Mm + 2328);
              __builtin_amdgcn_sched_barrier(0);
              a0 -= mr4[0] * X[28]; a1 -= mr4[1] * X[29]; a2 -= mr4[2] * X[30]; a3 -= mr4[3] * X[31];
              mr4 = *(const LAS f32x4*)(Mm + 2332);
              __builtin_amdgcn_sched_barrier(0);
              a0 -= mr5[0] * X[32];
              X[33] = (a0 + a1) + (a2 + a3); dst[4356] = X[33]; }
            __builtin_amdgcn_sched_barrier(0);
            rh0 = src[4752] * cf[36];
            { float a0 = rh1, a1 = 0.f, a2 = 0.f, a3 = 0.f;
              mr5 = *(const LAS f32x4*)(Mm + 2336);
              __builtin_amdgcn_sched_barrier(0);
              a0 -= mr6[0] * X[0]; a1 -= mr6[1] * X[1]; a2 -= mr6[2] * X[2]; a3 -= mr6[3] * X[3];
              mr6 = *(const LAS f32x4*)(Mm + 2340);
              __builtin_amdgcn_sched_barrier(0);
              a0 -= mr0[0] * X[4]; a1 -= mr0[1] * X[5]; a2 -= mr0[2] * X[6]; a3 -= mr0[3] * X[7];
              mr0 = *(const LAS f32x4*)(Mm + 2344);
              __builtin_amdgcn_sched_barrier(0);
              a0 -= mr1[0] * X[8]; a1 -= mr1[1] * X[9]; a2 -= mr1[2] * X[10]; a3 -= mr1[3] * X[11];
              mr1 = *(const LAS f32x4*)(Mm + 2380);
              __builtin_amdgcn_sched_barrier(0);
              a0 -= mr2[0] * X[12]; a1 -= mr2[1] * X[13]; a2 -= mr2[2] * X[14]; a3 -= mr2[3] * X[15];
              mr2 = *(const LAS f32x4*)(Mm + 2384);
              __builtin_amdgcn_sched_barrier(0);
              a0 -= mr3[0] * X[16]; a1 -= mr3[1] * X[17]; a2 -= mr3[2] * X[18]; a3 -= mr3[3] * X[19];
              mr3 = *(const LAS f32x4*)(Mm + 2388);
              __builtin_amdgcn_sched_barrier(0);
              a0 -= mr4[0] * X[20]; a1 -= mr4[1] * X[21]; a2 -= mr4[2] * X[22]; a3 -= mr4[3] * X[23];
              mr4 = *(const LAS f32x4*)(Mm + 2392);
              __builtin_amdgcn_sched_barrier(0);
              a0 -= mr5[0] * X[24]; a1 -= mr5[1] * X[25]; a2 -= mr5[2] * X[26]; a3 -= mr5[3] * X[27];
              mr5 = *(const LAS f32x4*)(Mm + 2396);
              __builtin_amdgcn_sched_barrier(0);
              a0 -= mr6[0] * X[28]; a1 -= mr6[1] * X[29]; a2 -= mr6[2] * X[30]; a3 -= mr6[3] * X[31];
              mr6 = *(const LAS f32x4*)(Mm + 2400);
              __builtin_amdgcn_sched_barrier(0);
              a0 -= mr0[0] * X[32]; a1 -= mr0[1] * X[33];
              X[34] = (a0 + a1) + (a2 + a3); dst[4488] = X[34]; }
            __builtin_amdgcn_sched_barrier(0);
            rh1 = src[4884] * cf[37];
            { float a0 = rh2, a1 = 0.f, a2 = 0.f, a3 = 0.f;
              mr0 = *(const LAS f32x4*)(Mm + 2404);
              __builtin_amdgcn_sched_barrier(0);
              a0 -= mr1[0] * X[0]; a1 -= mr1[1] * X[1]; a2 -= mr1[2] * X[2]; a3 -= mr1[3] * X[3];
              mr1 = *(const LAS f32x4*)(Mm + 2408);
              __builtin_amdgcn_sched_barrier(0);
              a0 -= mr2[0] * X[4]; a1 -= mr2[1] * X[5]; a2 -= mr2[2] * X[6]; a3 -= mr2[3] * X[7];
              mr2 = *(const LAS f32x4*)(Mm + 2412);
              __builtin_amdgcn_sched_barrier(0);
              a0 -= mr3[0] * X[8]; a1 -= mr3[1] * X[9]; a2 -= mr3[2] * X[10]; a3 -= mr3[3] * X[11];
              mr3 = *(const LAS f32x4*)(Mm + 2448);
              __builtin_amdgcn_sched_barrier(0);
              a0 -= mr4[0] * X[12]; a1 -= mr4[1] * X[13]; a2 -= mr4[2] * X[14]; a3 -= mr4[3] * X[15];
              mr4 = *(const LAS f32x4*)(Mm + 2452);
              __builtin_amdgcn_sched_barrier(0);
              a0 -= mr5[0] * X[16]; a1 -= mr5[1] * X[17]; a2 -= mr5[2] * X[18]; a3 -= mr5[3] * X[19];
              mr5 = *(const LAS f32x4*)(Mm + 2456);
              __builtin_amdgcn_sched_barrier(0);
              a0 -= mr6[0] * X[20]; a1 -= mr6[1] * X[21]; a2 -= mr6[2] * X[22]; a3 -= mr6[3] * X[23];
              mr6 = *(const LAS f32x4*)(Mm + 2460);
              __builtin_amdgcn_sched_barrier(0);
              a0 -= mr0[0] * X[24]; a1 -= mr0[1] * X[25]; a2 -= mr0[2] * X[26]; a3 -= mr0[3] * X[27];
              mr0 = *(const LAS f32x4*)(Mm + 2464);
              __builtin_amdgcn_sched_barrier(0);
              a0 -= mr1[0] * X[28]; a1 -= mr1[1] * X[29]; a2 -= mr1[2] * X[30]; a3 -= mr1[3] * X[31];
              mr1 = *(const LAS f32x4*)(Mm + 2468);
              __builtin_amdgcn_sched_barrier(0);
              a0 -= mr2[0] * X[32]; a1 -= mr2[1] * X[33]; a2 -= mr2[2] * X[34];
              X[35] = (a0 + a1) + (a2 + a3); dst[4620] = X[35]; }
            __builtin_amdgcn_sched_barrier(0);
            rh2 = src[5016] * cf[38];
            { float a0 = rh0, a1 = 0.f, a2 = 0.f, a3 = 0.f;
              mr2 = *(const LAS f32x4*)(Mm + 2472);
              __builtin_amdgcn_sched_barrier(0);
              a0 -= mr3[0] * X[0]; a1 -= mr3[1] * X[1]; a2 -= mr3[2] * X[2]; a3 -= mr3[3] * X[3];
              mr3 = *(const LAS f32x4*)(Mm + 2476);
              __builtin_amdgcn_sched_barrier(0);
              a0 -= mr4[0] * X[4]; a1 -= mr4[1] * X[5]; a2 -= mr4[2] * X[6]; a3 -= mr4[3] * X[7];
              mr4 = *(const LAS f32x4*)(Mm + 2480);
              __builtin_amdgcn_sched_barrier(0);
              a0 -= mr5[0] * X[8]; a1 -= mr5[1] * X[9]; a2 -= mr5[2] * X[10]; a3 -= mr5[3] * X[11];
              mr5 = *(const LAS f32x4*)(Mm + 2516);
              __builtin_amdgcn_sched_barrier(0);
              a0 -= mr6[0] * X[12]; a1 -= mr6[1] * X[13]; a2 -= mr6[2] * X[14]; a3 -= mr6[3] * X[15];
              mr6 = *(const LAS f32x4*)(Mm + 2520);
              __builtin_amdgcn_sched_barrier(0);
              a0 -= mr0[0] * X[16]; a1 -= mr0[1] * X[17]; a2 -= mr0[2] * X[18]; a3 -= mr0[3] * X[19];
              mr0 = *(const LAS f32x4*)(Mm + 2524);
              __builtin_amdgcn_sched_barrier(0);
              a0 -= mr1[0] * X[20]; a1 -= mr1[1] * X[21]; a2 -= mr1[2] * X[22]; a3 -= mr1[3] * X[23];
              mr1 = *(const LAS f32x4*)(Mm + 2528);
              __builtin_amdgcn_sched_barrier(0);
              a0 -= mr2[0] * X[24]; a1 -= mr2[1] * X[25]; a2 -= mr2[2] * X[26]; a3 -= mr2[3] * X[27];
              mr2 = *(const LAS f32x4*)(Mm + 2532);
              __builtin_amdgcn_sched_barrier(0);
              a0 -= mr3[0] * X[28]; a1 -= mr3[1] * X[29]; a2 -= mr3[2] * X[30]; a3 -= mr3[3] * X[31];
              mr3 = *(const LAS f32x4*)(Mm + 2536);
              __builtin_amdgcn_sched_barrier(0);
              a0 -= mr4[0] * X[32]; a1 -= mr4[1] * X[33]; a2 -= mr4[2] * X[34]; a3 -= mr4[3] * X[35];
              X[36] = (a0 + a1) + (a2 + a3); dst[4752] = X[36]; }
            __builtin_amdgcn_sched_barrier(0);
            rh0 = src[5148] * cf[39];
            { float a0 = rh1, a1 = 0.f, a2 = 0.f, a3 = 0.f;
              mr4 = *(const LAS f32x4*)(Mm + 2540);
              __builtin_amdgcn_sched_barrier(0);
              a0 -= mr5[0] * X[0]; a1 -= mr5[1] * X[1]; a2 -= mr5[2] * X[2]; a3 -= mr5[3] * X[3];
              mr5 = *(const LAS f32x4*)(Mm + 2544);
              __builtin_amdgcn_sched_barrier(0);
              a0 -= mr6[0] * X[4]; a1 -= mr6[1] * X[5]; a2 -= mr6[2] * X[6]; a3 -= mr6[3] * X[7];
              mr6 = *(const LAS f32x4*)(Mm + 2548);
              __builtin_amdgcn_sched_barrier(0);
              a0 -= mr0[0] * X[8]; a1 -= mr0[1] * X[9]; a2 -= mr0[2] * X[10]; a3 -= mr0[3] * X[11];
              mr0 = *(const LAS f32x4*)(Mm + 2552);
              __builtin_amdgcn_sched_barrier(0);
              a0 -= mr1[0] * X[12]; a1 -= mr1[1] * X[13]; a2 -= mr1[2] * X[14]; a3 -= mr1[3] * X[15];
              mr1 = *(const LAS f32x4*)(Mm + 2584);
              __builtin_amdgcn_sched_barrier(0);
              a0 -= mr2[0] * X[16]; a1 -= mr2[1] * X[17]; a2 -= mr2[2] * X[18]; a3 -= mr2[3] * X[19];
              mr2 = *(const LAS f32x4*)(Mm + 2588);
              __builtin_amdgcn_sched_barrier(0);
              a0 -= mr3[0] * X[20]; a1 -= mr3[1] * X[21]; a2 -= mr3[2] * X[22]; a3 -= mr3[3] * X[23];
              mr3 = *(const LAS f32x4*)(Mm + 2592);
              __builtin_amdgcn_sched_barrier(0);
              a0 -= mr4[0] * X[24]; a1 -= mr4[1] * X[25]; a2 -= mr4[2] * X[26]; a3 -= mr4[3] * X[27];
              mr4 = *(const LAS f32x4*)(Mm + 2596);
              __builtin_amdgcn_sched_barrier(0);
              a0 -= mr5[0] * X[28]; a1 -= mr5[1] * X[29]; a2 -= mr5[2] * X[30]; a3 -= mr5[3] * X[31];
              mr5 = *(const LAS f32x4*)(Mm + 2600);
              __builtin_amdgcn_sched_barrier(0);
              a0 -= mr6[0] * X[32]; a1 -= mr6[1] * X[33]; a2 -= mr6[2] * X[34]; a3 -= mr6[3] * X[35];
              mr6 = *(const LAS f32x4*)(Mm + 2604);
              __builtin_amdgcn_sched_barrier(0);
              a0 -= mr0[0] * X[36];
              X[37] = (a0 + a1) + (a2 + a3); dst[4884] = X[37]; }
            __builtin_amdgcn_sched_barrier(0);
            rh1 = src[5280] * cf[40];
            { float a0 = rh2, a1 = 0.f, a2 = 0.f, a3 = 0.f;
              mr0 = *(const LAS f32x4*)(Mm + 2608);
              __builtin_amdgcn_sched_barrier(0);
              a0 -= mr1[0] * X[0]; a1 -= mr1[1] * X[1]; a2 -= mr1[2] * X[2]; a3 -= mr1[3] * X[3];
              mr1 = *(const LAS f32x4*)(Mm + 2612);
              __builtin_amdgcn_sched_barrier(0);
              a0 -= mr2[0] * X[4]; a1 -= mr2[1] * X[5]; a2 -= mr2[2] * X[6]; a3 -= mr2[3] * X[7];
              mr2 = *(const LAS f32x4*)(Mm + 2616);
              __builtin_amdgcn_sched_barrier(0);
              a0 -= mr3[0] * X[8]; a1 -= mr3[1] * X[9]; a2 -= mr3[2] * X[10]; a3 -= mr3[3] * X[11];
              mr3 = *(const LAS f32x4*)(Mm + 2620);
              __builtin_amdgcn_sched_barrier(0);
              a0 -= mr4[0] * X[12]; a1 -= mr4[1] * X[13]; a2 -= mr4[2] * X[14]; a3 -= mr4[3] * X[15];
              mr4 = *(const LAS f32x4*)(Mm + 2652);
              __builtin_amdgcn_sched_barrier(0);
              a0 -= mr5[0] * X[16]; a1 -= mr5[1] * X[17]; a2 -= mr5[2] * X[18]; a3 -= mr5[3] * X[19];
              mr5 = *(const LAS f32x4*)(Mm + 2656);
              __builtin_amdgcn_sched_barrier(0);
              a0 -= mr6[0] * X[20]; a1 -= mr6[1] * X[21]; a2 -= mr6[2] * X[22]; a3 -= mr6[3] * X[23];
              mr6 = *(const LAS f32x4*)(Mm + 2660);
              __builtin_amdgcn_sched_barrier(0);
              a0 -= mr0[0] * X[24]; a1 -= mr0[1] * X[25]; a2 -= mr0[2] * X[26]; a3 -= mr0[3] * X[27];
              mr0 = *(const LAS f32x4*)(Mm + 2664);
              __builtin_amdgcn_sched_barrier(0);
              a0 -= mr1[0] * X[28]; a1 -= mr1[1] * X[29]; a2 -= mr1[2] * X[30]; a3 -= mr1[3] * X[31];
              mr1 = *(const LAS f32x4*)(Mm + 2668);
              __builtin_amdgcn_sched_barrier(0);
              a0 -= mr2[0] * X[32]; a1 -= mr2[1] * X[33]; a2 -= mr2[2] * X[34]; a3 -= mr2[3] * X[35];
              mr2 = *(const LAS f32x4*)(Mm + 2672);
              __builtin_amdgcn_sched_barrier(0);
              a0 -= mr3[0] * X[36]; a1 -= mr3[1] * X[37];
              X[38] = (a0 + a1) + (a2 + a3); dst[5016] = X[38]; }
            __builtin_amdgcn_sched_barrier(0);
            rh2 = src[5412] * cf[41];
            { float a0 = rh0, a1 = 0.f, a2 = 0.f, a3 = 0.f;
              mr3 = *(const LAS f32x4*)(Mm + 2676);
              __builtin_amdgcn_sched_barrier(0);
              a0 -= mr4[0] * X[0]; a1 -= mr4[1] * X[1]; a2 -= mr4[2] * X[2]; a3 -= mr4[3] * X[3];
              mr4 = *(const LAS f32x4*)(Mm + 2680);
              __builtin_amdgcn_sched_barrier(0);
              a0 -= mr5[0] * X[4]; a1 -= mr5[1] * X[5]; a2 -= mr5[2] * X[6]; a3 -= mr5[3] * X[7];
              mr5 = *(const LAS f32x4*)(Mm + 2684);
              __builtin_amdgcn_sched_barrier(0);
              a0 -= mr6[0] * X[8]; a1 -= mr6[1] * X[9]; a2 -= mr6[2] * X[10]; a3 -= mr6[3] * X[11];
              mr6 = *(const LAS f32x4*)(Mm + 2688);
              __builtin_amdgcn_sched_barrier(0);
              a0 -= mr0[0] * X[12]; a1 -= mr0[1] * X[13]; a2 -= mr0[2] * X[14]; a3 -= mr0[3] * X[15];
              mr0 = *(const LAS f32x4*)(Mm + 2720);
              __builtin_amdgcn_sched_barrier(0);
              a0 -= mr1[0] * X[16]; a1 -= mr1[1] * X[17]; a2 -= mr1[2] * X[18]; a3 -= mr1[3] * X[19];
              mr1 = *(const LAS f32x4*)(Mm + 2724);
              __builtin_amdgcn_sched_barrier(0);
              a0 -= mr2[0] * X[20]; a1 -= mr2[1] * X[21]; a2 -= mr2[2] * X[22]; a3 -= mr2[3] * X[23];
              mr2 = *(const LAS f32x4*)(Mm + 2728);
              __builtin_amdgcn_sched_barrier(0);
              a0 -= mr3[0] * X[24]; a1 -= mr3[1] * X[25]; a2 -= mr3[2] * X[26]; a3 -= mr3[3] * X[27];
              mr3 = *(const LAS f32x4*)(Mm + 2732);
              __builtin_amdgcn_sched_barrier(0);
              a0 -= mr4[0] * X[28]; a1 -= mr4[1] * X[29]; a2 -= mr4[2] * X[30]; a3 -= mr4[3] * X[31];
              mr4 = *(const LAS f32x4*)(Mm + 2736);
              __builtin_amdgcn_sched_barrier(0);
              a0 -= mr5[0] * X[32]; a1 -= mr5[1] * X[33]; a2 -= mr5[2] * X[34]; a3 -= mr5[3] * X[35];
              mr5 = *(const LAS f32x4*)(Mm + 2740);
              __builtin_amdgcn_sched_barrier(0);
              a0 -= mr6[0] * X[36]; a1 -= mr6[1] * X[37]; a2 -= mr6[2] * X[38];
              X[39] = (a0 + a1) + (a2 + a3); dst[5148] = X[39]; }
            __builtin_amdgcn_sched_barrier(0);
            rh0 = src[5544] * cf[42];
            { float a0 = rh1, a1 = 0.f, a2 = 0.f, a3 = 0.f;
              mr6 = *(const LAS f32x4*)(Mm + 2744);
              __builtin_amdgcn_sched_barrier(0);
              a0 -= mr0[0] * X[0]; a1 -= mr0[1] * X[1]; a2 -= mr0[2] * X[2]; a3 -= mr0[3] * X[3];
              mr0 = *(const LAS f32x4*)(Mm + 2748);
              __builtin_amdgcn_sched_barrier(0);
              a0 -= mr1[0] * X[4]; a1 -= mr1[1] * X[5]; a2 -= mr1[2] * X[6]; a3 -= mr1[3] * X[7];
              mr1 = *(const LAS f32x4*)(Mm + 2752);
              __builtin_amdgcn_sched_barrier(0);
              a0 -= mr2[0] * X[8]; a1 -= mr2[1] * X[9]; a2 -= mr2[2] * X[10]; a3 -= mr2[3] * X[11];
              mr2 = *(const LAS f32x4*)(Mm + 2756);
              __builtin_amdgcn_sched_barrier(0);
              a0 -= mr3[0] * X[12]; a1 -= mr3[1] * X[13]; a2 -= mr3[2] * X[14]; a3 -= mr3[3] * X[15];
              mr3 = *(const LAS f32x4*)(Mm + 2788);
              __builtin_amdgcn_sched_barrier(0);
              a0 -= mr4[0] * X[16]; a1 -= mr4[1] * X[17]; a2 -= mr4[2] * X[18]; a3 -= mr4[3] * X[19];
              mr4 = *(const LAS f32x4*)(Mm + 2792);
              __builtin_amdgcn_sched_barrier(0);
              a0 -= mr5[0] * X[20]; a1 -= mr5[1] * X[21]; a2 -= mr5[2] * X[22]; a3 -= mr5[3] * X[23];
              mr5 = *(const LAS f32x4*)(Mm + 2796);
              __builtin_amdgcn_sched_barrier(0);
              a0 -= mr6[0] * X[24]; a1 -= mr6[1] * X[25]; a2 -= mr6[2] * X[26]; a3 -= mr6[3] * X[27];
              mr6 = *(const LAS f32x4*)(Mm + 2800);
              __builtin_amdgcn_sched_barrier(0);
              a0 -= mr0[0] * X[28]; a1 -= mr0[1] * X[29]; a2 -= mr0[2] * X[30]; a3 -= mr0[3] * X[31];
              mr0 = *(const LAS f32x4*)(Mm + 2804);
              __builtin_amdgcn_sched_barrier(0);
              a0 -= mr1[0] * X[32]; a1 -= mr1[1] * X[33]; a2 -= mr1[2] * X[34]; a3 -= mr1[3] * X[35];
              mr1 = *(const LAS f32x4*)(Mm + 2808);
              __builtin_amdgcn_sched_barrier(0);
              a0 -= mr2[0] * X[36]; a1 -= mr2[1] * X[37]; a2 -= mr2[2] * X[38]; a3 -= mr2[3] * X[39];
              X[40] = (a0 + a1) + (a2 + a3); dst[5280] = X[40]; }
            __builtin_amdgcn_sched_barrier(0);
            rh1 = src[5676] * cf[43];
            { float a0 = rh2, a1 = 0.f, a2 = 0.f, a3 = 0.f;
              mr2 = *(const LAS f32x4*)(Mm + 2812);
              __builtin_amdgcn_sched_barrier(0);
              a0 -= mr3[0] * X[0]; a1 -= mr3[1] * X[1]; a2 -= mr3[2] * X[2]; a3 -= mr3[3] * X[3];
              mr3 = *(const LAS f32x4*)(Mm + 2816);
              __builtin_amdgcn_sched_barrier(0);
              a0 -= mr4[0] * X[4]; a1 -= mr4[1] * X[5]; a2 -= mr4[2] * X[6]; a3 -= mr4[3] * X[7];
              mr4 = *(const LAS f32x4*)(Mm + 2820);
              __builtin_amdgcn_sched_barrier(0);
              a0 -= mr5[0] * X[8]; a1 -= mr5[1] * X[9]; a2 -= mr5[2] * X[10]; a3 -= mr5[3] * X[11];
              mr5 = *(const LAS f32x4*)(Mm + 2824);
              __builtin_amdgcn_sched_barrier(0);
              a0 -= mr6[0] * X[12]; a1 -= mr6[1] * X[13]; a2 -= mr6[2] * X[14]; a3 -= mr6[3] * X[15];
              mr6 = *(const LAS f32x4*)(Mm + 2828);
              __builtin_amdgcn_sched_barrier(0);
              a0 -= mr0[0] * X[16]; a1 -= mr0[1] * X[17]; a2 -= mr0[2] * X[18]; a3 -= mr0[3] * X[19];
              mr0 = *(const LAS f32x4*)(Mm + 2856);
              __builtin_amdgcn_sched_barrier(0);
              a0 -= mr1[0] * X[20]; a1 -= mr1[1] * X[21]; a2 -= mr1[2] * X[22]; a3 -= mr1[3] * X[23];
              mr1 = *(const LAS f32x4*)(Mm + 2860);
              __builtin_amdgcn_sched_barrier(0);
              a0 -= mr2[0] * X[24]; a1 -= mr2[1] * X[25]; a2 -= mr2[2] * X[26]; a3 -= mr2[3] * X[27];
              mr2 = *(const LAS f32x4*)(Mm + 2864);
              __builtin_amdgcn_sched_barrier(0);
              a0 -= mr3[0] * X[28]; a1 -= mr3[1] * X[29]; a2 -= mr3[2] * X[30]; a3 -= mr3[3] * X[31];
              mr3 = *(const LAS f32x4*)(Mm + 2868);
              __builtin_amdgcn_sched_barrier(0);
              a0 -= mr4[0] * X[32]; a1 -= mr4[1] * X[33]; a2 -= mr4[2] * X[34]; a3 -= mr4[3] * X[35];
              mr4 = *(const LAS f32x4*)(Mm + 2872);
              __builtin_amdgcn_sched_barrier(0);
              a0 -= mr5[0] * X[36]; a1 -= mr5[1] * X[37]; a2 -= mr5[2] * X[38]; a3 -= mr5[3] * X[39];
              mr5 = *(const LAS f32x4*)(Mm + 2876);
              __builtin_amdgcn_sched_barrier(0);
              a0 -= mr6[0] * X[40];
              X[41] = (a0 + a1) + (a2 + a3); dst[5412] = X[41]; }
            __builtin_amdgcn_sched_barrier(0);
            rh2 = src[5808] * cf[44];
            { float a0 = rh0, a1 = 0.f, a2 = 0.f, a3 = 0.f;
              mr6 = *(const LAS f32x4*)(Mm + 2880);
              __builtin_amdgcn_sched_barrier(0);
              a0 -= mr0[0] * X[0]; a1 -= mr0[1] * X[1]; a2 -= mr0[2] * X[2]; a3 -= mr0[3] * X[3];
              mr0 = *(const LAS f32x4*)(Mm + 2884);
              __builtin_amdgcn_sched_barrier(0);
              a0 -= mr1[0] * X[4]; a1 -= mr1[1] * X[5]; a2 -= mr1[2] * X[6]; a3 -= mr1[3] * X[7];
              mr1 = *(const LAS f32x4*)(Mm + 2888);
              __builtin_amdgcn_sched_barrier(0);
              a0 -= mr2[0] * X[8]; a1 -= mr2[1] * X[9]; a2 -= mr2[2] * X[10]; a3 -= mr2[3] * X[11];
              mr2 = *(const LAS f32x4*)(Mm + 2892);
              __builtin_amdgcn_sched_barrier(0);
              a0 -= mr3[0] * X[12]; a1 -= mr3[1] * X[13]; a2 -= mr3[2] * X[14]; a3 -= mr3[3] * X[15];
              mr3 = *(const LAS f32x4*)(Mm + 2896);
              __builtin_amdgcn_sched_barrier(0);
              a0 -= mr4[0] * X[16]; a1 -= mr4[1] * X[17]; a2 -= mr4[2] * X[18]; a3 -= mr4[3] * X[19];
              mr4 = *(const LAS f32x4*)(Mm + 2924);
              __builtin_amdgcn_sched_barrier(0);
              a0 -= mr5[0] * X[20]; a1 -= mr5[1] * X[21]; a2 -= mr5[2] * X[22]; a3 -= mr5[3] * X[23];
              mr5 = *(const LAS f32x4*)(Mm + 2928);
              __builtin_amdgcn_sched_barrier(0);
              a0 -= mr6[0] * X[24]; a1 -= mr6[1] * X[25]; a2 -= mr6[2] * X[26]; a3 -= mr6[3] * X[27];
              mr6 = *(const LAS f32x4*)(Mm + 2932);
              __builtin_amdgcn_sched_barrier(0);
              a0 -= mr0[0] * X[28]; a1 -= mr0[1] * X[29]; a2 -= mr0[2] * X[30]; a3 -= mr0[3] * X[31];
              mr0 = *(const LAS f32x4*)(Mm + 2936);
              __builtin_amdgcn_sched_barrier(0);
              a0 -= mr1[0] * X[32]; a1 -= mr1[1] * X[33]; a2 -= mr1[2] * X[34]; a3 -= mr1[3] * X[35];
              mr1 = *(const LAS f32x4*)(Mm + 2940);
              __builtin_amdgcn_sched_barrier(0);
              a0 -= mr2[0] * X[36]; a1 -= mr2[1] * X[37]; a2 -= mr2[2] * X[38]; a3 -= mr2[3] * X[39];
              mr2 = *(const LAS f32x4*)(Mm + 2944);
              __builtin_amdgcn_sched_barrier(0);
              a0 -= mr3[0] * X[40]; a1 -= mr3[1] * X[41];
              X[42] = (a0 + a1) + (a2 + a3); dst[5544] = X[42]; }
            __builtin_amdgcn_sched_barrier(0);
            rh0 = src[5940] * cf[45];
            { float a0 = rh1, a1 = 0.f, a2 = 0.f, a3 = 0.f;
              mr3 = *(const LAS f32x4*)(Mm + 2948);
              __builtin_amdgcn_sched_barrier(0);
              a0 -= mr4[0] * X[0]; a1 -= mr4[1] * X[1]; a2 -= mr4[2] * X[2]; a3 -= mr4[3] * X[3];
              mr4 = *(const LAS f32x4*)(Mm + 2952);
              __builtin_amdgcn_sched_barrier(0);
              a0 -= mr5[0] * X[4]; a1 -= mr5[1] * X[5]; a2 -= mr5[2] * X[6]; a3 -= mr5[3] * X[7];
              mr5 = *(const LAS f32x4*)(Mm + 2956);
              __builtin_amdgcn_sched_barrier(0);
              a0 -= mr6[0] * X[8]; a1 -= mr6[1] * X[9]; a2 -= mr6[2] * X[10]; a3 -= mr6[3] * X[11];
              mr6 = *(const LAS f32x4*)(Mm + 2960);
              __builtin_amdgcn_sched_barrier(0);
              a0 -= mr0[0] * X[12]; a1 -= mr0[1] * X[13]; a2 -= mr0[2] * X[14]; a3 -= mr0[3] * X[15];
              mr0 = *(const LAS f32x4*)(Mm + 2964);
              __builtin_amdgcn_sched_barrier(0);
              a0 -= mr1[0] * X[16]; a1 -= mr1[1] * X[17]; a2 -= mr1[2] * X[18]; a3 -= mr1[3] * X[19];
              mr1 = *(const LAS f32x4*)(Mm + 2992);
              __builtin_amdgcn_sched_barrier(0);
              a0 -= mr2[0] * X[20]; a1 -= mr2[1] * X[21]; a2 -= mr2[2] * X[22]; a3 -= mr2[3] * X[23];
              mr2 = *(const LAS f32x4*)(Mm + 2996);
              __builtin_amdgcn_sched_barrier(0);
              a0 -= mr3[0] * X[24]; a1 -= mr3[1] * X[25]; a2 -= mr3[2] * X[26]; a3 -= mr3[3] * X[27];
              mr3 = *(const LAS f32x4*)(Mm + 3000);
              __builtin_amdgcn_sched_barrier(0);
              a0 -= mr4[0] * X[28]; a1 -= mr4[1] * X[29]; a2 -= mr4[2] * X[30]; a3 -= mr4[3] * X[31];
              mr4 = *(const LAS f32x4*)(Mm + 3004);
              __builtin_amdgcn_sched_barrier(0);
              a0 -= mr5[0] * X[32]; a1 -= mr5[1] * X[33]; a2 -= mr5[2] * X[34]; a3 -= mr5[3] * X[35];
              mr5 = *(const LAS f32x4*)(Mm + 3008);
              __builtin_amdgcn_sched_barrier(0);
              a0 -= mr6[0] * X[36]; a1 -= mr6[1] * X[37]; a2 -= mr6[2] * X[38]; a3 -= mr6[3] * X[39];
              mr6 = *(const LAS f32x4*)(Mm + 3012);
              __builtin_amdgcn_sched_barrier(0);
              a0 -= mr0[0] * X[40]; a1 -= mr0[1] * X[41]; a2 -= mr0[2] * X[42];
              X[43] = (a0 + a1) + (a2 + a3); dst[5676] = X[43]; }
            __builtin_amdgcn_sched_barrier(0);
            rh1 = src[6072] * cf[46];
            { float a0 = rh2, a1 = 0.f, a2 = 0.f, a3 = 0.f;
              mr0 = *(const LAS f32x4*)(Mm + 3016);
              __builtin_amdgcn_sched_barrier(0);
              a0 -= mr1[0] * X[0]; a1 -= mr1[1] * X[1]; a2 -= mr1[2] * X[2]; a3 -= mr1[3] * X[3];
              mr1 = *(const LAS f32x4*)(Mm + 3020);
              __builtin_amdgcn_sched_barrier(0);
              a0 -= mr2[0] * X[4]; a1 -= mr2[1] * X[5]; a2 -= mr2[2] * X[6]; a3 -= mr2[3] * X[7];
              mr2 = *(const LAS f32x4*)(Mm + 3024);
              __builtin_amdgcn_sched_barrier(0);
              a0 -= mr3[0] * X[8]; a1 -= mr3[1] * X[9]; a2 -= mr3[2] * X[10]; a3 -= mr3[3] * X[11];
              mr3 = *(const LAS f32x4*)(Mm + 3028);
              __builtin_amdgcn_sched_barrier(0);
              a0 -= mr4[0] * X[12]; a1 -= mr4[1] * X[13]; a2 -= mr4[2] * X[14]; a3 -= mr4[3] * X[15];
              mr4 = *(const LAS f32x4*)(Mm + 3032);
              __builtin_amdgcn_sched_barrier(0);
              a0 -= mr5[0] * X[16]; a1 -= mr5[1] * X[17]; a2 -= mr5[2] * X[18]; a3 -= mr5[3] * X[19];
              mr5 = *(const LAS f32x4*)(Mm + 3060);
              __builtin_amdgcn_sched_barrier(0);
              a0 -= mr6[0] * X[20]; a1 -= mr6[1] * X[21]; a2 -= mr6[2] * X[22]; a3 -= mr6[3] * X[23];
              mr6 = *(const LAS f32x4*)(Mm + 3064);
              __builtin_amdgcn_sched_barrier(0);
              a0 -= mr0[0] * X[24]; a1 -= mr0[1] * X[25]; a2 -= mr0[2] * X[26]; a3 -= mr0[3] * X[27];
              mr0 = *(const LAS f32x4*)(Mm + 3068);
              __builtin_amdgcn_sched_barrier(0);
              a0 -= mr1[0] * X[28]; a1 -= mr1[1] * X[29]; a2 -= mr1[2] * X[30]; a3 -= mr1[3] * X[31];
              mr1 = *(const LAS f32x4*)(Mm + 3072);
              __builtin_amdgcn_sched_barrier(0);
              a0 -= mr2[0] * X[32]; a1 -= mr2[1] * X[33]; a2 -= mr2[2] * X[34]; a3 -= mr2[3] * X[35];
              mr2 = *(const LAS f32x4*)(Mm + 3076);
              __builtin_amdgcn_sched_barrier(0);
              a0 -= mr3[0] * X[36]; a1 -= mr3[1] * X[37]; a2 -= mr3[2] * X[38]; a3 -= mr3[3] * X[39];
              mr3 = *(const LAS f32x4*)(Mm + 3080);
              __builtin_amdgcn_sched_barrier(0);
              a0 -= mr4[0] * X[40]; a1 -= mr4[1] * X[41]; a2 -= mr4[2] * X[42]; a3 -= mr4[3] * X[43];
              X[44] = (a0 + a1) + (a2 + a3); dst[5808] = X[44]; }
            __builtin_amdgcn_sched_barrier(0);
            rh2 = src[6204] * cf[47];
            { float a0 = rh0, a1 = 0.f, a2 = 0.f, a3 = 0.f;
              mr4 = *(const LAS f32x4*)(Mm + 3084);
              __builtin_amdgcn_sched_barrier(0);
              a0 -= mr5[0] * X[0]; a1 -= mr5[1] * X[1]; a2 -= mr5[2] * X[2]; a3 -= mr5[3] * X[3];
              mr5 = *(const LAS f32x4*)(Mm + 3088);
              __builtin_amdgcn_sched_barrier(0);
              a0 -= mr6[0] * X[4]; a1 -= mr6[1] * X[5]; a2 -= mr6[2] * X[6]; a3 -= mr6[3] * X[7];
              mr6 = *(const LAS f32x4*)(Mm + 3092);
              __builtin_amdgcn_sched_barrier(0);
              a0 -= mr0[0] * X[8]; a1 -= mr0[1] * X[9]; a2 -= mr0[2] * X[10]; a3 -= mr0[3] * X[11];
              mr0 = *(const LAS f32x4*)(Mm + 3096);
              __builtin_amdgcn_sched_barrier(0);
              a0 -= mr1[0] * X[12]; a1 -= mr1[1] * X[13]; a2 -= mr1[2] * X[14]; a3 -= mr1[3] * X[15];
              mr1 = *(const LAS f32x4*)(Mm + 3100);
              __builtin_amdgcn_sched_barrier(0);
              a0 -= mr2[0] * X[16]; a1 -= mr2[1] * X[17]; a2 -= mr2[2] * X[18]; a3 -= mr2[3] * X[19];
              mr2 = *(const LAS f32x4*)(Mm + 3104);
              __builtin_amdgcn_sched_barrier(0);
              a0 -= mr3[0] * X[20]; a1 -= mr3[1] * X[21]; a2 -= mr3[2] * X[22]; a3 -= mr3[3] * X[23];
              mr3 = *(const LAS f32x4*)(Mm + 3128);
              __builtin_amdgcn_sched_barrier(0);
              a0 -= mr4[0] * X[24]; a1 -= mr4[1] * X[25]; a2 -= mr4[2] * X[26]; a3 -= mr4[3] * X[27];
              mr4 = *(const LAS f32x4*)(Mm + 3132);
              __builtin_amdgcn_sched_barrier(0);
              a0 -= mr5[0] * X[28]; a1 -= mr5[1] * X[29]; a2 -= mr5[2] * X[30]; a3 -= mr5[3] * X[31];
              mr5 = *(const LAS f32x4*)(Mm + 3136);
              __builtin_amdgcn_sched_barrier(0);
              a0 -= mr6[0] * X[32]; a1 -= mr6[1] * X[33]; a2 -= mr6[2] * X[34]; a3 -= mr6[3] * X[35];
              mr6 = *(const LAS f32x4*)(Mm + 3140);
              __builtin_amdgcn_sched_barrier(0);
              a0 -= mr0[0] * X[36]; a1 -= mr0[1] * X[37]; a2 -= mr0[2] * X[38]; a3 -= mr0[3] * X[39];
              mr0 = *(const LAS f32x4*)(Mm + 3144);
              __builtin_amdgcn_sched_barrier(0);
              a0 -= mr1[0] * X[40]; a1 -= mr1[1] * X[41]; a2 -= mr1[2] * X[42]; a3 -= mr1[3] * X[43];
              mr1 = *(const LAS f32x4*)(Mm + 3148);
              __builtin_amdgcn_sched_barrier(0);
              a0 -= mr2[0] * X[44];
              X[45] = (a0 + a1) + (a2 + a3); dst[5940] = X[45]; }
            __builtin_amdgcn_sched_barrier(0);
            rh0 = src[6336] * cf[48];
            { float a0 = rh1, a1 = 0.f, a2 = 0.f, a3 = 0.f;
              mr2 = *(const LAS f32x4*)(Mm + 3152);
              __builtin_amdgcn_sched_barrier(0);
              a0 -= mr3[0] * X[0]; a1 -= mr3[1] * X[1]; a2 -= mr3[2] * X[2]; a3 -= mr3[3] * X[3];
              mr3 = *(const LAS f32x4*)(Mm + 3156);
              __builtin_amdgcn_sched_barrier(0);
              a0 -= mr4[0] * X[4]; a1 -= mr4[1] * X[5]; a2 -= mr4[2] * X[6]; a3 -= mr4[3] * X[7];
              mr4 = *(const LAS f32x4*)(Mm + 3160);
              __builtin_amdgcn_sched_barrier(0);
              a0 -= mr5[0] * X[8]; a1 -= mr5[1] * X[9]; a2 -= mr5[2] * X[10]; a3 -= mr5[3] * X[11];
              mr5 = *(const LAS f32x4*)(Mm + 3164);
              __builtin_amdgcn_sched_barrier(0);
              a0 -= mr6[0] * X[12]; a1 -= mr6[1] * X[13]; a2 -= mr6[2] * X[14]; a3 -= mr6[3] * X[15];
              mr6 = *(const LAS f32x4*)(Mm + 3168);
              __builtin_amdgcn_sched_barrier(0);
              a0 -= mr0[0] * X[16]; a1 -= mr0[1] * X[17]; a2 -= mr0[2] * X[18]; a3 -= mr0[3] * X[19];
              mr0 = *(const LAS f32x4*)(Mm + 3172);
              __builtin_amdgcn_sched_barrier(0);
              a0 -= mr1[0] * X[20]; a1 -= mr1[1] * X[21]; a2 -= mr1[2] * X[22]; a3 -= mr1[3] * X[23];
              mr1 = *(const LAS f32x4*)(Mm + 3196);
              __builtin_amdgcn_sched_barrier(0);
              a0 -= mr2[0] * X[24]; a1 -= mr2[1] * X[25]; a2 -= mr2[2] * X[26]; a3 -= mr2[3] * X[27];
              mr2 = *(const LAS f32x4*)(Mm + 3200);
              __builtin_amdgcn_sched_barrier(0);
              a0 -= mr3[0] * X[28]; a1 -= mr3[1] * X[29]; a2 -= mr3[2] * X[30]; a3 -= mr3[3] * X[31];
              mr3 = *(const LAS f32x4*)(Mm + 3204);
              __builtin_amdgcn_sched_barrier(0);
              a0 -= mr4[0] * X[32]; a1 -= mr4[1] * X[33]; a2 -= mr4[2] * X[34]; a3 -= mr4[3] * X[35];
              mr4 = *(const LAS f32x4*)(Mm + 3208);
              __builtin_amdgcn_sched_barrier(0);
              a0 -= mr5[0] * X[36]; a1 -= mr5[1] * X[37]; a2 -= mr5[2] * X[38]; a3 -= mr5[3] * X[39];
              mr5 = *(const LAS f32x4*)(Mm + 3212);
              __builtin_amdgcn_sched_barrier(0);
              a0 -= mr6[0] * X[40]; a1 -= mr6[1] * X[41]; a2 -= mr6[2] * X[42]; a3 -= mr6[3] * X[43];
              mr6 = *(const LAS f32x4*)(Mm + 3216);
              __builtin_amdgcn_sched_barrier(0);
              a0 -= mr0[0] * X[44]; a1 -= mr0[1] * X[45];
              X[46] = (a0 + a1) + (a2 + a3); dst[6072] = X[46]; }
            __builtin_amdgcn_sched_barrier(0);
            rh1 = src[6468] * cf[49];
            { float a0 = rh2, a1 = 0.f, a2 = 0.f, a3 = 0.f;
              mr0 = *(const LAS f32x4*)(Mm + 3220);
              __builtin_amdgcn_sched_barrier(0);
              a0 -= mr1[0] * X[0]; a1 -= mr1[1] * X[1]; a2 -= mr1[2] * X[2]; a3 -= mr1[3] * X[3];
              mr1 = *(const LAS f32x4*)(Mm + 3224);
              __builtin_amdgcn_sched_barrier(0);
              a0 -= mr2[0] * X[4]; a1 -= mr2[1] * X[5]; a2 -= mr2[2] * X[6]; a3 -= mr2[3] * X[7];
              mr2 = *(const LAS f32x4*)(Mm + 3228);
              __builtin_amdgcn_sched_barrier(0);
              a0 -= mr3[0] * X[8]; a1 -= mr3[1] * X[9]; a2 -= mr3[2] * X[10]; a3 -= mr3[3] * X[11];
              mr3 = *(const LAS f32x4*)(Mm + 3232);
              __builtin_amdgcn_sched_barrier(0);
              a0 -= mr4[0] * X[12]; a1 -= mr4[1] * X[13]; a2 -= mr4[2] * X[14]; a3 -= mr4[3] * X[15];
              mr4 = *(const LAS f32x4*)(Mm + 3236);
              __builtin_amdgcn_sched_barrier(0);
              a0 -= mr5[0] * X[16]; a1 -= mr5[1] * X[17]; a2 -= mr5[2] * X[18]; a3 -= mr5[3] * X[19];
              mr5 = *(const LAS f32x4*)(Mm + 3240);
              __builtin_amdgcn_sched_barrier(0);
              a0 -= mr6[0] * X[20]; a1 -= mr6[1] * X[21]; a2 -= mr6[2] * X[22]; a3 -= mr6[3] * X[23];
              mr6 = *(const LAS f32x4*)(Mm + 3264);
              __builtin_amdgcn_sched_barrier(0);
              a0 -= mr0[0] * X[24]; a1 -= mr0[1] * X[25]; a2 -= mr0[2] * X[26]; a3 -= mr0[3] * X[27];
              mr0 = *(const LAS f32x4*)(Mm + 3268);
              __builtin_amdgcn_sched_barrier(0);
              a0 -= mr1[0] * X[28]; a1 -= mr1[1] * X[29]; a2 -= mr1[2] * X[30]; a3 -= mr1[3] * X[31];
              mr1 = *(const LAS f32x4*)(Mm + 3272);
              __builtin_amdgcn_sched_barrier(0);
              a0 -= mr2[0] * X[32]; a1 -= mr2[1] * X[33]; a2 -= mr2[2] * X[34]; a3 -= mr2[3] * X[35];
              mr2 = *(const LAS f32x4*)(Mm + 3276);
              __builtin_amdgcn_sched_barrier(0);
              a0 -= mr3[0] * X[36]; a1 -= mr3[1] * X[37]; a2 -= mr3[2] * X[38]; a3 -= mr3[3] * X[39];
              mr3 = *(const LAS f32x4*)(Mm + 3280);
              __builtin_amdgcn_sched_barrier(0);
              a0 -= mr4[0] * X[40]; a1 -= mr4[1] * X[41]; a2 -= mr4[2] * X[42]; a3 -= mr4[3] * X[43];
              mr4 = *(const LAS f32x4*)(Mm + 3284);
              __builtin_amdgcn_sched_barrier(0);
              a0 -= mr5[0] * X[44]; a1 -= mr5[1] * X[45]; a2 -= mr5[2] * X[46];
              X[47] = (a0 + a1) + (a2 + a3); dst[6204] = X[47]; }
            __builtin_amdgcn_sched_barrier(0);
            rh2 = src[6600] * cf[50];
            { float a0 = rh0, a1 = 0.f, a2 = 0.f, a3 = 0.f;
              mr5 = *(const LAS f32x4*)(Mm + 3288);
              __builtin_amdgcn_sched_barrier(0);
              a0 -= mr6[0] * X[0]; a1 -= mr6[1] * X[1]; a2 -= mr6[2] * X[2]; a3 -= mr6[3] * X[3];
              mr6 = *(const LAS f32x4*)(Mm + 3292);
              __builtin_amdgcn_sched_barrier(0);
              a0 -= mr0[0] * X[4]; a1 -= mr0[1] * X[5]; a2 -= mr0[2] * X[6]; a3 -= mr0[3] * X[7];
              mr0 = *(const LAS f32x4*)(Mm + 3296);
              __builtin_amdgcn_sched_barrier(0);
              a0 -= mr1[0] * X[8]; a1 -= mr1[1] * X[9]; a2 -= mr1[2] * X[10]; a3 -= mr1[3] * X[11];
              mr1 = *(const LAS f32x4*)(Mm + 3300);
              __builtin_amdgcn_sched_barrier(0);
              a0 -= mr2[0] * X[12]; a1 -= mr2[1] * X[13]; a2 -= mr2[2] * X[14]; a3 -= mr2[3] * X[15];
              mr2 = *(const LAS f32x4*)(Mm + 3304);
              __builtin_amdgcn_sched_barrier(0);
              a0 -= mr3[0] * X[16]; a1 -= mr3[1] * X[17]; a2 -= mr3[2] * X[18]; a3 -= mr3[3] * X[19];
              mr3 = *(const LAS f32x4*)(Mm + 3308);
              __builtin_amdgcn_sched_barrier(0);
              a0 -= mr4[0] * X[20]; a1 -= mr4[1] * X[21]; a2 -= mr4[2] * X[22]; a3 -= mr4[3] * X[23];
              mr4 = *(const LAS f32x4*)(Mm + 3332);
              __builtin_amdgcn_sched_barrier(0);
              a0 -= mr5[0] * X[24]; a1 -= mr5[1] * X[25]; a2 -= mr5[2] * X[26]; a3 -= mr5[3] * X[27];
              mr5 = *(const LAS f32x4*)(Mm + 3336);
              __builtin_amdgcn_sched_barrier(0);
              a0 -= mr6[0] * X[28]; a1 -= mr6[1] * X[29]; a2 -= mr6[2] * X[30]; a3 -= mr6[3] * X[31];
              mr6 = *(const LAS f32x4*)(Mm + 3340);
              __builtin_amdgcn_sched_barrier(0);
              a0 -= mr0[0] * X[32]; a1 -= mr0[1] * X[33]; a2 -= mr0[2] * X[34]; a3 -= mr0[3] * X[35];
              mr0 = *(const LAS f32x4*)(Mm + 3344);
              __builtin_amdgcn_sched_barrier(0);
              a0 -= mr1[0] * X[36]; a1 -= mr1[1] * X[37]; a2 -= mr1[2] * X[38]; a3 -= mr1[3] * X[39];
              mr1 = *(const LAS f32x4*)(Mm + 3348);
              __builtin_amdgcn_sched_barrier(0);
              a0 -= mr2[0] * X[40]; a1 -= mr2[1] * X[41]; a2 -= mr2[2] * X[42]; a3 -= mr2[3] * X[43];
              mr2 = *(const LAS f32x4*)(Mm + 3352);
              __builtin_amdgcn_sched_barrier(0);
              a0 -= mr3[0] * X[44]; a1 -= mr3[1] * X[45]; a2 -= mr3[2] * X[46]; a3 -= mr3[3] * X[47];
              X[48] = (a0 + a1) + (a2 + a3); dst[6336] = X[48]; }
            __builtin_amdgcn_sched_barrier(0);
            rh0 = src[6732] * cf[51];
            { float a0 = rh1, a1 = 0.f, a2 = 0.f, a3 = 0.f;
              mr3 = *(const LAS f32x4*)(Mm + 3356);
              __builtin_amdgcn_sched_barrier(0);
              a0 -= mr4[0] * X[0]; a1 -= mr4[1] * X[1]; a2 -= mr4[2] * X[2]; a3 -= mr4[3] * X[3];
              mr4 = *(const LAS f32x4*)(Mm + 3360);
              __builtin_amdgcn_sched_barrier(0);
              a0 -= mr5[0] * X[4]; a1 -= mr5[1] * X[5]; a2 -= mr5[2] * X[6]; a3 -= mr5[3] * X[7];
              mr5 = *(const LAS f32x4*)(Mm + 3364);
              __builtin_amdgcn_sched_barrier(0);
              a0 -= mr6[0] * X[8]; a1 -= mr6[1] * X[9]; a2 -= mr6[2] * X[10]; a3 -= mr6[3] * X[11];
              mr6 = *(const LAS f32x4*)(Mm + 3368);
              __builtin_amdgcn_sched_barrier(0);
              a0 -= mr0[0] * X[12]; a1 -= mr0[1] * X[13]; a2 -= mr0[2] * X[14]; a3 -= mr0[3] * X[15];
              mr0 = *(const LAS f32x4*)(Mm + 3372);
              __builtin_amdgcn_sched_barrier(0);
              a0 -= mr1[0] * X[16]; a1 -= mr1[1] * X[17]; a2 -= mr1[2] * X[18]; a3 -= mr1[3] * X[19];
              mr1 = *(const LAS f32x4*)(Mm + 3376);
              __builtin_amdgcn_sched_barrier(0);
              a0 -= mr2[0] * X[20]; a1 -= mr2[1] * X[21]; a2 -= mr2[2] * X[22]; a3 -= mr2[3] * X[23];
              mr2 = *(const LAS f32x4*)(Mm + 3380);
              __builtin_amdgcn_sched_barrier(0);
              a0 -= mr3[0] * X[24]; a1 -= mr3[1] * X[25]; a2 -= mr3[2] * X[26]; a3 -= mr3[3] * X[27];
              mr3 = *(const LAS f32x4*)(Mm + 3400);
              __builtin_amdgcn_sched_barrier(0);
              a0 -= mr4[0] * X[28]; a1 -= mr4[1] * X[29]; a2 -= mr4[2] * X[30]; a3 -= mr4[3] * X[31];
              mr4 = *(const LAS f32x4*)(Mm + 3404);
              __builtin_amdgcn_sched_barrier(0);
              a0 -= mr5[0] * X[32]; a1 -= mr5[1] * X[33]; a2 -= mr5[2] * X[34]; a3 -= mr5[3] * X[35];
              mr5 = *(const LAS f32x4*)(Mm + 3408);
              __builtin_amdgcn_sched_barrier(0);
              a0 -= mr6[0] * X[36]; a1 -= mr6[1] * X[37]; a2 -= mr6[2] * X[38]; a3 -= mr6[3] * X[39];
              mr6 = *(const LAS f32x4*)(Mm + 3412);
              __builtin_amdgcn_sched_barrier(0);
              a0 -= mr0[0] * X[40]; a1 -= mr0[1] * X[41]; a2 -= mr0[2] * X[42]; a3 -= mr0[3] * X[43];
              mr0 = *(const LAS f32x4*)(Mm + 3416);
              __builtin_amdgcn_sched_barrier(0);
              a0 -= mr1[0] * X[44]; a1 -= mr1[1] * X[45]; a2 -= mr1[2] * X[46]; a3 -= mr1[3] * X[47];
              mr1 = *(const LAS f32x4*)(Mm + 3420);
              __builtin_amdgcn_sched_barrier(0);
              a0 -= mr2[0] * X[48];
              X[49] = (a0 + a1) + (a2 + a3); dst[6468] = X[49]; }
            __builtin_amdgcn_sched_barrier(0);
            rh1 = src[6864] * cf[52];
            { float a0 = rh2, a1 = 0.f, a2 = 0.f, a3 = 0.f;
              mr2 = *(const LAS f32x4*)(Mm + 3424);
              __builtin_amdgcn_sched_barrier(0);
              a0 -= mr3[0] * X[0]; a1 -= mr3[1] * X[1]; a2 -= mr3[2] * X[2]; a3 -= mr3[3] * X[3];
              mr3 = *(const LAS f32x4*)(Mm + 3428);
              __builtin_amdgcn_sched_barrier(0);
              a0 -= mr4[0] * X[4]; a1 -= mr4[1] * X[5]; a2 -= mr4[2] * X[6]; a3 -= mr4[3] * X[7];
              mr4 = *(const LAS f32x4*)(Mm + 3432);
              __builtin_amdgcn_sched_barrier(0);
              a0 -= mr5[0] * X[8]; a1 -= mr5[1] * X[9]; a2 -= mr5[2] * X[10]; a3 -= mr5[3] * X[11];
              mr5 = *(const LAS f32x4*)(Mm + 3436);
              __builtin_amdgcn_sched_barrier(0);
              a0 -= mr6[0] * X[12]; a1 -= mr6[1] * X[13]; a2 -= mr6[2] * X[14]; a3 -= mr6[3] * X[15];
              mr6 = *(const LAS f32x4*)(Mm + 3440);
              __builtin_amdgcn_sched_barrier(0);
              a0 -= mr0[0] * X[16]; a1 -= mr0[1] * X[17]; a2 -= mr0[2] * X[18]; a3 -= mr0[3] * X[19];
              mr0 = *(const LAS f32x4*)(Mm + 3444);
              __builtin_amdgcn_sched_barrier(0);
              a0 -= mr1[0] * X[20]; a1 -= mr1[1] * X[21]; a2 -= mr1[2] * X[22]; a3 -= mr1[3] * X[23];
              mr1 = *(const LAS f32x4*)(Mm + 3448);
              __builtin_amdgcn_sched_barrier(0);
              a0 -= mr2[0] * X[24]; a1 -= mr2[1] * X[25]; a2 -= mr2[2] * X[26]; a3 -= mr2[3] * X[27];
              mr2 = *(const LAS f32x4*)(Mm + 3468);
              __builtin_amdgcn_sched_barrier(0);
              a0 -= mr3[0] * X[28]; a1 -= mr3[1] * X[29]; a2 -= mr3[2] * X[30]; a3 -= mr3[3] * X[31];
              mr3 = *(const LAS f32x4*)(Mm + 3472);
              __builtin_amdgcn_sched_barrier(0);
              a0 -= mr4[0] * X[32]; a1 -= mr4[1] * X[33]; a2 -= mr4[2] * X[34]; a3 -= mr4[3] * X[35];
              mr4 = *(const LAS f32x4*)(Mm + 3476);
              __builtin_amdgcn_sched_barrier(0);
              a0 -= mr5[0] * X[36]; a1 -= mr5[1] * X[37]; a2 -= mr5[2] * X[38]; a3 -= mr5[3] * X[39];
              mr5 = *(const LAS f32x4*)(Mm + 3480);
              __builtin_amdgcn_sched_barrier(0);
              a0 -= mr6[0] * X[40]; a1 -= mr6[1] * X[41]; a2 -= mr6[2] * X[42]; a3 -= mr6[3] * X[43];
              mr6 = *(const LAS f32x4*)(Mm + 3484);
              __builtin_amdgcn_sched_barrier(0);
              a0 -= mr0[0] * X[44]; a1 -= mr0[1] * X[45]; a2 -= mr0[2] * X[46]; a3 -= mr0[3] * X[47];
              mr0 = *(const LAS f32x4*)(Mm + 3488);
              __builtin_amdgcn_sched_barrier(0);
              a0 -= mr1[0] * X[48]; a1 -= mr1[1] * X[49];
              X[50] = (a0 + a1) + (a2 + a3); dst[6600] = X[50]; }
            __builtin_amdgcn_sched_barrier(0);
            rh2 = src[6996] * cf[53];
            { float a0 = rh0, a1 = 0.f, a2 = 0.f, a3 = 0.f;
              mr1 = *(const LAS f32x4*)(Mm + 3492);
              __builtin_amdgcn_sched_barrier(0);
              a0 -= mr2[0] * X[0]; a1 -= mr2[1] * X[1]; a2 -= mr2[2] * X[2]; a3 -= mr2[3] * X[3];
              mr2 = *(const LAS f32x4*)(Mm + 3496);
              __builtin_amdgcn_sched_barrier(0);
              a0 -= mr3[0] * X[4]; a1 -= mr3[1] * X[5]; a2 -= mr3[2] * X[6]; a3 -= mr3[3] * X[7];
              mr3 = *(const LAS f32x4*)(Mm + 3500);
              __builtin_amdgcn_sched_barrier(0);
              a0 -= mr4[0] * X[8]; a1 -= mr4[1] * X[9]; a2 -= mr4[2] * X[10]; a3 -= mr4[3] * X[11];
              mr4 = *(const LAS f32x4*)(Mm + 3504);
              __builtin_amdgcn_sched_barrier(0);
              a0 -= mr5[0] * X[12]; a1 -= mr5[1] * X[13]; a2 -= mr5[2] * X[14]; a3 -= mr5[3] * X[15];
              mr5 = *(const LAS f32x4*)(Mm + 3508);
              __builtin_amdgcn_sched_barrier(0);
              a0 -= mr6[0] * X[16]; a1 -= mr6[1] * X[17]; a2 -= mr6[2] * X[18]; a3 -= mr6[3] * X[19];
              mr6 = *(const LAS f32x4*)(Mm + 3512);
              __builtin_amdgcn_sched_barrier(0);
              a0 -= mr0[0] * X[20]; a1 -= mr0[1] * X[21]; a2 -= mr0[2] * X[22]; a3 -= mr0[3] * X[23];
              mr0 = *(const LAS f32x4*)(Mm + 3516);
              __builtin_amdgcn_sched_barrier(0);
              a0 -= mr1[0] * X[24]; a1 -= mr1[1] * X[25]; a2 -= mr1[2] * X[26]; a3 -= mr1[3] * X[27];
              mr1 = *(const LAS f32x4*)(Mm + 3536);
              __builtin_amdgcn_sched_barrier(0);
              a0 -= mr2[0] * X[28]; a1 -= mr2[1] * X[29]; a2 -= mr2[2] * X[30]; a3 -= mr2[3] * X[31];
              mr2 = *(const LAS f32x4*)(Mm + 3540);
              __builtin_amdgcn_sched_barrier(0);
              a0 -= mr3[0] * X[32]; a1 -= mr3[1] * X[33]; a2 -= mr3[2] * X[34]; a3 -= mr3[3] * X[35];
              mr3 = *(const LAS f32x4*)(Mm + 3544);
              __builtin_amdgcn_sched_barrier(0);
              a0 -= mr4[0] * X[36]; a1 -= mr4[1] * X[37]; a2 -= mr4[2] * X[38]; a3 -= mr4[3] * X[39];
              mr4 = *(const LAS f32x4*)(Mm + 3548);
              __builtin_amdgcn_sched_barrier(0);
              a0 -= mr5[0] * X[40]; a1 -= mr5[1] * X[41]; a2 -= mr5[2] * X[42]; a3 -= mr5[3] * X[43];
              mr5 = *(const LAS f32x4*)(Mm + 3552);
              __builtin_amdgcn_sched_barrier(0);
              a0 -= mr6[0] * X[44]; a1 -= mr6[1] * X[45]; a2 -= mr6[2] * X[46]; a3 -= mr6[3] * X[47];
              mr6 = *(const LAS f32x4*)(Mm + 3556);
              __builtin_amdgcn_sched_barrier(0);
              a0 -= mr0[0] * X[48]; a1 -= mr0[1] * X[49]; a2 -= mr0[2] * X[50];
              X[51] = (a0 + a1) + (a2 + a3); dst[6732] = X[51]; }
            __builtin_amdgcn_sched_barrier(0);
            rh0 = src[7128] * cf[54];
            { float a0 = rh1, a1 = 0.f, a2 = 0.f, a3 = 0.f;
              mr0 = *(const LAS f32x4*)(Mm + 3560);
              __builtin_amdgcn_sched_barrier(0);
              a0 -= mr1[0] * X[0]; a1 -= mr1[1] * X[1]; a2 -= mr1[2] * X[2]; a3 -= mr1[3] * X[3];
              mr1 = *(const LAS f32x4*)(Mm + 3564);
              __builtin_amdgcn_sched_barrier(0);
              a0 -= mr2[0] * X[4]; a1 -= mr2[1] * X[5]; a2 -= mr2[2] * X[6]; a3 -= mr2[3] * X[7];
              mr2 = *(const LAS f32x4*)(Mm + 3568);
              __builtin_amdgcn_sched_barrier(0);
              a0 -= mr3[0] * X[8]; a1 -= mr3[1] * X[9]; a2 -= mr3[2] * X[10]; a3 -= mr3[3] * X[11];
              mr3 = *(const LAS f32x4*)(Mm + 3572);
              __builtin_amdgcn_sched_barrier(0);
              a0 -= mr4[0] * X[12]; a1 -= mr4[1] * X[13]; a2 -= mr4[2] * X[14]; a3 -= mr4[3] * X[15];
              mr4 = *(const LAS f32x4*)(Mm + 3576);
              __builtin_amdgcn_sched_barrier(0);
              a0 -= mr5[0] * X[16]; a1 -= mr5[1] * X[17]; a2 -= mr5[2] * X[18]; a3 -= mr5[3] * X[19];
              mr5 = *(const LAS f32x4*)(Mm + 3580);
              __builtin_amdgcn_sched_barrier(0);
              a0 -= mr6[0] * X[20]; a1 -= mr6[1] * X[21]; a2 -= mr6[2] * X[22]; a3 -= mr6[3] * X[23];
              mr6 = *(const LAS f32x4*)(Mm + 3584);
              __builtin_amdgcn_sched_barrier(0);
              a0 -= mr0[0] * X[24]; a1 -= mr0[1] * X[25]; a2 -= mr0[2] * X[26]; a3 -= mr0[3] * X[27];
              mr0 = *(const LAS f32x4*)(Mm + 3604);
              __builtin_amdgcn_sched_barrier(0);
              a0 -= mr1[0] * X[28]; a1 -= mr1[1] * X[29]; a2 -= mr1[2] * X[30]; a3 -= mr1[3] * X[31];
              mr1 = *(const LAS f32x4*)(Mm + 3608);
              __builtin_amdgcn_sched_barrier(0);
              a0 -= mr2[0] * X[32]; a1 -= mr2[1] * X[33]; a2 -= mr2[2] * X[34]; a3 -= mr2[3] * X[35];
              mr2 = *(const LAS f32x4*)(Mm + 3612);
              __builtin_amdgcn_sched_barrier(0);
              a0 -= mr3[0] * X[36]; a1 -= mr3[1] * X[37]; a2 -= mr3[2] * X[38]; a3 -= mr3[3] * X[39];
              mr3 = *(const LAS f32x4*)(Mm + 3616);
              __builtin_amdgcn_sched_barrier(0);
              a0 -= mr4[0] * X[40]; a1 -= mr4[1] * X[41]; a2 -= mr4[2] * X[42]; a3 -= mr4[3] * X[43];
              mr4 = *(const LAS f32x4*)(Mm + 3620);
              __builtin_amdgcn_sched_barrier(0);
              a0 -= mr5[0] * X[44]; a1 -= mr5[1] * X[45]; a2 -= mr5[2] * X[46]; a3 -= mr5[3] * X[47];
              mr5 = *(const LAS f32x4*)(Mm + 3624);
              __builtin_amdgcn_sched_barrier(0);
              a0 -= mr6[0] * X[48]; a1 -= mr6[1] * X[49]; a2 -= mr6[2] * X[50]; a3 -= mr6[3] * X[51];
              X[52] = (a0 + a1) + (a2 + a3); dst[6864] = X[52]; }
            __builtin_amdgcn_sched_barrier(0);
            rh1 = src[7260] * cf[55];
            { float a0 = rh2, a1 = 0.f, a2 = 0.f, a3 = 0.f;
              mr6 = *(const LAS f32x4*)(Mm + 3628);
              __builtin_amdgcn_sched_barrier(0);
              a0 -= mr0[0] * X[0]; a1 -= mr0[1] * X[1]; a2 -= mr0[2] * X[2]; a3 -= mr0[3] * X[3];
              mr0 = *(const LAS f32x4*)(Mm + 3632);
              __builtin_amdgcn_sched_barrier(0);
              a0 -= mr1[0] * X[4]; a1 -= mr1[1] * X[5]; a2 -= mr1[2] * X[6]; a3 -= mr1[3] * X[7];
              mr1 = *(const LAS f32x4*)(Mm + 3636);
              __builtin_amdgcn_sched_barrier(0);
              a0 -= mr2[0] * X[8]; a1 -= mr2[1] * X[9]; a2 -= mr2[2] * X[10]; a3 -= mr2[3] * X[11];
              mr2 = *(const LAS f32x4*)(Mm + 3640);
              __builtin_amdgcn_sched_barrier(0);
              a0 -= mr3[0] * X[12]; a1 -= mr3[1] * X[13]; a2 -= mr3[2] * X[14]; a3 -= mr3[3] * X[15];
              mr3 = *(const LAS f32x4*)(Mm + 3644);
              __builtin_amdgcn_sched_barrier(0);
              a0 -= mr4[0] * X[16]; a1 -= mr4[1] * X[17]; a2 -= mr4[2] * X[18]; a3 -= mr4[3] * X[19];
              mr4 = *(const LAS f32x4*)(Mm + 3648);
              __builtin_amdgcn_sched_barrier(0);
              a0 -= mr5[0] * X[20]; a1 -= mr5[1] * X[21]; a2 -= mr5[2] * X[22]; a3 -= mr5[3] * X[23];
              mr5 = *(const LAS f32x4*)(Mm + 3652);
              __builtin_amdgcn_sched_barrier(0);
              a0 -= mr6[0] * X[24]; a1 -= mr6[1] * X[25]; a2 -= mr6[2] * X[26]; a3 -= mr6[3] * X[27];
              mr6 = *(const LAS f32x4*)(Mm + 3656);
              __builtin_amdgcn_sched_barrier(0);
              a0 -= mr0[0] * X[28]; a1 -= mr0[1] * X[29]; a2 -= mr0[2] * X[30]; a3 -= mr0[3] * X[31];
              mr0 = *(const LAS f32x4*)(Mm + 3672);
              __builtin_amdgcn_sched_barrier(0);
              a0 -= mr1[0] * X[32]; a1 -= mr1[1] * X[33]; a2 -= mr1[2] * X[34]; a3 -= mr1[3] * X[35];
              mr1 = *(const LAS f32x4*)(Mm + 3676);
              __builtin_amdgcn_sched_barrier(0);
              a0 -= mr2[0] * X[36]; a1 -= mr2[1] * X[37]; a2 -= mr2[2] * X[38]; a3 -= mr2[3] * X[39];
              mr2 = *(const LAS f32x4*)(Mm + 3680);
              __builtin_amdgcn_sched_barrier(0);
              a0 -= mr3[0] * X[40]; a1 -= mr3[1] * X[41]; a2 -= mr3[2] * X[42]; a3 -= mr3[3] * X[43];
              mr3 = *(const LAS f32x4*)(Mm + 3684);
              __builtin_amdgcn_sched_barrier(0);
              a0 -= mr4[0] * X[44]; a1 -= mr4[1] * X[45]; a2 -= mr4[2] * X[46]; a3 -= mr4[3] * X[47];
              mr4 = *(const LAS f32x4*)(Mm + 3688);
              __builtin_amdgcn_sched_barrier(0);
              a0 -= mr5[0] * X[48]; a1 -= mr5[1] * X[49]; a2 -= mr5[2] * X[50]; a3 -= mr5[3] * X[51];
              mr5 = *(const LAS f32x4*)(Mm + 3692);
              __builtin_amdgcn_sched_barrier(0);
              a0 -= mr6[0] * X[52];
              X[53] = (a0 + a1) + (a2 + a3); dst[6996] = X[53]; }
            __builtin_amdgcn_sched_barrier(0);
            rh2 = src[7392] * cf[56];
            { float a0 = rh0, a1 = 0.f, a2 = 0.f, a3 = 0.f;
              mr6 = *(const LAS f32x4*)(Mm + 3696);
              __builtin_amdgcn_sched_barrier(0);
              a0 -= mr0[0] * X[0]; a1 -= mr0[1] * X[1]; a2 -= mr0[2] * X[2]; a3 -= mr0[3] * X[3];
              mr0 = *(const LAS f32x4*)(Mm + 3700);
              __builtin_amdgcn_sched_barrier(0);
              a0 -= mr1[0] * X[4]; a1 -= mr1[1] * X[5]; a2 -= mr1[2] * X[6]; a3 -= mr1[3] * X[7];
              mr1 = *(const LAS f32x4*)(Mm + 3704);
              __builtin_amdgcn_sched_barrier(0);
              a0 -= mr2[0] * X[8]; a1 -= mr2[1] * X[9]; a2 -= mr2[2] * X[10]; a3 -= mr2[3] * X[11];
              mr2 = *(const LAS f32x4*)(Mm + 3708);
              __builtin_amdgcn_sched_barrier(0);
              a0 -= mr3[0] * X[12]; a1 -= mr3[1] * X[13]; a2 -= mr3[2] * X[14]; a3 -= mr3[3] * X[15];
              mr3 = *(const LAS f32x4*)(Mm + 3712);
              __builtin_amdgcn_sched_barrier(0);
              a0 -= mr4[0] * X[16]; a1 -= mr4[1] * X[17]; a2 -= mr4[2] * X[18]; a3 -= mr4[3] * X[19];
              mr4 = *(const LAS f32x4*)(Mm + 3716);
              __builtin_amdgcn_sched_barrier(0);
              a0 -= mr5[0] * X[20]; a1 -= mr5[1] * X[21]; a2 -= mr5[2] * X[22]; a3 -= mr5[3] * X[23];
              mr5 = *(const LAS f32x4*)(Mm + 3720);
              __builtin_amdgcn_sched_barrier(0);
              a0 -= mr6[0] * X[24]; a1 -= mr6[1] * X[25]; a2 -= mr6[2] * X[26]; a3 -= mr6[3] * X[27];
              mr6 = *(const LAS f32x4*)(Mm + 3724);
              __builtin_amdgcn_sched_barrier(0);
              a0 -= mr0[0] * X[28]; a1 -= mr0[1] * X[29]; a2 -= mr0[2] * X[30]; a3 -= mr0[3] * X[31];
              mr0 = *(const LAS f32x4*)(Mm + 3740);
              __builtin_amdgcn_sched_barrier(0);
              a0 -= mr1[0] * X[32]; a1 -= mr1[1] * X[33]; a2 -= mr1[2] * X[34]; a3 -= mr1[3] * X[35];
              mr1 = *(const LAS f32x4*)(Mm + 3744);
              __builtin_amdgcn_sched_barrier(0);
              a0 -= mr2[0] * X[36]; a1 -= mr2[1] * X[37]; a2 -= mr2[2] * X[38]; a3 -= mr2[3] * X[39];
              mr2 = *(const LAS f32x4*)(Mm + 3748);
              __builtin_amdgcn_sched_barrier(0);
              a0 -= mr3[0] * X[40]; a1 -= mr3[1] * X[41]; a2 -= mr3[2] * X[42]; a3 -= mr3[3] * X[43];
              mr3 = *(const LAS f32x4*)(Mm + 3752);
              __builtin_amdgcn_sched_barrier(0);
              a0 -= mr4[0] * X[44]; a1 -= mr4[1] * X[45]; a2 -= mr4[2] * X[46]; a3 -= mr4[3] * X[47];
              mr4 = *(const LAS f32x4*)(Mm + 3756);
              __builtin_amdgcn_sched_barrier(0);
              a0 -= mr5[0] * X[48]; a1 -= mr5[1] * X[49]; a2 -= mr5[2] * X[50]; a3 -= mr5[3] * X[51];
              mr5 = *(const LAS f32x4*)(Mm + 3760);
              __builtin_amdgcn_sched_barrier(0);
              a0 -= mr6[0] * X[52]; a1 -= mr6[1] * X[53];
              X[54] = (a0 + a1) + (a2 + a3); dst[7128] = X[54]; }
            __builtin_amdgcn_sched_barrier(0);
            rh0 = src[7524] * cf[57];
            { float a0 = rh1, a1 = 0.f, a2 = 0.f, a3 = 0.f;
              mr6 = *(const LAS f32x4*)(Mm + 3764);
              __builtin_amdgcn_sched_barrier(0);
              a0 -= mr0[0] * X[0]; a1 -= mr0[1] * X[1]; a2 -= mr0[2] * X[2]; a3 -= mr0[3] * X[3];
              mr0 = *(const LAS f32x4*)(Mm + 3768);
              __builtin_amdgcn_sched_barrier(0);
              a0 -= mr1[0] * X[4]; a1 -= mr1[1] * X[5]; a2 -= mr1[2] * X[6]; a3 -= mr1[3] * X[7];
              mr1 = *(const LAS f32x4*)(Mm + 3772);
              __builtin_amdgcn_sched_barrier(0);
              a0 -= mr2[0] * X[8]; a1 -= mr2[1] * X[9]; a2 -= mr2[2] * X[10]; a3 -= mr2[3] * X[11];
              mr2 = *(const LAS f32x4*)(Mm + 3776);
              __builtin_amdgcn_sched_barrier(0);
              a0 -= mr3[0] * X[12]; a1 -= mr3[1] * X[13]; a2 -= mr3[2] * X[14]; a3 -= mr3[3] * X[15];
              mr3 = *(const LAS f32x4*)(Mm + 3780);
              __builtin_amdgcn_sched_barrier(0);
              a0 -= mr4[0] * X[16]; a1 -= mr4[1] * X[17]; a2 -= mr4[2] * X[18]; a3 -= mr4[3] * X[19];
              mr4 = *(const LAS f32x4*)(Mm + 3784);
              __builtin_amdgcn_sched_barrier(0);
              a0 -= mr5[0] * X[20]; a1 -= mr5[1] * X[21]; a2 -= mr5[2] * X[22]; a3 -= mr5[3] * X[23];
              mr5 = *(const LAS f32x4*)(Mm + 3788);
              __builtin_amdgcn_sched_barrier(0);
              a0 -= mr6[0] * X[24]; a1 -= mr6[1] * X[25]; a2 -= mr6[2] * X[26]; a3 -= mr6[3] * X[27];
              mr6 = *(const LAS f32x4*)(Mm + 3792);
              __builtin_amdgcn_sched_barrier(0);
              a0 -= mr0[0] * X[28]; a1 -= mr0[1] * X[29]; a2 -= mr0[2] * X[30]; a3 -= mr0[3] * X[31];
              mr0 = *(const LAS f32x4*)(Mm + 3808);
              __builtin_amdgcn_sched_barrier(0);
              a0 -= mr1[0] * X[32]; a1 -= mr1[1] * X[33]; a2 -= mr1[2] * X[34]; a3 -= mr1[3] * X[35];
              mr1 = *(const LAS f32x4*)(Mm + 3812);
              __builtin_amdgcn_sched_barrier(0);
              a0 -= mr2[0] * X[36]; a1 -= mr2[1] * X[37]; a2 -= mr2[2] * X[38]; a3 -= mr2[3] * X[39];
              mr2 = *(const LAS f32x4*)(Mm + 3816);
              __builtin_amdgcn_sched_barrier(0);
              a0 -= mr3[0] * X[40]; a1 -= mr3[1] * X[41]; a2 -= mr3[2] * X[42]; a3 -= mr3[3] * X[43];
              mr3 = *(const LAS f32x4*)(Mm + 3820);
              __builtin_amdgcn_sched_barrier(0);
              a0 -= mr4[0] * X[44]; a1 -= mr4[1] * X[45]; a2 -= mr4[2] * X[46]; a3 -= mr4[3] * X[47];
              mr4 = *(const LAS f32x4*)(Mm + 3824);
              __builtin_amdgcn_sched_barrier(0);
              a0 -= mr5[0] * X[48]; a1 -= mr5[1] * X[49]; a2 -= mr5[2] * X[50]; a3 -= mr5[3] * X[51];
              mr5 = *(const LAS f32x4*)(Mm + 3828);
              __builtin_amdgcn_sched_barrier(0);
              a0 -= mr6[0] * X[52]; a1 -= mr6[1] * X[53]; a2 -= mr6[2] * X[54];
              X[55] = (a0 + a1) + (a2 + a3); dst[7260] = X[55]; }
            __builtin_amdgcn_sched_barrier(0);
            rh1 = src[7656] * cf[58];
            { float a0 = rh2, a1 = 0.f, a2 = 0.f, a3 = 0.f;
              mr6 = *(const LAS f32x4*)(Mm + 3832);
              __builtin_amdgcn_sched_barrier(0);
              a0 -= mr0[0] * X[0]; a1 -= mr0[1] * X[1]; a2 -= mr0[2] * X[2]; a3 -= mr0[3] * X[3];
              mr0 = *(const LAS f32x4*)(Mm + 3836);
              __builtin_amdgcn_sched_barrier(0);
              a0 -= mr1[0] * X[4]; a1 -= mr1[1] * X[5]; a2 -= mr1[2] * X[6]; a3 -= mr1[3] * X[7];
              mr1 = *(const LAS f32x4*)(Mm + 3840);
              __builtin_amdgcn_sched_barrier(0);
              a0 -= mr2[0] * X[8]; a1 -= mr2[1] * X[9]; a2 -= mr2[2] * X[10]; a3 -= mr2[3] * X[11];
              mr2 = *(const LAS f32x4*)(Mm + 3844);
              __builtin_amdgcn_sched_barrier(0);
              a0 -= mr3[0] * X[12]; a1 -= mr3[1] * X[13]; a2 -= mr3[2] * X[14]; a3 -= mr3[3] * X[15];
              mr3 = *(const LAS f32x4*)(Mm + 3848);
              __builtin_amdgcn_sched_barrier(0);
              a0 -= mr4[0] * X[16]; a1 -= mr4[1] * X[17]; a2 -= mr4[2] * X[18]; a3 -= mr4[3] * X[19];
              mr4 = *(const LAS f32x4*)(Mm + 3852);
              __builtin_amdgcn_sched_barrier(0);
              a0 -= mr5[0] * X[20]; a1 -= mr5[1] * X[21]; a2 -= mr5[2] * X[22]; a3 -= mr5[3] * X[23];
              mr5 = *(const LAS f32x4*)(Mm + 3856);
              __builtin_amdgcn_sched_barrier(0);
              a0 -= mr6[0] * X[24]; a1 -= mr6[1] * X[25]; a2 -= mr6[2] * X[26]; a3 -= mr6[3] * X[27];
              mr6 = *(const LAS f32x4*)(Mm + 3860);
              __builtin_amdgcn_sched_barrier(0);
              a0 -= mr0[0] * X[28]; a1 -= mr0[1] * X[29]; a2 -= mr0[2] * X[30]; a3 -= mr0[3] * X[31];
              mr0 = *(const LAS f32x4*)(Mm + 3876);
              __builtin_amdgcn_sched_barrier(0);
              a0 -= mr1[0] * X[32]; a1 -= mr1[1] * X[33]; a2 -= mr1[2] * X[34]; a3 -= mr1[3] * X[35];
              mr1 = *(const LAS f32x4*)(Mm + 3880);
              __builtin_amdgcn_sched_barrier(0);
              a0 -= mr2[0] * X[36]; a1 -= mr2[1] * X[37]; a2 -= mr2[2] * X[38]; a3 -= mr2[3] * X[39];
              mr2 = *(const LAS f32x4*)(Mm + 3884);
              __builtin_amdgcn_sched_barrier(0);
              a0 -= mr3[0] * X[40]; a1 -= mr3[1] * X[41]; a2 -= mr3[2] * X[42]; a3 -= mr3[3] * X[43];
              mr3 = *(const LAS f32x4*)(Mm + 3888);
              __builtin_amdgcn_sched_barrier(0);
              a0 -= mr4[0] * X[44]; a1 -= mr4[1] * X[45]; a2 -= mr4[2] * X[46]; a3 -= mr4[3] * X[47];
              mr4 = *(const LAS f32x4*)(Mm + 3892);
              __builtin_amdgcn_sched_barrier(0);
              a0 -= mr5[0] * X[48]; a1 -= mr5[1] * X[49]; a2 -= mr5[2] * X[50]; a3 -= mr5[3] * X[51];
              mr5 = *(const LAS f32x4*)(Mm + 3896);
              __builtin_amdgcn_sched_barrier(0);
              a0 -= mr6[0] * X[52]; a1 -= mr6[1] * X[53]; a2 -= mr6[2] * X[54]; a3 -= mr6[3] * X[55];
              X[56] = (a0 + a1) + (a2 + a3); dst[7392] = X[56]; }
            __builtin_amdgcn_sched_barrier(0);
            rh2 = src[7788] * cf[59];
            { float a0 = rh0, a1 = 0.f, a2 = 0.f, a3 = 0.f;
              mr6 = *(const LAS f32x4*)(Mm + 3900);
              __builtin_amdgcn_sched_barrier(0);
              a0 -= mr0[0] * X[0]; a1 -= mr0[1] * X[1]; a2 -= mr0[2] * X[2]; a3 -= mr0[3] * X[3];
              mr0 = *(const LAS f32x4*)(Mm + 3904);
              __builtin_amdgcn_sched_barrier(0);
              a0 -= mr1[0] * X[4]; a1 -= mr1[1] * X[5]; a2 -= mr1[2] * X[6]; a3 -= mr1[3] * X[7];
              mr1 = *(const LAS f32x4*)(Mm + 3908);
              __builtin_amdgcn_sched_barrier(0);
              a0 -= mr2[0] * X[8]; a1 -= mr2[1] * X[9]; a2 -= mr2[2] * X[10]; a3 -= mr2[3] * X[11];
              mr2 = *(const LAS f32x4*)(Mm + 3912);
              __builtin_amdgcn_sched_barrier(0);
              a0 -= mr3[0] * X[12]; a1 -= mr3[1] * X[13]; a2 -= mr3[2] * X[14]; a3 -= mr3[3] * X[15];
              mr3 = *(const LAS f32x4*)(Mm + 3916);
              __builtin_amdgcn_sched_barrier(0);
              a0 -= mr4[0] * X[16]; a1 -= mr4[1] * X[17]; a2 -= mr4[2] * X[18]; a3 -= mr4[3] * X[19];
              mr4 = *(const LAS f32x4*)(Mm + 3920);
              __builtin_amdgcn_sched_barrier(0);
              a0 -= mr5[0] * X[20]; a1 -= mr5[1] * X[21]; a2 -= mr5[2] * X[22]; a3 -= mr5[3] * X[23];
              mr5 = *(const LAS f32x4*)(Mm + 3924);
              __builtin_amdgcn_sched_barrier(0);
              a0 -= mr6[0] * X[24]; a1 -= mr6[1] * X[25]; a2 -= mr6[2] * X[26]; a3 -= mr6[3] * X[27];
              mr6 = *(const LAS f32x4*)(Mm + 3928);
              __builtin_amdgcn_sched_barrier(0);
              a0 -= mr0[0] * X[28]; a1 -= mr0[1] * X[29]; a2 -= mr0[2] * X[30]; a3 -= mr0[3] * X[31];
              mr0 = *(const LAS f32x4*)(Mm + 3932);
              __builtin_amdgcn_sched_barrier(0);
              a0 -= mr1[0] * X[32]; a1 -= mr1[1] * X[33]; a2 -= mr1[2] * X[34]; a3 -= mr1[3] * X[35];
              mr1 = *(const LAS f32x4*)(Mm + 3944);
              __builtin_amdgcn_sched_barrier(0);
              a0 -= mr2[0] * X[36]; a1 -= mr2[1] * X[37]; a2 -= mr2[2] * X[38]; a3 -= mr2[3] * X[39];
              mr2 = *(const LAS f32x4*)(Mm + 3948);
              __builtin_amdgcn_sched_barrier(0);
              a0 -= mr3[0] * X[40]; a1 -= mr3[1] * X[41]; a2 -= mr3[2] * X[42]; a3 -= mr3[3] * X[43];
              mr3 = *(const LAS f32x4*)(Mm + 3952);
              __builtin_amdgcn_sched_barrier(0);
              a0 -= mr4[0] * X[44]; a1 -= mr4[1] * X[45]; a2 -= mr4[2] * X[46]; a3 -= mr4[3] * X[47];
              mr4 = *(const LAS f32x4*)(Mm + 3956);
              __builtin_amdgcn_sched_barrier(0);
              a0 -= mr5[0] * X[48]; a1 -= mr5[1] * X[49]; a2 -= mr5[2] * X[50]; a3 -= mr5[3] * X[51];
              mr5 = *(const LAS f32x4*)(Mm + 3960);
              __builtin_amdgcn_sched_barrier(0);
              a0 -= mr6[0] * X[52]; a1 -= mr6[1] * X[53]; a2 -= mr6[2] * X[54]; a3 -= mr6[3] * X[55];
              mr6 = *(const LAS f32x4*)(Mm + 3964);
              __builtin_amdgcn_sched_barrier(0);
              a0 -= mr0[0] * X[56];
              X[57] = (a0 + a1) + (a2 + a3); dst[7524] = X[57]; }
            __builtin_amdgcn_sched_barrier(0);
            rh0 = src[7920] * cf[60];
            { float a0 = rh1, a1 = 0.f, a2 = 0.f, a3 = 0.f;
              mr0 = *(const LAS f32x4*)(Mm + 3968);
              __builtin_amdgcn_sched_barrier(0);
              a0 -= mr1[0] * X[0]; a1 -= mr1[1] * X[1]; a2 -= mr1[2] * X[2]; a3 -= mr1[3] * X[3];
              mr1 = *(const LAS f32x4*)(Mm + 3972);
              __builtin_amdgcn_sched_barrier(0);
              a0 -= mr2[0] * X[4]; a1 -= mr2[1] * X[5]; a2 -= mr2[2] * X[6]; a3 -= mr2[3] * X[7];
              mr2 = *(const LAS f32x4*)(Mm + 3976);
              __builtin_amdgcn_sched_barrier(0);
              a0 -= mr3[0] * X[8]; a1 -= mr3[1] * X[9]; a2 -= mr3[2] * X[10]; a3 -= mr3[3] * X[11];
              mr3 = *(const LAS f32x4*)(Mm + 3980);
              __builtin_amdgcn_sched_barrier(0);
              a0 -= mr4[0] * X[12]; a1 -= mr4[1] * X[13]; a2 -= mr4[2] * X[14]; a3 -= mr4[3] * X[15];
              mr4 = *(const LAS f32x4*)(Mm + 3984);
              __builtin_amdgcn_sched_barrier(0);
              a0 -= mr5[0] * X[16]; a1 -= mr5[1] * X[17]; a2 -= mr5[2] * X[18]; a3 -= mr5[3] * X[19];
              mr5 = *(const LAS f32x4*)(Mm + 3988);
              __builtin_amdgcn_sched_barrier(0);
              a0 -= mr6[0] * X[20]; a1 -= mr6[1] * X[21]; a2 -= mr6[2] * X[22]; a3 -= mr6[3] * X[23];
              mr6 = *(const LAS f32x4*)(Mm + 3992);
              __builtin_amdgcn_sched_barrier(0);
              a0 -= mr0[0] * X[24]; a1 -= mr0[1] * X[25]; a2 -= mr0[2] * X[26]; a3 -= mr0[3] * X[27];
              mr0 = *(const LAS f32x4*)(Mm + 3996);
              __builtin_amdgcn_sched_barrier(0);
              a0 -= mr1[0] * X[28]; a1 -= mr1[1] * X[29]; a2 -= mr1[2] * X[30]; a3 -= mr1[3] * X[31];
              mr1 = *(const LAS f32x4*)(Mm + 4000);
              __builtin_amdgcn_sched_barrier(0);
              a0 -= mr2[0] * X[32]; a1 -= mr2[1] * X[33]; a2 -= mr2[2] * X[34]; a3 -= mr2[3] * X[35];
              mr2 = *(const LAS f32x4*)(Mm + 4012);
              __builtin_amdgcn_sched_barrier(0);
              a0 -= mr3[0] * X[36]; a1 -= mr3[1] * X[37]; a2 -= mr3[2] * X[38]; a3 -= mr3[3] * X[39];
              mr3 = *(const LAS f32x4*)(Mm + 4016);
              __builtin_amdgcn_sched_barrier(0);
              a0 -= mr4[0] * X[40]; a1 -= mr4[1] * X[41]; a2 -= mr4[2] * X[42]; a3 -= mr4[3] * X[43];
              mr4 = *(const LAS f32x4*)(Mm + 4020);
              __builtin_amdgcn_sched_barrier(0);
              a0 -= mr5[0] * X[44]; a1 -= mr5[1] * X[45]; a2 -= mr5[2] * X[46]; a3 -= mr5[3] * X[47];
              mr5 = *(const LAS f32x4*)(Mm + 4024);
              __builtin_amdgcn_sched_barrier(0);
              a0 -= mr6[0] * X[48]; a1 -= mr6[1] * X[49]; a2 -= mr6[2] * X[50]; a3 -= mr6[3] * X[51];
              mr6 = *(const LAS f32x4*)(Mm + 4028);
              __builtin_amdgcn_sched_barrier(0);
              a0 -= mr0[0] * X[52]; a1 -= mr0[1] * X[53]; a2 -= mr0[2] * X[54]; a3 -= mr0[3] * X[55];
              mr0 = *(const LAS f32x4*)(Mm + 4032);
              __builtin_amdgcn_sched_barrier(0);
              a0 -= mr1[0] * X[56]; a1 -= mr1[1] * X[57];
              X[58] = (a0 + a1) + (a2 + a3); dst[7656] = X[58]; }
            __builtin_amdgcn_sched_barrier(0);
            rh1 = src[8052] * cf[61];
            { float a0 = rh2, a1 = 0.f, a2 = 0.f, a3 = 0.f;
              mr1 = *(const LAS f32x4*)(Mm + 4036);
              __builtin_amdgcn_sched_barrier(0);
              a0 -= mr2[0] * X[0]; a1 -= mr2[1] * X[1]; a2 -= mr2[2] * X[2]; a3 -= mr2[3] * X[3];
              mr2 = *(const LAS f32x4*)(Mm + 4040);
              __builtin_amdgcn_sched_barrier(0);
              a0 -= mr3[0] * X[4]; a1 -= mr3[1] * X[5]; a2 -= mr3[2] * X[6]; a3 -= mr3[3] * X[7];
              mr3 = *(const LAS f32x4*)(Mm + 4044);
              __builtin_amdgcn_sched_barrier(0);
              a0 -= mr4[0] * X[8]; a1 -= mr4[1] * X[9]; a2 -= mr4[2] * X[10]; a3 -= mr4[3] * X[11];
              mr4 = *(const LAS f32x4*)(Mm + 4048);
              __builtin_amdgcn_sched_barrier(0);
              a0 -= mr5[0] * X[12]; a1 -= mr5[1] * X[13]; a2 -= mr5[2] * X[14]; a3 -= mr5[3] * X[15];
              mr5 = *(const LAS f32x4*)(Mm + 4052);
              __builtin_amdgcn_sched_barrier(0);
              a0 -= mr6[0] * X[16]; a1 -= mr6[1] * X[17]; a2 -= mr6[2] * X[18]; a3 -= mr6[3] * X[19];
              mr6 = *(const LAS f32x4*)(Mm + 4056);
              __builtin_amdgcn_sched_barrier(0);
              a0 -= mr0[0] * X[20]; a1 -= mr0[1] * X[21]; a2 -= mr0[2] * X[22]; a3 -= mr0[3] * X[23];
              mr0 = *(const LAS f32x4*)(Mm + 4060);
              __builtin_amdgcn_sched_barrier(0);
              a0 -= mr1[0] * X[24]; a1 -= mr1[1] * X[25]; a2 -= mr1[2] * X[26]; a3 -= mr1[3] * X[27];
              mr1 = *(const LAS f32x4*)(Mm + 4064);
              __builtin_amdgcn_sched_barrier(0);
              a0 -= mr2[0] * X[28]; a1 -= mr2[1] * X[29]; a2 -= mr2[2] * X[30]; a3 -= mr2[3] * X[31];
              mr2 = *(const LAS f32x4*)(Mm + 4068);
              __builtin_amdgcn_sched_barrier(0);
              a0 -= mr3[0] * X[32]; a1 -= mr3[1] * X[33]; a2 -= mr3[2] * X[34]; a3 -= mr3[3] * X[35];
              mr3 = *(const LAS f32x4*)(Mm + 4080);
              __builtin_amdgcn_sched_barrier(0);
              a0 -= mr4[0] * X[36]; a1 -= mr4[1] * X[37]; a2 -= mr4[2] * X[38]; a3 -= mr4[3] * X[39];
              mr4 = *(const LAS f32x4*)(Mm + 4084);
              __builtin_amdgcn_sched_barrier(0);
              a0 -= mr5[0] * X[40]; a1 -= mr5[1] * X[41]; a2 -= mr5[2] * X[42]; a3 -= mr5[3] * X[43];
              mr5 = *(const LAS f32x4*)(Mm + 4088);
              __builtin_amdgcn_sched_barrier(0);
              a0 -= mr6[0] * X[44]; a1 -= mr6[1] * X[45]; a2 -= mr6[2] * X[46]; a3 -= mr6[3] * X[47];
              mr6 = *(const LAS f32x4*)(Mm + 4092);
              __builtin_amdgcn_sched_barrier(0);
              a0 -= mr0[0] * X[48]; a1 -= mr0[1] * X[49]; a2 -= mr0[2] * X[50]; a3 -= mr0[3] * X[51];
              mr0 = *(const LAS f32x4*)(Mm + 4096);
              __builtin_amdgcn_sched_barrier(0);
              a0 -= mr1[0] * X[52]; a1 -= mr1[1] * X[53]; a2 -= mr1[2] * X[54]; a3 -= mr1[3] * X[55];
              mr1 = *(const LAS f32x4*)(Mm + 4100);
              __builtin_amdgcn_sched_barrier(0);
              a0 -= mr2[0] * X[56]; a1 -= mr2[1] * X[57]; a2 -= mr2[2] * X[58];
              X[59] = (a0 + a1) + (a2 + a3); dst[7788] = X[59]; }
            __builtin_amdgcn_sched_barrier(0);
            rh2 = src[8184] * cf[62];
            { float a0 = rh0, a1 = 0.f, a2 = 0.f, a3 = 0.f;
              mr2 = *(const LAS f32x4*)(Mm + 4104);
              __builtin_amdgcn_sched_barrier(0);
              a0 -= mr3[0] * X[0]; a1 -= mr3[1] * X[1]; a2 -= mr3[2] * X[2]; a3 -= mr3[3] * X[3];
              mr3 = *(const LAS f32x4*)(Mm + 4108);
              __builtin_amdgcn_sched_barrier(0);
              a0 -= mr4[0] * X[4]; a1 -= mr4[1] * X[5]; a2 -= mr4[2] * X[6]; a3 -= mr4[3] * X[7];
              mr4 = *(const LAS f32x4*)(Mm + 4112);
              __builtin_amdgcn_sched_barrier(0);
              a0 -= mr5[0] * X[8]; a1 -= mr5[1] * X[9]; a2 -= mr5[2] * X[10]; a3 -= mr5[3] * X[11];
              mr5 = *(const LAS f32x4*)(Mm + 4116);
              __builtin_amdgcn_sched_barrier(0);
              a0 -= mr6[0] * X[12]; a1 -= mr6[1] * X[13]; a2 -= mr6[2] * X[14]; a3 -= mr6[3] * X[15];
              mr6 = *(const LAS f32x4*)(Mm + 4120);
              __builtin_amdgcn_sched_barrier(0);
              a0 -= mr0[0] * X[16]; a1 -= mr0[1] * X[17]; a2 -= mr0[2] * X[18]; a3 -= mr0[3] * X[19];
              mr0 = *(const LAS f32x4*)(Mm + 4124);
              __builtin_amdgcn_sched_barrier(0);
              a0 -= mr1[0] * X[20]; a1 -= mr1[1] * X[21]; a2 -= mr1[2] * X[22]; a3 -= mr1[3] * X[23];
              mr1 = *(const LAS f32x4*)(Mm + 4128);
              __builtin_amdgcn_sched_barrier(0);
              a0 -= mr2[0] * X[24]; a1 -= mr2[1] * X[25]; a2 -= mr2[2] * X[26]; a3 -= mr2[3] * X[27];
              mr2 = *(const LAS f32x4*)(Mm + 4132);
              __builtin_amdgcn_sched_barrier(0);
              a0 -= mr3[0] * X[28]; a1 -= mr3[1] * X[29]; a2 -= mr3[2] * X[30]; a3 -= mr3[3] * X[31];
              mr3 = *(const LAS f32x4*)(Mm + 4136);
              __builtin_amdgcn_sched_barrier(0);
              a0 -= mr4[0] * X[32]; a1 -= mr4[1] * X[33]; a2 -= mr4[2] * X[34]; a3 -= mr4[3] * X[35];
              mr4 = *(const LAS f32x4*)(Mm + 4148);
              __builtin_amdgcn_sched_barrier(0);
              a0 -= mr5[0] * X[36]; a1 -= mr5[1] * X[37]; a2 -= mr5[2] * X[38]; a3 -= mr5[3] * X[39];
              mr5 = *(const LAS f32x4*)(Mm + 4152);
              __builtin_amdgcn_sched_barrier(0);
              a0 -= mr6[0] * X[40]; a1 -= mr6[1] * X[41]; a2 -= mr6[2] * X[42]; a3 -= mr6[3] * X[43];
              mr6 = *(const LAS f32x4*)(Mm + 4156);
              __builtin_amdgcn_sched_barrier(0);
              a0 -= mr0[0] * X[44]; a1 -= mr0[1] * X[45]; a2 -= mr0[2] * X[46]; a3 -= mr0[3] * X[47];
              mr0 = *(const LAS f32x4*)(Mm + 4160);
              __builtin_amdgcn_sched_barrier(0);
              a0 -= mr1[0] * X[48]; a1 -= mr1[1] * X[49]; a2 -= mr1[2] * X[50]; a3 -= mr1[3] * X[51];
              mr1 = *(const LAS f32x4*)(Mm + 4164);
              __builtin_amdgcn_sched_barrier(0);
              a0 -= mr2[0] * X[52]; a1 -= mr2[1] * X[53]; a2 -= mr2[2] * X[54]; a3 -= mr2[3] * X[55];
              mr2 = *(const LAS f32x4*)(Mm + 4168);
              __builtin_amdgcn_sched_barrier(0);
              a0 -= mr3[0] * X[56]; a1 -= mr3[1] * X[57]; a2 -= mr3[2] * X[58]; a3 -= mr3[3] * X[59];
              X[60] = (a0 + a1) + (a2 + a3); dst[7920] = X[60]; }
            __builtin_amdgcn_sched_barrier(0);
            rh0 = src[8316] * cf[63];
            { float a0 = rh1, a1 = 0.f, a2 = 0.f, a3 = 0.f;
              mr3 = *(const LAS f32x4*)(Mm + 4172);
              __builtin_amdgcn_sched_barrier(0);
              a0 -= mr4[0] * X[0]; a1 -= mr4[1] * X[1]; a2 -= mr4[2] * X[2]; a3 -= mr4[3] * X[3];
              mr4 = *(const LAS f32x4*)(Mm + 4176);
              __builtin_amdgcn_sched_barrier(0);
              a0 -= mr5[0] * X[4]; a1 -= mr5[1] * X[5]; a2 -= mr5[2] * X[6]; a3 -= mr5[3] * X[7];
              mr5 = *(const LAS f32x4*)(Mm + 4180);
              __builtin_amdgcn_sched_barrier(0);
              a0 -= mr6[0] * X[8]; a1 -= mr6[1] * X[9]; a2 -= mr6[2] * X[10]; a3 -= mr6[3] * X[11];
              mr6 = *(const LAS f32x4*)(Mm + 4184);
              __builtin_amdgcn_sched_barrier(0);
              a0 -= mr0[0] * X[12]; a1 -= mr0[1] * X[13]; a2 -= mr0[2] * X[14]; a3 -= mr0[3] * X[15];
              mr0 = *(const LAS f32x4*)(Mm + 4188);
              __builtin_amdgcn_sched_barrier(0);
              a0 -= mr1[0] * X[16]; a1 -= mr1[1] * X[17]; a2 -= mr1[2] * X[18]; a3 -= mr1[3] * X[19];
              mr1 = *(const LAS f32x4*)(Mm + 4192);
              __builtin_amdgcn_sched_barrier(0);
              a0 -= mr2[0] * X[20]; a1 -= mr2[1] * X[21]; a2 -= mr2[2] * X[22]; a3 -= mr2[3] * X[23];
              mr2 = *(const LAS f32x4*)(Mm + 4196);
              __builtin_amdgcn_sched_barrier(0);
              a0 -= mr3[0] * X[24]; a1 -= mr3[1] * X[25]; a2 -= mr3[2] * X[26]; a3 -= mr3[3] * X[27];
              mr3 = *(const LAS f32x4*)(Mm + 4200);
              __builtin_amdgcn_sched_barrier(0);
              a0 -= mr4[0] * X[28]; a1 -= mr4[1] * X[29]; a2 -= mr4[2] * X[30]; a3 -= mr4[3] * X[31];
              mr4 = *(const LAS f32x4*)(Mm + 4204);
              __builtin_amdgcn_sched_barrier(0);
              a0 -= mr5[0] * X[32]; a1 -= mr5[1] * X[33]; a2 -= mr5[2] * X[34]; a3 -= mr5[3] * X[35];
              mr5 = *(const LAS f32x4*)(Mm + 4208);
              __builtin_amdgcn_sched_barrier(0);
              a0 -= mr6[0] * X[36]; a1 -= mr6[1] * X[37]; a2 -= mr6[2] * X[38]; a3 -= mr6[3] * X[39];
              mr6 = *(const LAS f32x4*)(Mm + 4216);
              __builtin_amdgcn_sched_barrier(0);
              a0 -= mr0[0] * X[40]; a1 -= mr0[1] * X[41]; a2 -= mr0[2] * X[42]; a3 -= mr0[3] * X[43];
              mr0 = *(const LAS f32x4*)(Mm + 4220);
              __builtin_amdgcn_sched_barrier(0);
              a0 -= mr1[0] * X[44]; a1 -= mr1[1] * X[45]; a2 -= mr1[2] * X[46]; a3 -= mr1[3] * X[47];
              mr1 = *(const LAS f32x4*)(Mm + 4224);
              __builtin_amdgcn_sched_barrier(0);
              a0 -= mr2[0] * X[48]; a1 -= mr2[1] * X[49]; a2 -= mr2[2] * X[50]; a3 -= mr2[3] * X[51];
              mr2 = *(const LAS f32x4*)(Mm + 4228);
              __builtin_amdgcn_sched_barrier(0);
              a0 -= mr3[0] * X[52]; a1 -= mr3[1] * X[53]; a2 -= mr3[2] * X[54]; a3 -= mr3[3] * X[55];
              mr3 = *(const LAS f32x4*)(Mm + 4232);
              __builtin_amdgcn_sched_barrier(0);
              a0 -= mr4[0] * X[56]; a1 -= mr4[1] * X[57]; a2 -= mr4[2] * X[58]; a3 -= mr4[3] * X[59];
              mr4 = *(const LAS f32x4*)(Mm + 4236);
              __builtin_amdgcn_sched_barrier(0);
              a0 -= mr5[0] * X[60];
              X[61] = (a0 + a1) + (a2 + a3); dst[8052] = X[61]; }
            __builtin_amdgcn_sched_barrier(0);
            { float a0 = rh2, a1 = 0.f, a2 = 0.f, a3 = 0.f;
              mr5 = *(const LAS f32x4*)(Mm + 4240);
              __builtin_amdgcn_sched_barrier(0);
              a0 -= mr6[0] * X[0]; a1 -= mr6[1] * X[1]; a2 -= mr6[2] * X[2]; a3 -= mr6[3] * X[3];
              mr6 = *(const LAS f32x4*)(Mm + 4244);
              __builtin_amdgcn_sched_barrier(0);
              a0 -= mr0[0] * X[4]; a1 -= mr0[1] * X[5]; a2 -= mr0[2] * X[6]; a3 -= mr0[3] * X[7];
              mr0 = *(const LAS f32x4*)(Mm + 4248);
              __builtin_amdgcn_sched_barrier(0);
              a0 -= mr1[0] * X[8]; a1 -= mr1[1] * X[9]; a2 -= mr1[2] * X[10]; a3 -= mr1[3] * X[11];
              mr1 = *(const LAS f32x4*)(Mm + 4252);
              __builtin_amdgcn_sched_barrier(0);
              a0 -= mr2[0] * X[12]; a1 -= mr2[1] * X[13]; a2 -= mr2[2] * X[14]; a3 -= mr2[3] * X[15];
              mr2 = *(const LAS f32x4*)(Mm + 4256);
              __builtin_amdgcn_sched_barrier(0);
              a0 -= mr3[0] * X[16]; a1 -= mr3[1] * X[17]; a2 -= mr3[2] * X[18]; a3 -= mr3[3] * X[19];
              mr3 = *(const LAS f32x4*)(Mm + 4260);
              __builtin_amdgcn_sched_barrier(0);
              a0 -= mr4[0] * X[20]; a1 -= mr4[1] * X[21]; a2 -= mr4[2] * X[22]; a3 -= mr4[3] * X[23];
              mr4 = *(const LAS f32x4*)(Mm + 4264);
              __builtin_amdgcn_sched_barrier(0);
              a0 -= mr5[0] * X[24]; a1 -= mr5[1] * X[25]; a2 -= mr5[2] * X[26]; a3 -= mr5[3] * X[27];
              mr5 = *(const LAS f32x4*)(Mm + 4268);
              __builtin_amdgcn_sched_barrier(0);
              a0 -= mr6[0] * X[28]; a1 -= mr6[1] * X[29]; a2 -= mr6[2] * X[30]; a3 -= mr6[3] * X[31];
              mr6 = *(const LAS f32x4*)(Mm + 4272);
              __builtin_amdgcn_sched_barrier(0);
              a0 -= mr0[0] * X[32]; a1 -= mr0[1] * X[33]; a2 -= mr0[2] * X[34]; a3 -= mr0[3] * X[35];
              mr0 = *(const LAS f32x4*)(Mm + 4276);
              __builtin_amdgcn_sched_barrier(0);
              a0 -= mr1[0] * X[36]; a1 -= mr1[1] * X[37]; a2 -= mr1[2] * X[38]; a3 -= mr1[3] * X[39];
              mr1 = *(const LAS f32x4*)(Mm + 4284);
              __builtin_amdgcn_sched_barrier(0);
              a0 -= mr2[0] * X[40]; a1 -= mr2[1] * X[41]; a2 -= mr2[2] * X[42]; a3 -= mr2[3] * X[43];
              mr2 = *(const LAS f32x4*)(Mm + 4288);
              __builtin_amdgcn_sched_barrier(0);
              a0 -= mr3[0] * X[44]; a1 -= mr3[1] * X[45]; a2 -= mr3[2] * X[46]; a3 -= mr3[3] * X[47];
              mr3 = *(const LAS f32x4*)(Mm + 4292);
              __builtin_amdgcn_sched_barrier(0);
              a0 -= mr4[0] * X[48]; a1 -= mr4[1] * X[49]; a2 -= mr4[2] * X[50]; a3 -= mr4[3] * X[51];
              mr4 = *(const LAS f32x4*)(Mm + 4296);
              __builtin_amdgcn_sched_barrier(0);
              a0 -= mr5[0] * X[52]; a1 -= mr5[1] * X[53]; a2 -= mr5[2] * X[54]; a3 -= mr5[3] * X[55];
              mr5 = *(const LAS f32x4*)(Mm + 4300);
              __builtin_amdgcn_sched_barrier(0);
              a0 -= mr6[0] * X[56]; a1 -= mr6[1] * X[57]; a2 -= mr6[2] * X[58]; a3 -= mr6[3] * X[59];
              mr6 = *(const LAS f32x4*)(Mm + 4304);
              __builtin_amdgcn_sched_barrier(0);
              a0 -= mr0[0] * X[60]; a1 -= mr0[1] * X[61];
              X[62] = (a0 + a1) + (a2 + a3); dst[8184] = X[62]; }
            __builtin_amdgcn_sched_barrier(0);
            { float a0 = rh0, a1 = 0.f, a2 = 0.f, a3 = 0.f;
              mr0 = *(const LAS f32x4*)(Mm + 4308);
              __builtin_amdgcn_sched_barrier(0);
              a0 -= mr1[0] * X[0]; a1 -= mr1[1] * X[1]; a2 -= mr1[2] * X[2]; a3 -= mr1[3] * X[3];
              mr1 = *(const LAS f32x4*)(Mm + 4312);
              __builtin_amdgcn_sched_barrier(0);
              a0 -= mr2[0] * X[4]; a1 -= mr2[1] * X[5]; a2 -= mr2[2] * X[6]; a3 -= mr2[3] * X[7];
              mr2 = *(const LAS f32x4*)(Mm + 4316);
              __builtin_amdgcn_sched_barrier(0);
              a0 -= mr3[0] * X[8]; a1 -= mr3[1] * X[9]; a2 -= mr3[2] * X[10]; a3 -= mr3[3] * X[11];
              mr3 = *(const LAS f32x4*)(Mm + 4320);
              __builtin_amdgcn_sched_barrier(0);
              a0 -= mr4[0] * X[12]; a1 -= mr4[1] * X[13]; a2 -= mr4[2] * X[14]; a3 -= mr4[3] * X[15];
              mr4 = *(const LAS f32x4*)(Mm + 4324);
              __builtin_amdgcn_sched_barrier(0);
              a0 -= mr5[0] * X[16]; a1 -= mr5[1] * X[17]; a2 -= mr5[2] * X[18]; a3 -= mr5[3] * X[19];
              mr5 = *(const LAS f32x4*)(Mm + 4328);
              __builtin_amdgcn_sched_barrier(0);
              a0 -= mr6[0] * X[20]; a1 -= mr6[1] * X[21]; a2 -= mr6[2] * X[22]; a3 -= mr6[3] * X[23];
              mr6 = *(const LAS f32x4*)(Mm + 4332);
              __builtin_amdgcn_sched_barrier(0);
              a0 -= mr0[0] * X[24]; a1 -= mr0[1] * X[25]; a2 -= mr0[2] * X[26]; a3 -= mr0[3] * X[27];
              mr0 = *(const LAS f32x4*)(Mm + 4336);
              __builtin_amdgcn_sched_barrier(0);
              a0 -= mr1[0] * X[28]; a1 -= mr1[1] * X[29]; a2 -= mr1[2] * X[30]; a3 -= mr1[3] * X[31];
              mr1 = *(const LAS f32x4*)(Mm + 4340);
              __builtin_amdgcn_sched_barrier(0);
              a0 -= mr2[0] * X[32]; a1 -= mr2[1] * X[33]; a2 -= mr2[2] * X[34]; a3 -= mr2[3] * X[35];
              mr2 = *(const LAS f32x4*)(Mm + 4344);
              __builtin_amdgcn_sched_barrier(0);
              a0 -= mr3[0] * X[36]; a1 -= mr3[1] * X[37]; a2 -= mr3[2] * X[38]; a3 -= mr3[3] * X[39];
              __builtin_amdgcn_sched_barrier(0);
              a0 -= mr4[0] * X[40]; a1 -= mr4[1] * X[41]; a2 -= mr4[2] * X[42]; a3 -= mr4[3] * X[43];
              __builtin_amdgcn_sched_barrier(0);
              a0 -= mr5[0] * X[44]; a1 -= mr5[1] * X[45]; a2 -= mr5[2] * X[46]; a3 -= mr5[3] * X[47];
              __builtin_amdgcn_sched_barrier(0);
              a0 -= mr6[0] * X[48]; a1 -= mr6[1] * X[49]; a2 -= mr6[2] * X[50]; a3 -= mr6[3] * X[51];
              __builtin_amdgcn_sched_barrier(0);
              a0 -= mr0[0] * X[52]; a1 -= mr0[1] * X[53]; a2 -= mr0[2] * X[54]; a3 -= mr0[3] * X[55];
              __builtin_amdgcn_sched_barrier(0);
              a0 -= mr1[0] * X[56]; a1 -= mr1[1] * X[57]; a2 -= mr1[2] * X[58]; a3 -= mr1[3] * X[59];
              __builtin_amdgcn_sched_barrier(0);
              a0 -= mr2[0] * X[60]; a1 -= mr2[1] * X[61]; a2 -= mr2[2] * X[62];
              X[63] = (a0 + a1) + (a2 + a3); dst[8316] = X[63]; }
            __builtin_amdgcn_sched_barrier(0);
            __builtin_amdgcn_s_setprio(0);
        } else {
            const int t2 = tid - 256; const float glast = gt[64 + 63];
#pragma unroll
            for (int i = 0; i < 4; ++i) { const int task = t2 + 256 * i, d = task & 127, gq = task >> 7, g = gq >> 2, q = gq & 3;
                float v[8];
#pragma unroll
                for (int e = 0; e < 4; ++e) { const int ta = 32 * g + 4 * q + e, tb = ta + 16;
                    v[e] = Kf[ta * 132 + d] * __expf(glast - gt[64 + ta]); v[4 + e] = Kf[tb * 132 + d] * __expf(glast - gt[64 + tb]); }
                v4u o; o.x = pk2(v[0], v[1]); o.y = pk2(v[2], v[3]); o.z = pk2(v[4], v[5]); o.w = pk2(v[6], v[7]);
                *(v4u*)(KDT + ((size_t)unit * 128 + d) * 64 + 32 * g + 8 * q) = o; }
            if (t2 == 0) GL[unit] = expf(glast);
        }
        bar_lds();
#pragma unroll
        for (int i = 0; i < 4; ++i) { const int idx = tid + NT * i, t = idx >> 5, c4 = (idx & 31) * 4;
            *(f32x4*)(U + ((size_t)unit * 64 + t) * 128 + c4) = *(const LAS f32x4*)(Vf + t * 132 + c4); }
#pragma unroll
        for (int i = 0; i < 2; ++i) { const int idx = tid + NT * i, t = idx >> 4, c8 = (idx & 15) * 8;
            const LAS float* wf = (const LAS float*)Qb + t * 132 + (c8 & ~31) + ((c8 & 31) >> 1);
            const f32x4 lo = *(const LAS f32x4*)wf, hi = *(const LAS f32x4*)(wf + 16);
            v4u o; o.x = pk2(lo[0], lo[1]); o.y = pk2(lo[2], lo[3]); o.z = pk2(hi[0], hi[1]); o.w = pk2(hi[2], hi[3]);
            *(v4u*)(WKb + ((size_t)unit * 64 + t) * 128 + c8) = o; }
        bar_lds();
    }
}

DI void phase_mix(const Args& a, int l, LAS unsigned char* lds, int tid, int lane, int wave, int bid, int G) {
    unsigned char* ws = a.ws;
    const bf16* P = (const bf16*)(ws + WS_P);
    bf16* MIX = (bf16*)a.out;
    const int r = lane & 15, q = lane >> 4;
    if (bid < 64) {
        const char* QDc = (const char*)(ws + WS_QD); const char* WKc = (const char*)(ws + WS_WK); const char* KDTc = (const char*)(ws + WS_KDT); const char* ACc = (const char*)(ws + WS_AC);
        const float* U = (const float*)(ws + WS_U); const float* GL = (const float*)(ws + WS_GL);
        const int bh = bid >> 1, h = bh & 3, b = bh >> 2, col = 64 * (bid & 1) + 16 * (wave & 3) + r; const bool act = wave < 4;
        constexpr int SBUF = 73728;
        const float glv = GL[(size_t)bh * 64 + lane];
        const unsigned ldsbase = (unsigned)__builtin_amdgcn_readfirstlane((int)(unsigned)(size_t)lds);
        unsigned o256[2], o128[2], ra[4], rk[2], ou[2];
        const char* Uc = (const char*)U + (bid & 1) * 256;
#pragma unroll
        for (int i = 0; i < 2; ++i) { const int sl = (wave + 8 * i) * 64 + lane;
            { const int row = sl >> 4, kc = (sl & 15) ^ (row & 15); o256[i] = (unsigned)(row * 256 + kc * 16); }
            { const int row = sl >> 3, kc = (sl & 7) ^ ((row >> 1) & 7); o128[i] = (unsigned)(row * 128 + kc * 16); }
            ou[i] = (unsigned)((sl >> 4) * 512 + (sl & 15) * 16); }
#pragma unroll
        for (int ks = 0; ks < 4; ++ks) ra[ks] = (unsigned)(r * 256 + (((4 * ks + q) ^ r) << 4));
#pragma unroll
        for (int ks = 0; ks < 2; ++ks) rk[ks] = (unsigned)(r * 128 + (((4 * ks + q) ^ (r >> 1)) << 4));
#define SC_GLDS(gp, loff) glds16((const void*)(gp), ldsbase + (unsigned)(loff))
#define SC_STAGE(n_, b_) do { const size_t un_ = (size_t)bh * 64 + (n_); const int lb_ = (b_) * SBUF + wave * 1024; \
            SC_GLDS(WKc + un_ * 16384 + o256[0], lb_); SC_GLDS(WKc + un_ * 16384 + o256[1], lb_ + 8192); \
            SC_GLDS(QDc + un_ * 16384 + o256[0], lb_ + 16384); SC_GLDS(QDc + un_ * 16384 + o256[1], lb_ + 16384 + 8192); \
            SC_GLDS(KDTc + un_ * 16384 + o128[0], lb_ + 32768); SC_GLDS(KDTc + un_ * 16384 + o128[1], lb_ + 32768 + 8192); \
            SC_GLDS(ACc + un_ * 8192 + o128[0], lb_ + 49152); \
            SC_GLDS(Uc + un_ * 32768 + ou[0], lb_ + 57344); SC_GLDS(Uc + un_ * 32768 + ou[1], lb_ + 57344 + 8192); } while (0)
        f32x4 S[8];
#pragma unroll
        for (int mt = 0; mt < 8; ++mt) S[mt] = (f32x4){0.f, 0.f, 0.f, 0.f};
        if (act) __builtin_amdgcn_s_setprio(2);
        SC_STAGE(0, 0);
        asm volatile("s_waitcnt vmcnt(0)" ::: "memory"); __syncthreads();
        bf16* Og = (bf16*)(ws + WS_P) + (size_t)b * SEQ * NP + 1024 + h * 128 + col;
        f32x4 ovp[4];
#pragma unroll
        for (int mt = 0; mt < 4; ++mt) ovp[mt] = (f32x4){0.f, 0.f, 0.f, 0.f};
        for (int n = 0; n <= 64; ++n) {
            const int cur = n & 1;
            if (n == 64) break;
            if (n + 1 < 64) SC_STAGE(n + 1, cur ^ 1);
            if (act) {
            const LAS unsigned char* sb = lds + cur * SBUF;
            bf16x8 fa[16], fb[16], fc[8]; float ul[16];
#pragma unroll
            for (int mt = 0; mt < 4; ++mt)
#pragma unroll
                for (int ks = 0; ks < 4; ++ks) fa[mt * 4 + ks] = *(const LAS bf16x8*)(sb + mt * 4096 + ra[ks]);
#pragma unroll
            for (int mt = 0; mt < 4; ++mt)
#pragma unroll
                for (int ks = 0; ks < 4; ++ks) fb[mt * 4 + ks] = *(const LAS bf16x8*)(sb + 16384 + mt * 4096 + ra[ks]);
            bf16x8 Sb[4];
#pragma unroll
            for (int ks = 0; ks < 4; ++ks) Sb[ks] = pack8(S[2 * ks], S[2 * ks + 1]);
            __builtin_amdgcn_sched_barrier(0);
            f32x4 wv[4], ov[4];
#pragma unroll
            for (int mt = 0; mt < 4; ++mt) { f32x4 acc = {0.f, 0.f, 0.f, 0.f};
#pragma unroll
                for (int ks = 0; ks < 4; ++ks) acc = MFMA16(fa[mt * 4 + ks], Sb[ks], acc);
                wv[mt] = acc; }
#pragma unroll
            for (int mt = 0; mt < 4; ++mt) { const LAS float* up = (const LAS float*)(sb + 57344 + (16 * mt + 4 * q) * 256 + (16 * (wave & 3) + r) * 4);
#pragma unroll
                for (int i = 0; i < 4; ++i) ul[mt * 4 + i] = up[i * 64];
#pragma unroll
                for (int ks = 0; ks < 2; ++ks) fc[mt * 2 + ks] = *(const LAS bf16x8*)(sb + 49152 + mt * 2048 + rk[ks]); }
            __builtin_amdgcn_sched_barrier(0);
#pragma unroll
            for (int mt = 0; mt < 4; ++mt) { f32x4 acc = {0.f, 0.f, 0.f, 0.f};
#pragma unroll
                for (int ks = 0; ks < 4; ++ks) acc = MFMA16(fb[mt * 4 + ks], Sb[ks], acc);
                ov[mt] = acc; }
#pragma unroll
            for (int mt = 0; mt < 8; ++mt)
#pragma unroll
                for (int ks = 0; ks < 2; ++ks) fa[mt * 2 + ks] = *(const LAS bf16x8*)(sb + 32768 + mt * 2048 + rk[ks]);
            __builtin_amdgcn_sched_barrier(0);
#pragma unroll
            for (int mt = 0; mt < 4; ++mt)
#pragma unroll
                for (int i = 0; i < 4; ++i) wv[mt][i] = ul[mt * 4 + i] - wv[mt][i];
            bf16x8 Wb[2];
#pragma unroll
            for (int ks = 0; ks < 2; ++ks) Wb[ks] = pack8(wv[2 * ks], wv[2 * ks + 1]);
#pragma unroll
            for (int mt = 0; mt < 4; ++mt)
#pragma unroll
                for (int ks = 0; ks < 2; ++ks) ov[mt] = MFMA16(fc[mt * 2 + ks], Wb[ks], ov[mt]);
            const float gl = __builtin_bit_cast(float, __builtin_amdgcn_readlane(__builtin_bit_cast(int, glv), n));
#pragma unroll
            for (int mt = 0; mt < 8; ++mt) { S[mt] = S[mt] * gl;
#pragma unroll
                for (int ks = 0; ks < 2; ++ks) S[mt] = MFMA16(fa[mt * 2 + ks], Wb[ks], S[mt]); }
            { GAS bf16* og = (GAS bf16*)(Og + (size_t)(n * 64 + 4 * q) * NP);
#pragma unroll
              for (int mt = 0; mt < 4; ++mt)
#pragma unroll
                  for (int i = 0; i < 4; ++i) og[(size_t)(16 * mt + i) * NP] = f2bf(ov[mt][i]); }
            asm volatile("s_waitcnt vmcnt(16) lgkmcnt(0)\n\ts_barrier" ::: "memory");
            } else {
            asm volatile("s_waitcnt vmcnt(0) lgkmcnt(0)\n\ts_barrier" ::: "memory");
            }
        }
__builtin_amdgcn_s_setprio(0);
#undef SC_STAGE
#undef SC_GLDS
    } else {
        const float* lng = a.in[6] + l * 512; const float* lnb = a.in[7] + l * 512;
        const float* sw = a.in[8] + (size_t)l * 4 * 128 * 128; const float* sb = a.in[9] + l * 4 * 128;
        LAS float* stat = (LAS float*)lds;
        LAS bf16* vnT = (LAS bf16*)(lds + 1024);
        for (int unit = bid - 64; unit < 256; unit += G - 64) {
            const int b = unit >> 5, n = unit & 31; const size_t m0 = (size_t)b * SEQ + n * 128;
            { const int row = tid >> 2, part = tid & 3; const bf16* src = P + (m0 + row) * NP + 512 + part * 128;
              float s = 0.f, s2 = 0.f;
#pragma unroll 4
              for (int i = 0; i < 16; ++i) { const v4u x = *(const v4u*)(src + 8 * i);
                  const float g0 = gelu_tanh(bflo(x.x)), g1 = gelu_tanh(bfhi(x.x)), g2 = gelu_tanh(bflo(x.y)), g3 = gelu_tanh(bfhi(x.y)),
                              g4 = gelu_tanh(bflo(x.z)), g5 = gelu_tanh(bfhi(x.z)), g6 = gelu_tanh(bflo(x.w)), g7 = gelu_tanh(bfhi(x.w));
                  s += ((g0 + g1) + (g2 + g3)) + ((g4 + g5) + (g6 + g7));
                  s2 += ((g0 * g0 + g1 * g1) + (g2 * g2 + g3 * g3)) + ((g4 * g4 + g5 * g5) + (g6 * g6 + g7 * g7)); }
              s += __shfl_xor(s, 1); s += __shfl_xor(s, 2); s2 += __shfl_xor(s2, 1); s2 += __shfl_xor(s2, 2);
              const float mean = s * (1.f / 512.f), var = fmaxf(s2 * (1.f / 512.f) - mean * mean, 0.f);
              if (part == 0) { stat[2 * row] = mean; stat[2 * row + 1] = rsqrtf(var + 1e-5f); } }
            bar_lds();
            for (int h = 0; h < 4; ++h) {
                LAS bf16* vt = vnT + (h & 1) * (128 * 136);
                const float* Wm = sw + ((size_t)h * 128 + 16 * wave + r) * 128;
                f32x4 wq[4][2];
#pragma unroll
                for (int ks = 0; ks < 4; ++ks) { wq[ks][0] = *(const f32x4*)(Wm + 32 * ks + 8 * q); wq[ks][1] = *(const f32x4*)(Wm + 32 * ks + 8 * q + 4); }
                bf16 uq[4][8];
#pragma unroll
                for (int i = 0; i < 4; ++i)
#pragma unroll
                    for (int nt = 0; nt < 8; ++nt) uq[i][nt] = P[(m0 + 16 * wave + 4 * q + i) * NP + h * 128 + 16 * nt + r];
#pragma unroll
                for (int i = 0; i < 4; ++i) { const int task = tid + NT * i, s = task & 127, dg = task >> 7;
                    const v4u x = *(const v4u*)(P + (m0 + s) * NP + 512 + h * 128 + dg * 8);
                    const float mean = stat[2 * s], rstd = stat[2 * s + 1];
                    const f32x4 g0 = *(const f32x4*)(lng + h * 128 + dg * 8), g1 = *(const f32x4*)(lng + h * 128 + dg * 8 + 4);
                    const f32x4 b0 = *(const f32x4*)(lnb + h * 128 + dg * 8), b1 = *(const f32x4*)(lnb + h * 128 + dg * 8 + 4);
                    const float xv[8] = {bflo(x.x), bfhi(x.x), bflo(x.y), bfhi(x.y), bflo(x.z), bfhi(x.z), bflo(x.w), bfhi(x.w)};
#pragma unroll
                    for (int e = 0; e < 8; ++e) { const float gg = e < 4 ? g0[e & 3] : g1[e & 3], bb = e < 4 ? b0[e & 3] : b1[e & 3];
                        vt[(dg * 8 + e) * 136 + s] = f2bf((gelu_tanh(xv[e]) - mean) * rstd * gg + bb); } }
                bar_lds();
                f32x4 acc[8];
#pragma unroll
                for (int nt = 0; nt < 8; ++nt) acc[nt] = (f32x4){0.f, 0.f, 0.f, 0.f};
                const int tA = 16 * wave + r;
#pragma unroll
                for (int ks = 0; ks < 4; ++ks) { if (ks > (wave >> 1)) break;
                    const int s0 = 32 * ks + 8 * q;
                    f32x4 w0 = wq[ks][0], w1 = wq[ks][1];
#pragma unroll
                    for (int e = 0; e < 4; ++e) { if (s0 + e > tA) w0[e] = 0.f; if (s0 + 4 + e > tA) w1[e] = 0.f; }
                    const bf16x8 af = pack8(w0, w1);
#pragma unroll
                    for (int nt = 0; nt < 8; ++nt) acc[nt] = MFMA16(af, *(const LAS bf16x8*)(vt + (16 * nt + r) * 136 + s0), acc[nt]);
                }
#pragma unroll
                for (int i = 0; i < 4; ++i) { const int t = 16 * wave + 4 * q + i; const float bs = sb[h * 128 + t];
#pragma unroll
                    for (int nt = 0; nt < 8; ++nt) { const int d = 16 * nt + r;
                        const float uu = bf2f(uq[i][nt]);
                        MIX[(m0 + t) * D + h * 128 + d] = f2bf(gelu_tanh(uu) * (acc[nt][i] + bs)); } }
            }
            bar_lds();
        }
        if (l + 1 < DEPTH && bid >= 128) convert_weights(a, l + 1, lds + 73728, wave, lane, (bid - 128) * NWAVES + wave, (G - 128) * NWAVES);
    }
}

DI void phase_gnorm(const Args& a, int l, int tid, int lane, int wave, int bid, int G) {
    const bf16* P = (const bf16*)(a.ws + WS_P); bf16* MIX = (bf16*)a.out;
    const float* ngp = a.in[13] + l * 128 + (lane & 15) * 8;
    const f32x4 g0 = *(const f32x4*)ngp, g1 = *(const f32x4*)(ngp + 4);
    for (int m = bid * NWAVES + wave; m < M; m += G * NWAVES) {
        const v4u ob = *(const v4u*)(P + (size_t)m * NP + 1024 + lane * 8), zb = *(const v4u*)(P + (size_t)m * NP + 2560 + lane * 8);
        f32x4 o0 = {bflo(ob.x), bfhi(ob.x), bflo(ob.y), bfhi(ob.y)}, o1 = {bflo(ob.z), bfhi(ob.z), bflo(ob.w), bfhi(ob.w)};
        const f32x4 z0 = {bflo(zb.x), bfhi(zb.x), bflo(zb.y), bfhi(zb.y)}, z1 = {bflo(zb.z), bfhi(zb.z), bflo(zb.w), bfhi(zb.w)};
        float ss = ((o0[0] * o0[0] + o0[1] * o0[1]) + (o0[2] * o0[2] + o0[3] * o0[3])) + ((o1[0] * o1[0] + o1[1] * o1[1]) + (o1[2] * o1[2] + o1[3] * o1[3]));
        ss = row16_sum(ss);
        const float rstd = rsqrtf(ss * (1.f / 128.f) + 1e-6f);
        o0 = o0 * rstd * g0; o1 = o1 * rstd * g1;
        v4u w; w.x = pk2(o0[0] * silu_f(z0[0]), o0[1] * silu_f(z0[1])); w.y = pk2(o0[2] * silu_f(z0[2]), o0[3] * silu_f(z0[3]));
        w.z = pk2(o1[0] * silu_f(z1[0]), o1[1] * silu_f(z1[1])); w.w = pk2(o1[2] * silu_f(z1[2]), o1[3] * silu_f(z1[3]));
        *(v4u*)(MIX + (size_t)m * D + 512 + lane * 8) = w;
    }
}

#define XB_TMO      128
#define XB_XCNT(j)  (256  + 64 * (j))
#define XB_XSUB(j)  (1280 + 64 * (j))
#define XB_XGEN(j)  (2304 + 64 * (j))
#define XB_TOP      3328
#define XB_TOPGEN   3392
#define XCD_BAR_WORDS 3456
#define XB_SPIN_CAP (1u << 18)

__device__ __forceinline__ unsigned xb_ld(unsigned* p)              { return __hip_atomic_load(p, __ATOMIC_RELAXED, __HIP_MEMORY_SCOPE_AGENT); }
__device__ __forceinline__ unsigned xb_add(unsigned* p, unsigned v) { return __hip_atomic_fetch_add(p, v, __ATOMIC_RELAXED, __HIP_MEMORY_SCOPE_AGENT); }
__device__ __forceinline__ unsigned xb_xcc_id() { return (unsigned)__builtin_amdgcn_s_getreg((3 << 11) | 20) & 0xFu; }
#define XB_SPIN(cond, bar) do { unsigned _sp = 0; while (cond) { __builtin_amdgcn_s_sleep(1); \
    if ((++_sp & 255u) == 0u) { if (xb_ld(&(bar)[XB_TMO])) break; if (_sp > XB_SPIN_CAP) { atomicAdd(&(bar)[XB_TMO], 1u); break; } } } } while (0)

struct XcdBarrier {
    unsigned* bar; unsigned x;
    volatile LAS unsigned* st;
};

__device__ __forceinline__ XcdBarrier xcd_barrier_post(unsigned* bar, volatile LAS unsigned* st) {
    XcdBarrier b; b.bar = bar; b.x = xb_xcc_id(); b.st = st;
    if (threadIdx.x == 0) (void)xb_add(&bar[XB_XCNT(b.x)], 1u);
    return b;
}
__device__ __forceinline__ void xcd_barrier_complete(unsigned* bar, unsigned x, unsigned& nloc, unsigned& nx) {
    const unsigned G = gridDim.x * gridDim.y * gridDim.z;
    unsigned sum, cnt, mine, sp = 0u;
    for (;;) {
        sum = 0u; cnt = 0u; mine = 0u;
#pragma unroll
        for (unsigned j = 0; j < 16; ++j) { const unsigned c = xb_ld(&bar[XB_XCNT(j)]); sum += c; cnt += (c > 0u) ? 1u : 0u; mine = (j == x) ? c : mine; }
        if (sum == G) break;
        __builtin_amdgcn_s_sleep(1);
        if ((++sp & 255u) == 0u) { if (xb_ld(&bar[XB_TMO])) break; if (sp > XB_SPIN_CAP) { atomicAdd(&bar[XB_TMO], 1u); break; } }
    }
    nloc = mine > 0u ? mine : 1u; nx = cnt > 0u ? cnt : 1u;
}

__device__ __forceinline__ void xcd_barrier(const XcdBarrier& b) {
    asm volatile("s_waitcnt vmcnt(0)" ::: "memory");
    __syncthreads();
    if (threadIdx.x == 0) {
        unsigned* bar = b.bar;
        __builtin_amdgcn_s_waitcnt(0);
        unsigned nloc = b.st[0], nx = b.st[1];
        if (nloc == 0u) { xcd_barrier_complete(bar, b.x, nloc, nx); b.st[0] = nloc; b.st[1] = nx; }
        const unsigned old = xb_add(&bar[XB_XSUB(b.x)], 1u);
        const unsigned gen = old / nloc;
        if (old + 1u == (gen + 1u) * nloc) {
            __builtin_amdgcn_fence(__ATOMIC_RELEASE, "agent");
            asm volatile("s_waitcnt vmcnt(0)" ::: "memory");
            const unsigned og = xb_add(&bar[XB_TOP], 1u);
            const unsigned tg = og / nx;
            if (og + 1u == (tg + 1u) * nx) xb_add(&bar[XB_TOPGEN], 1u);
            else XB_SPIN(xb_ld(&bar[XB_TOPGEN]) == tg, bar);
            __builtin_amdgcn_fence(__ATOMIC_ACQUIRE, "agent");
            xb_add(&bar[XB_XGEN(b.x)], 1u);
            asm volatile("s_waitcnt vmcnt(0)" ::: "memory");
        } else {
            XB_SPIN(xb_ld(&bar[XB_XGEN(b.x)]) == gen, bar);
            __builtin_amdgcn_fence(__ATOMIC_ACQUIRE, "agent");
            asm volatile("s_waitcnt vmcnt(0)" ::: "memory");
        }
    }
    __syncthreads();
}

__global__ void __launch_bounds__(NT, 2) mk_fwd(Args a_in) {
    extern __shared__ __attribute__((aligned(16))) unsigned char lds_raw[];
    LAS unsigned char* lds = (LAS unsigned char*)lds_raw;
    cg::grid_group grid = cg::this_grid();
    volatile LAS unsigned* bst = (volatile LAS unsigned*)(lds + LDS_BYTES - 64);
    if (threadIdx.x < 2) bst[threadIdx.x] = 0u;
    __syncthreads();
    XcdBarrier xbar = xcd_barrier_post((unsigned*)(a_in.ws + WS_CTL), bst);
    int rep = 0;
    for (int ph = a_in.ph_lo; ph < a_in.ph_hi; ) {
        int tid = threadIdx.x; asm volatile("" : "+v"(tid));
        const int lane = tid & 63, wave = __builtin_amdgcn_readfirstlane(tid >> 6);
        int bid = blockIdx.x, G = gridDim.x; asm volatile("" : "+s"(bid)); asm volatile("" : "+s"(G));
        Args a = a_in; asm volatile("" : "+s"(a.ws)); asm volatile("" : "+s"(a.out));
        unsigned char* ws = a.ws;
        const float* mod = (const float*)(ws + WS_MOD);
        if (ph == 0) { if (PH_EN(8)) { phase_mod(a, lds, tid, lane, wave, bid, G); convert_weights(a, 0, lds + 49152, wave, lane, bid * NWAVES + wave, G * NWAVES); } }
        else if (ph == NPHASE - 1) { if (PH_EN(9)) phase_norm<2>(a, 0, lds, tid, lane, wave, bid, G); }
        else {
            const int l = (ph - 1) / 9, s0 = (ph - 1) % 9, s = s0 <= 3 ? s0 : s0 - 1;
            if (s0 == 4) { if (PH_EN(10)) phase_gnorm(a, l, tid, lane, wave, bid, G); }
            else if (s == 0) { if (PH_EN(0)) phase_norm<0>(a, l, lds, tid, lane, wave, bid, G); }
            else if (s == 1) { if (PH_EN(1)) {
                pg8::Gemm g{(const bf16*)(ws + WS_H), (const bf16*)(ws + ws_wset(l)), M, NP, D}; pg8::StaticOrder S; S.init(M, NP, G, bid);
                pg8::EpiBf16<0> E{(bf16*)(ws + WS_P), NP, nullptr, 0, 0, 1.f};
                pg8::gemm_phase<pg8::EpiBf16<0>, pg8::StaticOrder, true, true>(lds, g, S, E, tid);
            } }
            else if (s == 2) { if (PH_EN(2)) phase_prep(a, l, lds, tid, lane, wave, bid, G); }
            else if (s == 3) { if (PH_EN(3) && rep < (bid < 64 ? REP_SCAN : REP_SGU)) phase_mix(a, l, lds, tid, lane, wave, bid, G); }
            else if (s == 4) { if (PH_EN(4)) {
                pg8::Gemm g{(const bf16*)a.out, (const bf16*)(ws + ws_wset(l) + W_OFF_OUT), M, D, D}; pg8::StaticOrder S; S.init(M, D, G, bid);
                if (l == 0) { pg8::EpiGateRes<true> E{(const void*)a.in[0], (bf16*)(ws + WS_X), D, mod + 2048};
                    pg8::gemm_phase<pg8::EpiGateRes<true>, pg8::StaticOrder, true, true>(lds, g, S, E, tid); }
                else { pg8::EpiGateRes<false> E{(const void*)(ws + WS_X), (bf16*)(ws + WS_X), D, mod + (size_t)l * 8 * NMOD + 2048};
                    pg8::gemm_phase<pg8::EpiGateRes<false>, pg8::StaticOrder, true, true>(lds, g, S, E, tid); }
            } }
            else if (s == 5) { if (PH_EN(5)) phase_norm<1>(a, l, lds, tid, lane, wave, bid, G); }
            else if (s == 6) { if (PH_EN(6)) {
                pg8::Gemm g{(const bf16*)(ws + WS_H), (const bf16*)(ws + ws_wset(l) + W_OFF_1), M, FF, D}; pg8::StaticOrder S; S.init(M, FF, G, bid);
                pg8::EpiBf16<2> E{(bf16*)(ws + WS_F), FF, nullptr, 0, 0, 1.f};
                pg8::gemm_phase<pg8::EpiBf16<2>, pg8::StaticOrder, true, true>(lds, g, S, E, tid);
            } }
            else { if (PH_EN(7)) {
                pg8::Gemm g{(const bf16*)(ws + WS_F), (const bf16*)(ws + ws_wset(l) + W_OFF_2), M, D, FF}; pg8::StaticOrder S; S.init(M, D, G, bid);
                pg8::EpiGateRes<false> E{(const void*)(ws + WS_X), (bf16*)(ws + WS_X), D, mod + (size_t)l * 8 * NMOD + 5120};
                pg8::gemm_phase<pg8::EpiGateRes<false>, pg8::StaticOrder, true, true>(lds, g, S, E, tid);
            } }
        }
        { const int s9 = (ph - 1) % 9; const int sx = (ph == 0) ? 8 : (ph == NPHASE - 1) ? 9 : s9 == 4 ? 10 : s9 < 4 ? s9 : s9 - 1;
          const int reps = sx == 8 ? REP_MOD : sx == 0 ? REP_N0 : sx == 1 ? REP_G1 : sx == 2 ? REP_PREP : sx == 3 ? (REP_SCAN > REP_SGU ? REP_SCAN : REP_SGU) : sx == 5 ? REP_N1 : sx == 6 ? REP_FF1 : 1;
          const bool again = rep + 1 < reps;
          if (again || ph + 1 < a_in.ph_hi) { if (a_in.ph_lo < 0) grid.sync();   xcd_barrier(xbar); for (int i = 0; i < REP_SYNC; ++i) xcd_barrier(xbar); }
          if (again) ++rep; else { rep = 0; ++ph; } }
    }
}

extern "C" void kernel_launch(void* const* d_in, const int* in_sizes, int n_in, void* d_out, int out_size, void* d_ws, size_t ws_size, hipStream_t stream) {
    static int grid = 0;
    if (grid == 0) {
        if (n_in != 19 || in_sizes[0] != M * D || out_size != M * D || ws_size < WS_END) {
            fprintf(stderr, "kernel_launch: unexpected problem: n_in %d in0 %d out %d ws %zu (need %zu)\n", n_in, n_in > 0 ? in_sizes[0] : -1, out_size, ws_size, (size_t)WS_END); grid = -1; return; }
        int dev = 0, cus = 0, per_cu = 0;
        if (hipGetDevice(&dev) != hipSuccess || hipDeviceGetAttribute(&cus, hipDeviceAttributeMultiprocessorCount, dev) != hipSuccess) { fprintf(stderr, "kernel_launch: device query failed\n"); grid = -1; return; }
        if (hipFuncSetAttribute((const void*)mk_fwd, hipFuncAttributeMaxDynamicSharedMemorySize, LDS_BYTES) != hipSuccess) { fprintf(stderr, "kernel_launch: hipFuncSetAttribute failed\n"); grid = -1; return; }
        if (hipOccupancyMaxActiveBlocksPerMultiprocessor(&per_cu, (const void*)mk_fwd, NT, LDS_BYTES) != hipSuccess || per_cu < 1) { fprintf(stderr, "kernel_launch: occupancy query gives %d\n", per_cu); per_cu = 1; }
        (void)hipGetLastError();
        grid = cus * per_cu;
        if (grid > 256) grid = 256;
        if (grid < 64) { fprintf(stderr, "kernel_launch: grid %d too small\n", grid); grid = -1; return; }
    }
    if (grid < 0) return;
    if (hipMemsetAsync((char*)d_ws + WS_CTL, 0, 16384, stream) != hipSuccess) { fprintf(stderr, "kernel_launch: memset of the barrier words failed\n"); return; }
    Args a{};
    for (int i = 0; i < 19; ++i) a.in[i] = (const float*)d_in[i];
    a.out = (float*)d_out; a.ws = (unsigned char*)d_ws;
#if MK_LAUNCHES == 1
    a.ph_lo = 0; a.ph_hi = NPHASE;
    { void* args[] = {&a};
      hipError_t e = hipLaunchCooperativeKernel((const void*)mk_fwd, dim3(grid), dim3(NT), args, LDS_BYTES, stream);
      if (e != hipSuccess) fprintf(stderr, "kernel_launch: cooperative launch failed: %s (grid %d)\n", hipGetErrorString(e), grid); }
#else
    for (int ph = 0; ph < NPHASE; ++ph) {
        a.ph_lo = ph; a.ph_hi = ph + 1;
        void* args[] = {&a};
        hipError_t e = hipLaunchCooperativeKernel((const void*)mk_fwd, dim3(grid), dim3(NT), args, LDS_BYTES, stream);
        if (e != hipSuccess) { fprintf(stderr, "kernel_launch: launch of phase %d failed: %s (grid %d)\n", ph, hipGetErrorString(e), grid); break; }
    }
#endif
}
```
